# Optimizing an MI355X kernel written in HIP

```python
import math
import jax, jax.numpy as jnp
from jax import lax
import numpy as np

D_MODEL = 1024
BATCH = 2
SEQ = 8192
DEPTH = 4

CHUNK = 64
Q_BLOCK = 128
MIX_WIDTH = D_MODEL
SSM_WIDTH = MIX_WIDTH // 2
SSM_GROUP_CH = 16
SSM_GROUPS = SSM_WIDTH // SSM_GROUP_CH
SSM_STATE = 64
ATTN_WIDTH = MIX_WIDTH - SSM_WIDTH
DIFF_HEADS = 4
DIFF_V_DIM = ATTN_WIDTH // DIFF_HEADS
DIFF_QK_DIM = DIFF_V_DIM // 2
QK_WIDTH = DIFF_HEADS * 2 * DIFF_QK_DIM
ROT_DIM = DIFF_QK_DIM // 4
ROT_HALF = ROT_DIM // 2
ROPE_THETA = 500000.0
IN_WIDTH = SSM_WIDTH + 2 * QK_WIDTH + ATTN_WIDTH
FFN_DIM = 2816
CONV_WIDTH = 3
EPS = 1e-6

kernel_name = "hybrid_s5_diffattn_convffn_trunk"


def _rmsnorm(x, g):
    xf = x.astype(jnp.float32)
    y = xf * lax.rsqrt(jnp.mean(xf * xf, axis=-1, keepdims=True) + EPS)
    return y.astype(x.dtype) * g


def _rotary(t, cos, sin):
    cos = cos.astype(t.dtype)
    sin = sin.astype(t.dtype)
    t1 = t[..., :ROT_HALF]
    t2 = t[..., ROT_HALF:ROT_DIM]
    return jnp.concatenate([t1 * cos - t2 * sin, t2 * cos + t1 * sin, t[..., ROT_DIM:]], axis=-1)


def _complex_affine_combine(e1, e2):
    a1r, a1i, b1r, b1i = e1
    a2r, a2i, b2r, b2i = e2
    ar = a2r * a1r - a2i * a1i
    ai = a2r * a1i + a2i * a1r
    br = a2r * b1r - a2i * b1i + b2r
    bi = a2r * b1i + a2i * b1r + b2i
    return (ar, ai, br, bi)


def _s5_group(u, lam_re, lam_im, log_step, b_re, b_im, c_re, c_im, d, w_glu, g_norm):
    bsz, seqlen, _ = u.shape
    f32 = jnp.float32
    uf = u.astype(f32).reshape(bsz, seqlen, SSM_GROUPS, SSM_GROUP_CH)
    lr = lam_re.astype(f32)
    li = lam_im.astype(f32)
    step = jnp.exp(log_step.astype(f32))[:, None]
    mag = jnp.exp(step * lr)
    ar = mag * jnp.cos(step * li)
    ai = mag * jnp.sin(step * li)
    den = lr * lr + li * li
    fr = ((ar - 1.0) * lr + ai * li) / den
    fi = (ai * lr - (ar - 1.0) * li) / den
    bur = jnp.einsum('blgc,gpc->blgp', uf, b_re.astype(f32))
    bui = jnp.einsum('blgc,gpc->blgp', uf, b_im.astype(f32))
    xr0 = fr * bur - fi * bui
    xi0 = fr * bui + fi * bur
    a_r = jnp.broadcast_to(ar, xr0.shape)
    a_i = jnp.broadcast_to(ai, xr0.shape)
    _, _, sr, si = lax.associative_scan(_complex_affine_combine, (a_r, a_i, xr0, xi0), axis=1)
    y = (jnp.einsum('blgp,gcp->blgc', sr, c_re.astype(f32))
         - jnp.einsum('blgp,gcp->blgc', si, c_im.astype(f32))
         + d.astype(f32) * uf)
    y = jax.nn.gelu(y.reshape(bsz, seqlen, SSM_WIDTH)).astype(u.dtype)
    ab = y @ w_glu
    out = ab[..., :SSM_WIDTH] * jax.nn.sigmoid(ab[..., SSM_WIDTH:])
    return _rmsnorm(out, g_norm)


def _diff_attention_group(q, k, v, cos, sin, lam, lam_init, g_subln):
    bsz, seqlen, _ = q.shape
    f32 = jnp.float32
    q = _rotary(q.reshape(bsz, seqlen, DIFF_HEADS, 2, DIFF_QK_DIM), cos, sin)
    k = _rotary(k.reshape(bsz, seqlen, DIFF_HEADS, 2, DIFF_QK_DIM), cos, sin)
    q = q.transpose(0, 2, 3, 1, 4).astype(f32)
    k = k.transpose(0, 2, 3, 1, 4).astype(f32)
    vf = v.reshape(bsz, seqlen, DIFF_HEADS, DIFF_V_DIM).transpose(0, 2, 1, 3).astype(f32)
    n_blocks = seqlen // Q_BLOCK
    q_blocks = jnp.moveaxis(q.reshape(bsz, DIFF_HEADS, 2, n_blocks, Q_BLOCK, DIFF_QK_DIM), 3, 0)
    key_chunk = jnp.arange(seqlen) // CHUNK
    scale = 1.0 / math.sqrt(DIFF_QK_DIM)

    def block(args):
        qb, bi = args
        s = jnp.einsum('bhcqd,bhckd->bhcqk', qb, k) * scale
        q_chunk = (bi * Q_BLOCK + jnp.arange(Q_BLOCK)) // CHUNK
        mask = key_chunk[None, :] <= q_chunk[:, None]
        s = jnp.where(mask, s, -jnp.inf)
        p = jax.nn.softmax(s, axis=-1)
        w = p[:, :, 0] - lam * p[:, :, 1]
        return jnp.einsum('bhqk,bhkd->bhqd', w, vf)

    out = lax.map(block, (q_blocks, jnp.arange(n_blocks)))
    out = out.transpose(1, 0, 3, 2, 4).reshape(bsz, seqlen, DIFF_HEADS, DIFF_V_DIM).astype(v.dtype)
    out = _rmsnorm(out, g_subln) * (1.0 - lam_init)
    return out.reshape(bsz, seqlen, ATTN_WIDTH)


def _conv_gated_ffn(h, w_up, w_conv, b_conv, w_down):
    seqlen = h.shape[1]
    up = h @ w_up
    padded = jnp.pad(up, ((0, 0), (CONV_WIDTH - 1, 0), (0, 0)))
    conv = b_conv + sum(w_conv[j] * padded[:, j:j + seqlen] for j in range(CONV_WIDTH))
    gate = conv[..., :FFN_DIM]
    val = conv[..., FFN_DIM:]
    return (jax.nn.silu(gate) * val) @ w_down


def setup_inputs(seed: int = 0) -> dict:
    key = jax.random.key(seed)
    ks = jax.random.split(key, 26)
    f32 = jnp.float32
    nrm = lambda k, shape, s: jax.random.normal(k, shape, f32) * s
    x = jax.random.normal(ks[0], (BATCH, SEQ, D_MODEL), f32)
    offset = jax.random.randint(ks[1], (BATCH, 1), 0, 4096, dtype=jnp.int32)
    positions = offset + jnp.arange(SEQ, dtype=jnp.int32)[None, :]
    n_idx = jnp.arange(SSM_STATE, dtype=f32)
    ssm_lambda_re = -0.5 + nrm(ks[2], (DEPTH, SSM_GROUPS, SSM_STATE), 0.01)
    ssm_lambda_im = math.pi * n_idx + nrm(ks[3], (DEPTH, SSM_GROUPS, SSM_STATE), 0.01)
    ssm_log_step = jax.random.uniform(ks[4], (DEPTH, SSM_GROUPS), f32, math.log(1e-3), math.log(1e-1))
    return {
        "x": x,
        "positions": positions,
        "norm_mix": 1.0 + nrm(ks[5], (DEPTH, D_MODEL), 0.02),
        "w_in": nrm(ks[6], (DEPTH, D_MODEL, IN_WIDTH), D_MODEL ** -0.5),
        "ssm_lambda_re": ssm_lambda_re,
        "ssm_lambda_im": ssm_lambda_im,
        "ssm_log_step": ssm_log_step,
        "ssm_b_re": nrm(ks[7], (DEPTH, SSM_GROUPS, SSM_STATE, SSM_GROUP_CH), (2 * SSM_GROUP_CH) ** -0.5),
        "ssm_b_im": nrm(ks[8], (DEPTH, SSM_GROUPS, SSM_STATE, SSM_GROUP_CH), (2 * SSM_GROUP_CH) ** -0.5),
        "ssm_c_re": nrm(ks[9], (DEPTH, SSM_GROUPS, SSM_GROUP_CH, SSM_STATE), (2 * SSM_STATE) ** -0.5),
        "ssm_c_im": nrm(ks[10], (DEPTH, SSM_GROUPS, SSM_GROUP_CH, SSM_STATE), (2 * SSM_STATE) ** -0.5),
        "ssm_d": nrm(ks[11], (DEPTH, SSM_GROUPS, SSM_GROUP_CH), 1.0),
        "ssm_w_glu": nrm(ks[12], (DEPTH, SSM_WIDTH, 2 * SSM_WIDTH), SSM_WIDTH ** -0.5),
        "ssm_norm": 1.0 + nrm(ks[13], (DEPTH, SSM_WIDTH), 0.02),
        "lambda_q1": nrm(ks[14], (DEPTH, DIFF_QK_DIM), 0.1),
        "lambda_k1": nrm(ks[15], (DEPTH, DIFF_QK_DIM), 0.1),
        "lambda_q2": nrm(ks[16], (DEPTH, DIFF_QK_DIM), 0.1),
        "lambda_k2": nrm(ks[17], (DEPTH, DIFF_QK_DIM), 0.1),
        "attn_subln": 1.0 + nrm(ks[18], (DEPTH, DIFF_V_DIM), 0.02),
        "w_out": nrm(ks[19], (DEPTH, MIX_WIDTH, D_MODEL), MIX_WIDTH ** -0.5),
        "norm_ffn": 1.0 + nrm(ks[20], (DEPTH, D_MODEL), 0.02),
        "w_up": nrm(ks[21], (DEPTH, D_MODEL, 2 * FFN_DIM), D_MODEL ** -0.5),
        "w_conv": nrm(ks[22], (DEPTH, CONV_WIDTH, 2 * FFN_DIM), CONV_WIDTH ** -0.5),
        "b_conv": nrm(ks[23], (DEPTH, 2 * FFN_DIM), 0.02),
        "w_down": nrm(ks[24], (DEPTH, FFN_DIM, D_MODEL), FFN_DIM ** -0.5),
        "norm_final": 1.0 + nrm(ks[25], (D_MODEL,), 0.02),
    }


def reference(x, positions, norm_mix, w_in, ssm_lambda_re, ssm_lambda_im, ssm_log_step,
              ssm_b_re, ssm_b_im, ssm_c_re, ssm_c_im, ssm_d, ssm_w_glu, ssm_norm,
              lambda_q1, lambda_k1, lambda_q2, lambda_k2, attn_subln, w_out,
              norm_ffn, w_up, w_conv, b_conv, w_down, norm_final):
    f32 = jnp.float32
    inv_freq = ROPE_THETA ** (-(jnp.arange(0, ROT_DIM, 2, dtype=f32) / ROT_DIM))
    ang = positions.astype(f32)[..., None] * inv_freq
    cos = jnp.cos(ang)[:, :, None, None, :]
    sin = jnp.sin(ang)[:, :, None, None, :]
    for i in range(DEPTH):
        lam_init = 0.8 - 0.6 * math.exp(-0.3 * i)
        lam = (jnp.exp(jnp.sum(lambda_q1[i].astype(f32) * lambda_k1[i].astype(f32)))
               - jnp.exp(jnp.sum(lambda_q2[i].astype(f32) * lambda_k2[i].astype(f32)))
               + lam_init)
        h = _rmsnorm(x, norm_mix[i])
        proj = h @ w_in[i]
        u = proj[..., :SSM_WIDTH]
        q = proj[..., SSM_WIDTH:SSM_WIDTH + QK_WIDTH]
        k = proj[..., SSM_WIDTH + QK_WIDTH:SSM_WIDTH + 2 * QK_WIDTH]
        v = proj[..., SSM_WIDTH + 2 * QK_WIDTH:]
        y_ssm = _s5_group(u, ssm_lambda_re[i], ssm_lambda_im[i], ssm_log_step[i],
                          ssm_b_re[i], ssm_b_im[i], ssm_c_re[i], ssm_c_im[i], ssm_d[i],
                          ssm_w_glu[i], ssm_norm[i])
        y_att = _diff_attention_group(q, k, v, cos, sin, lam, lam_init, attn_subln[i])
        x = x + jnp.concatenate([y_ssm, y_att], axis=-1) @ w_out[i]
        h = _rmsnorm(x, norm_ffn[i])
        x = x + _conv_gated_ffn(h, w_up[i], w_conv[i], b_conv[i], w_down[i])
    return _rmsnorm(x, norm_final)
```

```cpp
#include <hip/hip_runtime.h>
#include <hip/hip_cooperative_groups.h>
#include <cstdio>
namespace cg = cooperative_groups;

#ifndef COOP
#define COOP 1
#endif

typedef unsigned short bf16_t;
typedef __attribute__((ext_vector_type(8))) short bf16x8;
typedef __attribute__((ext_vector_type(16))) float f32x16;
typedef __attribute__((ext_vector_type(2))) __bf16 bf2_t;
typedef __attribute__((ext_vector_type(2))) float f2_t;
typedef __attribute__((ext_vector_type(4))) unsigned u32x4;
typedef __attribute__((ext_vector_type(2))) unsigned u32x2;

#define DI __device__ __forceinline__
#define MFMA(a, b, c) __builtin_amdgcn_mfma_f32_32x32x16_bf16((a), (b), (c), 0, 0, 0)

constexpr int NTOK = 16384, DM = 1024, SEQL = 8192, FFN = 2816;
constexpr int LDS_BYTES = 135168;
constexpr float EPS = 1e-6f;

struct Params {
  const float* x; const int* pos;
  const float *norm_mix, *w_in, *lam_re, *lam_im, *log_step, *b_re, *b_im, *c_re, *c_im, *ssm_d, *w_glu, *ssm_norm;
  const float *lq1, *lk1, *lq2, *lk2, *subln, *w_out, *norm_ffn, *w_up, *w_conv, *b_conv, *w_down, *norm_final;
  float* out;
  bf16_t *WinT, *WgluT, *WoutT, *WupT, *WdownT;
  float* xf; bf16_t* xb;
  float* u; bf16_t *q, *k, *vt, *gy, *outg, *att, *act;
  float *ss, *ssm_ss, *cs, *s5tab, *sloc;
  long long phase_lo, phase_hi;
};

typedef const __attribute__((address_space(4))) Params* KP;

DI unsigned pack_bf2(float a, float b) { f2_t v = {a, b}; return __builtin_bit_cast(unsigned, __builtin_convertvector(v, bf2_t)); }
DI bf16_t f2bf(float a) { return (bf16_t)(pack_bf2(a, 0.f) & 0xffffu); }
DI float bf2f(bf16_t v) { return __uint_as_float(((unsigned)v) << 16); }
DI int opaque_tid() { int t = threadIdx.x; asm volatile("" : "+v"(t)); return t; }
DI float4 ss_sum4(const float* base, int row0) {
  float4 a = *(const float4*)(base + row0);
#pragma unroll
  for (int pz = 1; pz < 8; pz++) {
    float4 b = *(const float4*)(base + (size_t)pz * NTOK + row0);
    a.x += b.x; a.y += b.y; a.z += b.z; a.w += b.w;
  }
  return a;
}
DI float ss_sum1(const float* base, int row) {
  float a = base[row];
#pragma unroll
  for (int pz = 1; pz < 8; pz++) a += base[(size_t)pz * NTOK + row];
  return a;
}
DI float wave_sum(float v) { for (int o = 32; o; o >>= 1) v += __shfl_xor(v, o); return v; }
DI float fast_exp2(float x) { return __builtin_amdgcn_exp2f(x); }
DI float gelu_tanh(float x) {
  float z = 0.7978845608028654f * (x + 0.044715f * x * x * x);
  float e = __expf(2.f * z);
  float t = 1.f - 2.f / (1.f + e);
  return 0.5f * x * (1.f + t);
}
DI float reduce_2pi(double a) {
  double n = rint(a * 0.15915494309189535);
  return (float)(a - n * 6.283185307179586);
}

DI void transpose_tile(const float* src, int ldsrc, int k0, int c0, const float* scale, int nscale,
                       bf16_t* dst, int lddst, int n0, float* lds, const int tid) {
#pragma unroll
  for (int i = 0; i < 16; i++) {
    int kk = i * 4 + (tid >> 6), nn = tid & 63;
    float v = src[(size_t)(k0 + kk) * ldsrc + c0 + nn];
    if (scale != nullptr && (k0 + kk) < nscale) v *= scale[k0 + kk];
    lds[kk * 65 + nn] = v;
  }
  __syncthreads();
  {
    int nn = tid >> 2, kq = (tid & 3) * 16;
    unsigned pk[8];
#pragma unroll
    for (int i = 0; i < 8; i++) pk[i] = pack_bf2(lds[(kq + 2 * i) * 65 + nn], lds[(kq + 2 * i + 1) * 65 + nn]);
    u32x4* d = (u32x4*)(dst + (size_t)(n0 + nn) * lddst + k0 + kq);
    u32x4 a = {pk[0], pk[1], pk[2], pk[3]}, b = {pk[4], pk[5], pk[6], pk[7]};
    d[0] = a; d[1] = b;
  }
  __syncthreads();
}

__device__ __forceinline__ void phase_prep(KP p, char* smem, const int tid) {
  const int nb = gridDim.x, bid = blockIdx.x;
  const int wave = tid >> 6, lane = tid & 63;
  for (int row = bid * 4 + wave; row < NTOK; row += nb * 4) {
    const float4* src = (const float4*)(p->x + (size_t)row * DM);
    float s = 0.f;
#pragma unroll
    for (int i = 0; i < 4; i++) {
      float4 v = src[lane + 64 * i];
      s += v.x * v.x + v.y * v.y + v.z * v.z + v.w * v.w;
      ((float4*)(p->xf + (size_t)row * DM))[lane + 64 * i] = v;
      u32x2 pk = {pack_bf2(v.x, v.y), pack_bf2(v.z, v.w)};
      ((u32x2*)(p->xb + (size_t)row * DM))[lane + 64 * i] = pk;
    }
    s = wave_sum(s);
    if (lane < 8) p->ss[(size_t)lane * NTOK + row] = (lane == 0) ? s : 0.f;
  }
  for (int i = bid * 256 + tid; i < NTOK * 8; i += nb * 256) {
    int tok = i >> 3, j = i & 7;
    double inv = (j & 4) ? ((j & 2) ? ((j & 1) ? 1.031338537721246e-05 : 5.318295896944988e-05) : ((j & 1) ? 0.0002742481756762073 : 0.001414213562373095))
                         : ((j & 2) ? ((j & 1) ? 0.007292664737217109 : 0.03760603093086393) : ((j & 1) ? 0.19392274474868576 : 1.0));
    double ang = (double)p->pos[tok] * inv;
    float r = reduce_2pi(ang);
    p->cs[2 * i] = cosf(r); p->cs[2 * i + 1] = sinf(r);
  }
  for (int i = bid * 256 + tid; i < 4 * 32 * 64; i += nb * 256) {
    int lg = i >> 6;
    float lr = p->lam_re[i], li = p->lam_im[i];
    float step = expf(p->log_step[lg]);
    float mag = expf(step * lr);
    double angd = (double)step * (double)li;
    float r1 = reduce_2pi(angd);
    float ar = mag * cosf(r1), ai = mag * sinf(r1);
    float den = lr * lr + li * li;
    float fr = ((ar - 1.f) * lr + ai * li) / den;
    float fi = (ai * lr - (ar - 1.f) * li) / den;
    float magT = expf(64.f * step * lr);
    float rT = reduce_2pi(64.0 * angd);
    float* tb = p->s5tab + (size_t)i * 40;
    tb[0] = ar; tb[1] = ai; tb[2] = magT * cosf(rT); tb[3] = magT * sinf(rT);
    for (int c = 0; c < 16; c++) {
      float br = p->b_re[(size_t)i * 16 + c], bi = p->b_im[(size_t)i * 16 + c];
      tb[4 + c] = fr * br - fi * bi;
      tb[20 + c] = fr * bi + fi * br;
    }
  }
  float* lds = (float*)smem;
  for (int job = bid; job < 4 * 3008; job += nb) {
    int layer = job / 3008, t = job % 3008;
    if (t < 512) {
      int a = t >> 4, kt = t & 15;
      transpose_tile(p->w_in + (size_t)layer * 1024 * 2048, 2048, kt * 64, a * 64, p->norm_mix + layer * 1024, 1024,
                     p->WinT + (size_t)layer * 2048 * 1024, 1024, a * 64, lds, tid);
    } else if (t < 640) {
      t -= 512; int a = t >> 3, kt = t & 7;
      transpose_tile(p->w_glu + (size_t)layer * 512 * 1024, 1024, kt * 64, (a & 1) * 512 + (a >> 1) * 64, nullptr, 0,
                     p->WgluT + (size_t)layer * 1024 * 512, 512, a * 64, lds, tid);
    } else if (t < 896) {
      t -= 640; int a = t >> 4, kt = t & 15;
      transpose_tile(p->w_out + (size_t)layer * 1024 * 1024, 1024, kt * 64, a * 64, p->ssm_norm + layer * 512, 512,
                     p->WoutT + (size_t)layer * 1024 * 1024, 1024, a * 64, lds, tid);
    } else if (t < 2304) {
      t -= 896; int a = t >> 4, kt = t & 15;
      transpose_tile(p->w_up + (size_t)layer * 1024 * 5632, 5632, kt * 64, (a & 1) * FFN + (a >> 1) * 64, p->norm_ffn + layer * 1024, 1024,
                     p->WupT + (size_t)layer * 5632 * 1024, 1024, a * 64, lds, tid);
    } else {
      t -= 2304; int a = t / 44, kt = t % 44;
      transpose_tile(p->w_down + (size_t)layer * FFN * 1024, 1024, kt * 64, a * 64, nullptr, 0,
                     p->WdownT + (size_t)layer * 1024 * FFN, FFN, a * 64, lds, tid);
    }
  }
}

enum { G_IN = 0, G_GLU = 1, G_WOUT = 2, G_UP = 3, G_DOWN = 4 };
#define ACC_PIN(tag) _Pragma("unroll") for (int i_ = 0; i_ < 4; i_++) _Pragma("unroll") for (int j_ = 0; j_ < 4; j_++) asm volatile("; pin " tag : "+a"(acc[i_][j_]));


__device__ __forceinline__ void gemm_tile(KP p, const int MODE, int layer, int tile, char* smem, const int tid) {
  const int lane = tid & 63, w = tid >> 6, wm = w >> 1, wn = w & 1, g = lane >> 5, l32 = lane & 31;
  int tn, KT, ldb, rowbase, lda;
  const bf16_t* Bt;
  const bf16_t* A0;
  int upb = 0, upti = 0;
  if (MODE == G_IN) { tn = tile & 7; rowbase = (tile >> 3) * 256; KT = 16; ldb = 1024; Bt = p->WinT + (size_t)layer * 2048 * 1024; A0 = p->xb; lda = 1024; }
  else if (MODE == G_GLU) { tn = tile & 3; rowbase = (tile >> 2) * 256; KT = 8; ldb = 512; Bt = p->WgluT + (size_t)layer * 1024 * 512; A0 = p->gy; lda = 512; }
  else if (MODE == G_WOUT) { tn = tile & 3; rowbase = (tile >> 2) * 256; KT = 16; ldb = 1024; Bt = p->WoutT + (size_t)layer * 1024 * 1024; A0 = p->outg; lda = 512; }
  else if (MODE == G_UP) { tn = tile % 22; int tr = tile / 22; upb = tr / 33; upti = tr % 33; rowbase = upb * SEQL + 254 * upti - 2; KT = 16; ldb = 1024; Bt = p->WupT + (size_t)layer * 5632 * 1024; A0 = p->xb; lda = 1024; }
  else { tn = tile & 3; rowbase = (tile >> 2) * 256; KT = 44; ldb = FFN; Bt = p->WdownT + (size_t)layer * 1024 * FFN; A0 = p->act; lda = FFN; }

  u32x4 ra[8], rb[8];
  const int lrow = tid >> 3, lc = tid & 7;
  float arow_sc[8];
#pragma unroll
  for (int i = 0; i < 8; i++) arow_sc[i] = 1.f;
  if (MODE == G_WOUT) {
    const float* ssq = p->ssm_ss + (size_t)layer * 8 * NTOK;
#pragma unroll
    for (int i = 0; i < 8; i++) arow_sc[i] = rsqrtf(ss_sum1(ssq, rowbase + lrow + 32 * i) * (1.f / 512.f) + EPS);
  }
  const bf16_t* bptr = Bt + (size_t)(tn * 256 + lrow) * ldb + lc * 8;
  auto gload = [&](int kt) {
    const bf16_t* abase = A0;
    int kofs = kt * 64;
    if (MODE == G_WOUT && kt >= 8) { abase = p->att; kofs = (kt - 8) * 64; }
#pragma unroll
    for (int i = 0; i < 8; i++) {
      int gr = min(max(rowbase + lrow + 32 * i, 0), NTOK - 1);
      ra[i] = *(const u32x4*)(abase + (size_t)gr * lda + kofs + lc * 8);
      rb[i] = *(const u32x4*)(bptr + (size_t)(32 * i) * ldb + kt * 64);
    }
    if (MODE == G_WOUT && kt < 8) {
#pragma unroll
      for (int i = 0; i < 8; i++)
#pragma unroll
        for (int e = 0; e < 4; e++) {
          unsigned v = ra[i][e];
          float lo = __uint_as_float(v << 16) * arow_sc[i], hi = __uint_as_float(v & 0xffff0000u) * arow_sc[i];
          ra[i][e] = pack_bf2(lo, hi);
        }
    }
  };
  const int wr_off = lrow * 128 + ((lc ^ ((lrow >> 1) & 7)) << 4);
  auto lwrite = [&](int st) {
    char* sa = smem + st * 65536;
    char* sb = sa + 32768;
#pragma unroll
    for (int i = 0; i < 8; i++) {
      *(u32x4*)(sa + wr_off + i * 4096) = ra[i];
      *(u32x4*)(sb + wr_off + i * 4096) = rb[i];
    }
  };

  f32x16 acc[4][4];
#pragma unroll
  for (int i = 0; i < 4; i++)
#pragma unroll
    for (int j = 0; j < 4; j++)
#pragma unroll
      for (int r = 0; r < 16; r++) acc[i][j][r] = 0.f;

  const int swz = (l32 >> 1) & 7;
  const int a_base = (wm * 128 + l32) * 128;
  const int b_base = 32768 + (wn * 128 + l32) * 128;

  gload(0);
  lwrite(0);
  __syncthreads();
  for (int kt = 0; kt < KT; kt++) {
    if (kt + 1 < KT) gload(kt + 1);
    const char* st = smem + (kt & 1) * 65536;
    bf16x8 af[2][4], bfr[2][4];
    {
      const int coff = ((g ^ swz) << 4);
#pragma unroll
      for (int i = 0; i < 4; i++) af[0][i] = *(const bf16x8*)(st + a_base + i * 4096 + coff);
#pragma unroll
      for (int j = 0; j < 4; j++) bfr[0][j] = *(const bf16x8*)(st + b_base + j * 4096 + coff);
    }
#pragma unroll
    for (int ks = 0; ks < 4; ks++) {
      if (ks < 3) {
        const int coff = ((((ks + 1) * 2 + g) ^ swz) << 4);
#pragma unroll
        for (int i = 0; i < 4; i++) af[(ks + 1) & 1][i] = *(const bf16x8*)(st + a_base + i * 4096 + coff);
#pragma unroll
        for (int j = 0; j < 4; j++) bfr[(ks + 1) & 1][j] = *(const bf16x8*)(st + b_base + j * 4096 + coff);
      }
#pragma unroll
      for (int i = 0; i < 4; i++)
#pragma unroll
        for (int j = 0; j < 4; j++) acc[i][j] = MFMA(af[ks & 1][i], bfr[ks & 1][j], acc[i][j]);
      __builtin_amdgcn_sched_barrier(0);
    }
    if (kt + 1 < KT) lwrite((kt + 1) & 1);
    __syncthreads();
  }

  int tid2 = tid;
  asm volatile("" : "+v"(tid2));
  {
  const int tid = tid2;
  const int lane = tid & 63, w = tid >> 6, wm = w >> 1, wn = w & 1, g = lane >> 5, l32 = lane & 31;
  if (MODE == G_IN) {
    const float* ssq = p->ss + (size_t)(2 * layer) * 8 * NTOK;
    const int region = tn >> 1;
    const int colb = (tn & 1) * 256 + wn * 128 + l32;
    bf16_t* dst = (region == 1) ? p->q : p->k;
#pragma unroll
    for (int i = 0; i < 4; i++)
#pragma unroll
      for (int rq = 0; rq < 4; rq++) {
        const int row0 = rowbase + wm * 128 + i * 32 + rq * 8 + g * 4;
        float4 s4 = ss_sum4(ssq, row0);
        float sc[4] = {rsqrtf(s4.x * (1.f / 1024.f) + EPS), rsqrtf(s4.y * (1.f / 1024.f) + EPS),
                       rsqrtf(s4.z * (1.f / 1024.f) + EPS), rsqrtf(s4.w * (1.f / 1024.f) + EPS)};
#pragma unroll
        for (int j = 0; j < 4; j++) {
          const int col = colb + j * 32;
          float v[4];
#pragma unroll
          for (int r4 = 0; r4 < 4; r4++) v[r4] = acc[i][j][rq * 4 + r4] * sc[r4];
          if (region == 0) {
#pragma unroll
            for (int r4 = 0; r4 < 4; r4++) p->u[(size_t)(row0 + r4) * 512 + col] = v[r4];
          } else if (region == 3) {
            const int h = col >> 7, d = col & 127;
            const int bb = row0 >> 13, t = row0 & (SEQL - 1);
            const int q4 = (t >> 2) & 3;
            const int pq = ((q4 & 1) << 1) | (q4 >> 1);
            u32x2 pk = {pack_bf2(v[0], v[1]), pack_bf2(v[2], v[3])};
            *(u32x2*)(p->vt + ((size_t)((bb * 4 + h) * 128 + d)) * SEQL + (t & ~15) + pq * 4) = pk;
          } else {
            if ((j & 1) == 0) {
              float other[4];
#pragma unroll
              for (int r4 = 0; r4 < 4; r4++) other[r4] = __shfl_xor(v[r4], 8);
              if (l32 < 16) {
                const float sgn = (l32 < 8) ? -1.f : 1.f;
#pragma unroll
                for (int r4 = 0; r4 < 4; r4++) {
                  const float2 csv = *(const float2*)(p->cs + ((size_t)(row0 + r4) * 8 + (l32 & 7)) * 2);
                  v[r4] = v[r4] * csv.x + sgn * other[r4] * csv.y;
                }
              }
            }
#pragma unroll
            for (int r4 = 0; r4 < 4; r4++) dst[(size_t)(row0 + r4) * 512 + col] = f2bf(v[r4]);
          }
        }
      }
  } else if (MODE == G_GLU) {
    float* ssq = p->ssm_ss + ((size_t)layer * 8 + tn * 2 + wn) * NTOK;
#pragma unroll
    for (int i = 0; i < 4; i++)
#pragma unroll
      for (int rq = 0; rq < 4; rq++) {
        const int row0 = rowbase + wm * 128 + i * 32 + rq * 8 + g * 4;
#pragma unroll
        for (int r4 = 0; r4 < 4; r4++) {
          float sq = 0.f;
#pragma unroll
          for (int j = 0; j < 2; j++) {
            float a = acc[i][j][rq * 4 + r4], b = acc[i][j + 2][rq * 4 + r4];
            float o = a / (1.f + __expf(-b));
            const int col = (tn * 2 + wn) * 64 + j * 32 + l32;
            p->outg[(size_t)(row0 + r4) * 512 + col] = f2bf(o);
            sq += o * o;
          }
#pragma unroll
          for (int o = 16; o; o >>= 1) sq += __shfl_xor(sq, o);
          if (l32 == 0) ssq[row0 + r4] = sq;
        }
      }
  } else if (MODE == G_WOUT || MODE == G_DOWN) {
    float* ssq = p->ss + ((size_t)(MODE == G_WOUT ? 2 * layer + 1 : 2 * layer + 2) * 8 + tn * 2 + wn) * NTOK;
#pragma unroll
    for (int i = 0; i < 4; i++)
#pragma unroll
      for (int rq = 0; rq < 4; rq++) {
        const int row0 = rowbase + wm * 128 + i * 32 + rq * 8 + g * 4;
#pragma unroll
        for (int r4 = 0; r4 < 4; r4++) {
          float sq = 0.f;
#pragma unroll
          for (int j = 0; j < 4; j++) {
            const int col = tn * 256 + wn * 128 + j * 32 + l32;
            const size_t idx = (size_t)(row0 + r4) * 1024 + col;
            float xn = p->xf[idx] + acc[i][j][rq * 4 + r4];
            p->xf[idx] = xn;
            p->xb[idx] = f2bf(xn);
            sq += xn * xn;
          }
#pragma unroll
          for (int o = 16; o; o >>= 1) sq += __shfl_xor(sq, o);
          if (l32 == 0) ssq[row0 + r4] = sq;
        }
      }
  } else {
#pragma unroll
    for (int i = 0; i < 4; i++)
#pragma unroll
      for (int j = 0; j < 4; j++)
#pragma unroll
        for (int r = 0; r < 16; r++) {
          const int lr = wm * 128 + i * 32 + (r >> 2) * 8 + g * 4 + (r & 3);
          const int pc = wn * 128 + j * 32 + l32;
          *(bf16_t*)(smem + lr * 528 + pc * 2) = f2bf(acc[i][j][r]);
        }
    __syncthreads();
    {
      const int cp = tid & 127, half = tid >> 7;
      const int pg = (cp >> 6) * 128 + (cp & 63), pv = pg + 64;
      const int ocol = tn * 128 + cp;
      const float* wc = p->w_conv + (size_t)layer * 3 * 5632;
      const float* bc = p->b_conv + (size_t)layer * 5632;
      const float wg0 = wc[ocol], wg1 = wc[5632 + ocol], wg2 = wc[2 * 5632 + ocol], bg = bc[ocol];
      const float wv0 = wc[FFN + ocol], wv1 = wc[5632 + FFN + ocol], wv2 = wc[2 * 5632 + FFN + ocol], bv = bc[FFN + ocol];
      const float* ssq = p->ss + (size_t)(2 * layer + 1) * 8 * NTOK;
      const int lr_lo = half ? 129 : 2, lr_hi = half ? 256 : 129;
      auto fetch = [&](int lr, float& gq, float& vq) {
        const int tb = 254 * upti - 2 + lr;
        float sc = 0.f;
        if (tb >= 0) {
          int gr = min(upb * SEQL + tb, NTOK - 1);
          sc = rsqrtf(ss_sum1(ssq, gr) * (1.f / 1024.f) + EPS);
        }
        gq = sc * bf2f(*(const bf16_t*)(smem + lr * 528 + pg * 2));
        vq = sc * bf2f(*(const bf16_t*)(smem + lr * 528 + pv * 2));
      };
      float g0, v0, g1, v1, g2, v2;
      fetch(lr_lo - 2, g0, v0);
      fetch(lr_lo - 1, g1, v1);
      for (int lr = lr_lo; lr < lr_hi; lr++) {
        fetch(lr, g2, v2);
        const int tb = 254 * upti - 2 + lr;
        if (tb < SEQL) {
          float gate = bg + wg0 * g0 + wg1 * g1 + wg2 * g2;
          float val = bv + wv0 * v0 + wv1 * v1 + wv2 * v2;
          float o = gate / (1.f + __expf(-gate)) * val;
          p->act[(size_t)(upb * SEQL + tb) * FFN + ocol] = f2bf(o);
        }
        g0 = g1; v0 = v1; g1 = g2; v1 = v2;
      }
    }
    __syncthreads();
  }
  }
}

__device__ __forceinline__ void attn_item(KP p, int layer, int b, int h, int qt, float lam, float outscale, char* smem, const int tid) {
  const int lane = tid & 63, w = tid >> 6, g = lane >> 5, l32 = lane & 31;
  const int tok_q = b * SEQL + qt * 128 + w * 32 + l32;
  {
    const int qrow = tid >> 4, qc = tid & 15;
#pragma unroll
    for (int i = 0; i < 8; i++) {
      const int row = qrow + 16 * i;
      u32x4 v = *(const u32x4*)(p->q + (size_t)(b * SEQL + qt * 128 + row) * 512 + h * 128 + qc * 8);
      *(u32x4*)(smem + 65536 + row * 256 + ((qc ^ (row & 15)) << 4)) = v;
    }
  }
  const int q_off = 65536 + (w * 32 + l32) * 256;
  const int q_swz = (l32 & 15);

  const int NT = 2 * qt + 2;
  const int nkt = 2 * qt + 1 + (w >> 1);
  f32x16 O[2][4];
#pragma unroll
  for (int c = 0; c < 2; c++)
#pragma unroll
    for (int dt = 0; dt < 4; dt++)
#pragma unroll
      for (int r = 0; r < 16; r++) O[c][dt][r] = 0.f;
  float mrun[2] = {-1e30f, -1e30f}, lrun[2] = {0.f, 0.f};
  const float c1 = 0.125f * 1.4426950408889634f;

  u32x4 rk[4], rv[4];
  const bf16_t* kbase = p->k + (size_t)(b * SEQL) * 512 + h * 128;
  const bf16_t* vbase = p->vt + (size_t)((b * 4 + h) * 128) * SEQL;
  const int kkey = tid >> 4, kc = tid & 15;
  const int vd = tid >> 3, vc = tid & 7;
  auto gload = [&](int kt) {
#pragma unroll
    for (int i = 0; i < 4; i++) {
      rk[i] = *(const u32x4*)(kbase + (size_t)(kt * 64 + kkey + 16 * i) * 512 + kc * 8);
      rv[i] = *(const u32x4*)(vbase + (size_t)(vd + 32 * i) * SEQL + kt * 64 + vc * 8);
    }
  };
  const int kw_off = kkey * 256 + ((kc ^ (kkey & 15)) << 4);
  const int vw_off = 16384 + vd * 128 + ((vc ^ ((vd >> 1) & 7)) << 4);
  auto lwrite = [&](int st) {
    char* s = smem + st * 32768;
#pragma unroll
    for (int i = 0; i < 4; i++) {
      *(u32x4*)(s + kw_off + i * 4096) = rk[i];
      *(u32x4*)(s + vw_off + i * 4096) = rv[i];
    }
  };

  gload(0);
  lwrite(0);
  __syncthreads();
  for (int kt = 0; kt < NT; kt++) {
    if (kt + 1 < NT) gload(kt + 1);
    if (kt < nkt) {
      const char* st = smem + (kt & 1) * 32768;
      bf16x8 pf[2][2][2];
#pragma unroll
      for (int c = 0; c < 2; c++) {
        f32x16 S[2];
#pragma unroll
        for (int kb = 0; kb < 2; kb++) {
#pragma unroll
          for (int r = 0; r < 16; r++) S[kb][r] = 0.f;
          const int key = kb * 32 + l32;
#pragma unroll
          for (int ks = 0; ks < 4; ks++) {
            const int chunk = c * 8 + ks * 2 + g;
            bf16x8 kf = *(const bf16x8*)(st + key * 256 + ((chunk ^ (key & 15)) << 4));
            bf16x8 qfr = *(const bf16x8*)(smem + q_off + ((chunk ^ q_swz) << 4));
            S[kb] = MFMA(kf, qfr, S[kb]);
          }
        }
        float mx = S[0][0];
#pragma unroll
        for (int r = 1; r < 16; r++) mx = fmaxf(mx, S[0][r]);
#pragma unroll
        for (int r = 0; r < 16; r++) mx = fmaxf(mx, S[1][r]);
        mx = fmaxf(mx, __shfl_xor(mx, 32));
        const float mnew = fmaxf(mrun[c], mx * c1);
        const float alpha = fast_exp2(mrun[c] - mnew);
        mrun[c] = mnew;
        float psum = 0.f;
#pragma unroll
        for (int kb = 0; kb < 2; kb++)
#pragma unroll
          for (int r = 0; r < 16; r++) {
            float e = fast_exp2(S[kb][r] * c1 - mnew);
            S[kb][r] = e;
            psum += e;
          }
        lrun[c] = lrun[c] * alpha + psum;
        if (__any(alpha != 1.f)) {
#pragma unroll
          for (int dt = 0; dt < 4; dt++)
#pragma unroll
            for (int r = 0; r < 16; r++) O[c][dt][r] *= alpha;
        }
#pragma unroll
        for (int kb = 0; kb < 2; kb++)
#pragma unroll
          for (int m = 0; m < 2; m++) {
            u32x4 pk = {pack_bf2(S[kb][8 * m + 0], S[kb][8 * m + 1]), pack_bf2(S[kb][8 * m + 2], S[kb][8 * m + 3]),
                        pack_bf2(S[kb][8 * m + 4], S[kb][8 * m + 5]), pack_bf2(S[kb][8 * m + 6], S[kb][8 * m + 7])};
            pf[c][kb][m] = __builtin_bit_cast(bf16x8, pk);
          }
      }
#pragma unroll
      for (int kb = 0; kb < 2; kb++)
#pragma unroll
        for (int m = 0; m < 2; m++)
#pragma unroll
          for (int dt = 0; dt < 4; dt++) {
            const int d = dt * 32 + l32;
            const int chunk = (kb * 2 + m) * 2 + g;
            bf16x8 vf = *(const bf16x8*)(st + 16384 + d * 128 + ((chunk ^ ((d >> 1) & 7)) << 4));
            O[0][dt] = MFMA(vf, pf[0][kb][m], O[0][dt]);
            O[1][dt] = MFMA(vf, pf[1][kb][m], O[1][dt]);
          }
    }
    if (kt + 1 < NT) lwrite((kt + 1) & 1);
    __syncthreads();
  }

  const float l1 = lrun[0] + __shfl_xor(lrun[0], 32);
  const float l2 = lrun[1] + __shfl_xor(lrun[1], 32);
  const float i1 = 1.f / l1, i2 = lam / l2;
  float ssq = 0.f;
#pragma unroll
  for (int dt = 0; dt < 4; dt++)
#pragma unroll
    for (int r = 0; r < 16; r++) {
      float o = O[0][dt][r] * i1 - O[1][dt][r] * i2;
      O[0][dt][r] = o;
      ssq += o * o;
    }
  ssq += __shfl_xor(ssq, 32);
  const float rstd = rsqrtf(ssq * (1.f / 128.f) + EPS) * outscale;
  const float* gsub = p->subln + layer * 128;
#pragma unroll
  for (int dt = 0; dt < 4; dt++)
#pragma unroll
    for (int rq = 0; rq < 4; rq++) {
      const int d0 = dt * 32 + rq * 8 + g * 4;
      float4 gg = *(const float4*)(gsub + d0);
      u32x2 pk = {pack_bf2(O[0][dt][rq * 4 + 0] * rstd * gg.x, O[0][dt][rq * 4 + 1] * rstd * gg.y),
                  pack_bf2(O[0][dt][rq * 4 + 2] * rstd * gg.z, O[0][dt][rq * 4 + 3] * rstd * gg.w)};
      *(u32x2*)(p->att + (size_t)tok_q * 512 + h * 128 + d0) = pk;
    }
}

DI void s5_load_u(KP p, int b, int g, int j, int lane, float* ul) {
  const float4* src = (const float4*)(p->u + (size_t)(b * SEQL + j * 64 + lane) * 512 + g * 16);
  float4 v0 = src[0], v1 = src[1], v2 = src[2], v3 = src[3];
  float4* d = (float4*)(ul + lane * 16);
  d[0] = v0; d[1] = v1; d[2] = v2; d[3] = v3;
}

#define S5_BU(ul, t, bur, bui)                                              \
  {                                                                         \
    const float4* up_ = (const float4*)((ul) + (t) * 16);                   \
    float4 q0 = up_[0], q1 = up_[1], q2 = up_[2], q3 = up_[3];              \
    float uu[16] = {q0.x, q0.y, q0.z, q0.w, q1.x, q1.y, q1.z, q1.w, q2.x, q2.y, q2.z, q2.w, q3.x, q3.y, q3.z, q3.w}; \
    bur = 0.f; bui = 0.f;                                                   \
    _Pragma("unroll") for (int c_ = 0; c_ < 16; c_++) { bur += Bre[c_] * uu[c_]; bui += Bim[c_] * uu[c_]; } \
  }

__device__ __forceinline__ void s5_pass1(KP p, int layer, char* smem, const int tid) {
  const int lane = tid & 63, w = tid >> 6;
  float* ul = (float*)(smem + w * 4096);
  for (int base = blockIdx.x * 4; base < 8192; base += gridDim.x * 4) {
    const int item = base + w;
    const int j = item & 127, g = (item >> 7) & 31, b = item >> 12;
    s5_load_u(p, b, g, j, lane, ul);
    const float* tb = p->s5tab + (size_t)((layer * 32 + g) * 64 + lane) * 40;
    const float ar = tb[0], ai = tb[1];
    float Bre[16], Bim[16];
#pragma unroll
    for (int c = 0; c < 16; c++) { Bre[c] = tb[4 + c]; Bim[c] = tb[20 + c]; }
    __syncthreads();
    float xr = 0.f, xi = 0.f;
    for (int t = 0; t < 64; t++) {
      float bur, bui;
      S5_BU(ul, t, bur, bui);
      const float nr = ar * xr - ai * xi + bur;
      const float ni = ar * xi + ai * xr + bui;
      xr = nr; xi = ni;
    }
    float* so = p->sloc + (size_t)((b * 32 + g) * 128 + j) * 128;
    so[lane] = xr; so[64 + lane] = xi;
    __syncthreads();
  }
}

__device__ __forceinline__ void s5_pass2(KP p, int layer, char* smem, const int tid) {
  const int lane = tid & 63, w = tid >> 6;
  float* ul = (float*)(smem + w * 29696);
  float* X = ul + 1024;
  float* Cl = X + 32 * 129 + 32;
  const int t32 = lane & 31, hc = lane >> 5;
  for (int base = blockIdx.x * 4; base < 8192; base += gridDim.x * 4) {
    const int item = base + w;
    const int j = item & 127, g = (item >> 7) & 31, b = item >> 12;
    s5_load_u(p, b, g, j, lane, ul);
    const float* tb = p->s5tab + (size_t)((layer * 32 + g) * 64 + lane) * 40;
    const float ar = tb[0], ai = tb[1], aTr = tb[2], aTi = tb[3];
    float Bre[16], Bim[16];
#pragma unroll
    for (int c = 0; c < 16; c++) { Bre[c] = tb[4 + c]; Bim[c] = tb[20 + c]; }
    {
      const float* cr = p->c_re + (size_t)((layer * 32 + g) * 16) * 64;
      const float* ci = p->c_im + (size_t)((layer * 32 + g) * 16) * 64;
#pragma unroll
      for (int c = 0; c < 16; c++) {
        Cl[lane * 32 + (c >> 3) * 16 + (c & 7)] = cr[c * 64 + lane];
        Cl[lane * 32 + (c >> 3) * 16 + 8 + (c & 7)] = ci[c * 64 + lane];
      }
    }
    float dd[8];
    {
      const float* dp = p->ssm_d + (size_t)(layer * 32 + g) * 16 + hc * 8;
#pragma unroll
      for (int i = 0; i < 8; i++) dd[i] = dp[i];
    }
    float xr = 0.f, xi = 0.f;
    {
      const float* sl = p->sloc + (size_t)((b * 32 + g) * 128) * 128;
      for (int i = 0; i < j; i++) {
        const float sr = sl[i * 128 + lane], si = sl[i * 128 + 64 + lane];
        const float nr = aTr * xr - aTi * xi + sr;
        const float ni = aTr * xi + aTi * xr + si;
        xr = nr; xi = ni;
      }
    }
    __syncthreads();
    for (int sub = 0; sub < 2; sub++) {
      for (int t = 0; t < 32; t++) {
        float bur, bui;
        S5_BU(ul, sub * 32 + t, bur, bui);
        const float nr = ar * xr - ai * xi + bur;
        const float ni = ar * xi + ai * xr + bui;
        xr = nr; xi = ni;
        X[t * 129 + lane] = xr;
        X[t * 129 + 64 + lane] = xi;
      }
      __syncthreads();
      float y[8];
#pragma unroll
      for (int i = 0; i < 8; i++) y[i] = 0.f;
      for (int pp = 0; pp < 64; pp++) {
        const float sxr = X[t32 * 129 + pp], sxi = X[t32 * 129 + 64 + pp];
        const float4* cp = (const float4*)(Cl + pp * 32 + hc * 16);
        float4 c0 = cp[0], c1 = cp[1], c2 = cp[2], c3 = cp[3];
        y[0] += c0.x * sxr - c2.x * sxi; y[1] += c0.y * sxr - c2.y * sxi;
        y[2] += c0.z * sxr - c2.z * sxi; y[3] += c0.w * sxr - c2.w * sxi;
        y[4] += c1.x * sxr - c3.x * sxi; y[5] += c1.y * sxr - c3.y * sxi;
        y[6] += c1.z * sxr - c3.z * sxi; y[7] += c1.w * sxr - c3.w * sxi;
      }
      const int tl = sub * 32 + t32;
      unsigned pk[4];
#pragma unroll
      for (int i = 0; i < 4; i++) {
        float a0 = y[2 * i] + dd[2 * i] * ul[tl * 16 + hc * 8 + 2 * i];
        float a1 = y[2 * i + 1] + dd[2 * i + 1] * ul[tl * 16 + hc * 8 + 2 * i + 1];
        pk[i] = pack_bf2(gelu_tanh(a0), gelu_tanh(a1));
      }
      u32x4 o = {pk[0], pk[1], pk[2], pk[3]};
      *(u32x4*)(p->gy + (size_t)(b * SEQL + j * 64 + tl) * 512 + g * 16 + hc * 8) = o;
      __syncthreads();
    }
  }
}

__device__ __forceinline__ void phase_attn(KP p, int layer, char* smem, const int tid) {
  const int lane = tid & 63;
  const float s1 = wave_sum(p->lq1[layer * 64 + lane] * p->lk1[layer * 64 + lane]);
  const float s2 = wave_sum(p->lq2[layer * 64 + lane] * p->lk2[layer * 64 + lane]);
  const float lam_init = 0.8f - 0.6f * expf(-0.3f * (float)layer);
  const float lam = expf(s1) - expf(s2) + lam_init;
  for (int pi = blockIdx.x; pi < 256; pi += gridDim.x) {
    const int b = pi >> 7, h = (pi >> 5) & 3, i = pi & 31;
    attn_item(p, layer, b, h, 63 - i, lam, 1.f - lam_init, smem, tid);
    attn_item(p, layer, b, h, i, lam, 1.f - lam_init, smem, tid);
  }
  s5_pass1(p, layer, smem, tid);
}

__device__ __forceinline__ void phase_final(KP p, const int tid) {
  const int wave = tid >> 6, lane = tid & 63;
  const float* ssq = p->ss + (size_t)8 * 8 * NTOK;
  for (int row = blockIdx.x * 4 + wave; row < NTOK; row += gridDim.x * 4) {
    const float rstd = rsqrtf(ss_sum1(ssq, row) * (1.f / 1024.f) + EPS);
#pragma unroll
    for (int i = 0; i < 4; i++) {
      float4 v = ((const float4*)(p->xf + (size_t)row * DM))[lane + 64 * i];
      float4 gq = ((const float4*)p->norm_final)[lane + 64 * i];
      float4 o = {v.x * rstd * gq.x, v.y * rstd * gq.y, v.z * rstd * gq.z, v.w * rstd * gq.w};
      ((float4*)(p->out + (size_t)row * DM))[lane + 64 * i] = o;
    }
  }
}

__device__ __forceinline__ void run_phase(KP p, int ph, char* smem) {
  const int tid = opaque_tid();
  if (ph == 0) { phase_prep(p, smem, tid); return; }
  if (ph == 29) { phase_final(p, tid); return; }
  const int layer = (ph - 1) / 7, k = (ph - 1) % 7;
  const int nb = gridDim.x, bid = blockIdx.x;
  if (k == 1) { phase_attn(p, layer, smem, tid); return; }
  if (k == 2) { s5_pass2(p, layer, smem, tid); return; }
  if (k == 0) { for (int t = bid; t < 512; t += nb) gemm_tile(p, G_IN, layer, t, smem, tid); }
  else if (k == 3) { for (int t = bid; t < 256; t += nb) gemm_tile(p, G_GLU, layer, t, smem, tid); }
  else if (k == 4) { for (int t = bid; t < 256; t += nb) gemm_tile(p, G_WOUT, layer, t, smem, tid); }
  else if (k == 5) { for (int t = bid; t < 2 * 33 * 22; t += nb) gemm_tile(p, G_UP, layer, t, smem, tid); }
  else { for (int t = bid; t < 256; t += nb) gemm_tile(p, G_DOWN, layer, t, smem, tid); }
}

#define PHASE_KERNEL(name, body)                                                      \
  __global__ void __launch_bounds__(256) name(Params p_unused) {                      \
    extern __shared__ __attribute__((aligned(16))) char smem[];                       \
    KP p = (KP)__builtin_amdgcn_kernarg_segment_ptr();                                \
    const int tid = threadIdx.x, nb = gridDim.x, bid = blockIdx.x;                    \
    const int layer = (int)p->phase_lo;                                               \
    (void)nb; (void)bid; (void)layer;                                                 \
    body                                                                              \
  }
PHASE_KERNEL(k_prep, phase_prep(p, smem, tid);)
PHASE_KERNEL(k_gin, for (int t = bid; t < 512; t += nb) gemm_tile(p, G_IN, layer, t, smem, tid);)
PHASE_KERNEL(k_attn, phase_attn(p, layer, smem, tid);)
PHASE_KERNEL(k_s5p2, s5_pass2(p, layer, smem, tid);)
PHASE_KERNEL(k_glu, for (int t = bid; t < 256; t += nb) gemm_tile(p, G_GLU, layer, t, smem, tid);)
PHASE_KERNEL(k_wout, for (int t = bid; t < 256; t += nb) gemm_tile(p, G_WOUT, layer, t, smem, tid);)
PHASE_KERNEL(k_up, for (int t = bid; t < 2 * 33 * 22; t += nb) gemm_tile(p, G_UP, layer, t, smem, tid);)
PHASE_KERNEL(k_down, for (int t = bid; t < 256; t += nb) gemm_tile(p, G_DOWN, layer, t, smem, tid);)
PHASE_KERNEL(k_final, phase_final(p, tid);)

#if COOP
__global__ void __launch_bounds__(256) mega_kernel(Params p_unused) {
  extern __shared__ __attribute__((aligned(16))) char smem[];
#if COOP
  cg::grid_group grid = cg::this_grid();
#endif
  KP p0 = (KP)__builtin_amdgcn_kernarg_segment_ptr();
  const int ph_lo = (int)p0->phase_lo, ph_hi = (int)p0->phase_hi;
  for (int ph = ph_lo; ph < ph_hi; ph++) {
    KP p = p0;
    asm volatile("" : "+s"(p));
    run_phase(p, ph, smem);
#if COOP
    if (ph + 1 < ph_hi) grid.sync();
#endif
  }
}

#endif

extern "C" void kernel_launch(void* const* d_in, const int* in_sizes, int n_in, void* d_out, int out_size, void* d_ws,
                              size_t ws_size, hipStream_t stream) {
  static int grid_blocks = 0;
  if (!grid_blocks) {
    int dev = 0, cus = 0, per_cu = 0;
    (void)hipGetDevice(&dev);
    (void)hipDeviceGetAttribute(&cus, hipDeviceAttributeMultiprocessorCount, dev);
#if COOP
    (void)hipFuncSetAttribute((const void*)mega_kernel, hipFuncAttributeMaxDynamicSharedMemorySize, LDS_BYTES);
    (void)hipOccupancyMaxActiveBlocksPerMultiprocessor(&per_cu, (const void*)mega_kernel, 256, LDS_BYTES);
    if (per_cu < 1) { fprintf(stderr, "occupancy query returned %d\n", per_cu); per_cu = 1; }
#endif
    grid_blocks = cus;
    (void)hipGetLastError();
  }
  Params p{};
  p.x = (const float*)d_in[0]; p.pos = (const int*)d_in[1];
  p.norm_mix = (const float*)d_in[2]; p.w_in = (const float*)d_in[3];
  p.lam_re = (const float*)d_in[4]; p.lam_im = (const float*)d_in[5]; p.log_step = (const float*)d_in[6];
  p.b_re = (const float*)d_in[7]; p.b_im = (const float*)d_in[8]; p.c_re = (const float*)d_in[9]; p.c_im = (const float*)d_in[10];
  p.ssm_d = (const float*)d_in[11]; p.w_glu = (const float*)d_in[12]; p.ssm_norm = (const float*)d_in[13];
  p.lq1 = (const float*)d_in[14]; p.lk1 = (const float*)d_in[15]; p.lq2 = (const float*)d_in[16]; p.lk2 = (const float*)d_in[17];
  p.subln = (const float*)d_in[18]; p.w_out = (const float*)d_in[19]; p.norm_ffn = (const float*)d_in[20];
  p.w_up = (const float*)d_in[21]; p.w_conv = (const float*)d_in[22]; p.b_conv = (const float*)d_in[23];
  p.w_down = (const float*)d_in[24]; p.norm_final = (const float*)d_in[25];
  p.out = (float*)d_out;
  char* ws = (char*)d_ws;
  size_t off = 0;
  auto take = [&](size_t bytes) { char* r = ws + off; off += (bytes + 255) & ~(size_t)255; return r; };
  p.WinT = (bf16_t*)take((size_t)4 * 2048 * 1024 * 2);
  p.WgluT = (bf16_t*)take((size_t)4 * 1024 * 512 * 2);
  p.WoutT = (bf16_t*)take((size_t)4 * 1024 * 1024 * 2);
  p.WupT = (bf16_t*)take((size_t)4 * 5632 * 1024 * 2);
  p.WdownT = (bf16_t*)take((size_t)4 * 1024 * FFN * 2);
  p.xf = (float*)take((size_t)NTOK * DM * 4);
  p.xb = (bf16_t*)take((size_t)NTOK * DM * 2);
  p.ss = (float*)take((size_t)9 * 8 * NTOK * 4);
  p.ssm_ss = (float*)take((size_t)4 * 8 * NTOK * 4);
  p.cs = (float*)take((size_t)NTOK * 16 * 4);
  p.s5tab = (float*)take((size_t)4 * 32 * 64 * 40 * 4);
  p.sloc = (float*)take((size_t)2 * 32 * 128 * 128 * 4);
  char* region = take((size_t)134217728);
  p.u = (float*)region;
  p.q = (bf16_t*)(region + 33554432);
  p.k = p.q + (size_t)NTOK * 512;
  p.vt = p.k + (size_t)NTOK * 512;
  p.gy = p.vt + (size_t)NTOK * 512;
  p.outg = p.gy + (size_t)NTOK * 512;
  p.att = p.outg + (size_t)NTOK * 512;
  p.act = (bf16_t*)region;
  if (off > ws_size) { fprintf(stderr, "workspace too small: need %zu have %zu\n", off, ws_size); return; }
#if COOP
  p.phase_lo = 0; p.phase_hi = 30;
  void* args[] = {&p};
  hipError_t e = hipLaunchCooperativeKernel((const void*)mega_kernel, dim3(grid_blocks), dim3(256), args, LDS_BYTES, stream);
  if (e != hipSuccess) fprintf(stderr, "cooperative launch failed: %s (grid %d)\n", hipGetErrorString(e), grid_blocks);
#else
  typedef void (*kfn)(Params);
  const kfn seq[7] = {k_gin, k_attn, k_s5p2, k_glu, k_wout, k_up, k_down};
  static bool attr_done = false;
  if (!attr_done) {
    (void)hipFuncSetAttribute((const void*)k_prep, hipFuncAttributeMaxDynamicSharedMemorySize, LDS_BYTES);
    (void)hipFuncSetAttribute((const void*)k_final, hipFuncAttributeMaxDynamicSharedMemorySize, LDS_BYTES);
    for (int i = 0; i < 7; i++) (void)hipFuncSetAttribute((const void*)seq[i], hipFuncAttributeMaxDynamicSharedMemorySize, LDS_BYTES);
    attr_done = true;
  }
  p.phase_lo = 0; p.phase_hi = 0;
  hipLaunchKernelGGL(k_prep, dim3(grid_blocks), dim3(256), LDS_BYTES, stream, p);
  for (int layer = 0; layer < 4; layer++) {
    p.phase_lo = layer;
    for (int i = 0; i < 7; i++) hipLaunchKernelGGL(seq[i], dim3(grid_blocks), dim3(256), LDS_BYTES, stream, p);
  }
  hipLaunchKernelGGL(k_final, dim3(grid_blocks), dim3(256), LDS_BYTES, stream, p);
#endif
}
```

```cpp
#include <hip/hip_runtime.h>
#include <hip/hip_cooperative_groups.h>
#include <cstdio>
namespace cg = cooperative_groups;

#ifndef COOP
#define COOP 1
#endif
#ifndef TPROBE
#define TPROBE 0
#endif
#ifndef TP_A
#define TP_A 1
#endif
#ifndef TP_B
#define TP_B 2
#endif

typedef unsigned short bf16_t;
typedef __attribute__((ext_vector_type(8))) short bf16x8;
typedef __attribute__((ext_vector_type(16))) float f32x16;
typedef __attribute__((ext_vector_type(2))) __bf16 bf2_t;
typedef __attribute__((ext_vector_type(2))) float f2_t;
typedef __attribute__((ext_vector_type(4))) unsigned u32x4;
typedef __attribute__((ext_vector_type(2))) unsigned u32x2;

#define DI __device__ __forceinline__
#define MFMA(a, b, c) __builtin_amdgcn_mfma_f32_32x32x16_bf16((a), (b), (c), 0, 0, 0)

constexpr int NTOK = 16384, DM = 1024, SEQL = 8192, FFN = 2816;
constexpr int LDS_BYTES = 136192;
constexpr float EPS = 1e-6f;

struct Params {
  const float* x; const int* pos;
  const float *norm_mix, *w_in, *lam_re, *lam_im, *log_step, *b_re, *b_im, *c_re, *c_im, *ssm_d, *w_glu, *ssm_norm;
  const float *lq1, *lk1, *lq2, *lk2, *subln, *w_out, *norm_ffn, *w_up, *w_conv, *b_conv, *w_down, *norm_final;
  float* out;
  bf16_t *WinT, *WgluT, *WoutT, *WupT, *WdownT;
  float* xf; bf16_t* xb;
  float* u; bf16_t *q, *k, *vt, *gy, *outg, *att, *act;
  float *ss, *ssm_ss, *cs, *s5tab, *sloc;
  long long phase_lo, phase_hi;
  long long* ts;
  unsigned* bar;
};

typedef const __attribute__((address_space(4))) Params* KP;

DI unsigned pack_bf2(float a, float b) { f2_t v = {a, b}; return __builtin_bit_cast(unsigned, __builtin_convertvector(v, bf2_t)); }
DI bf16_t f2bf(float a) { return (bf16_t)(pack_bf2(a, 0.f) & 0xffffu); }
DI float bf2f(bf16_t v) { return __uint_as_float(((unsigned)v) << 16); }
DI void grid_barrier(unsigned* ctr, unsigned target, int tid) {
  __syncthreads();
  if (tid == 0) {
    __threadfence();
    __hip_atomic_fetch_add(ctr, 1u, __ATOMIC_RELAXED, __HIP_MEMORY_SCOPE_AGENT);
    while (__hip_atomic_load(ctr, __ATOMIC_RELAXED, __HIP_MEMORY_SCOPE_AGENT) < target) __builtin_amdgcn_s_sleep(2);
    __threadfence();
  }
  __syncthreads();
}
DI int opaque_tid() { int t = threadIdx.x; asm volatile("" : "+v"(t)); return t; }
DI float4 ss_sum4(const float* base, int row0) {
  float4 a = *(const float4*)(base + row0);
#pragma unroll
  for (int pz = 1; pz < 8; pz++) {
    float4 b = *(const float4*)(base + (size_t)pz * NTOK + row0);
    a.x += b.x; a.y += b.y; a.z += b.z; a.w += b.w;
  }
  return a;
}
DI float ss_sum1(const float* base, int row) {
  float a = base[row];
#pragma unroll
  for (int pz = 1; pz < 8; pz++) a += base[(size_t)pz * NTOK + row];
  return a;
}
DI float wave_sum(float v) { for (int o = 32; o; o >>= 1) v += __shfl_xor(v, o); return v; }
DI float fast_exp2(float x) { return __builtin_amdgcn_exp2f(x); }
DI float gelu_tanh(float x) {
  float z = 0.7978845608028654f * (x + 0.044715f * x * x * x);
  float e = __expf(2.f * z);
  float t = 1.f - 2.f / (1.f + e);
  return 0.5f * x * (1.f + t);
}
DI float reduce_2pi(double a) {
  double n = rint(a * 0.15915494309189535);
  return (float)(a - n * 6.283185307179586);
}

DI void transpose_tile(const float* src, int ldsrc, int k0, int c0, const float* scale, int nscale,
                       bf16_t* dst, int lddst, int n0, float* lds, const int tid) {
#pragma unroll
  for (int i = 0; i < 16; i++) {
    int kk = i * 4 + (tid >> 6), nn = tid & 63;
    float v = src[(size_t)(k0 + kk) * ldsrc + c0 + nn];
    if (scale != nullptr && (k0 + kk) < nscale) v *= scale[k0 + kk];
    lds[kk * 65 + nn] = v;
  }
  __syncthreads();
  {
    int nn = tid >> 2, kq = (tid & 3) * 16;
    unsigned pk[8];
#pragma unroll
    for (int i = 0; i < 8; i++) pk[i] = pack_bf2(lds[(kq + 2 * i) * 65 + nn], lds[(kq + 2 * i + 1) * 65 + nn]);
    u32x4* d = (u32x4*)(dst + (size_t)(n0 + nn) * lddst + k0 + kq);
    u32x4 a = {pk[0], pk[1], pk[2], pk[3]}, b = {pk[4], pk[5], pk[6], pk[7]};
    d[0] = a; d[1] = b;
  }
  __syncthreads();
}

__device__ __forceinline__ void phase_prep(KP p, char* smem, const int tid) {
  const int nb = gridDim.x, bid = blockIdx.x;
  const int wave = tid >> 6, lane = tid & 63;
  for (int row = bid * 4 + wave; row < NTOK; row += nb * 4) {
    const float4* src = (const float4*)(p->x + (size_t)row * DM);
    float s = 0.f;
#pragma unroll
    for (int i = 0; i < 4; i++) {
      float4 v = src[lane + 64 * i];
      s += v.x * v.x + v.y * v.y + v.z * v.z + v.w * v.w;
      ((float4*)(p->xf + (size_t)row * DM))[lane + 64 * i] = v;
      u32x2 pk = {pack_bf2(v.x, v.y), pack_bf2(v.z, v.w)};
      ((u32x2*)(p->xb + (size_t)row * DM))[lane + 64 * i] = pk;
    }
    s = wave_sum(s);
    if (lane < 8) p->ss[(size_t)lane * NTOK + row] = (lane == 0) ? s : 0.f;
  }
  for (int i = bid * 256 + tid; i < NTOK * 8; i += nb * 256) {
    int tok = i >> 3, j = i & 7;
    double inv = (j & 4) ? ((j & 2) ? ((j & 1) ? 1.031338537721246e-05 : 5.318295896944988e-05) : ((j & 1) ? 0.0002742481756762073 : 0.001414213562373095))
                         : ((j & 2) ? ((j & 1) ? 0.007292664737217109 : 0.03760603093086393) : ((j & 1) ? 0.19392274474868576 : 1.0));
    double ang = (double)p->pos[tok] * inv;
    float r = reduce_2pi(ang);
    p->cs[2 * i] = cosf(r); p->cs[2 * i + 1] = sinf(r);
  }
  for (int i = bid * 256 + tid; i < 4 * 32 * 64; i += nb * 256) {
    int lg = i >> 6;
    float lr = p->lam_re[i], li = p->lam_im[i];
    float step = expf(p->log_step[lg]);
    float mag = expf(step * lr);
    double angd = (double)step * (double)li;
    float r1 = reduce_2pi(angd);
    float ar = mag * cosf(r1), ai = mag * sinf(r1);
    float den = lr * lr + li * li;
    float fr = ((ar - 1.f) * lr + ai * li) / den;
    float fi = (ai * lr - (ar - 1.f) * li) / den;
    float magT = expf(64.f * step * lr);
    float rT = reduce_2pi(64.0 * angd);
    float* tb = p->s5tab + (size_t)i * 40;
    tb[0] = ar; tb[1] = ai; tb[2] = magT * cosf(rT); tb[3] = magT * sinf(rT);
    for (int c = 0; c < 16; c++) {
      float br = p->b_re[(size_t)i * 16 + c], bi = p->b_im[(size_t)i * 16 + c];
      tb[4 + c] = fr * br - fi * bi;
      tb[20 + c] = fr * bi + fi * br;
    }
  }
  float* lds = (float*)smem;
  for (int job = bid; job < 4 * 3008; job += nb) {
    int layer = job / 3008, t = job % 3008;
    if (t < 512) {
      int a = t >> 4, kt = t & 15;
      transpose_tile(p->w_in + (size_t)layer * 1024 * 2048, 2048, kt * 64, a * 64, p->norm_mix + layer * 1024, 1024,
                     p->WinT + (size_t)layer * 2048 * 1024, 1024, a * 64, lds, tid);
    } else if (t < 640) {
      t -= 512; int a = t >> 3, kt = t & 7;
      transpose_tile(p->w_glu + (size_t)layer * 512 * 1024, 1024, kt * 64, (a & 1) * 512 + (a >> 1) * 64, nullptr, 0,
                     p->WgluT + (size_t)layer * 1024 * 512, 512, a * 64, lds, tid);
    } else if (t < 896) {
      t -= 640; int a = t >> 4, kt = t & 15;
      transpose_tile(p->w_out + (size_t)layer * 1024 * 1024, 1024, kt * 64, a * 64, p->ssm_norm + layer * 512, 512,
                     p->WoutT + (size_t)layer * 1024 * 1024, 1024, a * 64, lds, tid);
    } else if (t < 2304) {
      t -= 896; int a = t >> 4, kt = t & 15;
      transpose_tile(p->w_up + (size_t)layer * 1024 * 5632, 5632, kt * 64, (a & 1) * FFN + (a >> 1) * 64, p->norm_ffn + layer * 1024, 1024,
                     p->WupT + (size_t)layer * 5632 * 1024, 1024, a * 64, lds, tid);
    } else {
      t -= 2304; int a = t / 44, kt = t % 44;
      transpose_tile(p->w_down + (size_t)layer * FFN * 1024, 1024, kt * 64, a * 64, nullptr, 0,
                     p->WdownT + (size_t)layer * 1024 * FFN, FFN, a * 64, lds, tid);
    }
  }
}

enum { G_IN = 0, G_GLU = 1, G_WOUT = 2, G_UP = 3, G_DOWN = 4 };
#define ACC_PIN(tag) _Pragma("unroll") for (int i_ = 0; i_ < 4; i_++) _Pragma("unroll") for (int j_ = 0; j_ < 4; j_++) asm volatile("; pin " tag : "+a"(acc[i_][j_]));


__device__ __forceinline__ void gemm_tile(KP p, const int MODE, int layer, int tile, char* smem, const int tid) {
  const int lane = tid & 63, w = tid >> 6, wm = w >> 1, wn = w & 1, g = lane >> 5, l32 = lane & 31;
  int tn, KT, ldb, rowbase, lda;
  const bf16_t* Bt;
  const bf16_t* A0;
  int upb = 0, upti = 0;
  {
    const int TM = (MODE == G_UP) ? 66 : 64;
    const int TN = (MODE == G_IN) ? 8 : (MODE == G_UP ? 22 : 4);
    const int nfull = TN >> 2, rem = TN & 3;
    int tm;
    if (tile < nfull * 4 * TM) { const int band = tile / (4 * TM), within = tile % (4 * TM); tm = within >> 2; tn = band * 4 + (within & 3); }
    else { const int s2 = tile - nfull * 4 * TM; tm = s2 / rem; tn = nfull * 4 + s2 % rem; }
    rowbase = tm * 256;
    if (MODE == G_UP) { upb = tm / 33; upti = tm % 33; rowbase = upb * SEQL + 254 * upti - 2; }
  }
  if (MODE == G_IN) { KT = 16; ldb = 1024; Bt = p->WinT + (size_t)layer * 2048 * 1024; A0 = p->xb; lda = 1024; }
  else if (MODE == G_GLU) { KT = 8; ldb = 512; Bt = p->WgluT + (size_t)layer * 1024 * 512; A0 = p->gy; lda = 512; }
  else if (MODE == G_WOUT) { KT = 16; ldb = 1024; Bt = p->WoutT + (size_t)layer * 1024 * 1024; A0 = p->outg; lda = 512; }
  else if (MODE == G_UP) { KT = 16; ldb = 1024; Bt = p->WupT + (size_t)layer * 5632 * 1024; A0 = p->xb; lda = 1024; }
  else { KT = 44; ldb = FFN; Bt = p->WdownT + (size_t)layer * 1024 * FFN; A0 = p->act; lda = FFN; }

  u32x4 ra[8], rb[8];
  const int lrow = tid >> 3, lc = tid & 7;
  float arow_sc[8];
#pragma unroll
  for (int i = 0; i < 8; i++) arow_sc[i] = 1.f;
  if (MODE == G_WOUT) {
    const float* ssq = p->ssm_ss + (size_t)layer * 8 * NTOK;
#pragma unroll
    for (int i = 0; i < 8; i++) arow_sc[i] = rsqrtf(ss_sum1(ssq, rowbase + lrow + 32 * i) * (1.f / 512.f) + EPS);
  }
  const bf16_t* bptr = Bt + (size_t)(tn * 256 + lrow) * ldb + lc * 8;
  auto gload = [&](int kt) {
    const bf16_t* abase = A0;
    int kofs = kt * 64;
    if (MODE == G_WOUT && kt >= 8) { abase = p->att; kofs = (kt - 8) * 64; }
#pragma unroll
    for (int i = 0; i < 8; i++) {
      int gr = min(max(rowbase + lrow + 32 * i, 0), NTOK - 1);
      ra[i] = *(const u32x4*)(abase + (size_t)gr * lda + kofs + lc * 8);
      rb[i] = *(const u32x4*)(bptr + (size_t)(32 * i) * ldb + kt * 64);
    }
    if (MODE == G_WOUT && kt < 8) {
#pragma unroll
      for (int i = 0; i < 8; i++)
#pragma unroll
        for (int e = 0; e < 4; e++) {
          unsigned v = ra[i][e];
          float lo = __uint_as_float(v << 16) * arow_sc[i], hi = __uint_as_float(v & 0xffff0000u) * arow_sc[i];
          ra[i][e] = pack_bf2(lo, hi);
        }
    }
  };
  const int wr_off = lrow * 128 + ((lc ^ ((lrow >> 1) & 7)) << 4);
  auto lwrite = [&](int st) {
    char* sa = smem + st * 65536;
    char* sb = sa + 32768;
#pragma unroll
    for (int i = 0; i < 8; i++) {
      *(u32x4*)(sa + wr_off + i * 4096) = ra[i];
      *(u32x4*)(sb + wr_off + i * 4096) = rb[i];
    }
  };

  f32x16 acc[4][4];
#pragma unroll
  for (int i = 0; i < 4; i++)
#pragma unroll
    for (int j = 0; j < 4; j++)
#pragma unroll
      for (int r = 0; r < 16; r++) acc[i][j][r] = 0.f;

  const int swz = (l32 >> 1) & 7;
  const int a_base = (wm * 128 + l32) * 128;
  const int b_base = 32768 + (wn * 128 + l32) * 128;

  gload(0);
  lwrite(0);
  __syncthreads();
  for (int kt = 0; kt < KT; kt++) {
    if (kt + 1 < KT) gload(kt + 1);
    const char* st = smem + (kt & 1) * 65536;
    bf16x8 af[2][4], bfr[2][4];
    {
      const int coff = ((g ^ swz) << 4);
#pragma unroll
      for (int i = 0; i < 4; i++) af[0][i] = *(const bf16x8*)(st + a_base + i * 4096 + coff);
#pragma unroll
      for (int j = 0; j < 4; j++) bfr[0][j] = *(const bf16x8*)(st + b_base + j * 4096 + coff);
    }
#pragma unroll
    for (int ks = 0; ks < 4; ks++) {
      if (ks < 3) {
        const int coff = ((((ks + 1) * 2 + g) ^ swz) << 4);
#pragma unroll
        for (int i = 0; i < 4; i++) af[(ks + 1) & 1][i] = *(const bf16x8*)(st + a_base + i * 4096 + coff);
#pragma unroll
        for (int j = 0; j < 4; j++) bfr[(ks + 1) & 1][j] = *(const bf16x8*)(st + b_base + j * 4096 + coff);
      }
#pragma unroll
      for (int i = 0; i < 4; i++)
#pragma unroll
        for (int j = 0; j < 4; j++) acc[i][j] = MFMA(af[ks & 1][i], bfr[ks & 1][j], acc[i][j]);
      __builtin_amdgcn_sched_barrier(0);
    }
    if (kt + 1 < KT) lwrite((kt + 1) & 1);
    __syncthreads();
  }

  int tid2 = tid;
  asm volatile("" : "+v"(tid2));
  {
  const int tid = tid2;
  const int lane = tid & 63, w = tid >> 6, wm = w >> 1, wn = w & 1, g = lane >> 5, l32 = lane & 31;
  if (MODE == G_IN) {
    const float* ssq = p->ss + (size_t)(2 * layer) * 8 * NTOK;
    const int region = tn >> 1;
    const int colb = (tn & 1) * 256 + wn * 128 + l32;
    bf16_t* dst = (region == 1) ? p->q : p->k;
#pragma unroll
    for (int i = 0; i < 4; i++)
#pragma unroll
      for (int rq = 0; rq < 4; rq++) {
        const int row0 = rowbase + wm * 128 + i * 32 + rq * 8 + g * 4;
        float4 s4 = ss_sum4(ssq, row0);
        float sc[4] = {rsqrtf(s4.x * (1.f / 1024.f) + EPS), rsqrtf(s4.y * (1.f / 1024.f) + EPS),
                       rsqrtf(s4.z * (1.f / 1024.f) + EPS), rsqrtf(s4.w * (1.f / 1024.f) + EPS)};
#pragma unroll
        for (int j = 0; j < 4; j++) {
          const int col = colb + j * 32;
          float v[4];
#pragma unroll
          for (int r4 = 0; r4 < 4; r4++) v[r4] = acc[i][j][rq * 4 + r4] * sc[r4];
          if (region == 0) {
#pragma unroll
            for (int r4 = 0; r4 < 4; r4++) p->u[(size_t)(row0 + r4) * 512 + col] = v[r4];
          } else if (region == 3) {
            const int h = col >> 7, d = col & 127;
            const int bb = row0 >> 13, t = row0 & (SEQL - 1);
            const int q4 = (t >> 2) & 3;
            const int pq = ((q4 & 1) << 1) | (q4 >> 1);
            u32x2 pk = {pack_bf2(v[0], v[1]), pack_bf2(v[2], v[3])};
            *(u32x2*)(p->vt + ((size_t)((bb * 4 + h) * 128 + d)) * SEQL + (t & ~15) + pq * 4) = pk;
          } else {
            if ((j & 1) == 0) {
              float other[4];
#pragma unroll
              for (int r4 = 0; r4 < 4; r4++) other[r4] = __shfl_xor(v[r4], 8);
              if (l32 < 16) {
                const float sgn = (l32 < 8) ? -1.f : 1.f;
#pragma unroll
                for (int r4 = 0; r4 < 4; r4++) {
                  const float2 csv = *(const float2*)(p->cs + ((size_t)(row0 + r4) * 8 + (l32 & 7)) * 2);
                  v[r4] = v[r4] * csv.x + sgn * other[r4] * csv.y;
                }
              }
            }
#pragma unroll
            for (int r4 = 0; r4 < 4; r4++) dst[(size_t)(row0 + r4) * 512 + col] = f2bf(v[r4]);
          }
        }
      }
  } else if (MODE == G_GLU) {
    float* ssq = p->ssm_ss + ((size_t)layer * 8 + tn * 2 + wn) * NTOK;
#pragma unroll
    for (int i = 0; i < 4; i++)
#pragma unroll
      for (int rq = 0; rq < 4; rq++) {
        const int row0 = rowbase + wm * 128 + i * 32 + rq * 8 + g * 4;
#pragma unroll
        for (int r4 = 0; r4 < 4; r4++) {
          float sq = 0.f;
#pragma unroll
          for (int j = 0; j < 2; j++) {
            float a = acc[i][j][rq * 4 + r4], b = acc[i][j + 2][rq * 4 + r4];
            float o = a / (1.f + __expf(-b));
            const int col = (tn * 2 + wn) * 64 + j * 32 + l32;
            p->outg[(size_t)(row0 + r4) * 512 + col] = f2bf(o);
            sq += o * o;
          }
#pragma unroll
          for (int o = 16; o; o >>= 1) sq += __shfl_xor(sq, o);
          if (l32 == 0) ssq[row0 + r4] = sq;
        }
      }
  } else if (MODE == G_WOUT || MODE == G_DOWN) {
    float* ssq = p->ss + ((size_t)(MODE == G_WOUT ? 2 * layer + 1 : 2 * layer + 2) * 8 + tn * 2 + wn) * NTOK;
#pragma unroll
    for (int i = 0; i < 4; i++)
#pragma unroll
      for (int rq = 0; rq < 4; rq++) {
        const int row0 = rowbase + wm * 128 + i * 32 + rq * 8 + g * 4;
#pragma unroll
        for (int r4 = 0; r4 < 4; r4++) {
          float sq = 0.f;
#pragma unroll
          for (int j = 0; j < 4; j++) {
            const int col = tn * 256 + wn * 128 + j * 32 + l32;
            const size_t idx = (size_t)(row0 + r4) * 1024 + col;
            float xn = p->xf[idx] + acc[i][j][rq * 4 + r4];
            p->xf[idx] = xn;
            p->xb[idx] = f2bf(xn);
            sq += xn * xn;
          }
#pragma unroll
          for (int o = 16; o; o >>= 1) sq += __shfl_xor(sq, o);
          if (l32 == 0) ssq[row0 + r4] = sq;
        }
      }
  } else {
#pragma unroll
    for (int i = 0; i < 4; i++)
#pragma unroll
      for (int j = 0; j < 4; j++)
#pragma unroll
        for (int r = 0; r < 16; r++) {
          const int lr = wm * 128 + i * 32 + (r >> 2) * 8 + g * 4 + (r & 3);
          const int pc = wn * 128 + j * 32 + l32;
          *(bf16_t*)(smem + lr * 528 + pc * 2) = f2bf(acc[i][j][r]);
        }
    {
      float* rs = (float*)(smem + 135168);
      const int tb = 254 * upti - 2 + tid;
      float sc = 0.f;
      if (tb >= 0) {
        const int gr = min(upb * SEQL + tb, NTOK - 1);
        sc = rsqrtf(ss_sum1(p->ss + (size_t)(2 * layer + 1) * 8 * NTOK, gr) * (1.f / 1024.f) + EPS);
      }
      rs[tid] = sc;
    }
    __syncthreads();
    {
      const int cp = tid & 127, half = tid >> 7;
      const int pg = (cp >> 6) * 128 + (cp & 63), pv = pg + 64;
      const int ocol = tn * 128 + cp;
      const float* wc = p->w_conv + (size_t)layer * 3 * 5632;
      const float* bc = p->b_conv + (size_t)layer * 5632;
      const float wg0 = wc[ocol], wg1 = wc[5632 + ocol], wg2 = wc[2 * 5632 + ocol], bg = bc[ocol];
      const float wv0 = wc[FFN + ocol], wv1 = wc[5632 + FFN + ocol], wv2 = wc[2 * 5632 + FFN + ocol], bv = bc[FFN + ocol];
      const float* rs = (const float*)(smem + 135168);
      const int lr_lo = half ? 129 : 2, lr_hi = half ? 256 : 129;
      auto fetch = [&](int lr, float& gq, float& vq) {
        const float sc = rs[lr];
        gq = sc * bf2f(*(const bf16_t*)(smem + lr * 528 + pg * 2));
        vq = sc * bf2f(*(const bf16_t*)(smem + lr * 528 + pv * 2));
      };
      float g0, v0, g1, v1, g2, v2;
      fetch(lr_lo - 2, g0, v0);
      fetch(lr_lo - 1, g1, v1);
      for (int lr = lr_lo; lr < lr_hi; lr++) {
        fetch(lr, g2, v2);
        const int tb = 254 * upti - 2 + lr;
        if (tb < SEQL) {
          float gate = bg + wg0 * g0 + wg1 * g1 + wg2 * g2;
          float val = bv + wv0 * v0 + wv1 * v1 + wv2 * v2;
          float o = gate / (1.f + __expf(-gate)) * val;
          p->act[(size_t)(upb * SEQL + tb) * FFN + ocol] = f2bf(o);
        }
        g0 = g1; v0 = v1; g1 = g2; v1 = v2;
      }
    }
    __syncthreads();
  }
  }
}

__device__ __forceinline__ void attn_item(KP p, int layer, int b, int h, int qt, float lam, float outscale, char* smem, const int tid) {
  const int lane = tid & 63, w = tid >> 6, g = lane >> 5, l32 = lane & 31;
  const int tok_q = b * SEQL + qt * 128 + w * 32 + l32;
  {
    const int qrow = tid >> 4, qc = tid & 15;
#pragma unroll
    for (int i = 0; i < 8; i++) {
      const int row = qrow + 16 * i;
      u32x4 v = *(const u32x4*)(p->q + (size_t)(b * SEQL + qt * 128 + row) * 512 + h * 128 + qc * 8);
      *(u32x4*)(smem + 65536 + row * 256 + ((qc ^ (row & 15)) << 4)) = v;
    }
  }
  const int q_off = 65536 + (w * 32 + l32) * 256;
  const int q_swz = (l32 & 15);

  const int NT = 2 * qt + 2;
  const int nkt = 2 * qt + 1 + (w >> 1);
  f32x16 O[2][4];
#pragma unroll
  for (int c = 0; c < 2; c++)
#pragma unroll
    for (int dt = 0; dt < 4; dt++)
#pragma unroll
      for (int r = 0; r < 16; r++) O[c][dt][r] = 0.f;
  float mrun[2] = {-1e30f, -1e30f}, lrun[2] = {0.f, 0.f};
  const float c1 = 0.125f * 1.4426950408889634f;

  u32x4 rk[4], rv[4];
  const bf16_t* kbase = p->k + (size_t)(b * SEQL) * 512 + h * 128;
  const bf16_t* vbase = p->vt + (size_t)((b * 4 + h) * 128) * SEQL;
  const int kkey = tid >> 4, kc = tid & 15;
  const int vd = tid >> 3, vc = tid & 7;
  auto gload = [&](int kt) {
#pragma unroll
    for (int i = 0; i < 4; i++) {
      rk[i] = *(const u32x4*)(kbase + (size_t)(kt * 64 + kkey + 16 * i) * 512 + kc * 8);
      rv[i] = *(const u32x4*)(vbase + (size_t)(vd + 32 * i) * SEQL + kt * 64 + vc * 8);
    }
  };
  const int kw_off = kkey * 256 + ((kc ^ (kkey & 15)) << 4);
  const int vw_off = 16384 + vd * 128 + ((vc ^ ((vd >> 1) & 7)) << 4);
  auto lwrite = [&](int st) {
    char* s = smem + st * 32768;
#pragma unroll
    for (int i = 0; i < 4; i++) {
      *(u32x4*)(s + kw_off + i * 4096) = rk[i];
      *(u32x4*)(s + vw_off + i * 4096) = rv[i];
    }
  };

  gload(0);
  lwrite(0);
  __syncthreads();
  for (int kt = 0; kt < NT; kt++) {
    if (kt + 1 < NT) gload(kt + 1);
    if (kt < nkt) {
      const char* st = smem + (kt & 1) * 32768;
      bf16x8 pf[2][2][2];
      bf16x8 kf[8], qfr[4], vf[2][4];
      f32x16 S[1][2];
      auto loadkq = [&](int c) {
#pragma unroll
        for (int kb = 0; kb < 2; kb++)
#pragma unroll
          for (int ks = 0; ks < 4; ks++) {
            const int key = kb * 32 + l32, chunk = c * 8 + ks * 2 + g;
            kf[kb * 4 + ks] = *(const bf16x8*)(st + key * 256 + ((chunk ^ (key & 15)) << 4));
          }
#pragma unroll
        for (int ks = 0; ks < 4; ks++) qfr[ks] = *(const bf16x8*)(smem + q_off + (((c * 8 + ks * 2 + g) ^ q_swz) << 4));
      };
      auto qk = [&](int c) {
#pragma unroll
        for (int kb = 0; kb < 2; kb++) {
#pragma unroll
          for (int r = 0; r < 16; r++) S[0][kb][r] = 0.f;
#pragma unroll
          for (int ks = 0; ks < 4; ks++) S[0][kb] = MFMA(kf[kb * 4 + ks], qfr[ks], S[0][kb]);
        }
      };
      auto loadv = [&](int bi) {
#pragma unroll
        for (int dt = 0; dt < 4; dt++) {
          const int d = dt * 32 + l32, chunk = bi * 2 + g;
          vf[bi & 1][dt] = *(const bf16x8*)(st + 16384 + d * 128 + ((chunk ^ ((d >> 1) & 7)) << 4));
        }
      };
      auto softmax = [&](int c) {
        float mx = S[0][0][0];
#pragma unroll
        for (int r = 1; r < 16; r++) mx = fmaxf(mx, S[0][0][r]);
#pragma unroll
        for (int r = 0; r < 16; r++) mx = fmaxf(mx, S[0][1][r]);
        mx = fmaxf(mx, __shfl_xor(mx, 32));
        const float mnew = fmaxf(mrun[c], mx * c1);
        const float alpha = fast_exp2(mrun[c] - mnew);
        mrun[c] = mnew;
        float psum = 0.f;
#pragma unroll
        for (int kb = 0; kb < 2; kb++)
#pragma unroll
          for (int r = 0; r < 16; r++) {
            float e = fast_exp2(S[0][kb][r] * c1 - mnew);
            S[0][kb][r] = e;
            psum += e;
          }
        lrun[c] = lrun[c] * alpha + psum;
        if (__any(alpha != 1.f)) {
#pragma unroll
          for (int dt = 0; dt < 4; dt++)
#pragma unroll
            for (int r = 0; r < 16; r++) O[c][dt][r] *= alpha;
        }
#pragma unroll
        for (int kb = 0; kb < 2; kb++)
#pragma unroll
          for (int m = 0; m < 2; m++) {
            u32x4 pk = {pack_bf2(S[0][kb][8 * m + 0], S[0][kb][8 * m + 1]), pack_bf2(S[0][kb][8 * m + 2], S[0][kb][8 * m + 3]),
                        pack_bf2(S[0][kb][8 * m + 4], S[0][kb][8 * m + 5]), pack_bf2(S[0][kb][8 * m + 6], S[0][kb][8 * m + 7])};
            pf[c][kb][m] = __builtin_bit_cast(bf16x8, pk);
          }
      };
      loadkq(0);
      __builtin_amdgcn_sched_barrier(0);
      qk(0);
      __builtin_amdgcn_sched_barrier(0);
      loadkq(1);
      __builtin_amdgcn_sched_barrier(0);
      softmax(0);
      __builtin_amdgcn_sched_barrier(0);
      qk(1);
      loadv(0);
      __builtin_amdgcn_sched_barrier(0);
      softmax(1);
      __builtin_amdgcn_sched_barrier(0);
#pragma unroll
      for (int bi = 0; bi < 4; bi++) {
        if (bi < 3) loadv(bi + 1);
#pragma unroll
        for (int dt = 0; dt < 4; dt++) {
          O[0][dt] = MFMA(vf[bi & 1][dt], pf[0][bi >> 1][bi & 1], O[0][dt]);
          O[1][dt] = MFMA(vf[bi & 1][dt], pf[1][bi >> 1][bi & 1], O[1][dt]);
        }
        __builtin_amdgcn_sched_barrier(0);
      }
    }
    if (kt + 1 < NT) lwrite((kt + 1) & 1);
    __syncthreads();
  }

  const float l1 = lrun[0] + __shfl_xor(lrun[0], 32);
  const float l2 = lrun[1] + __shfl_xor(lrun[1], 32);
  const float i1 = 1.f / l1, i2 = lam / l2;
  float ssq = 0.f;
#pragma unroll
  for (int dt = 0; dt < 4; dt++)
#pragma unroll
    for (int r = 0; r < 16; r++) {
      float o = O[0][dt][r] * i1 - O[1][dt][r] * i2;
      O[0][dt][r] = o;
      ssq += o * o;
    }
  ssq += __shfl_xor(ssq, 32);
  const float rstd = rsqrtf(ssq * (1.f / 128.f) + EPS) * outscale;
  const float* gsub = p->subln + layer * 128;
#pragma unroll
  for (int dt = 0; dt < 4; dt++)
#pragma unroll
    for (int rq = 0; rq < 4; rq++) {
      const int d0 = dt * 32 + rq * 8 + g * 4;
      float4 gg = *(const float4*)(gsub + d0);
      u32x2 pk = {pack_bf2(O[0][dt][rq * 4 + 0] * rstd * gg.x, O[0][dt][rq * 4 + 1] * rstd * gg.y),
                  pack_bf2(O[0][dt][rq * 4 + 2] * rstd * gg.z, O[0][dt][rq * 4 + 3] * rstd * gg.w)};
      *(u32x2*)(p->att + (size_t)tok_q * 512 + h * 128 + d0) = pk;
    }
}

DI void s5_load_u(KP p, int b, int g, int j, int lane, float* ul) {
  const float4* src = (const float4*)(p->u + (size_t)(b * SEQL + j * 64 + lane) * 512 + g * 16);
  float4 v0 = src[0], v1 = src[1], v2 = src[2], v3 = src[3];
  float4* d = (float4*)(ul + lane * 16);
  d[0] = v0; d[1] = v1; d[2] = v2; d[3] = v3;
}

#define S5_BU(ul, t, bur, bui)                                              \
  {                                                                         \
    const float4* up_ = (const float4*)((ul) + (t) * 16);                   \
    float4 q0 = up_[0], q1 = up_[1], q2 = up_[2], q3 = up_[3];              \
    float uu[16] = {q0.x, q0.y, q0.z, q0.w, q1.x, q1.y, q1.z, q1.w, q2.x, q2.y, q2.z, q2.w, q3.x, q3.y, q3.z, q3.w}; \
    bur = 0.f; bui = 0.f;                                                   \
    _Pragma("unroll") for (int c_ = 0; c_ < 16; c_++) { bur += Bre[c_] * uu[c_]; bui += Bim[c_] * uu[c_]; } \
  }

__device__ __forceinline__ void s5_pass1(KP p, int layer, char* smem, const int tid) {
  const int lane = tid & 63, w = tid >> 6;
  float* ul = (float*)(smem + w * 4096);
  for (int base = blockIdx.x * 4; base < 8192; base += gridDim.x * 4) {
    const int item = base + w;
    const int j = item & 127, g = (item >> 7) & 31, b = item >> 12;
    s5_load_u(p, b, g, j, lane, ul);
    const float* tb = p->s5tab + (size_t)((layer * 32 + g) * 64 + lane) * 40;
    const float ar = tb[0], ai = tb[1];
    float Bre[16], Bim[16];
#pragma unroll
    for (int c = 0; c < 16; c++) { Bre[c] = tb[4 + c]; Bim[c] = tb[20 + c]; }
    __syncthreads();
    float xr = 0.f, xi = 0.f;
#pragma unroll 4
    for (int t = 0; t < 64; t++) {
      float bur, bui;
      S5_BU(ul, t, bur, bui);
      const float nr = ar * xr - ai * xi + bur;
      const float ni = ar * xi + ai * xr + bui;
      xr = nr; xi = ni;
    }
    float* so = p->sloc + (size_t)((b * 32 + g) * 128 + j) * 128;
    so[lane] = xr; so[64 + lane] = xi;
    __syncthreads();
  }
}

__device__ __forceinline__ void s5_pass2(KP p, int layer, char* smem, const int tid) {
  const int lane = tid & 63, w = tid >> 6;
  float* ul = (float*)(smem + w * 29696);
  float* X = ul + 1024;
  float* Cl = X + 32 * 129 + 32;
  const int t32 = lane & 31, hc = lane >> 5;
  for (int wbase = blockIdx.x * 4; wbase < 1024; wbase += gridDim.x * 4) {
   const int wi = wbase + w;
   const int j0 = (wi & 15) * 8, g = (wi >> 4) & 31, b = wi >> 9;
   const float* tb = p->s5tab + (size_t)((layer * 32 + g) * 64 + lane) * 40;
   const float ar = tb[0], ai = tb[1], aTr = tb[2], aTi = tb[3];
   float Bre[16], Bim[16];
#pragma unroll
   for (int c = 0; c < 16; c++) { Bre[c] = tb[4 + c]; Bim[c] = tb[20 + c]; }
   {
     const float* cr = p->c_re + (size_t)((layer * 32 + g) * 16) * 64;
     const float* ci = p->c_im + (size_t)((layer * 32 + g) * 16) * 64;
#pragma unroll
     for (int c = 0; c < 16; c++) {
       Cl[lane * 32 + (c >> 3) * 16 + (c & 7)] = cr[c * 64 + lane];
       Cl[lane * 32 + (c >> 3) * 16 + 8 + (c & 7)] = ci[c * 64 + lane];
     }
   }
   float dd[8];
   {
     const float* dp = p->ssm_d + (size_t)(layer * 32 + g) * 16 + hc * 8;
#pragma unroll
     for (int i = 0; i < 8; i++) dd[i] = dp[i];
   }
   float xr = 0.f, xi = 0.f;
   {
     const float* sl = p->sloc + (size_t)((b * 32 + g) * 128) * 128;
     for (int i0 = 0; i0 < j0; i0 += 8) {
       float sr[8], si[8];
#pragma unroll
       for (int q = 0; q < 8; q++) { sr[q] = sl[(i0 + q) * 128 + lane]; si[q] = sl[(i0 + q) * 128 + 64 + lane]; }
#pragma unroll
       for (int q = 0; q < 8; q++) {
         const float nr = aTr * xr - aTi * xi + sr[q];
         const float ni = aTr * xi + aTi * xr + si[q];
         xr = nr; xi = ni;
       }
     }
   }
   for (int jj = 0; jj < 8; jj++) {
    const int j = j0 + jj;
    s5_load_u(p, b, g, j, lane, ul);
    __syncthreads();
    for (int sub = 0; sub < 2; sub++) {
#pragma unroll 4
      for (int t = 0; t < 32; t++) {
        float bur, bui;
        S5_BU(ul, sub * 32 + t, bur, bui);
        const float nr = ar * xr - ai * xi + bur;
        const float ni = ar * xi + ai * xr + bui;
        xr = nr; xi = ni;
        X[t * 129 + lane] = xr;
        X[t * 129 + 64 + lane] = xi;
      }
      __syncthreads();
      float y[8];
#pragma unroll
      for (int i = 0; i < 8; i++) y[i] = 0.f;
#pragma unroll 4
      for (int pp = 0; pp < 64; pp++) {
        const float sxr = X[t32 * 129 + pp], sxi = X[t32 * 129 + 64 + pp];
        const float4* cp = (const float4*)(Cl + pp * 32 + hc * 16);
        float4 c0 = cp[0], c1 = cp[1], c2 = cp[2], c3 = cp[3];
        y[0] += c0.x * sxr - c2.x * sxi; y[1] += c0.y * sxr - c2.y * sxi;
        y[2] += c0.z * sxr - c2.z * sxi; y[3] += c0.w * sxr - c2.w * sxi;
        y[4] += c1.x * sxr - c3.x * sxi; y[5] += c1.y * sxr - c3.y * sxi;
        y[6] += c1.z * sxr - c3.z * sxi; y[7] += c1.w * sxr - c3.w * sxi;
      }
      const int tl = sub * 32 + t32;
      unsigned pk[4];
#pragma unroll
      for (int i = 0; i < 4; i++) {
        float a0 = y[2 * i] + dd[2 * i] * ul[tl * 16 + hc * 8 + 2 * i];
        float a1 = y[2 * i + 1] + dd[2 * i + 1] * ul[tl * 16 + hc * 8 + 2 * i + 1];
        pk[i] = pack_bf2(gelu_tanh(a0), gelu_tanh(a1));
      }
      u32x4 o = {pk[0], pk[1], pk[2], pk[3]};
      *(u32x4*)(p->gy + (size_t)(b * SEQL + j * 64 + tl) * 512 + g * 16 + hc * 8) = o;
      __syncthreads();
    }
   }
  }
}

__device__ __forceinline__ void phase_attn(KP p, int layer, char* smem, const int tid) {
  const int lane = tid & 63;
  const float s1 = wave_sum(p->lq1[layer * 64 + lane] * p->lk1[layer * 64 + lane]);
  const float s2 = wave_sum(p->lq2[layer * 64 + lane] * p->lk2[layer * 64 + lane]);
  const float lam_init = 0.8f - 0.6f * expf(-0.3f * (float)layer);
  const float lam = expf(s1) - expf(s2) + lam_init;
  for (int pb = blockIdx.x; pb < 256; pb += gridDim.x) {
    const int pi = (pb & 7) * 32 + (pb >> 3);
    const int b = pi >> 7, h = (pi >> 5) & 3, i = pi & 31;
    attn_item(p, layer, b, h, 63 - i, lam, 1.f - lam_init, smem, tid);
    attn_item(p, layer, b, h, i, lam, 1.f - lam_init, smem, tid);
  }
  s5_pass1(p, layer, smem, tid);
}

__device__ __forceinline__ void phase_final(KP p, const int tid) {
  const int wave = tid >> 6, lane = tid & 63;
  const float* ssq = p->ss + (size_t)8 * 8 * NTOK;
  for (int row = blockIdx.x * 4 + wave; row < NTOK; row += gridDim.x * 4) {
    const float rstd = rsqrtf(ss_sum1(ssq, row) * (1.f / 1024.f) + EPS);
#pragma unroll
    for (int i = 0; i < 4; i++) {
      float4 v = ((const float4*)(p->xf + (size_t)row * DM))[lane + 64 * i];
      float4 gq = ((const float4*)p->norm_final)[lane + 64 * i];
      float4 o = {v.x * rstd * gq.x, v.y * rstd * gq.y, v.z * rstd * gq.z, v.w * rstd * gq.w};
      ((float4*)(p->out + (size_t)row * DM))[lane + 64 * i] = o;
    }
  }
}

__device__ __forceinline__ void run_phase(KP p, int ph, char* smem) {
  const int tid = opaque_tid();
  if (ph == 0) { phase_prep(p, smem, tid); return; }
  if (ph == 29) { phase_final(p, tid); return; }
  const int layer = (ph - 1) / 7, k = (ph - 1) % 7;
  const int nb = gridDim.x, bid = blockIdx.x;
  if (k == 1) { phase_attn(p, layer, smem, tid); return; }
  if (k == 2) { s5_pass2(p, layer, smem, tid); return; }
  if (k == 0) { for (int r = 0; ; r++) { const int t = (r * 8 + (bid & 7)) * (nb >> 3) + (bid >> 3); if (r * nb >= 512) break; if (t < 512) gemm_tile(p, G_IN, layer, t, smem, tid); } }
  else if (k == 3) { for (int r = 0; ; r++) { const int t = (r * 8 + (bid & 7)) * (nb >> 3) + (bid >> 3); if (r * nb >= 256) break; if (t < 256) gemm_tile(p, G_GLU, layer, t, smem, tid); } }
  else if (k == 4) { for (int r = 0; ; r++) { const int t = (r * 8 + (bid & 7)) * (nb >> 3) + (bid >> 3); if (r * nb >= 256) break; if (t < 256) gemm_tile(p, G_WOUT, layer, t, smem, tid); } }
  else if (k == 5) { for (int r = 0; ; r++) { const int t = (r * 8 + (bid & 7)) * (nb >> 3) + (bid >> 3); if (r * nb >= 2 * 33 * 22) break; if (t < 2 * 33 * 22) gemm_tile(p, G_UP, layer, t, smem, tid); } }
  else { for (int r = 0; ; r++) { const int t = (r * 8 + (bid & 7)) * (nb >> 3) + (bid >> 3); if (r * nb >= 256) break; if (t < 256) gemm_tile(p, G_DOWN, layer, t, smem, tid); } }
}

#define PHASE_KERNEL(name, body)                                                      \
  __global__ void __launch_bounds__(256) name(Params p_unused) {                      \
    extern __shared__ __attribute__((aligned(16))) char smem[];                       \
    KP p = (KP)__builtin_amdgcn_kernarg_segment_ptr();                                \
    const int tid = threadIdx.x, nb = gridDim.x, bid = blockIdx.x;                    \
    const int layer = (int)p->phase_lo;                                               \
    (void)nb; (void)bid; (void)layer;                                                 \
    body                                                                              \
  }
PHASE_KERNEL(k_prep, phase_prep(p, smem, tid);)
PHASE_KERNEL(k_gin, for (int r = 0; ; r++) { const int t = (r * 8 + (bid & 7)) * (nb >> 3) + (bid >> 3); if (r * nb >= 512) break; if (t < 512) gemm_tile(p, G_IN, layer, t, smem, tid); })
PHASE_KERNEL(k_attn, phase_attn(p, layer, smem, tid);)
PHASE_KERNEL(k_s5p2, s5_pass2(p, layer, smem, tid);)
PHASE_KERNEL(k_glu, for (int r = 0; ; r++) { const int t = (r * 8 + (bid & 7)) * (nb >> 3) + (bid >> 3); if (r * nb >= 256) break; if (t < 256) gemm_tile(p, G_GLU, layer, t, smem, tid); })
PHASE_KERNEL(k_wout, for (int r = 0; ; r++) { const int t = (r * 8 + (bid & 7)) * (nb >> 3) + (bid >> 3); if (r * nb >= 256) break; if (t < 256) gemm_tile(p, G_WOUT, layer, t, smem, tid); })
PHASE_KERNEL(k_up, for (int r = 0; ; r++) { const int t = (r * 8 + (bid & 7)) * (nb >> 3) + (bid >> 3); if (r * nb >= 2 * 33 * 22) break; if (t < 2 * 33 * 22) gemm_tile(p, G_UP, layer, t, smem, tid); })
PHASE_KERNEL(k_down, for (int r = 0; ; r++) { const int t = (r * 8 + (bid & 7)) * (nb >> 3) + (bid >> 3); if (r * nb >= 256) break; if (t < 256) gemm_tile(p, G_DOWN, layer, t, smem, tid); })
PHASE_KERNEL(k_final, phase_final(p, tid);)

#if COOP
__global__ void __launch_bounds__(256) mega_kernel(Params p_unused) {
  extern __shared__ __attribute__((aligned(16))) char smem[];
  KP p0 = (KP)__builtin_amdgcn_kernarg_segment_ptr();
  const int ph_lo = (int)p0->phase_lo, ph_hi = (int)p0->phase_hi;
#if COOP
  if (ph_hi > 1000) cg::this_grid().sync();
#endif
  for (int ph = ph_lo; ph < ph_hi; ph++) {
    KP p = p0;
    asm volatile("" : "+s"(p));
#if TPROBE
    if (blockIdx.x == 0) p->ts[ph] = (long long)wall_clock64();
#endif
    run_phase(p, ph, smem);
#if COOP
    if (ph + 1 < ph_hi) grid_barrier(p->bar, (unsigned)(ph + 1 - ph_lo) * gridDim.x, opaque_tid());
#endif
  }
#if TPROBE
  grid_barrier(p0->bar, (unsigned)(ph_hi - ph_lo) * gridDim.x, opaque_tid());
  if (blockIdx.x == 0) {
    KP p = p0;
    long long tend = (long long)wall_clock64();
    float a = 0.f, b = 0.f;
    for (int ph = 0; ph < 30; ph++) {
      long long t0 = p->ts[ph], t1 = (ph == 29) ? tend : p->ts[ph + 1];
      int c = (ph == 0) ? 0 : (ph == 29 ? 8 : 1 + (ph - 1) % 7);
      float d = (float)(t1 - t0) * 0.01f;
      if (c == TP_A || TP_A == 9) a += d;
      if (c == TP_B || TP_B == 9) b += d;
    }
    const int t = opaque_tid();
    if (t <= 100) p->out[t] += (t == 0) ? a : b;
  }
#endif
}

#endif

extern "C" void kernel_launch(void* const* d_in, const int* in_sizes, int n_in, void* d_out, int out_size, void* d_ws,
                              size_t ws_size, hipStream_t stream) {
  static int grid_blocks = 0;
  if (!grid_blocks) {
    int dev = 0, cus = 0, per_cu = 0;
    (void)hipGetDevice(&dev);
    (void)hipDeviceGetAttribute(&cus, hipDeviceAttributeMultiprocessorCount, dev);
#if COOP
    (void)hipFuncSetAttribute((const void*)mega_kernel, hipFuncAttributeMaxDynamicSharedMemorySize, LDS_BYTES);
    (void)hipOccupancyMaxActiveBlocksPerMultiprocessor(&per_cu, (const void*)mega_kernel, 256, LDS_BYTES);
    if (per_cu < 1) { fprintf(stderr, "occupancy query returned %d\n", per_cu); per_cu = 1; }
#endif
    grid_blocks = cus;
    (void)hipGetLastError();
  }
  Params p{};
  p.x = (const float*)d_in[0]; p.pos = (const int*)d_in[1];
  p.norm_mix = (const float*)d_in[2]; p.w_in = (const float*)d_in[3];
  p.lam_re = (const float*)d_in[4]; p.lam_im = (const float*)d_in[5]; p.log_step = (const float*)d_in[6];
  p.b_re = (const float*)d_in[7]; p.b_im = (const float*)d_in[8]; p.c_re = (const float*)d_in[9]; p.c_im = (const float*)d_in[10];
  p.ssm_d = (const float*)d_in[11]; p.w_glu = (const float*)d_in[12]; p.ssm_norm = (const float*)d_in[13];
  p.lq1 = (const float*)d_in[14]; p.lk1 = (const float*)d_in[15]; p.lq2 = (const float*)d_in[16]; p.lk2 = (const float*)d_in[17];
  p.subln = (const float*)d_in[18]; p.w_out = (const float*)d_in[19]; p.norm_ffn = (const float*)d_in[20];
  p.w_up = (const float*)d_in[21]; p.w_conv = (const float*)d_in[22]; p.b_conv = (const float*)d_in[23];
  p.w_down = (const float*)d_in[24]; p.norm_final = (const float*)d_in[25];
  p.out = (float*)d_out;
  char* ws = (char*)d_ws;
  size_t off = 0;
  auto take = [&](size_t bytes) { char* r = ws + off; off += (bytes + 255) & ~(size_t)255; return r; };
  p.WinT = (bf16_t*)take((size_t)4 * 2048 * 1024 * 2);
  p.WgluT = (bf16_t*)take((size_t)4 * 1024 * 512 * 2);
  p.WoutT = (bf16_t*)take((size_t)4 * 1024 * 1024 * 2);
  p.WupT = (bf16_t*)take((size_t)4 * 5632 * 1024 * 2);
  p.WdownT = (bf16_t*)take((size_t)4 * 1024 * FFN * 2);
  p.xf = (float*)take((size_t)NTOK * DM * 4);
  p.xb = (bf16_t*)take((size_t)NTOK * DM * 2);
  p.ss = (float*)take((size_t)9 * 8 * NTOK * 4);
  p.ssm_ss = (float*)take((size_t)4 * 8 * NTOK * 4);
  p.cs = (float*)take((size_t)NTOK * 16 * 4);
  p.s5tab = (float*)take((size_t)4 * 32 * 64 * 40 * 4);
  p.sloc = (float*)take((size_t)2 * 32 * 128 * 128 * 4);
  p.ts = (long long*)take(256);
  p.bar = (unsigned*)take(256);
  char* region = take((size_t)134217728);
  p.u = (float*)region;
  p.q = (bf16_t*)(region + 33554432);
  p.k = p.q + (size_t)NTOK * 512;
  p.vt = p.k + (size_t)NTOK * 512;
  p.gy = p.vt + (size_t)NTOK * 512;
  p.outg = p.gy + (size_t)NTOK * 512;
  p.att = p.outg + (size_t)NTOK * 512;
  p.act = (bf16_t*)region;
  if (off > ws_size) { fprintf(stderr, "workspace too small: need %zu have %zu\n", off, ws_size); return; }
#if COOP
  p.phase_lo = 0; p.phase_hi = 30;
  if (hipMemsetAsync(p.bar, 0, 256, stream) != hipSuccess) fprintf(stderr, "barrier memset failed\n");
  void* args[] = {&p};
  hipError_t e = hipLaunchCooperativeKernel((const void*)mega_kernel, dim3(grid_blocks), dim3(256), args, LDS_BYTES, stream);
  if (e != hipSuccess) fprintf(stderr, "cooperative launch failed: %s (grid %d)\n", hipGetErrorString(e), grid_blocks);
#else
  typedef void (*kfn)(Params);
  const kfn seq[7] = {k_gin, k_attn, k_s5p2, k_glu, k_wout, k_up, k_down};
  static bool attr_done = false;
  if (!attr_done) {
    (void)hipFuncSetAttribute((const void*)k_prep, hipFuncAttributeMaxDynamicSharedMemorySize, LDS_BYTES);
    (void)hipFuncSetAttribute((const void*)k_final, hipFuncAttributeMaxDynamicSharedMemorySize, LDS_BYTES);
    for (int i = 0; i < 7; i++) (void)hipFuncSetAttribute((const void*)seq[i], hipFuncAttributeMaxDynamicSharedMemorySize, LDS_BYTES);
    attr_done = true;
  }
  p.phase_lo = 0; p.phase_hi = 0;
  hipLaunchKernelGGL(k_prep, dim3(grid_blocks), dim3(256), LDS_BYTES, stream, p);
  for (int layer = 0; layer < 4; layer++) {
    p.phase_lo = layer;
    for (int i = 0; i < 7; i++) hipLaunchKernelGGL(seq[i], dim3(grid_blocks), dim3(256), LDS_BYTES, stream, p);
  }
  hipLaunchKernelGGL(k_final, dim3(grid_blocks), dim3(256), LDS_BYTES, stream, p);
#endif
}
```

```cpp
#include <hip/hip_runtime.h>
#include <hip/hip_cooperative_groups.h>
#include <cstdio>
namespace cg = cooperative_groups;

#ifndef COOP
#define COOP 1
#endif
#ifndef TPROBE
#define TPROBE 0
#endif
#ifndef TP_A
#define TP_A 1
#endif
#ifndef TP_B
#define TP_B 2
#endif

typedef unsigned short bf16_t;
typedef __attribute__((ext_vector_type(8))) short bf16x8;
typedef __attribute__((ext_vector_type(16))) float f32x16;
typedef __attribute__((ext_vector_type(2))) __bf16 bf2_t;
typedef __attribute__((ext_vector_type(2))) float f2_t;
typedef __attribute__((ext_vector_type(4))) unsigned u32x4;
typedef __attribute__((ext_vector_type(2))) unsigned u32x2;

#define DI __device__ __forceinline__
#define MFMA(a, b, c) __builtin_amdgcn_mfma_f32_32x32x16_bf16((a), (b), (c), 0, 0, 0)

constexpr int NTOK = 16384, DM = 1024, SEQL = 8192, FFN = 2816;
constexpr int LDS_BYTES = 136192;
constexpr float EPS = 1e-6f;

struct Params {
  const float* x; const int* pos;
  const float *norm_mix, *w_in, *lam_re, *lam_im, *log_step, *b_re, *b_im, *c_re, *c_im, *ssm_d, *w_glu, *ssm_norm;
  const float *lq1, *lk1, *lq2, *lk2, *subln, *w_out, *norm_ffn, *w_up, *w_conv, *b_conv, *w_down, *norm_final;
  float* out;
  bf16_t *WinT, *WgluT, *WoutT, *WupT, *WdownT;
  float* xf; bf16_t* xb;
  float* u; bf16_t *q, *k, *vt, *gy, *outg, *att, *act;
  float *ss, *ssm_ss, *cs, *s5tab, *sloc;
  long long phase_lo, phase_hi;
  long long* ts;
  unsigned* bar;
};

typedef const __attribute__((address_space(4))) Params* KP;

DI unsigned pack_bf2(float a, float b) { f2_t v = {a, b}; return __builtin_bit_cast(unsigned, __builtin_convertvector(v, bf2_t)); }
DI bf16_t f2bf(float a) { return (bf16_t)(pack_bf2(a, 0.f) & 0xffffu); }
DI float bf2f(bf16_t v) { return __uint_as_float(((unsigned)v) << 16); }
DI void grid_barrier(unsigned* ctr, unsigned target, int tid) {
  asm volatile("s_waitcnt vmcnt(0)" ::: "memory");
  __syncthreads();
  if (tid == 0) {
    __builtin_amdgcn_fence(__ATOMIC_RELEASE, "agent");
    asm volatile("s_waitcnt vmcnt(0)" ::: "memory");
    __hip_atomic_fetch_add(ctr, 1u, __ATOMIC_RELAXED, __HIP_MEMORY_SCOPE_AGENT);
    while (__hip_atomic_load(ctr, __ATOMIC_RELAXED, __HIP_MEMORY_SCOPE_AGENT) < target) __builtin_amdgcn_s_sleep(1);
    __builtin_amdgcn_fence(__ATOMIC_ACQUIRE, "agent");
    asm volatile("s_waitcnt vmcnt(0)" ::: "memory");
  }
  __syncthreads();
}
DI int opaque_tid() { int t = threadIdx.x; asm volatile("" : "+v"(t)); return t; }
DI float4 ss_sum4(const float* base, int row0) {
  float4 a = *(const float4*)(base + row0);
#pragma unroll
  for (int pz = 1; pz < 8; pz++) {
    float4 b = *(const float4*)(base + (size_t)pz * NTOK + row0);
    a.x += b.x; a.y += b.y; a.z += b.z; a.w += b.w;
  }
  return a;
}
DI float ss_sum1(const float* base, int row) {
  float a = base[row];
#pragma unroll
  for (int pz = 1; pz < 8; pz++) a += base[(size_t)pz * NTOK + row];
  return a;
}
DI float wave_sum(float v) { for (int o = 32; o; o >>= 1) v += __shfl_xor(v, o); return v; }
DI float fast_exp2(float x) { return __builtin_amdgcn_exp2f(x); }
DI float gelu_tanh(float x) {
  float z = 0.7978845608028654f * (x + 0.044715f * x * x * x);
  float e = __expf(2.f * z);
  float t = 1.f - 2.f / (1.f + e);
  return 0.5f * x * (1.f + t);
}
DI float reduce_2pi(double a) {
  double n = rint(a * 0.15915494309189535);
  return (float)(a - n * 6.283185307179586);
}

DI void transpose_tile(const float* src, int ldsrc, int k0, int c0, const float* scale, int nscale,
                       bf16_t* dst, int lddst, int n0, float* lds, const int tid) {
#pragma unroll
  for (int i = 0; i < 16; i++) {
    int kk = i * 4 + (tid >> 6), nn = tid & 63;
    float v = src[(size_t)(k0 + kk) * ldsrc + c0 + nn];
    if (scale != nullptr && (k0 + kk) < nscale) v *= scale[k0 + kk];
    lds[kk * 65 + nn] = v;
  }
  __syncthreads();
  {
    int nn = tid >> 2, kq = (tid & 3) * 16;
    unsigned pk[8];
#pragma unroll
    for (int i = 0; i < 8; i++) pk[i] = pack_bf2(lds[(kq + 2 * i) * 65 + nn], lds[(kq + 2 * i + 1) * 65 + nn]);
    u32x4* d = (u32x4*)(dst + (size_t)(n0 + nn) * lddst + k0 + kq);
    u32x4 a = {pk[0], pk[1], pk[2], pk[3]}, b = {pk[4], pk[5], pk[6], pk[7]};
    d[0] = a; d[1] = b;
  }
  __syncthreads();
}

__device__ __forceinline__ void phase_prep(KP p, char* smem, const int tid) {
  const int nb = gridDim.x, bid = blockIdx.x;
  const int wave = tid >> 6, lane = tid & 63;
  for (int row = bid * 4 + wave; row < NTOK; row += nb * 4) {
    const float4* src = (const float4*)(p->x + (size_t)row * DM);
    float s = 0.f;
#pragma unroll
    for (int i = 0; i < 4; i++) {
      float4 v = src[lane + 64 * i];
      s += v.x * v.x + v.y * v.y + v.z * v.z + v.w * v.w;
      ((float4*)(p->xf + (size_t)row * DM))[lane + 64 * i] = v;
      u32x2 pk = {pack_bf2(v.x, v.y), pack_bf2(v.z, v.w)};
      ((u32x2*)(p->xb + (size_t)row * DM))[lane + 64 * i] = pk;
    }
    s = wave_sum(s);
    if (lane < 8) p->ss[(size_t)lane * NTOK + row] = (lane == 0) ? s : 0.f;
  }
  for (int i = bid * 256 + tid; i < NTOK * 8; i += nb * 256) {
    int tok = i >> 3, j = i & 7;
    double inv = (j & 4) ? ((j & 2) ? ((j & 1) ? 1.031338537721246e-05 : 5.318295896944988e-05) : ((j & 1) ? 0.0002742481756762073 : 0.001414213562373095))
                         : ((j & 2) ? ((j & 1) ? 0.007292664737217109 : 0.03760603093086393) : ((j & 1) ? 0.19392274474868576 : 1.0));
    double ang = (double)p->pos[tok] * inv;
    float r = reduce_2pi(ang);
    p->cs[2 * i] = cosf(r); p->cs[2 * i + 1] = sinf(r);
  }
  for (int i = bid * 256 + tid; i < 4 * 32 * 64; i += nb * 256) {
    int lg = i >> 6;
    float lr = p->lam_re[i], li = p->lam_im[i];
    float step = expf(p->log_step[lg]);
    float mag = expf(step * lr);
    double angd = (double)step * (double)li;
    float r1 = reduce_2pi(angd);
    float ar = mag * cosf(r1), ai = mag * sinf(r1);
    float den = lr * lr + li * li;
    float fr = ((ar - 1.f) * lr + ai * li) / den;
    float fi = (ai * lr - (ar - 1.f) * li) / den;
    float magT = expf(64.f * step * lr);
    float rT = reduce_2pi(64.0 * angd);
    float* tb = p->s5tab + (size_t)i * 40;
    tb[0] = ar; tb[1] = ai; tb[2] = magT * cosf(rT); tb[3] = magT * sinf(rT);
    for (int c = 0; c < 16; c++) {
      float br = p->b_re[(size_t)i * 16 + c], bi = p->b_im[(size_t)i * 16 + c];
      tb[4 + c] = fr * br - fi * bi;
      tb[20 + c] = fr * bi + fi * br;
    }
  }
  float* lds = (float*)smem;
  for (int job = bid; job < 4 * 3008; job += nb) {
    int layer = job / 3008, t = job % 3008;
    if (t < 512) {
      int a = t >> 4, kt = t & 15;
      transpose_tile(p->w_in + (size_t)layer * 1024 * 2048, 2048, kt * 64, a * 64, p->norm_mix + layer * 1024, 1024,
                     p->WinT + (size_t)layer * 2048 * 1024, 1024, a * 64, lds, tid);
    } else if (t < 640) {
      t -= 512; int a = t >> 3, kt = t & 7;
      transpose_tile(p->w_glu + (size_t)layer * 512 * 1024, 1024, kt * 64, (a & 1) * 512 + (a >> 1) * 64, nullptr, 0,
                     p->WgluT + (size_t)layer * 1024 * 512, 512, a * 64, lds, tid);
    } else if (t < 896) {
      t -= 640; int a = t >> 4, kt = t & 15;
      transpose_tile(p->w_out + (size_t)layer * 1024 * 1024, 1024, kt * 64, a * 64, p->ssm_norm + layer * 512, 512,
                     p->WoutT + (size_t)layer * 1024 * 1024, 1024, a * 64, lds, tid);
    } else if (t < 2304) {
      t -= 896; int a = t >> 4, kt = t & 15;
      transpose_tile(p->w_up + (size_t)layer * 1024 * 5632, 5632, kt * 64, (a & 1) * FFN + (a >> 1) * 64, p->norm_ffn + layer * 1024, 1024,
                     p->WupT + (size_t)layer * 5632 * 1024, 1024, a * 64, lds, tid);
    } else {
      t -= 2304; int a = t / 44, kt = t % 44;
      transpose_tile(p->w_down + (size_t)layer * FFN * 1024, 1024, kt * 64, a * 64, nullptr, 0,
                     p->WdownT + (size_t)layer * 1024 * FFN, FFN, a * 64, lds, tid);
    }
  }
}

enum { G_IN = 0, G_GLU = 1, G_WOUT = 2, G_UP = 3, G_DOWN = 4 };
#define ACC_PIN(tag) _Pragma("unroll") for (int i_ = 0; i_ < 4; i_++) _Pragma("unroll") for (int j_ = 0; j_ < 4; j_++) asm volatile("; pin " tag : "+a"(acc[i_][j_]));


__device__ __forceinline__ void gemm_tile(KP p, const int MODE, int layer, int tile, char* smem, const int tid) {
  const int lane = tid & 63, w = tid >> 6, wm = w >> 1, wn = w & 1, g = lane >> 5, l32 = lane & 31;
  int tn, KT, ldb, rowbase, lda;
  const bf16_t* Bt;
  const bf16_t* A0;
  int upb = 0, upti = 0;
  {
    const int TM = (MODE == G_UP) ? 66 : 64;
    const int TN = (MODE == G_IN) ? 8 : (MODE == G_UP ? 22 : 4);
    const int nfull = TN >> 2, rem = TN & 3;
    int tm;
    if (tile < nfull * 4 * TM) { const int band = tile / (4 * TM), within = tile % (4 * TM); tm = within >> 2; tn = band * 4 + (within & 3); }
    else { const int s2 = tile - nfull * 4 * TM; tm = s2 / rem; tn = nfull * 4 + s2 % rem; }
    rowbase = tm * 256;
    if (MODE == G_UP) { upb = tm / 33; upti = tm % 33; rowbase = upb * SEQL + 254 * upti - 2; }
  }
  if (MODE == G_IN) { KT = 16; ldb = 1024; Bt = p->WinT + (size_t)layer * 2048 * 1024; A0 = p->xb; lda = 1024; }
  else if (MODE == G_GLU) { KT = 8; ldb = 512; Bt = p->WgluT + (size_t)layer * 1024 * 512; A0 = p->gy; lda = 512; }
  else if (MODE == G_WOUT) { KT = 16; ldb = 1024; Bt = p->WoutT + (size_t)layer * 1024 * 1024; A0 = p->outg; lda = 512; }
  else if (MODE == G_UP) { KT = 16; ldb = 1024; Bt = p->WupT + (size_t)layer * 5632 * 1024; A0 = p->xb; lda = 1024; }
  else { KT = 44; ldb = FFN; Bt = p->WdownT + (size_t)layer * 1024 * FFN; A0 = p->act; lda = FFN; }

  u32x4 ra[8], rb[8];
  const int lrow = tid >> 3, lc = tid & 7;
  float arow_sc[8];
#pragma unroll
  for (int i = 0; i < 8; i++) arow_sc[i] = 1.f;
  if (MODE == G_WOUT) {
    const float* ssq = p->ssm_ss + (size_t)layer * 8 * NTOK;
#pragma unroll
    for (int i = 0; i < 8; i++) arow_sc[i] = rsqrtf(ss_sum1(ssq, rowbase + lrow + 32 * i) * (1.f / 512.f) + EPS);
  }
  const bf16_t* bptr = Bt + (size_t)(tn * 256 + lrow) * ldb + lc * 8;
  auto gload = [&](int kt) {
    const bf16_t* abase = A0;
    int kofs = kt * 64;
    if (MODE == G_WOUT && kt >= 8) { abase = p->att; kofs = (kt - 8) * 64; }
#pragma unroll
    for (int i = 0; i < 8; i++) {
      int gr = min(max(rowbase + lrow + 32 * i, 0), NTOK - 1);
      ra[i] = *(const u32x4*)(abase + (size_t)gr * lda + kofs + lc * 8);
      rb[i] = *(const u32x4*)(bptr + (size_t)(32 * i) * ldb + kt * 64);
    }
  };
  auto scaleA = [&](int kt) {
    if (MODE == G_WOUT && kt < 8) {
#pragma unroll
      for (int i = 0; i < 8; i++)
#pragma unroll
        for (int e = 0; e < 4; e++) {
          unsigned v = ra[i][e];
          float lo = __uint_as_float(v << 16) * arow_sc[i], hi = __uint_as_float(v & 0xffff0000u) * arow_sc[i];
          ra[i][e] = pack_bf2(lo, hi);
        }
    }
  };
  const int wr_off = lrow * 128 + ((lc ^ ((lrow >> 1) & 7)) << 4);
  auto lwriteA = [&](int st) {
    char* sa = smem + st * 65536;
#pragma unroll
    for (int i = 0; i < 8; i++) *(u32x4*)(sa + wr_off + i * 4096) = ra[i];
  };
  auto lwriteB = [&](int st) {
    char* sb = smem + st * 65536 + 32768;
#pragma unroll
    for (int i = 0; i < 8; i++) *(u32x4*)(sb + wr_off + i * 4096) = rb[i];
  };

  f32x16 acc[4][4];
#pragma unroll
  for (int i = 0; i < 4; i++)
#pragma unroll
    for (int j = 0; j < 4; j++)
#pragma unroll
      for (int r = 0; r < 16; r++) acc[i][j][r] = 0.f;

  const int swz = (l32 >> 1) & 7;
  const int a_base = (wm * 128 + l32) * 128;
  const int b_base = 32768 + (wn * 128 + l32) * 128;
  bf16x8 af[2][4], bfr[2][4];
  auto lfrag = [&](int buf, const char* st, int ks) {
    const int coff = (((ks * 2 + g) ^ swz) << 4);
#pragma unroll
    for (int i = 0; i < 4; i++) af[buf][i] = *(const bf16x8*)(st + a_base + i * 4096 + coff);
#pragma unroll
    for (int j = 0; j < 4; j++) bfr[buf][j] = *(const bf16x8*)(st + b_base + j * 4096 + coff);
  };
  auto mfma16 = [&](int buf) {
#pragma unroll
    for (int i = 0; i < 4; i++)
#pragma unroll
      for (int j = 0; j < 4; j++) acc[i][j] = MFMA(af[buf][i], bfr[buf][j], acc[i][j]);
  };

  gload(0);
  scaleA(0);
  lwriteA(0);
  lwriteB(0);
  __syncthreads();
  if (KT > 1) gload(1);
  lfrag(0, smem, 0);
  for (int kt = 0; kt < KT; kt++) {
    const char* st = smem + (kt & 1) * 65536;
    const bool has1 = (kt + 1 < KT), has2 = (kt + 2 < KT);
    lfrag(1, st, 1);
    if (has1) { scaleA(kt + 1); lwriteA((kt + 1) & 1); }
    mfma16(0);
    __builtin_amdgcn_sched_barrier(0);
    lfrag(0, st, 2);
    if (has1) lwriteB((kt + 1) & 1);
    mfma16(1);
    __builtin_amdgcn_sched_barrier(0);
    lfrag(1, st, 3);
    if (has2) gload(kt + 2);
    mfma16(0);
    __builtin_amdgcn_sched_barrier(0);
    asm volatile("s_waitcnt lgkmcnt(0)" ::: "memory");
    __builtin_amdgcn_s_barrier();
    __builtin_amdgcn_sched_barrier(0);
    if (has1) lfrag(0, smem + ((kt + 1) & 1) * 65536, 0);
    mfma16(1);
    __builtin_amdgcn_sched_barrier(0);
  }

  int tid2 = tid;
  asm volatile("" : "+v"(tid2));
  {
  const int tid = tid2;
  const int lane = tid & 63, w = tid >> 6, wm = w >> 1, wn = w & 1, g = lane >> 5, l32 = lane & 31;
  if (MODE == G_IN) {
    const float* ssq = p->ss + (size_t)(2 * layer) * 8 * NTOK;
    const int region = tn >> 1;
    const int colb = (tn & 1) * 256 + wn * 128 + l32;
    bf16_t* dst = (region == 1) ? p->q : p->k;
#pragma unroll
    for (int i = 0; i < 4; i++)
#pragma unroll
      for (int rq = 0; rq < 4; rq++) {
        const int row0 = rowbase + wm * 128 + i * 32 + rq * 8 + g * 4;
        float4 s4 = ss_sum4(ssq, row0);
        float sc[4] = {rsqrtf(s4.x * (1.f / 1024.f) + EPS), rsqrtf(s4.y * (1.f / 1024.f) + EPS),
                       rsqrtf(s4.z * (1.f / 1024.f) + EPS), rsqrtf(s4.w * (1.f / 1024.f) + EPS)};
#pragma unroll
        for (int j = 0; j < 4; j++) {
          const int col = colb + j * 32;
          float v[4];
#pragma unroll
          for (int r4 = 0; r4 < 4; r4++) v[r4] = acc[i][j][rq * 4 + r4] * sc[r4];
          if (region == 0) {
#pragma unroll
            for (int r4 = 0; r4 < 4; r4++) p->u[(size_t)(row0 + r4) * 512 + col] = v[r4];
          } else if (region == 3) {
            const int h = col >> 7, d = col & 127;
            const int bb = row0 >> 13, t = row0 & (SEQL - 1);
            const int q4 = (t >> 2) & 3;
            const int pq = ((q4 & 1) << 1) | (q4 >> 1);
            u32x2 pk = {pack_bf2(v[0], v[1]), pack_bf2(v[2], v[3])};
            *(u32x2*)(p->vt + ((size_t)((bb * 4 + h) * 128 + d)) * SEQL + (t & ~15) + pq * 4) = pk;
          } else {
            if ((j & 1) == 0) {
              float other[4];
#pragma unroll
              for (int r4 = 0; r4 < 4; r4++) other[r4] = __shfl_xor(v[r4], 8);
              if (l32 < 16) {
                const float sgn = (l32 < 8) ? -1.f : 1.f;
#pragma unroll
                for (int r4 = 0; r4 < 4; r4++) {
                  const float2 csv = *(const float2*)(p->cs + ((size_t)(row0 + r4) * 8 + (l32 & 7)) * 2);
                  v[r4] = v[r4] * csv.x + sgn * other[r4] * csv.y;
                }
              }
            }
#pragma unroll
            for (int r4 = 0; r4 < 4; r4++) dst[(size_t)(row0 + r4) * 512 + col] = f2bf(v[r4]);
          }
        }
      }
  } else if (MODE == G_GLU) {
    float* ssq = p->ssm_ss + ((size_t)layer * 8 + tn * 2 + wn) * NTOK;
#pragma unroll
    for (int i = 0; i < 4; i++)
#pragma unroll
      for (int rq = 0; rq < 4; rq++) {
        const int row0 = rowbase + wm * 128 + i * 32 + rq * 8 + g * 4;
#pragma unroll
        for (int r4 = 0; r4 < 4; r4++) {
          float sq = 0.f;
#pragma unroll
          for (int j = 0; j < 2; j++) {
            float a = acc[i][j][rq * 4 + r4], b = acc[i][j + 2][rq * 4 + r4];
            float o = a / (1.f + __expf(-b));
            const int col = (tn * 2 + wn) * 64 + j * 32 + l32;
            p->outg[(size_t)(row0 + r4) * 512 + col] = f2bf(o);
            sq += o * o;
          }
#pragma unroll
          for (int o = 16; o; o >>= 1) sq += __shfl_xor(sq, o);
          if (l32 == 0) ssq[row0 + r4] = sq;
        }
      }
  } else if (MODE == G_WOUT || MODE == G_DOWN) {
    float* ssq = p->ss + ((size_t)(MODE == G_WOUT ? 2 * layer + 1 : 2 * layer + 2) * 8 + tn * 2 + wn) * NTOK;
#pragma unroll
    for (int i = 0; i < 4; i++)
#pragma unroll
      for (int rq = 0; rq < 4; rq++) {
        const int row0 = rowbase + wm * 128 + i * 32 + rq * 8 + g * 4;
#pragma unroll
        for (int r4 = 0; r4 < 4; r4++) {
          float sq = 0.f;
#pragma unroll
          for (int j = 0; j < 4; j++) {
            const int col = tn * 256 + wn * 128 + j * 32 + l32;
            const size_t idx = (size_t)(row0 + r4) * 1024 + col;
            float xn = p->xf[idx] + acc[i][j][rq * 4 + r4];
            p->xf[idx] = xn;
            p->xb[idx] = f2bf(xn);
            sq += xn * xn;
          }
#pragma unroll
          for (int o = 16; o; o >>= 1) sq += __shfl_xor(sq, o);
          if (l32 == 0) ssq[row0 + r4] = sq;
        }
      }
  } else {
#pragma unroll
    for (int i = 0; i < 4; i++)
#pragma unroll
      for (int j = 0; j < 4; j++)
#pragma unroll
        for (int r = 0; r < 16; r++) {
          const int lr = wm * 128 + i * 32 + (r >> 2) * 8 + g * 4 + (r & 3);
          const int pc = wn * 128 + j * 32 + l32;
          *(bf16_t*)(smem + lr * 528 + pc * 2) = f2bf(acc[i][j][r]);
        }
    {
      float* rs = (float*)(smem + 135168);
      const int tb = 254 * upti - 2 + tid;
      float sc = 0.f;
      if (tb >= 0) {
        const int gr = min(upb * SEQL + tb, NTOK - 1);
        sc = rsqrtf(ss_sum1(p->ss + (size_t)(2 * layer + 1) * 8 * NTOK, gr) * (1.f / 1024.f) + EPS);
      }
      rs[tid] = sc;
    }
    __syncthreads();
    {
      const int cp = tid & 127, half = tid >> 7;
      const int pg = (cp >> 6) * 128 + (cp & 63), pv = pg + 64;
      const int ocol = tn * 128 + cp;
      const float* wc = p->w_conv + (size_t)layer * 3 * 5632;
      const float* bc = p->b_conv + (size_t)layer * 5632;
      const float wg0 = wc[ocol], wg1 = wc[5632 + ocol], wg2 = wc[2 * 5632 + ocol], bg = bc[ocol];
      const float wv0 = wc[FFN + ocol], wv1 = wc[5632 + FFN + ocol], wv2 = wc[2 * 5632 + FFN + ocol], bv = bc[FFN + ocol];
      const float* rs = (const float*)(smem + 135168);
      const int lr_lo = half ? 129 : 2, lr_hi = half ? 256 : 129;
      auto fetch = [&](int lr, float& gq, float& vq) {
        const float sc = rs[lr];
        gq = sc * bf2f(*(const bf16_t*)(smem + lr * 528 + pg * 2));
        vq = sc * bf2f(*(const bf16_t*)(smem + lr * 528 + pv * 2));
      };
      float g0, v0, g1, v1, g2, v2;
      fetch(lr_lo - 2, g0, v0);
      fetch(lr_lo - 1, g1, v1);
      for (int lr = lr_lo; lr < lr_hi; lr++) {
        fetch(lr, g2, v2);
        const int tb = 254 * upti - 2 + lr;
        if (tb < SEQL) {
          float gate = bg + wg0 * g0 + wg1 * g1 + wg2 * g2;
          float val = bv + wv0 * v0 + wv1 * v1 + wv2 * v2;
          float o = gate / (1.f + __expf(-gate)) * val;
          p->act[(size_t)(upb * SEQL + tb) * FFN + ocol] = f2bf(o);
        }
        g0 = g1; v0 = v1; g1 = g2; v1 = v2;
      }
    }
    __syncthreads();
  }
  }
}

__device__ __forceinline__ void attn_item(KP p, int layer, int b, int h, int qt, float lam, float outscale, char* smem, const int tid) {
  const int lane = tid & 63, w = tid >> 6, g = lane >> 5, l32 = lane & 31;
  const int tok_q = b * SEQL + qt * 128 + w * 32 + l32;
  {
    const int qrow = tid >> 4, qc = tid & 15;
#pragma unroll
    for (int i = 0; i < 8; i++) {
      const int row = qrow + 16 * i;
      u32x4 v = *(const u32x4*)(p->q + (size_t)(b * SEQL + qt * 128 + row) * 512 + h * 128 + qc * 8);
      *(u32x4*)(smem + 65536 + row * 256 + ((qc ^ (row & 15)) << 4)) = v;
    }
  }
  const int q_off = 65536 + (w * 32 + l32) * 256;
  const int q_swz = (l32 & 15);

  const int NT = 2 * qt + 2;
  const int nkt = 2 * qt + 1 + (w >> 1);
  f32x16 O[2][4];
#pragma unroll
  for (int c = 0; c < 2; c++)
#pragma unroll
    for (int dt = 0; dt < 4; dt++)
#pragma unroll
      for (int r = 0; r < 16; r++) O[c][dt][r] = 0.f;
  float mrun[2] = {-1e30f, -1e30f}, lrun[2] = {0.f, 0.f};
  const float c1 = 0.125f * 1.4426950408889634f;

  u32x4 rk[4], rv[4];
  const bf16_t* kbase = p->k + (size_t)(b * SEQL) * 512 + h * 128;
  const bf16_t* vbase = p->vt + (size_t)((b * 4 + h) * 128) * SEQL;
  const int kkey = tid >> 4, kc = tid & 15;
  const int vd = tid >> 3, vc = tid & 7;
  auto gload = [&](int kt) {
#pragma unroll
    for (int i = 0; i < 4; i++) {
      rk[i] = *(const u32x4*)(kbase + (size_t)(kt * 64 + kkey + 16 * i) * 512 + kc * 8);
      rv[i] = *(const u32x4*)(vbase + (size_t)(vd + 32 * i) * SEQL + kt * 64 + vc * 8);
    }
  };
  const int kw_off = kkey * 256 + ((kc ^ (kkey & 15)) << 4);
  const int vw_off = 16384 + vd * 128 + ((vc ^ ((vd >> 1) & 7)) << 4);
  auto lwrite = [&](int st) {
    char* s = smem + st * 32768;
#pragma unroll
    for (int i = 0; i < 4; i++) {
      *(u32x4*)(s + kw_off + i * 4096) = rk[i];
      *(u32x4*)(s + vw_off + i * 4096) = rv[i];
    }
  };

  gload(0);
  lwrite(0);
  __syncthreads();
  for (int kt = 0; kt < NT; kt++) {
    if (kt + 1 < NT) gload(kt + 1);
    if (kt < nkt) {
      const char* st = smem + (kt & 1) * 32768;
      bf16x8 pf[2][2][2];
      bf16x8 kf[8], qfr[4], vf[2][4];
      f32x16 S[1][2];
      auto loadkq = [&](int c) {
#pragma unroll
        for (int kb = 0; kb < 2; kb++)
#pragma unroll
          for (int ks = 0; ks < 4; ks++) {
            const int key = kb * 32 + l32, chunk = c * 8 + ks * 2 + g;
            kf[kb * 4 + ks] = *(const bf16x8*)(st + key * 256 + ((chunk ^ (key & 15)) << 4));
          }
#pragma unroll
        for (int ks = 0; ks < 4; ks++) qfr[ks] = *(const bf16x8*)(smem + q_off + (((c * 8 + ks * 2 + g) ^ q_swz) << 4));
      };
      auto qk = [&](int c) {
#pragma unroll
        for (int kb = 0; kb < 2; kb++) {
#pragma unroll
          for (int r = 0; r < 16; r++) S[0][kb][r] = 0.f;
#pragma unroll
          for (int ks = 0; ks < 4; ks++) S[0][kb] = MFMA(kf[kb * 4 + ks], qfr[ks], S[0][kb]);
        }
      };
      auto loadv = [&](int bi) {
#pragma unroll
        for (int dt = 0; dt < 4; dt++) {
          const int d = dt * 32 + l32, chunk = bi * 2 + g;
          vf[bi & 1][dt] = *(const bf16x8*)(st + 16384 + d * 128 + ((chunk ^ ((d >> 1) & 7)) << 4));
        }
      };
      auto softmax = [&](int c) {
        float mx = S[0][0][0];
#pragma unroll
        for (int r = 1; r < 16; r++) mx = fmaxf(mx, S[0][0][r]);
#pragma unroll
        for (int r = 0; r < 16; r++) mx = fmaxf(mx, S[0][1][r]);
        mx = fmaxf(mx, __shfl_xor(mx, 32));
        const float mcand = fmaxf(mrun[c], mx * c1);
        if (__any(mcand - mrun[c] > 8.f)) {
          const float alpha = fast_exp2(mrun[c] - mcand);
          mrun[c] = mcand;
          lrun[c] *= alpha;
#pragma unroll
          for (int dt = 0; dt < 4; dt++)
#pragma unroll
            for (int r = 0; r < 16; r++) O[c][dt][r] *= alpha;
        }
        const float mref = mrun[c];
        const f2_t c1v = {c1, c1}, mrv = {-mref, -mref};
        f2_t psum2 = {0.f, 0.f};
#pragma unroll
        for (int kb = 0; kb < 2; kb++)
#pragma unroll
          for (int r = 0; r < 16; r += 2) {
            f2_t sv = {S[0][kb][r], S[0][kb][r + 1]};
            f2_t av = __builtin_elementwise_fma(sv, c1v, mrv);
            f2_t ev = {fast_exp2(av[0]), fast_exp2(av[1])};
            S[0][kb][r] = ev[0]; S[0][kb][r + 1] = ev[1];
            psum2 += ev;
          }
        lrun[c] += psum2[0] + psum2[1];
#pragma unroll
        for (int kb = 0; kb < 2; kb++)
#pragma unroll
          for (int m = 0; m < 2; m++) {
            u32x4 pk = {pack_bf2(S[0][kb][8 * m + 0], S[0][kb][8 * m + 1]), pack_bf2(S[0][kb][8 * m + 2], S[0][kb][8 * m + 3]),
                        pack_bf2(S[0][kb][8 * m + 4], S[0][kb][8 * m + 5]), pack_bf2(S[0][kb][8 * m + 6], S[0][kb][8 * m + 7])};
            pf[c][kb][m] = __builtin_bit_cast(bf16x8, pk);
          }
      };
      loadkq(0);
      __builtin_amdgcn_sched_barrier(0);
      qk(0);
      __builtin_amdgcn_sched_barrier(0);
      loadkq(1);
      __builtin_amdgcn_sched_barrier(0);
      softmax(0);
      __builtin_amdgcn_sched_barrier(0);
      qk(1);
      loadv(0);
      __builtin_amdgcn_sched_barrier(0);
      softmax(1);
      __builtin_amdgcn_sched_barrier(0);
#pragma unroll
      for (int bi = 0; bi < 4; bi++) {
        if (bi < 3) loadv(bi + 1);
#pragma unroll
        for (int dt = 0; dt < 4; dt++) {
          O[0][dt] = MFMA(vf[bi & 1][dt], pf[0][bi >> 1][bi & 1], O[0][dt]);
          O[1][dt] = MFMA(vf[bi & 1][dt], pf[1][bi >> 1][bi & 1], O[1][dt]);
        }
        __builtin_amdgcn_sched_barrier(0);
      }
    }
    if (kt + 1 < NT) lwrite((kt + 1) & 1);
    __syncthreads();
  }

  const float l1 = lrun[0] + __shfl_xor(lrun[0], 32);
  const float l2 = lrun[1] + __shfl_xor(lrun[1], 32);
  const float i1 = 1.f / l1, i2 = lam / l2;
  float ssq = 0.f;
#pragma unroll
  for (int dt = 0; dt < 4; dt++)
#pragma unroll
    for (int r = 0; r < 16; r++) {
      float o = O[0][dt][r] * i1 - O[1][dt][r] * i2;
      O[0][dt][r] = o;
      ssq += o * o;
    }
  ssq += __shfl_xor(ssq, 32);
  const float rstd = rsqrtf(ssq * (1.f / 128.f) + EPS) * outscale;
  const float* gsub = p->subln + layer * 128;
#pragma unroll
  for (int dt = 0; dt < 4; dt++)
#pragma unroll
    for (int rq = 0; rq < 4; rq++) {
      const int d0 = dt * 32 + rq * 8 + g * 4;
      float4 gg = *(const float4*)(gsub + d0);
      u32x2 pk = {pack_bf2(O[0][dt][rq * 4 + 0] * rstd * gg.x, O[0][dt][rq * 4 + 1] * rstd * gg.y),
                  pack_bf2(O[0][dt][rq * 4 + 2] * rstd * gg.z, O[0][dt][rq * 4 + 3] * rstd * gg.w)};
      *(u32x2*)(p->att + (size_t)tok_q * 512 + h * 128 + d0) = pk;
    }
}

DI void s5_load_u(KP p, int b, int g, int j, int lane, float* ul) {
  const float4* src = (const float4*)(p->u + (size_t)(b * SEQL + j * 64 + lane) * 512 + g * 16);
  float4 v0 = src[0], v1 = src[1], v2 = src[2], v3 = src[3];
  float4* d = (float4*)(ul + lane * 16);
  d[0] = v0; d[1] = v1; d[2] = v2; d[3] = v3;
}

#define S5_BU(ul, t, bur, bui)                                              \
  {                                                                         \
    const float4* up_ = (const float4*)((ul) + (t) * 16);                   \
    float4 q0 = up_[0], q1 = up_[1], q2 = up_[2], q3 = up_[3];              \
    float uu[16] = {q0.x, q0.y, q0.z, q0.w, q1.x, q1.y, q1.z, q1.w, q2.x, q2.y, q2.z, q2.w, q3.x, q3.y, q3.z, q3.w}; \
    bur = 0.f; bui = 0.f;                                                   \
    _Pragma("unroll") for (int c_ = 0; c_ < 16; c_++) { bur += Bre[c_] * uu[c_]; bui += Bim[c_] * uu[c_]; } \
  }

__device__ __forceinline__ void s5_pass1(KP p, int layer, char* smem, const int tid) {
  const int lane = tid & 63, w = tid >> 6;
  float* ul = (float*)(smem + w * 4096);
  for (int wbase = blockIdx.x * 4; wbase < 1024; wbase += gridDim.x * 4) {
    const int wi = wbase + w;
    const int j0 = (wi & 15) * 8, g = (wi >> 4) & 31, b = wi >> 9;
    const float* tb = p->s5tab + (size_t)((layer * 32 + g) * 64 + lane) * 40;
    const float ar = tb[0], ai = tb[1];
    float Bre[16], Bim[16];
#pragma unroll
    for (int c = 0; c < 16; c++) { Bre[c] = tb[4 + c]; Bim[c] = tb[20 + c]; }
    const float4* src = (const float4*)(p->u + (size_t)(b * SEQL + j0 * 64 + lane) * 512 + g * 16);
    float4 v0 = src[0], v1 = src[1], v2 = src[2], v3 = src[3];
    for (int jj = 0; jj < 8; jj++) {
      const int j = j0 + jj;
      {
        float4* d = (float4*)(ul + lane * 16);
        d[0] = v0; d[1] = v1; d[2] = v2; d[3] = v3;
      }
      if (jj < 7) {
        const float4* nsrc = (const float4*)(p->u + (size_t)(b * SEQL + (j + 1) * 64 + lane) * 512 + g * 16);
        v0 = nsrc[0]; v1 = nsrc[1]; v2 = nsrc[2]; v3 = nsrc[3];
      }
      __syncthreads();
      float xr = 0.f, xi = 0.f;
#pragma unroll 4
      for (int t = 0; t < 64; t++) {
        float bur, bui;
        S5_BU(ul, t, bur, bui);
        const float nr = ar * xr - ai * xi + bur;
        const float ni = ar * xi + ai * xr + bui;
        xr = nr; xi = ni;
      }
      float* so = p->sloc + (size_t)((b * 32 + g) * 128 + j) * 128;
      so[lane] = xr; so[64 + lane] = xi;
      __syncthreads();
    }
  }
}

__device__ __forceinline__ void s5_pass2(KP p, int layer, char* smem, const int tid) {
  const int lane = tid & 63, w = tid >> 6;
  float* ul = (float*)(smem + w * 29696);
  float* X = ul + 1024;
  float* Cl = X + 32 * 129 + 32;
  const int t32 = lane & 31, hc = lane >> 5;
  for (int wbase = blockIdx.x * 4; wbase < 1024; wbase += gridDim.x * 4) {
   const int wi = wbase + w;
   const int j0 = (wi & 15) * 8, g = (wi >> 4) & 31, b = wi >> 9;
   const float* tb = p->s5tab + (size_t)((layer * 32 + g) * 64 + lane) * 40;
   const float ar = tb[0], ai = tb[1], aTr = tb[2], aTi = tb[3];
   float Bre[16], Bim[16];
#pragma unroll
   for (int c = 0; c < 16; c++) { Bre[c] = tb[4 + c]; Bim[c] = tb[20 + c]; }
   {
     const float* cr = p->c_re + (size_t)((layer * 32 + g) * 16) * 64;
     const float* ci = p->c_im + (size_t)((layer * 32 + g) * 16) * 64;
#pragma unroll
     for (int c = 0; c < 16; c++) {
       Cl[lane * 32 + (c >> 3) * 16 + (c & 7)] = cr[c * 64 + lane];
       Cl[lane * 32 + (c >> 3) * 16 + 8 + (c & 7)] = ci[c * 64 + lane];
     }
   }
   float dd[8];
   {
     const float* dp = p->ssm_d + (size_t)(layer * 32 + g) * 16 + hc * 8;
#pragma unroll
     for (int i = 0; i < 8; i++) dd[i] = dp[i];
   }
   float xr = 0.f, xi = 0.f;
   {
     const float* sl = p->sloc + (size_t)((b * 32 + g) * 128) * 128;
     for (int i0 = 0; i0 < j0; i0 += 8) {
       float sr[8], si[8];
#pragma unroll
       for (int q = 0; q < 8; q++) { sr[q] = sl[(i0 + q) * 128 + lane]; si[q] = sl[(i0 + q) * 128 + 64 + lane]; }
#pragma unroll
       for (int q = 0; q < 8; q++) {
         const float nr = aTr * xr - aTi * xi + sr[q];
         const float ni = aTr * xi + aTi * xr + si[q];
         xr = nr; xi = ni;
       }
     }
   }
   for (int jj = 0; jj < 8; jj++) {
    const int j = j0 + jj;
    s5_load_u(p, b, g, j, lane, ul);
    __syncthreads();
    for (int sub = 0; sub < 2; sub++) {
#pragma unroll 4
      for (int t = 0; t < 32; t++) {
        float bur, bui;
        S5_BU(ul, sub * 32 + t, bur, bui);
        const float nr = ar * xr - ai * xi + bur;
        const float ni = ar * xi + ai * xr + bui;
        xr = nr; xi = ni;
        X[t * 129 + lane] = xr;
        X[t * 129 + 64 + lane] = xi;
      }
      __syncthreads();
      float y[8];
#pragma unroll
      for (int i = 0; i < 8; i++) y[i] = 0.f;
#pragma unroll 4
      for (int pp = 0; pp < 64; pp++) {
        const float sxr = X[t32 * 129 + pp], sxi = X[t32 * 129 + 64 + pp];
        const float4* cp = (const float4*)(Cl + pp * 32 + hc * 16);
        float4 c0 = cp[0], c1 = cp[1], c2 = cp[2], c3 = cp[3];
        y[0] += c0.x * sxr - c2.x * sxi; y[1] += c0.y * sxr - c2.y * sxi;
        y[2] += c0.z * sxr - c2.z * sxi; y[3] += c0.w * sxr - c2.w * sxi;
        y[4] += c1.x * sxr - c3.x * sxi; y[5] += c1.y * sxr - c3.y * sxi;
        y[6] += c1.z * sxr - c3.z * sxi; y[7] += c1.w * sxr - c3.w * sxi;
      }
      const int tl = sub * 32 + t32;
      unsigned pk[4];
#pragma unroll
      for (int i = 0; i < 4; i++) {
        float a0 = y[2 * i] + dd[2 * i] * ul[tl * 16 + hc * 8 + 2 * i];
        float a1 = y[2 * i + 1] + dd[2 * i + 1] * ul[tl * 16 + hc * 8 + 2 * i + 1];
        pk[i] = pack_bf2(gelu_tanh(a0), gelu_tanh(a1));
      }
      u32x4 o = {pk[0], pk[1], pk[2], pk[3]};
      *(u32x4*)(p->gy + (size_t)(b * SEQL + j * 64 + tl) * 512 + g * 16 + hc * 8) = o;
      __syncthreads();
    }
   }
  }
}

__device__ __forceinline__ void phase_attn(KP p, int layer, char* smem, const int tid) {
  const int lane = tid & 63;
  const float s1 = wave_sum(p->lq1[layer * 64 + lane] * p->lk1[layer * 64 + lane]);
  const float s2 = wave_sum(p->lq2[layer * 64 + lane] * p->lk2[layer * 64 + lane]);
  const float lam_init = 0.8f - 0.6f * expf(-0.3f * (float)layer);
  const float lam = expf(s1) - expf(s2) + lam_init;
  for (int pb = blockIdx.x; pb < 256; pb += gridDim.x) {
    const int pi = (pb & 7) * 32 + (pb >> 3);
    const int b = pi >> 7, h = (pi >> 5) & 3, i = pi & 31;
    attn_item(p, layer, b, h, 63 - i, lam, 1.f - lam_init, smem, tid);
    attn_item(p, layer, b, h, i, lam, 1.f - lam_init, smem, tid);
  }
  s5_pass1(p, layer, smem, tid);
}

__device__ __forceinline__ void phase_final(KP p, const int tid) {
  const int wave = tid >> 6, lane = tid & 63;
  const float* ssq = p->ss + (size_t)8 * 8 * NTOK;
  for (int row = blockIdx.x * 4 + wave; row < NTOK; row += gridDim.x * 4) {
    const float rstd = rsqrtf(ss_sum1(ssq, row) * (1.f / 1024.f) + EPS);
#pragma unroll
    for (int i = 0; i < 4; i++) {
      float4 v = ((const float4*)(p->xf + (size_t)row * DM))[lane + 64 * i];
      float4 gq = ((const float4*)p->norm_final)[lane + 64 * i];
      float4 o = {v.x * rstd * gq.x, v.y * rstd * gq.y, v.z * rstd * gq.z, v.w * rstd * gq.w};
      ((float4*)(p->out + (size_t)row * DM))[lane + 64 * i] = o;
    }
  }
}

__device__ __forceinline__ void run_phase(KP p, int ph, char* smem) {
  const int tid = opaque_tid();
  if (ph == 0) { phase_prep(p, smem, tid); return; }
  if (ph == 29) { phase_final(p, tid); return; }
  const int layer = (ph - 1) / 7, k = (ph - 1) % 7;
  const int nb = gridDim.x, bid = blockIdx.x;
  if (k == 1) { phase_attn(p, layer, smem, tid); return; }
  if (k == 2) { s5_pass2(p, layer, smem, tid); return; }
  if (k == 0) { for (int r = 0; ; r++) { const int t = (r * 8 + (bid & 7)) * (nb >> 3) + (bid >> 3); if (r * nb >= 512) break; if (t < 512) gemm_tile(p, G_IN, layer, t, smem, tid); } }
  else if (k == 3) { for (int r = 0; ; r++) { const int t = (r * 8 + (bid & 7)) * (nb >> 3) + (bid >> 3); if (r * nb >= 256) break; if (t < 256) gemm_tile(p, G_GLU, layer, t, smem, tid); } }
  else if (k == 4) { for (int r = 0; ; r++) { const int t = (r * 8 + (bid & 7)) * (nb >> 3) + (bid >> 3); if (r * nb >= 256) break; if (t < 256) gemm_tile(p, G_WOUT, layer, t, smem, tid); } }
  else if (k == 5) { for (int r = 0; ; r++) { const int t = (r * 8 + (bid & 7)) * (nb >> 3) + (bid >> 3); if (r * nb >= 2 * 33 * 22) break; if (t < 2 * 33 * 22) gemm_tile(p, G_UP, layer, t, smem, tid); } }
  else { for (int r = 0; ; r++) { const int t = (r * 8 + (bid & 7)) * (nb >> 3) + (bid >> 3); if (r * nb >= 256) break; if (t < 256) gemm_tile(p, G_DOWN, layer, t, smem, tid); } }
}

#define PHASE_KERNEL(name, body)                                                      \
  __global__ void __launch_bounds__(256) name(Params p_unused) {                      \
    extern __shared__ __attribute__((aligned(16))) char smem[];                       \
    KP p = (KP)__builtin_amdgcn_kernarg_segment_ptr();                                \
    const int tid = threadIdx.x, nb = gridDim.x, bid = blockIdx.x;                    \
    const int layer = (int)p->phase_lo;                                               \
    (void)nb; (void)bid; (void)layer;                                                 \
    body                                                                              \
  }
PHASE_KERNEL(k_prep, phase_prep(p, smem, tid);)
PHASE_KERNEL(k_gin, for (int r = 0; ; r++) { const int t = (r * 8 + (bid & 7)) * (nb >> 3) + (bid >> 3); if (r * nb >= 512) break; if (t < 512) gemm_tile(p, G_IN, layer, t, smem, tid); })
PHASE_KERNEL(k_attn, phase_attn(p, layer, smem, tid);)
PHASE_KERNEL(k_s5p2, s5_pass2(p, layer, smem, tid);)
PHASE_KERNEL(k_glu, for (int r = 0; ; r++) { const int t = (r * 8 + (bid & 7)) * (nb >> 3) + (bid >> 3); if (r * nb >= 256) break; if (t < 256) gemm_tile(p, G_GLU, layer, t, smem, tid); })
PHASE_KERNEL(k_wout, for (int r = 0; ; r++) { const int t = (r * 8 + (bid & 7)) * (nb >> 3) + (bid >> 3); if (r * nb >= 256) break; if (t < 256) gemm_tile(p, G_WOUT, layer, t, smem, tid); })
PHASE_KERNEL(k_up, for (int r = 0; ; r++) { const int t = (r * 8 + (bid & 7)) * (nb >> 3) + (bid >> 3); if (r * nb >= 2 * 33 * 22) break; if (t < 2 * 33 * 22) gemm_tile(p, G_UP, layer, t, smem, tid); })
PHASE_KERNEL(k_down, for (int r = 0; ; r++) { const int t = (r * 8 + (bid & 7)) * (nb >> 3) + (bid >> 3); if (r * nb >= 256) break; if (t < 256) gemm_tile(p, G_DOWN, layer, t, smem, tid); })
PHASE_KERNEL(k_final, phase_final(p, tid);)

#if COOP
__global__ void __launch_bounds__(256) mega_kernel(Params p_unused) {
  extern __shared__ __attribute__((aligned(16))) char smem[];
  KP p0 = (KP)__builtin_amdgcn_kernarg_segment_ptr();
  const int ph_lo = (int)p0->phase_lo, ph_hi = (int)p0->phase_hi;
#if COOP
  if (ph_hi > 1000) cg::this_grid().sync();
#endif
  for (int ph = ph_lo; ph < ph_hi; ph++) {
    KP p = p0;
    asm volatile("" : "+s"(p));
#if TPROBE
    if (blockIdx.x == 0) p->ts[ph] = (long long)wall_clock64();
#endif
    run_phase(p, ph, smem);
#if COOP
    if (ph + 1 < ph_hi) grid_barrier(p->bar, (unsigned)(ph + 1 - ph_lo) * gridDim.x, opaque_tid());
#endif
  }
#if TPROBE
  grid_barrier(p0->bar, (unsigned)(ph_hi - ph_lo) * gridDim.x, opaque_tid());
  if (blockIdx.x == 0) {
    KP p = p0;
    long long tend = (long long)wall_clock64();
    float a = 0.f, b = 0.f;
    for (int ph = 0; ph < 30; ph++) {
      long long t0 = p->ts[ph], t1 = (ph == 29) ? tend : p->ts[ph + 1];
      int c = (ph == 0) ? 0 : (ph == 29 ? 8 : 1 + (ph - 1) % 7);
      float d = (float)(t1 - t0) * 0.01f;
      if (c == TP_A || TP_A == 9) a += d;
      if (c == TP_B || TP_B == 9) b += d;
    }
    const int t = opaque_tid();
    if (t <= 100) p->out[t] += (t == 0) ? a : b;
  }
#endif
}

#endif

extern "C" void kernel_launch(void* const* d_in, const int* in_sizes, int n_in, void* d_out, int out_size, void* d_ws,
                              size_t ws_size, hipStream_t stream) {
  static int grid_blocks = 0;
  if (!grid_blocks) {
    int dev = 0, cus = 0, per_cu = 0;
    (void)hipGetDevice(&dev);
    (void)hipDeviceGetAttribute(&cus, hipDeviceAttributeMultiprocessorCount, dev);
#if COOP
    (void)hipFuncSetAttribute((const void*)mega_kernel, hipFuncAttributeMaxDynamicSharedMemorySize, LDS_BYTES);
    (void)hipOccupancyMaxActiveBlocksPerMultiprocessor(&per_cu, (const void*)mega_kernel, 256, LDS_BYTES);
    if (per_cu < 1) { fprintf(stderr, "occupancy query returned %d\n", per_cu); per_cu = 1; }
#endif
    grid_blocks = cus;
    (void)hipGetLastError();
  }
  Params p{};
  p.x = (const float*)d_in[0]; p.pos = (const int*)d_in[1];
  p.norm_mix = (const float*)d_in[2]; p.w_in = (const float*)d_in[3];
  p.lam_re = (const float*)d_in[4]; p.lam_im = (const float*)d_in[5]; p.log_step = (const float*)d_in[6];
  p.b_re = (const float*)d_in[7]; p.b_im = (const float*)d_in[8]; p.c_re = (const float*)d_in[9]; p.c_im = (const float*)d_in[10];
  p.ssm_d = (const float*)d_in[11]; p.w_glu = (const float*)d_in[12]; p.ssm_norm = (const float*)d_in[13];
  p.lq1 = (const float*)d_in[14]; p.lk1 = (const float*)d_in[15]; p.lq2 = (const float*)d_in[16]; p.lk2 = (const float*)d_in[17];
  p.subln = (const float*)d_in[18]; p.w_out = (const float*)d_in[19]; p.norm_ffn = (const float*)d_in[20];
  p.w_up = (const float*)d_in[21]; p.w_conv = (const float*)d_in[22]; p.b_conv = (const float*)d_in[23];
  p.w_down = (const float*)d_in[24]; p.norm_final = (const float*)d_in[25];
  p.out = (float*)d_out;
  char* ws = (char*)d_ws;
  size_t off = 0;
  auto take = [&](size_t bytes) { char* r = ws + off; off += (bytes + 255) & ~(size_t)255; return r; };
  p.WinT = (bf16_t*)take((size_t)4 * 2048 * 1024 * 2);
  p.WgluT = (bf16_t*)take((size_t)4 * 1024 * 512 * 2);
  p.WoutT = (bf16_t*)take((size_t)4 * 1024 * 1024 * 2);
  p.WupT = (bf16_t*)take((size_t)4 * 5632 * 1024 * 2);
  p.WdownT = (bf16_t*)take((size_t)4 * 1024 * FFN * 2);
  p.xf = (float*)take((size_t)NTOK * DM * 4);
  p.xb = (bf16_t*)take((size_t)NTOK * DM * 2);
  p.ss = (float*)take((size_t)9 * 8 * NTOK * 4);
  p.ssm_ss = (float*)take((size_t)4 * 8 * NTOK * 4);
  p.cs = (float*)take((size_t)NTOK * 16 * 4);
  p.s5tab = (float*)take((size_t)4 * 32 * 64 * 40 * 4);
  p.sloc = (float*)take((size_t)2 * 32 * 128 * 128 * 4);
  p.ts = (long long*)take(256);
  p.bar = (unsigned*)take(256);
  char* region = take((size_t)134217728);
  p.u = (float*)region;
  p.q = (bf16_t*)(region + 33554432);
  p.k = p.q + (size_t)NTOK * 512;
  p.vt = p.k + (size_t)NTOK * 512;
  p.gy = p.vt + (size_t)NTOK * 512;
  p.outg = p.gy + (size_t)NTOK * 512;
  p.att = p.outg + (size_t)NTOK * 512;
  p.act = (bf16_t*)region;
  if (off > ws_size) { fprintf(stderr, "workspace too small: need %zu have %zu\n", off, ws_size); return; }
#if COOP
  p.phase_lo = 0; p.phase_hi = 30;
  if (hipMemsetAsync(p.bar, 0, 256, stream) != hipSuccess) fprintf(stderr, "barrier memset failed\n");
  void* args[] = {&p};
  hipError_t e = hipLaunchCooperativeKernel((const void*)mega_kernel, dim3(grid_blocks), dim3(256), args, LDS_BYTES, stream);
  if (e != hipSuccess) fprintf(stderr, "cooperative launch failed: %s (grid %d)\n", hipGetErrorString(e), grid_blocks);
#else
  typedef void (*kfn)(Params);
  const kfn seq[7] = {k_gin, k_attn, k_s5p2, k_glu, k_wout, k_up, k_down};
  static bool attr_done = false;
  if (!attr_done) {
    (void)hipFuncSetAttribute((const void*)k_prep, hipFuncAttributeMaxDynamicSharedMemorySize, LDS_BYTES);
    (void)hipFuncSetAttribute((const void*)k_final, hipFuncAttributeMaxDynamicSharedMemorySize, LDS_BYTES);
    for (int i = 0; i < 7; i++) (void)hipFuncSetAttribute((const void*)seq[i], hipFuncAttributeMaxDynamicSharedMemorySize, LDS_BYTES);
    attr_done = true;
  }
  p.phase_lo = 0; p.phase_hi = 0;
  hipLaunchKernelGGL(k_prep, dim3(grid_blocks), dim3(256), LDS_BYTES, stream, p);
  for (int layer = 0; layer < 4; layer++) {
    p.phase_lo = layer;
    for (int i = 0; i < 7; i++) hipLaunchKernelGGL(seq[i], dim3(grid_blocks), dim3(256), LDS_BYTES, stream, p);
  }
  hipLaunchKernelGGL(k_final, dim3(grid_blocks), dim3(256), LDS_BYTES, stream, p);
#endif
}
```

```cpp
#include <hip/hip_runtime.h>
#include <hip/hip_cooperative_groups.h>
#include <cstdio>
namespace cg = cooperative_groups;

#ifndef COOP
#define COOP 1
#endif
#ifndef TPROBE
#define TPROBE 0
#endif
#ifndef TP_A
#define TP_A 1
#endif
#ifndef TP_B
#define TP_B 2
#endif

typedef unsigned short bf16_t;
typedef __attribute__((ext_vector_type(8))) short bf16x8;
typedef __attribute__((ext_vector_type(16))) float f32x16;
typedef __attribute__((ext_vector_type(2))) __bf16 bf2_t;
typedef __attribute__((ext_vector_type(2))) float f2_t;
typedef __attribute__((ext_vector_type(4))) unsigned u32x4;
typedef __attribute__((ext_vector_type(2))) unsigned u32x2;

#define DI __device__ __forceinline__
#define MFMA(a, b, c) __builtin_amdgcn_mfma_f32_32x32x16_bf16((a), (b), (c), 0, 0, 0)

constexpr int NTOK = 16384, DM = 1024, SEQL = 8192, FFN = 2816;
constexpr int LDS_BYTES = 136192;
constexpr float EPS = 1e-6f;

struct Params {
  const float* x; const int* pos;
  const float *norm_mix, *w_in, *lam_re, *lam_im, *log_step, *b_re, *b_im, *c_re, *c_im, *ssm_d, *w_glu, *ssm_norm;
  const float *lq1, *lk1, *lq2, *lk2, *subln, *w_out, *norm_ffn, *w_up, *w_conv, *b_conv, *w_down, *norm_final;
  float* out;
  bf16_t *WinT, *WgluT, *WoutT, *WupT, *WdownT;
  float* xf; bf16_t* xb;
  float* u; bf16_t *q, *k, *vt, *gy, *outg, *att, *act;
  float *ss, *ssm_ss, *cs, *s5tab, *sloc;
  long long phase_lo, phase_hi;
  long long* ts;
  unsigned* bar;
};

typedef const __attribute__((address_space(4))) Params* KP;

DI unsigned pack_bf2(float a, float b) { f2_t v = {a, b}; return __builtin_bit_cast(unsigned, __builtin_convertvector(v, bf2_t)); }
DI bf16_t f2bf(float a) { return (bf16_t)(pack_bf2(a, 0.f) & 0xffffu); }
DI float bf2f(bf16_t v) { return __uint_as_float(((unsigned)v) << 16); }
DI void grid_barrier(unsigned* ctr, unsigned target, int tid) {
  asm volatile("s_waitcnt vmcnt(0)" ::: "memory");
  __syncthreads();
  if (tid == 0) {
    __builtin_amdgcn_fence(__ATOMIC_RELEASE, "agent");
    asm volatile("s_waitcnt vmcnt(0)" ::: "memory");
    __hip_atomic_fetch_add(ctr, 1u, __ATOMIC_RELAXED, __HIP_MEMORY_SCOPE_AGENT);
    while (__hip_atomic_load(ctr, __ATOMIC_RELAXED, __HIP_MEMORY_SCOPE_AGENT) < target) __builtin_amdgcn_s_sleep(1);
    __builtin_amdgcn_fence(__ATOMIC_ACQUIRE, "agent");
    asm volatile("s_waitcnt vmcnt(0)" ::: "memory");
  }
  __syncthreads();
}
DI int opaque_tid() { int t = threadIdx.x; asm volatile("" : "+v"(t)); return t; }
DI float4 ss_sum4(const float* base, int row0) {
  float4 a = *(const float4*)(base + row0);
#pragma unroll
  for (int pz = 1; pz < 8; pz++) {
    float4 b = *(const float4*)(base + (size_t)pz * NTOK + row0);
    a.x += b.x; a.y += b.y; a.z += b.z; a.w += b.w;
  }
  return a;
}
DI float ss_sum1(const float* base, int row) {
  float a = base[row];
#pragma unroll
  for (int pz = 1; pz < 8; pz++) a += base[(size_t)pz * NTOK + row];
  return a;
}
DI float wave_sum(float v) { for (int o = 32; o; o >>= 1) v += __shfl_xor(v, o); return v; }
DI float fast_exp2(float x) { return __builtin_amdgcn_exp2f(x); }
DI float gelu_tanh(float x) {
  float z = 0.7978845608028654f * (x + 0.044715f * x * x * x);
  float e = __expf(2.f * z);
  float t = 1.f - 2.f / (1.f + e);
  return 0.5f * x * (1.f + t);
}
DI float reduce_2pi(double a) {
  double n = rint(a * 0.15915494309189535);
  return (float)(a - n * 6.283185307179586);
}

DI void transpose_tile(const float* src, int ldsrc, int k0, int c0, const float* scale, int nscale,
                       bf16_t* dst, int lddst, int n0, float* lds, const int tid) {
#pragma unroll
  for (int i = 0; i < 16; i++) {
    int kk = i * 4 + (tid >> 6), nn = tid & 63;
    float v = src[(size_t)(k0 + kk) * ldsrc + c0 + nn];
    if (scale != nullptr && (k0 + kk) < nscale) v *= scale[k0 + kk];
    lds[kk * 65 + nn] = v;
  }
  __syncthreads();
  {
    int nn = tid >> 2, kq = (tid & 3) * 16;
    unsigned pk[8];
#pragma unroll
    for (int i = 0; i < 8; i++) pk[i] = pack_bf2(lds[(kq + 2 * i) * 65 + nn], lds[(kq + 2 * i + 1) * 65 + nn]);
    u32x4* d = (u32x4*)(dst + (size_t)(n0 + nn) * lddst + k0 + kq);
    u32x4 a = {pk[0], pk[1], pk[2], pk[3]}, b = {pk[4], pk[5], pk[6], pk[7]};
    d[0] = a; d[1] = b;
  }
  __syncthreads();
}

__device__ __forceinline__ void phase_prep(KP p, char* smem, const int tid) {
  const int nb = gridDim.x, bid = blockIdx.x;
  const int wave = tid >> 6, lane = tid & 63;
  for (int row = bid * 4 + wave; row < NTOK; row += nb * 4) {
    const float4* src = (const float4*)(p->x + (size_t)row * DM);
    float s = 0.f;
#pragma unroll
    for (int i = 0; i < 4; i++) {
      float4 v = src[lane + 64 * i];
      s += v.x * v.x + v.y * v.y + v.z * v.z + v.w * v.w;
      ((float4*)(p->xf + (size_t)row * DM))[lane + 64 * i] = v;
      u32x2 pk = {pack_bf2(v.x, v.y), pack_bf2(v.z, v.w)};
      ((u32x2*)(p->xb + (size_t)row * DM))[lane + 64 * i] = pk;
    }
    s = wave_sum(s);
    if (lane < 8) p->ss[(size_t)lane * NTOK + row] = (lane == 0) ? s : 0.f;
  }
  for (int i = bid * 256 + tid; i < NTOK * 8; i += nb * 256) {
    int tok = i >> 3, j = i & 7;
    double inv = (j & 4) ? ((j & 2) ? ((j & 1) ? 1.031338537721246e-05 : 5.318295896944988e-05) : ((j & 1) ? 0.0002742481756762073 : 0.001414213562373095))
                         : ((j & 2) ? ((j & 1) ? 0.007292664737217109 : 0.03760603093086393) : ((j & 1) ? 0.19392274474868576 : 1.0));
    double ang = (double)p->pos[tok] * inv;
    float r = reduce_2pi(ang);
    p->cs[2 * i] = cosf(r); p->cs[2 * i + 1] = sinf(r);
  }
  for (int i = bid * 256 + tid; i < 4 * 32 * 64; i += nb * 256) {
    int lg = i >> 6;
    float lr = p->lam_re[i], li = p->lam_im[i];
    float step = expf(p->log_step[lg]);
    float mag = expf(step * lr);
    double angd = (double)step * (double)li;
    float r1 = reduce_2pi(angd);
    float ar = mag * cosf(r1), ai = mag * sinf(r1);
    float den = lr * lr + li * li;
    float fr = ((ar - 1.f) * lr + ai * li) / den;
    float fi = (ai * lr - (ar - 1.f) * li) / den;
    float magT = expf(64.f * step * lr);
    float rT = reduce_2pi(64.0 * angd);
    float* tb = p->s5tab + (size_t)i * 40;
    tb[0] = ar; tb[1] = ai; tb[2] = magT * cosf(rT); tb[3] = magT * sinf(rT);
    for (int c = 0; c < 16; c++) {
      float br = p->b_re[(size_t)i * 16 + c], bi = p->b_im[(size_t)i * 16 + c];
      tb[4 + c] = fr * br - fi * bi;
      tb[20 + c] = fr * bi + fi * br;
    }
  }
  float* lds = (float*)smem;
  for (int job = bid; job < 4 * 3008; job += nb) {
    int layer = job / 3008, t = job % 3008;
    if (t < 512) {
      int a = t >> 4, kt = t & 15;
      transpose_tile(p->w_in + (size_t)layer * 1024 * 2048, 2048, kt * 64, a * 64, p->norm_mix + layer * 1024, 1024,
                     p->WinT + (size_t)layer * 2048 * 1024, 1024, a * 64, lds, tid);
    } else if (t < 640) {
      t -= 512; int a = t >> 3, kt = t & 7;
      transpose_tile(p->w_glu + (size_t)layer * 512 * 1024, 1024, kt * 64, (a & 1) * 512 + (a >> 1) * 64, nullptr, 0,
                     p->WgluT + (size_t)layer * 1024 * 512, 512, a * 64, lds, tid);
    } else if (t < 896) {
      t -= 640; int a = t >> 4, kt = t & 15;
      transpose_tile(p->w_out + (size_t)layer * 1024 * 1024, 1024, kt * 64, a * 64, p->ssm_norm + layer * 512, 512,
                     p->WoutT + (size_t)layer * 1024 * 1024, 1024, a * 64, lds, tid);
    } else if (t < 2304) {
      t -= 896; int a = t >> 4, kt = t & 15;
      transpose_tile(p->w_up + (size_t)layer * 1024 * 5632, 5632, kt * 64, (a & 1) * FFN + (a >> 1) * 64, p->norm_ffn + layer * 1024, 1024,
                     p->WupT + (size_t)layer * 5632 * 1024, 1024, a * 64, lds, tid);
    } else {
      t -= 2304; int a = t / 44, kt = t % 44;
      transpose_tile(p->w_down + (size_t)layer * FFN * 1024, 1024, kt * 64, a * 64, nullptr, 0,
                     p->WdownT + (size_t)layer * 1024 * FFN, FFN, a * 64, lds, tid);
    }
  }
}

enum { G_IN = 0, G_GLU = 1, G_WOUT = 2, G_UP = 3, G_DOWN = 4 };
#define ACC_PIN(tag) _Pragma("unroll") for (int i_ = 0; i_ < 4; i_++) _Pragma("unroll") for (int j_ = 0; j_ < 4; j_++) asm volatile("; pin " tag : "+a"(acc[i_][j_]));


__device__ __forceinline__ void gemm_tile(KP p, const int MODE, int layer, int tile, char* smem, const int tid) {
  const int lane = tid & 63, w = tid >> 6, wm = w >> 1, wn = w & 1, g = lane >> 5, l32 = lane & 31;
  int tn, KT, ldb, rowbase, lda;
  const bf16_t* Bt;
  const bf16_t* A0;
  int upb = 0, upti = 0;
  {
    const int TM = (MODE == G_UP) ? 66 : 64;
    const int TN = (MODE == G_IN) ? 8 : (MODE == G_UP ? 22 : 4);
    const int nfull = TN >> 2, rem = TN & 3;
    int tm;
    if (tile < nfull * 4 * TM) { const int band = tile / (4 * TM), within = tile % (4 * TM); tm = within >> 2; tn = band * 4 + (within & 3); }
    else { const int s2 = tile - nfull * 4 * TM; tm = s2 / rem; tn = nfull * 4 + s2 % rem; }
    rowbase = tm * 256;
    if (MODE == G_UP) { upb = tm / 33; upti = tm % 33; rowbase = upb * SEQL + 254 * upti - 2; }
  }
  if (MODE == G_IN) { KT = 16; ldb = 1024; Bt = p->WinT + (size_t)layer * 2048 * 1024; A0 = p->xb; lda = 1024; }
  else if (MODE == G_GLU) { KT = 8; ldb = 512; Bt = p->WgluT + (size_t)layer * 1024 * 512; A0 = p->gy; lda = 512; }
  else if (MODE == G_WOUT) { KT = 16; ldb = 1024; Bt = p->WoutT + (size_t)layer * 1024 * 1024; A0 = p->outg; lda = 512; }
  else if (MODE == G_UP) { KT = 16; ldb = 1024; Bt = p->WupT + (size_t)layer * 5632 * 1024; A0 = p->xb; lda = 1024; }
  else { KT = 44; ldb = FFN; Bt = p->WdownT + (size_t)layer * 1024 * FFN; A0 = p->act; lda = FFN; }

  u32x4 ra[8], rb[8];
  const int lrow = tid >> 3, lc = tid & 7;
  float arow_sc[8];
#pragma unroll
  for (int i = 0; i < 8; i++) arow_sc[i] = 1.f;
  if (MODE == G_WOUT) {
    const float* ssq = p->ssm_ss + (size_t)layer * 8 * NTOK;
#pragma unroll
    for (int i = 0; i < 8; i++) arow_sc[i] = rsqrtf(ss_sum1(ssq, rowbase + lrow + 32 * i) * (1.f / 512.f) + EPS);
  }
  const bf16_t* bptr = Bt + (size_t)(tn * 256 + lrow) * ldb + lc * 8;
  auto gload = [&](int kt) {
    const bf16_t* abase = A0;
    int kofs = kt * 64;
    if (MODE == G_WOUT && kt >= 8) { abase = p->att; kofs = (kt - 8) * 64; }
#pragma unroll
    for (int i = 0; i < 8; i++) {
      int gr = min(max(rowbase + lrow + 32 * i, 0), NTOK - 1);
      ra[i] = *(const u32x4*)(abase + (size_t)gr * lda + kofs + lc * 8);
      rb[i] = *(const u32x4*)(bptr + (size_t)(32 * i) * ldb + kt * 64);
    }
  };
  auto scaleA = [&](int kt) {
    if (MODE == G_WOUT && kt < 8) {
#pragma unroll
      for (int i = 0; i < 8; i++)
#pragma unroll
        for (int e = 0; e < 4; e++) {
          unsigned v = ra[i][e];
          float lo = __uint_as_float(v << 16) * arow_sc[i], hi = __uint_as_float(v & 0xffff0000u) * arow_sc[i];
          ra[i][e] = pack_bf2(lo, hi);
        }
    }
  };
  const int wr_off = lrow * 128 + ((lc ^ ((lrow >> 1) & 7)) << 4);
  auto lwriteA = [&](int st) {
    char* sa = smem + st * 65536;
#pragma unroll
    for (int i = 0; i < 8; i++) *(u32x4*)(sa + wr_off + i * 4096) = ra[i];
  };
  auto lwriteB = [&](int st) {
    char* sb = smem + st * 65536 + 32768;
#pragma unroll
    for (int i = 0; i < 8; i++) *(u32x4*)(sb + wr_off + i * 4096) = rb[i];
  };

  f32x16 acc[4][4];
#pragma unroll
  for (int i = 0; i < 4; i++)
#pragma unroll
    for (int j = 0; j < 4; j++)
#pragma unroll
      for (int r = 0; r < 16; r++) acc[i][j][r] = 0.f;

  const int swz = (l32 >> 1) & 7;
  const int a_base = (wm * 128 + l32) * 128;
  const int b_base = 32768 + (wn * 128 + l32) * 128;
  bf16x8 af[2][4], bfr[2][4];
  auto lfrag = [&](int buf, const char* st, int ks) {
    const int coff = (((ks * 2 + g) ^ swz) << 4);
#pragma unroll
    for (int i = 0; i < 4; i++) af[buf][i] = *(const bf16x8*)(st + a_base + i * 4096 + coff);
#pragma unroll
    for (int j = 0; j < 4; j++) bfr[buf][j] = *(const bf16x8*)(st + b_base + j * 4096 + coff);
  };
  auto mfma16 = [&](int buf) {
#pragma unroll
    for (int i = 0; i < 4; i++)
#pragma unroll
      for (int j = 0; j < 4; j++) acc[i][j] = MFMA(af[buf][i], bfr[buf][j], acc[i][j]);
  };

  gload(0);
  scaleA(0);
  lwriteA(0);
  lwriteB(0);
  __syncthreads();
  if (KT > 1) gload(1);
  lfrag(0, smem, 0);
  for (int kt = 0; kt < KT; kt++) {
    const char* st = smem + (kt & 1) * 65536;
    const bool has1 = (kt + 1 < KT), has2 = (kt + 2 < KT);
    lfrag(1, st, 1);
    if (has1) { scaleA(kt + 1); lwriteA((kt + 1) & 1); }
    mfma16(0);
    __builtin_amdgcn_sched_barrier(0);
    lfrag(0, st, 2);
    if (has1) lwriteB((kt + 1) & 1);
    mfma16(1);
    __builtin_amdgcn_sched_barrier(0);
    lfrag(1, st, 3);
    if (has2) gload(kt + 2);
    mfma16(0);
    __builtin_amdgcn_sched_barrier(0);
    asm volatile("s_waitcnt lgkmcnt(0)" ::: "memory");
    __builtin_amdgcn_s_barrier();
    __builtin_amdgcn_sched_barrier(0);
    if (has1) lfrag(0, smem + ((kt + 1) & 1) * 65536, 0);
    mfma16(1);
    __builtin_amdgcn_sched_barrier(0);
  }

  int tid2 = tid;
  asm volatile("" : "+v"(tid2));
  {
  const int tid = tid2;
  const int lane = tid & 63, w = tid >> 6, wm = w >> 1, wn = w & 1, g = lane >> 5, l32 = lane & 31;
  if (MODE == G_IN) {
    const float* ssq = p->ss + (size_t)(2 * layer) * 8 * NTOK;
    const int region = tn >> 1;
    const int colb = (tn & 1) * 256 + wn * 128 + l32;
    bf16_t* dst = (region == 1) ? p->q : p->k;
#pragma unroll
    for (int i = 0; i < 4; i++)
#pragma unroll
      for (int rq = 0; rq < 4; rq++) {
        const int row0 = rowbase + wm * 128 + i * 32 + rq * 8 + g * 4;
        float4 s4 = ss_sum4(ssq, row0);
        float sc[4] = {rsqrtf(s4.x * (1.f / 1024.f) + EPS), rsqrtf(s4.y * (1.f / 1024.f) + EPS),
                       rsqrtf(s4.z * (1.f / 1024.f) + EPS), rsqrtf(s4.w * (1.f / 1024.f) + EPS)};
#pragma unroll
        for (int j = 0; j < 4; j++) {
          const int col = colb + j * 32;
          float v[4];
#pragma unroll
          for (int r4 = 0; r4 < 4; r4++) v[r4] = acc[i][j][rq * 4 + r4] * sc[r4];
          if (region == 0) {
#pragma unroll
            for (int r4 = 0; r4 < 4; r4++) p->u[(size_t)(row0 + r4) * 512 + col] = v[r4];
          } else if (region == 3) {
            const int h = col >> 7, d = col & 127;
            const int bb = row0 >> 13, t = row0 & (SEQL - 1);
            const int q4 = (t >> 2) & 3;
            const int pq = ((q4 & 1) << 1) | (q4 >> 1);
            u32x2 pk = {pack_bf2(v[0], v[1]), pack_bf2(v[2], v[3])};
            *(u32x2*)(p->vt + ((size_t)((bb * 4 + h) * 128 + d)) * SEQL + (t & ~15) + pq * 4) = pk;
          } else {
            if ((j & 1) == 0) {
              float other[4];
#pragma unroll
              for (int r4 = 0; r4 < 4; r4++) other[r4] = __shfl_xor(v[r4], 8);
              if (l32 < 16) {
                const float sgn = (l32 < 8) ? -1.f : 1.f;
#pragma unroll
                for (int r4 = 0; r4 < 4; r4++) {
                  const float2 csv = *(const float2*)(p->cs + ((size_t)(row0 + r4) * 8 + (l32 & 7)) * 2);
                  v[r4] = v[r4] * csv.x + sgn * other[r4] * csv.y;
                }
              }
            }
#pragma unroll
            for (int r4 = 0; r4 < 4; r4++) dst[(size_t)(row0 + r4) * 512 + col] = f2bf(v[r4]);
          }
        }
      }
  } else if (MODE == G_GLU) {
    float* ssq = p->ssm_ss + ((size_t)layer * 8 + tn * 2 + wn) * NTOK;
#pragma unroll
    for (int i = 0; i < 4; i++)
#pragma unroll
      for (int rq = 0; rq < 4; rq++) {
        const int row0 = rowbase + wm * 128 + i * 32 + rq * 8 + g * 4;
#pragma unroll
        for (int r4 = 0; r4 < 4; r4++) {
          float sq = 0.f;
#pragma unroll
          for (int j = 0; j < 2; j++) {
            float a = acc[i][j][rq * 4 + r4], b = acc[i][j + 2][rq * 4 + r4];
            float o = a / (1.f + __expf(-b));
            const int col = (tn * 2 + wn) * 64 + j * 32 + l32;
            p->outg[(size_t)(row0 + r4) * 512 + col] = f2bf(o);
            sq += o * o;
          }
#pragma unroll
          for (int o = 16; o; o >>= 1) sq += __shfl_xor(sq, o);
          if (l32 == 0) ssq[row0 + r4] = sq;
        }
      }
  } else if (MODE == G_WOUT || MODE == G_DOWN) {
    float* ssq = p->ss + ((size_t)(MODE == G_WOUT ? 2 * layer + 1 : 2 * layer + 2) * 8 + tn * 2 + wn) * NTOK;
#pragma unroll
    for (int i = 0; i < 4; i++)
#pragma unroll
      for (int rq = 0; rq < 4; rq++) {
        const int row0 = rowbase + wm * 128 + i * 32 + rq * 8 + g * 4;
#pragma unroll
        for (int r4 = 0; r4 < 4; r4++) {
          float sq = 0.f;
#pragma unroll
          for (int j = 0; j < 4; j++) {
            const int col = tn * 256 + wn * 128 + j * 32 + l32;
            const size_t idx = (size_t)(row0 + r4) * 1024 + col;
            float xn = p->xf[idx] + acc[i][j][rq * 4 + r4];
            p->xf[idx] = xn;
            p->xb[idx] = f2bf(xn);
            sq += xn * xn;
          }
#pragma unroll
          for (int o = 16; o; o >>= 1) sq += __shfl_xor(sq, o);
          if (l32 == 0) ssq[row0 + r4] = sq;
        }
      }
  } else {
#pragma unroll
    for (int i = 0; i < 4; i++)
#pragma unroll
      for (int j = 0; j < 4; j++)
#pragma unroll
        for (int r = 0; r < 16; r++) {
          const int lr = wm * 128 + i * 32 + (r >> 2) * 8 + g * 4 + (r & 3);
          const int pc = wn * 128 + j * 32 + l32;
          *(bf16_t*)(smem + lr * 528 + pc * 2) = f2bf(acc[i][j][r]);
        }
    {
      float* rs = (float*)(smem + 135168);
      const int tb = 254 * upti - 2 + tid;
      float sc = 0.f;
      if (tb >= 0) {
        const int gr = min(upb * SEQL + tb, NTOK - 1);
        sc = rsqrtf(ss_sum1(p->ss + (size_t)(2 * layer + 1) * 8 * NTOK, gr) * (1.f / 1024.f) + EPS);
      }
      rs[tid] = sc;
    }
    __syncthreads();
    {
      const int cp = tid & 127, half = tid >> 7;
      const int pg = (cp >> 6) * 128 + (cp & 63), pv = pg + 64;
      const int ocol = tn * 128 + cp;
      const float* wc = p->w_conv + (size_t)layer * 3 * 5632;
      const float* bc = p->b_conv + (size_t)layer * 5632;
      const float wg0 = wc[ocol], wg1 = wc[5632 + ocol], wg2 = wc[2 * 5632 + ocol], bg = bc[ocol];
      const float wv0 = wc[FFN + ocol], wv1 = wc[5632 + FFN + ocol], wv2 = wc[2 * 5632 + FFN + ocol], bv = bc[FFN + ocol];
      const float* rs = (const float*)(smem + 135168);
      const int lr_lo = half ? 129 : 2, lr_hi = half ? 256 : 129;
      auto fetch = [&](int lr, float& gq, float& vq) {
        const float sc = rs[lr];
        gq = sc * bf2f(*(const bf16_t*)(smem + lr * 528 + pg * 2));
        vq = sc * bf2f(*(const bf16_t*)(smem + lr * 528 + pv * 2));
      };
      float g0, v0, g1, v1, g2, v2;
      fetch(lr_lo - 2, g0, v0);
      fetch(lr_lo - 1, g1, v1);
      for (int lr = lr_lo; lr < lr_hi; lr++) {
        fetch(lr, g2, v2);
        const int tb = 254 * upti - 2 + lr;
        if (tb < SEQL) {
          float gate = bg + wg0 * g0 + wg1 * g1 + wg2 * g2;
          float val = bv + wv0 * v0 + wv1 * v1 + wv2 * v2;
          float o = gate / (1.f + __expf(-gate)) * val;
          p->act[(size_t)(upb * SEQL + tb) * FFN + ocol] = f2bf(o);
        }
        g0 = g1; v0 = v1; g1 = g2; v1 = v2;
      }
    }
    __syncthreads();
  }
  }
}

__device__ __forceinline__ void attn_item(KP p, int layer, int b, int h, int qt, float lam, float outscale, char* smem, const int tid) {
  const int lane = tid & 63, w = tid >> 6, g = lane >> 5, l32 = lane & 31;
  const int tok_q = b * SEQL + qt * 128 + w * 32 + l32;
  {
    const int qrow = tid >> 4, qc = tid & 15;
#pragma unroll
    for (int i = 0; i < 8; i++) {
      const int row = qrow + 16 * i;
      u32x4 v = *(const u32x4*)(p->q + (size_t)(b * SEQL + qt * 128 + row) * 512 + h * 128 + qc * 8);
      *(u32x4*)(smem + 65536 + row * 256 + ((qc ^ (row & 15)) << 4)) = v;
    }
  }
  const int q_off = 65536 + (w * 32 + l32) * 256;
  const int q_swz = (l32 & 15);

  const int NT = 2 * qt + 2;
  const int nkt = 2 * qt + 1 + (w >> 1);
  f32x16 O[2][4];
#pragma unroll
  for (int c = 0; c < 2; c++)
#pragma unroll
    for (int dt = 0; dt < 4; dt++)
#pragma unroll
      for (int r = 0; r < 16; r++) O[c][dt][r] = 0.f;
  float mrun[2] = {-1e30f, -1e30f}, lrun[2] = {0.f, 0.f};
  const float c1 = 0.125f * 1.4426950408889634f;

  u32x4 rk[4], rv[4];
  const bf16_t* kbase = p->k + (size_t)(b * SEQL) * 512 + h * 128;
  const bf16_t* vbase = p->vt + (size_t)((b * 4 + h) * 128) * SEQL;
  const int kkey = tid >> 4, kc = tid & 15;
  const int vd = tid >> 3, vc = tid & 7;
  auto gload = [&](int kt) {
#pragma unroll
    for (int i = 0; i < 4; i++) {
      rk[i] = *(const u32x4*)(kbase + (size_t)(kt * 64 + kkey + 16 * i) * 512 + kc * 8);
      rv[i] = *(const u32x4*)(vbase + (size_t)(vd + 32 * i) * SEQL + kt * 64 + vc * 8);
    }
  };
  const int kw_off = kkey * 256 + ((kc ^ (kkey & 15)) << 4);
  const int vw_off = 16384 + vd * 128 + ((vc ^ ((vd >> 1) & 7)) << 4);
  auto lwrite = [&](int st) {
    char* s = smem + st * 32768;
#pragma unroll
    for (int i = 0; i < 4; i++) {
      *(u32x4*)(s + kw_off + i * 4096) = rk[i];
      *(u32x4*)(s + vw_off + i * 4096) = rv[i];
    }
  };

  gload(0);
  lwrite(0);
  __syncthreads();
  for (int kt = 0; kt < NT; kt++) {
    if (kt + 1 < NT) gload(kt + 1);
    if (kt < nkt) {
      const char* st = smem + (kt & 1) * 32768;
      bf16x8 pf[2][2][2];
      bf16x8 kf[8], qfr[4], vf[2][4];
      f32x16 S[1][2];
      auto loadkq = [&](int c) {
#pragma unroll
        for (int kb = 0; kb < 2; kb++)
#pragma unroll
          for (int ks = 0; ks < 4; ks++) {
            const int key = kb * 32 + l32, chunk = c * 8 + ks * 2 + g;
            kf[kb * 4 + ks] = *(const bf16x8*)(st + key * 256 + ((chunk ^ (key & 15)) << 4));
          }
#pragma unroll
        for (int ks = 0; ks < 4; ks++) qfr[ks] = *(const bf16x8*)(smem + q_off + (((c * 8 + ks * 2 + g) ^ q_swz) << 4));
      };
      auto qk = [&](int c) {
#pragma unroll
        for (int kb = 0; kb < 2; kb++) {
#pragma unroll
          for (int r = 0; r < 16; r++) S[0][kb][r] = 0.f;
#pragma unroll
          for (int ks = 0; ks < 4; ks++) S[0][kb] = MFMA(kf[kb * 4 + ks], qfr[ks], S[0][kb]);
        }
      };
      auto loadv = [&](int bi) {
#pragma unroll
        for (int dt = 0; dt < 4; dt++) {
          const int d = dt * 32 + l32, chunk = bi * 2 + g;
          vf[bi & 1][dt] = *(const bf16x8*)(st + 16384 + d * 128 + ((chunk ^ ((d >> 1) & 7)) << 4));
        }
      };
      auto softmax = [&](int c) {
        float mx = S[0][0][0];
#pragma unroll
        for (int r = 1; r < 16; r++) mx = fmaxf(mx, S[0][0][r]);
#pragma unroll
        for (int r = 0; r < 16; r++) mx = fmaxf(mx, S[0][1][r]);
        mx = fmaxf(mx, __shfl_xor(mx, 32));
        const float mcand = fmaxf(mrun[c], mx * c1);
        if (__any(mcand - mrun[c] > 8.f)) {
          const float alpha = fast_exp2(mrun[c] - mcand);
          mrun[c] = mcand;
          lrun[c] *= alpha;
#pragma unroll
          for (int dt = 0; dt < 4; dt++)
#pragma unroll
            for (int r = 0; r < 16; r++) O[c][dt][r] *= alpha;
        }
        const float mref = mrun[c];
        const f2_t c1v = {c1, c1}, mrv = {-mref, -mref};
        f2_t psum2 = {0.f, 0.f};
#pragma unroll
        for (int kb = 0; kb < 2; kb++)
#pragma unroll
          for (int r = 0; r < 16; r += 2) {
            f2_t sv = {S[0][kb][r], S[0][kb][r + 1]};
            f2_t av = __builtin_elementwise_fma(sv, c1v, mrv);
            f2_t ev = {fast_exp2(av[0]), fast_exp2(av[1])};
            S[0][kb][r] = ev[0]; S[0][kb][r + 1] = ev[1];
            psum2 += ev;
          }
        lrun[c] += psum2[0] + psum2[1];
#pragma unroll
        for (int kb = 0; kb < 2; kb++)
#pragma unroll
          for (int m = 0; m < 2; m++) {
            u32x4 pk = {pack_bf2(S[0][kb][8 * m + 0], S[0][kb][8 * m + 1]), pack_bf2(S[0][kb][8 * m + 2], S[0][kb][8 * m + 3]),
                        pack_bf2(S[0][kb][8 * m + 4], S[0][kb][8 * m + 5]), pack_bf2(S[0][kb][8 * m + 6], S[0][kb][8 * m + 7])};
            pf[c][kb][m] = __builtin_bit_cast(bf16x8, pk);
          }
      };
      loadkq(0);
      __builtin_amdgcn_sched_barrier(0);
      qk(0);
      __builtin_amdgcn_sched_barrier(0);
      loadkq(1);
      __builtin_amdgcn_sched_barrier(0);
      softmax(0);
      __builtin_amdgcn_sched_barrier(0);
      qk(1);
      loadv(0);
      __builtin_amdgcn_sched_barrier(0);
      softmax(1);
      __builtin_amdgcn_sched_barrier(0);
#pragma unroll
      for (int bi = 0; bi < 4; bi++) {
        if (bi < 3) loadv(bi + 1);
#pragma unroll
        for (int dt = 0; dt < 4; dt++) {
          O[0][dt] = MFMA(vf[bi & 1][dt], pf[0][bi >> 1][bi & 1], O[0][dt]);
          O[1][dt] = MFMA(vf[bi & 1][dt], pf[1][bi >> 1][bi & 1], O[1][dt]);
        }
        __builtin_amdgcn_sched_barrier(0);
      }
    }
    if (kt + 1 < NT) lwrite((kt + 1) & 1);
    __syncthreads();
  }

  const float l1 = lrun[0] + __shfl_xor(lrun[0], 32);
  const float l2 = lrun[1] + __shfl_xor(lrun[1], 32);
  const float i1 = 1.f / l1, i2 = lam / l2;
  float ssq = 0.f;
#pragma unroll
  for (int dt = 0; dt < 4; dt++)
#pragma unroll
    for (int r = 0; r < 16; r++) {
      float o = O[0][dt][r] * i1 - O[1][dt][r] * i2;
      O[0][dt][r] = o;
      ssq += o * o;
    }
  ssq += __shfl_xor(ssq, 32);
  const float rstd = rsqrtf(ssq * (1.f / 128.f) + EPS) * outscale;
  const float* gsub = p->subln + layer * 128;
#pragma unroll
  for (int dt = 0; dt < 4; dt++)
#pragma unroll
    for (int rq = 0; rq < 4; rq++) {
      const int d0 = dt * 32 + rq * 8 + g * 4;
      float4 gg = *(const float4*)(gsub + d0);
      u32x2 pk = {pack_bf2(O[0][dt][rq * 4 + 0] * rstd * gg.x, O[0][dt][rq * 4 + 1] * rstd * gg.y),
                  pack_bf2(O[0][dt][rq * 4 + 2] * rstd * gg.z, O[0][dt][rq * 4 + 3] * rstd * gg.w)};
      *(u32x2*)(p->att + (size_t)tok_q * 512 + h * 128 + d0) = pk;
    }
}

DI void s5_load_u(KP p, int b, int g, int j, int lane, float* ul) {
  const float4* src = (const float4*)(p->u + (size_t)(b * SEQL + j * 64 + lane) * 512 + g * 16);
  float4 v0 = src[0], v1 = src[1], v2 = src[2], v3 = src[3];
  float4* d = (float4*)(ul + lane * 16);
  d[0] = v0; d[1] = v1; d[2] = v2; d[3] = v3;
}

#define S5_BU(ul, t, bur, bui)                                              \
  {                                                                         \
    const float4* up_ = (const float4*)((ul) + (t) * 16);                   \
    float4 q0 = up_[0], q1 = up_[1], q2 = up_[2], q3 = up_[3];              \
    float uu[16] = {q0.x, q0.y, q0.z, q0.w, q1.x, q1.y, q1.z, q1.w, q2.x, q2.y, q2.z, q2.w, q3.x, q3.y, q3.z, q3.w}; \
    bur = 0.f; bui = 0.f;                                                   \
    _Pragma("unroll") for (int c_ = 0; c_ < 16; c_++) { bur += Bre[c_] * uu[c_]; bui += Bim[c_] * uu[c_]; } \
  }

__device__ __forceinline__ void s5_pass1(KP p, int layer, char* smem, const int tid) {
  const int lane = tid & 63, w = tid >> 6;
  float* ul = (float*)(smem + w * 4096);
  for (int wbase = blockIdx.x * 4; wbase < 1024; wbase += gridDim.x * 4) {
    const int wi = wbase + w;
    const int j0 = (wi & 15) * 8, g = (wi >> 4) & 31, b = wi >> 9;
    const float* tb = p->s5tab + (size_t)((layer * 32 + g) * 64 + lane) * 40;
    const float ar = tb[0], ai = tb[1];
    float Bre[16], Bim[16];
#pragma unroll
    for (int c = 0; c < 16; c++) { Bre[c] = tb[4 + c]; Bim[c] = tb[20 + c]; }
    const float4* src = (const float4*)(p->u + (size_t)(b * SEQL + j0 * 64 + lane) * 512 + g * 16);
    float4 v0 = src[0], v1 = src[1], v2 = src[2], v3 = src[3];
    for (int jj = 0; jj < 8; jj++) {
      const int j = j0 + jj;
      {
        float4* d = (float4*)(ul + lane * 16);
        d[0] = v0; d[1] = v1; d[2] = v2; d[3] = v3;
      }
      if (jj < 7) {
        const float4* nsrc = (const float4*)(p->u + (size_t)(b * SEQL + (j + 1) * 64 + lane) * 512 + g * 16);
        v0 = nsrc[0]; v1 = nsrc[1]; v2 = nsrc[2]; v3 = nsrc[3];
      }
      __syncthreads();
      float xr = 0.f, xi = 0.f;
#pragma unroll 4
      for (int t = 0; t < 64; t++) {
        float bur, bui;
        S5_BU(ul, t, bur, bui);
        const float nr = ar * xr - ai * xi + bur;
        const float ni = ar * xi + ai * xr + bui;
        xr = nr; xi = ni;
      }
      float* so = p->sloc + (size_t)((b * 32 + g) * 128 + j) * 128;
      so[lane] = xr; so[64 + lane] = xi;
      __syncthreads();
    }
  }
}

__device__ __forceinline__ void s5_pass2(KP p, int layer, char* smem, const int tid) {
  const int lane = tid & 63, w = tid >> 6;
  float* ul = (float*)(smem + w * 21504);
  float* X = ul + 1024;
  const int l32 = lane & 31, grp = lane >> 5;
  for (int wbase = blockIdx.x * 4; wbase < 1024; wbase += gridDim.x * 4) {
   const int wi = wbase + w;
   const int j0 = (wi & 15) * 8, g = (wi >> 4) & 31, b = wi >> 9;
   const float* tb = p->s5tab + (size_t)((layer * 32 + g) * 64 + lane) * 40;
   const float ar = tb[0], ai = tb[1], aTr = tb[2], aTi = tb[3];
   float Bre[16], Bim[16];
#pragma unroll
   for (int c = 0; c < 16; c++) { Bre[c] = tb[4 + c]; Bim[c] = tb[20 + c]; }
   bf16x8 cfr[8];
   {
     const int c = l32 & 15;
     const float* cr = p->c_re + (size_t)((layer * 32 + g) * 16 + c) * 64;
     const float* ci = p->c_im + (size_t)((layer * 32 + g) * 16 + c) * 64;
#pragma unroll
     for (int s8 = 0; s8 < 8; s8++) {
       const int k0 = (s8 & 3) * 16 + grp * 8;
       const float* src = (s8 < 4) ? (cr + k0) : (ci + k0);
       const float sg = (l32 < 16) ? ((s8 < 4) ? 1.f : -1.f) : 0.f;
       float4 a = *(const float4*)src, bq = *(const float4*)(src + 4);
       u32x4 pk = {pack_bf2(a.x * sg, a.y * sg), pack_bf2(a.z * sg, a.w * sg), pack_bf2(bq.x * sg, bq.y * sg), pack_bf2(bq.z * sg, bq.w * sg)};
       cfr[s8] = __builtin_bit_cast(bf16x8, pk);
     }
   }
   const float dd = p->ssm_d[(size_t)(layer * 32 + g) * 16 + (l32 & 15)];
   float xr = 0.f, xi = 0.f;
   {
     const float* sl = p->sloc + (size_t)((b * 32 + g) * 128) * 128;
     for (int i0 = 0; i0 < j0; i0 += 8) {
       float sr[8], si[8];
#pragma unroll
       for (int q = 0; q < 8; q++) { sr[q] = sl[(i0 + q) * 128 + lane]; si[q] = sl[(i0 + q) * 128 + 64 + lane]; }
#pragma unroll
       for (int q = 0; q < 8; q++) {
         const float nr = aTr * xr - aTi * xi + sr[q];
         const float ni = aTr * xi + aTi * xr + si[q];
         xr = nr; xi = ni;
       }
     }
   }
   for (int jj = 0; jj < 8; jj++) {
    const int j = j0 + jj;
    s5_load_u(p, b, g, j, lane, ul);
    __syncthreads();
    for (int sub = 0; sub < 2; sub++) {
#pragma unroll 4
      for (int t = 0; t < 32; t++) {
        float bur, bui;
        S5_BU(ul, sub * 32 + t, bur, bui);
        const float nr = ar * xr - ai * xi + bur;
        const float ni = ar * xi + ai * xr + bui;
        xr = nr; xi = ni;
        X[t * 132 + lane] = xr;
        X[t * 132 + 64 + lane] = xi;
      }
      __syncthreads();
      f32x16 yacc;
#pragma unroll
      for (int r = 0; r < 16; r++) yacc[r] = 0.f;
#pragma unroll
      for (int s8 = 0; s8 < 8; s8++) {
        const float* xs = X + l32 * 132 + ((s8 < 4) ? 0 : 64) + (s8 & 3) * 16 + grp * 8;
        float4 a = *(const float4*)xs, bq = *(const float4*)(xs + 4);
        u32x4 pk = {pack_bf2(a.x, a.y), pack_bf2(a.z, a.w), pack_bf2(bq.x, bq.y), pack_bf2(bq.z, bq.w)};
        yacc = MFMA(__builtin_bit_cast(bf16x8, pk), cfr[s8], yacc);
      }
      if (l32 < 16) {
#pragma unroll
        for (int r = 0; r < 16; r++) {
          const int tl = sub * 32 + (r >> 2) * 8 + grp * 4 + (r & 3);
          const float yv = yacc[r] + dd * ul[tl * 16 + l32];
          p->gy[(size_t)(b * SEQL + j * 64 + tl) * 512 + g * 16 + l32] = f2bf(gelu_tanh(yv));
        }
      }
      __syncthreads();
    }
   }
  }
}

__device__ __forceinline__ void phase_attn(KP p, int layer, char* smem, const int tid) {
  const int lane = tid & 63;
  const float s1 = wave_sum(p->lq1[layer * 64 + lane] * p->lk1[layer * 64 + lane]);
  const float s2 = wave_sum(p->lq2[layer * 64 + lane] * p->lk2[layer * 64 + lane]);
  const float lam_init = 0.8f - 0.6f * expf(-0.3f * (float)layer);
  const float lam = expf(s1) - expf(s2) + lam_init;
  for (int pb = blockIdx.x; pb < 256; pb += gridDim.x) {
    const int pi = (pb & 7) * 32 + (pb >> 3);
    const int b = pi >> 7, h = (pi >> 5) & 3, i = pi & 31;
    attn_item(p, layer, b, h, 63 - i, lam, 1.f - lam_init, smem, tid);
    attn_item(p, layer, b, h, i, lam, 1.f - lam_init, smem, tid);
  }
  s5_pass1(p, layer, smem, tid);
}

__device__ __forceinline__ void phase_final(KP p, const int tid) {
  const int wave = tid >> 6, lane = tid & 63;
  const float* ssq = p->ss + (size_t)8 * 8 * NTOK;
  for (int row = blockIdx.x * 4 + wave; row < NTOK; row += gridDim.x * 4) {
    const float rstd = rsqrtf(ss_sum1(ssq, row) * (1.f / 1024.f) + EPS);
#pragma unroll
    for (int i = 0; i < 4; i++) {
      float4 v = ((const float4*)(p->xf + (size_t)row * DM))[lane + 64 * i];
      float4 gq = ((const float4*)p->norm_final)[lane + 64 * i];
      float4 o = {v.x * rstd * gq.x, v.y * rstd * gq.y, v.z * rstd * gq.z, v.w * rstd * gq.w};
      ((float4*)(p->out + (size_t)row * DM))[lane + 64 * i] = o;
    }
  }
}

__device__ __forceinline__ void run_phase(KP p, int ph, char* smem) {
  const int tid = opaque_tid();
  if (ph == 0) { phase_prep(p, smem, tid); return; }
  if (ph == 29) { phase_final(p, tid); return; }
  const int layer = (ph - 1) / 7, k = (ph - 1) % 7;
  const int nb = gridDim.x, bid = blockIdx.x;
  if (k == 1) { phase_attn(p, layer, smem, tid); return; }
  if (k == 2) { s5_pass2(p, layer, smem, tid); return; }
  if (k == 0) { for (int r = 0; ; r++) { const int t = (r * 8 + (bid & 7)) * (nb >> 3) + (bid >> 3); if (r * nb >= 512) break; if (t < 512) gemm_tile(p, G_IN, layer, t, smem, tid); } }
  else if (k == 3) { for (int r = 0; ; r++) { const int t = (r * 8 + (bid & 7)) * (nb >> 3) + (bid >> 3); if (r * nb >= 256) break; if (t < 256) gemm_tile(p, G_GLU, layer, t, smem, tid); } }
  else if (k == 4) { for (int r = 0; ; r++) { const int t = (r * 8 + (bid & 7)) * (nb >> 3) + (bid >> 3); if (r * nb >= 256) break; if (t < 256) gemm_tile(p, G_WOUT, layer, t, smem, tid); } }
  else if (k == 5) { for (int r = 0; ; r++) { const int t = (r * 8 + (bid & 7)) * (nb >> 3) + (bid >> 3); if (r * nb >= 2 * 33 * 22) break; if (t < 2 * 33 * 22) gemm_tile(p, G_UP, layer, t, smem, tid); } }
  else { for (int r = 0; ; r++) { const int t = (r * 8 + (bid & 7)) * (nb >> 3) + (bid >> 3); if (r * nb >= 256) break; if (t < 256) gemm_tile(p, G_DOWN, layer, t, smem, tid); } }
}

#define PHASE_KERNEL(name, body)                                                      \
  __global__ void __launch_bounds__(256) name(Params p_unused) {                      \
    extern __shared__ __attribute__((aligned(16))) char smem[];                       \
    KP p = (KP)__builtin_amdgcn_kernarg_segment_ptr();                                \
    const int tid = threadIdx.x, nb = gridDim.x, bid = blockIdx.x;                    \
    const int layer = (int)p->phase_lo;                                               \
    (void)nb; (void)bid; (void)layer;                                                 \
    body                                                                              \
  }
PHASE_KERNEL(k_prep, phase_prep(p, smem, tid);)
PHASE_KERNEL(k_gin, for (int r = 0; ; r++) { const int t = (r * 8 + (bid & 7)) * (nb >> 3) + (bid >> 3); if (r * nb >= 512) break; if (t < 512) gemm_tile(p, G_IN, layer, t, smem, tid); })
PHASE_KERNEL(k_attn, phase_attn(p, layer, smem, tid);)
PHASE_KERNEL(k_s5p2, s5_pass2(p, layer, smem, tid);)
PHASE_KERNEL(k_glu, for (int r = 0; ; r++) { const int t = (r * 8 + (bid & 7)) * (nb >> 3) + (bid >> 3); if (r * nb >= 256) break; if (t < 256) gemm_tile(p, G_GLU, layer, t, smem, tid); })
PHASE_KERNEL(k_wout, for (int r = 0; ; r++) { const int t = (r * 8 + (bid & 7)) * (nb >> 3) + (bid >> 3); if (r * nb >= 256) break; if (t < 256) gemm_tile(p, G_WOUT, layer, t, smem, tid); })
PHASE_KERNEL(k_up, for (int r = 0; ; r++) { const int t = (r * 8 + (bid & 7)) * (nb >> 3) + (bid >> 3); if (r * nb >= 2 * 33 * 22) break; if (t < 2 * 33 * 22) gemm_tile(p, G_UP, layer, t, smem, tid); })
PHASE_KERNEL(k_down, for (int r = 0; ; r++) { const int t = (r * 8 + (bid & 7)) * (nb >> 3) + (bid >> 3); if (r * nb >= 256) break; if (t < 256) gemm_tile(p, G_DOWN, layer, t, smem, tid); })
PHASE_KERNEL(k_final, phase_final(p, tid);)

#if COOP
__global__ void __launch_bounds__(256) mega_kernel(Params p_unused) {
  extern __shared__ __attribute__((aligned(16))) char smem[];
  KP p0 = (KP)__builtin_amdgcn_kernarg_segment_ptr();
  const int ph_lo = (int)p0->phase_lo, ph_hi = (int)p0->phase_hi;
#if COOP
  if (ph_hi > 1000) cg::this_grid().sync();
#endif
  for (int ph = ph_lo; ph < ph_hi; ph++) {
    KP p = p0;
    asm volatile("" : "+s"(p));
#if TPROBE
    if (blockIdx.x == 0) p->ts[ph] = (long long)wall_clock64();
#endif
    run_phase(p, ph, smem);
#if COOP
    if (ph + 1 < ph_hi) grid_barrier(p->bar, (unsigned)(ph + 1 - ph_lo) * gridDim.x, opaque_tid());
#endif
  }
#if TPROBE
  grid_barrier(p0->bar, (unsigned)(ph_hi - ph_lo) * gridDim.x, opaque_tid());
  if (blockIdx.x == 0) {
    KP p = p0;
    long long tend = (long long)wall_clock64();
    float a = 0.f, b = 0.f;
    for (int ph = 0; ph < 30; ph++) {
      long long t0 = p->ts[ph], t1 = (ph == 29) ? tend : p->ts[ph + 1];
      int c = (ph == 0) ? 0 : (ph == 29 ? 8 : 1 + (ph - 1) % 7);
      float d = (float)(t1 - t0) * 0.01f;
      if (c == TP_A || TP_A == 9) a += d;
      if (c == TP_B || TP_B == 9) b += d;
    }
    const int t = opaque_tid();
    if (t <= 100) p->out[t] += (t == 0) ? a : b;
  }
#endif
}

#endif

extern "C" void kernel_launch(void* const* d_in, const int* in_sizes, int n_in, void* d_out, int out_size, void* d_ws,
                              size_t ws_size, hipStream_t stream) {
  static int grid_blocks = 0;
  if (!grid_blocks) {
    int dev = 0, cus = 0, per_cu = 0;
    (void)hipGetDevice(&dev);
    (void)hipDeviceGetAttribute(&cus, hipDeviceAttributeMultiprocessorCount, dev);
#if COOP
    (void)hipFuncSetAttribute((const void*)mega_kernel, hipFuncAttributeMaxDynamicSharedMemorySize, LDS_BYTES);
    (void)hipOccupancyMaxActiveBlocksPerMultiprocessor(&per_cu, (const void*)mega_kernel, 256, LDS_BYTES);
    if (per_cu < 1) { fprintf(stderr, "occupancy query returned %d\n", per_cu); per_cu = 1; }
#endif
    grid_blocks = cus;
    (void)hipGetLastError();
  }
  Params p{};
  p.x = (const float*)d_in[0]; p.pos = (const int*)d_in[1];
  p.norm_mix = (const float*)d_in[2]; p.w_in = (const float*)d_in[3];
  p.lam_re = (const float*)d_in[4]; p.lam_im = (const float*)d_in[5]; p.log_step = (const float*)d_in[6];
  p.b_re = (const float*)d_in[7]; p.b_im = (const float*)d_in[8]; p.c_re = (const float*)d_in[9]; p.c_im = (const float*)d_in[10];
  p.ssm_d = (const float*)d_in[11]; p.w_glu = (const float*)d_in[12]; p.ssm_norm = (const float*)d_in[13];
  p.lq1 = (const float*)d_in[14]; p.lk1 = (const float*)d_in[15]; p.lq2 = (const float*)d_in[16]; p.lk2 = (const float*)d_in[17];
  p.subln = (const float*)d_in[18]; p.w_out = (const float*)d_in[19]; p.norm_ffn = (const float*)d_in[20];
  p.w_up = (const float*)d_in[21]; p.w_conv = (const float*)d_in[22]; p.b_conv = (const float*)d_in[23];
  p.w_down = (const float*)d_in[24]; p.norm_final = (const float*)d_in[25];
  p.out = (float*)d_out;
  char* ws = (char*)d_ws;
  size_t off = 0;
  auto take = [&](size_t bytes) { char* r = ws + off; off += (bytes + 255) & ~(size_t)255; return r; };
  p.WinT = (bf16_t*)take((size_t)4 * 2048 * 1024 * 2);
  p.WgluT = (bf16_t*)take((size_t)4 * 1024 * 512 * 2);
  p.WoutT = (bf16_t*)take((size_t)4 * 1024 * 1024 * 2);
  p.WupT = (bf16_t*)take((size_t)4 * 5632 * 1024 * 2);
  p.WdownT = (bf16_t*)take((size_t)4 * 1024 * FFN * 2);
  p.xf = (float*)take((size_t)NTOK * DM * 4);
  p.xb = (bf16_t*)take((size_t)NTOK * DM * 2);
  p.ss = (float*)take((size_t)9 * 8 * NTOK * 4);
  p.ssm_ss = (float*)take((size_t)4 * 8 * NTOK * 4);
  p.cs = (float*)take((size_t)NTOK * 16 * 4);
  p.s5tab = (float*)take((size_t)4 * 32 * 64 * 40 * 4);
  p.sloc = (float*)take((size_t)2 * 32 * 128 * 128 * 4);
  p.ts = (long long*)take(256);
  p.bar = (unsigned*)take(256);
  char* region = take((size_t)134217728);
  p.u = (float*)region;
  p.q = (bf16_t*)(region + 33554432);
  p.k = p.q + (size_t)NTOK * 512;
  p.vt = p.k + (size_t)NTOK * 512;
  p.gy = p.vt + (size_t)NTOK * 512;
  p.outg = p.gy + (size_t)NTOK * 512;
  p.att = p.outg + (size_t)NTOK * 512;
  p.act = (bf16_t*)region;
  if (off > ws_size) { fprintf(stderr, "workspace too small: need %zu have %zu\n", off, ws_size); return; }
#if COOP
  p.phase_lo = 0; p.phase_hi = 30;
  if (hipMemsetAsync(p.bar, 0, 256, stream) != hipSuccess) fprintf(stderr, "barrier memset failed\n");
  void* args[] = {&p};
  hipError_t e = hipLaunchCooperativeKernel((const void*)mega_kernel, dim3(grid_blocks), dim3(256), args, LDS_BYTES, stream);
  if (e != hipSuccess) fprintf(stderr, "cooperative launch failed: %s (grid %d)\n", hipGetErrorString(e), grid_blocks);
#else
  typedef void (*kfn)(Params);
  const kfn seq[7] = {k_gin, k_attn, k_s5p2, k_glu, k_wout, k_up, k_down};
  static bool attr_done = false;
  if (!attr_done) {
    (void)hipFuncSetAttribute((const void*)k_prep, hipFuncAttributeMaxDynamicSharedMemorySize, LDS_BYTES);
    (void)hipFuncSetAttribute((const void*)k_final, hipFuncAttributeMaxDynamicSharedMemorySize, LDS_BYTES);
    for (int i = 0; i < 7; i++) (void)hipFuncSetAttribute((const void*)seq[i], hipFuncAttributeMaxDynamicSharedMemorySize, LDS_BYTES);
    attr_done = true;
  }
  p.phase_lo = 0; p.phase_hi = 0;
  hipLaunchKernelGGL(k_prep, dim3(grid_blocks), dim3(256), LDS_BYTES, stream, p);
  for (int layer = 0; layer < 4; layer++) {
    p.phase_lo = layer;
    for (int i = 0; i < 7; i++) hipLaunchKernelGGL(seq[i], dim3(grid_blocks), dim3(256), LDS_BYTES, stream, p);
  }
  hipLaunchKernelGGL(k_final, dim3(grid_blocks), dim3(256), LDS_BYTES, stream, p);
#endif
}
```

```cpp
#include <hip/hip_runtime.h>
#include <hip/hip_cooperative_groups.h>
#include <cstdio>
namespace cg = cooperative_groups;

#ifndef COOP
#define COOP 1
#endif
#ifndef TPROBE
#define TPROBE 0
#endif
#ifndef TP_A
#define TP_A 1
#endif
#ifndef TP_B
#define TP_B 2
#endif

typedef unsigned short bf16_t;
typedef __attribute__((ext_vector_type(8))) short bf16x8;
typedef __attribute__((ext_vector_type(16))) float f32x16;
typedef __attribute__((ext_vector_type(2))) __bf16 bf2_t;
typedef __attribute__((ext_vector_type(2))) float f2_t;
typedef __attribute__((ext_vector_type(4))) unsigned u32x4;
typedef __attribute__((ext_vector_type(2))) unsigned u32x2;

#define DI __device__ __forceinline__
#define MFMA(a, b, c) __builtin_amdgcn_mfma_f32_32x32x16_bf16((a), (b), (c), 0, 0, 0)

constexpr int NTOK = 16384, DM = 1024, SEQL = 8192, FFN = 2816;
constexpr int LDS_BYTES = 136192;
constexpr float EPS = 1e-6f;

struct Params {
  const float* x; const int* pos;
  const float *norm_mix, *w_in, *lam_re, *lam_im, *log_step, *b_re, *b_im, *c_re, *c_im, *ssm_d, *w_glu, *ssm_norm;
  const float *lq1, *lk1, *lq2, *lk2, *subln, *w_out, *norm_ffn, *w_up, *w_conv, *b_conv, *w_down, *norm_final;
  float* out;
  bf16_t *WinT, *WgluT, *WoutT, *WupT, *WdownT;
  float* xf; bf16_t* xb;
  float* u; bf16_t *q, *k, *vt, *gy, *outg, *att, *act;
  float *ss, *ssm_ss, *cs, *s5tab, *sloc;
  long long phase_lo, phase_hi;
  long long* ts;
  unsigned* bar;
};

typedef const __attribute__((address_space(4))) Params* KP;

DI unsigned pack_bf2(float a, float b) { f2_t v = {a, b}; return __builtin_bit_cast(unsigned, __builtin_convertvector(v, bf2_t)); }
DI bf16_t f2bf(float a) { return (bf16_t)(pack_bf2(a, 0.f) & 0xffffu); }
DI float bf2f(bf16_t v) { return __uint_as_float(((unsigned)v) << 16); }
DI void grid_barrier(unsigned* ctr, unsigned target, int tid) {
  asm volatile("s_waitcnt vmcnt(0)" ::: "memory");
  __syncthreads();
  if (tid == 0) {
    __builtin_amdgcn_fence(__ATOMIC_RELEASE, "agent");
    asm volatile("s_waitcnt vmcnt(0)" ::: "memory");
    __hip_atomic_fetch_add(ctr, 1u, __ATOMIC_RELAXED, __HIP_MEMORY_SCOPE_AGENT);
    while (__hip_atomic_load(ctr, __ATOMIC_RELAXED, __HIP_MEMORY_SCOPE_AGENT) < target) __builtin_amdgcn_s_sleep(1);
    __builtin_amdgcn_fence(__ATOMIC_ACQUIRE, "agent");
    asm volatile("s_waitcnt vmcnt(0)" ::: "memory");
  }
  __syncthreads();
}
DI int opaque_tid() { int t = threadIdx.x; asm volatile("" : "+v"(t)); return t; }
DI float4 ss_sum4(const float* base, int row0) {
  float4 a = *(const float4*)(base + row0);
#pragma unroll
  for (int pz = 1; pz < 8; pz++) {
    float4 b = *(const float4*)(base + (size_t)pz * NTOK + row0);
    a.x += b.x; a.y += b.y; a.z += b.z; a.w += b.w;
  }
  return a;
}
DI float ss_sum1(const float* base, int row) {
  float a = base[row];
#pragma unroll
  for (int pz = 1; pz < 8; pz++) a += base[(size_t)pz * NTOK + row];
  return a;
}
DI float wave_sum(float v) { for (int o = 32; o; o >>= 1) v += __shfl_xor(v, o); return v; }
DI float fast_exp2(float x) { return __builtin_amdgcn_exp2f(x); }
DI float gelu_tanh(float x) {
  float z = 0.7978845608028654f * (x + 0.044715f * x * x * x);
  float e = __expf(2.f * z);
  float t = 1.f - 2.f / (1.f + e);
  return 0.5f * x * (1.f + t);
}
DI float reduce_2pi(double a) {
  double n = rint(a * 0.15915494309189535);
  return (float)(a - n * 6.283185307179586);
}

DI void transpose_tile(const float* src, int ldsrc, int k0, int c0, const float* scale, int nscale,
                       bf16_t* dst, int lddst, int n0, float* lds, const int tid) {
#pragma unroll
  for (int i = 0; i < 16; i++) {
    int kk = i * 4 + (tid >> 6), nn = tid & 63;
    float v = src[(size_t)(k0 + kk) * ldsrc + c0 + nn];
    if (scale != nullptr && (k0 + kk) < nscale) v *= scale[k0 + kk];
    lds[kk * 65 + nn] = v;
  }
  __syncthreads();
  {
    int nn = tid >> 2, kq = (tid & 3) * 16;
    unsigned pk[8];
#pragma unroll
    for (int i = 0; i < 8; i++) pk[i] = pack_bf2(lds[(kq + 2 * i) * 65 + nn], lds[(kq + 2 * i + 1) * 65 + nn]);
    u32x4* d = (u32x4*)(dst + (size_t)(n0 + nn) * lddst + k0 + kq);
    u32x4 a = {pk[0], pk[1], pk[2], pk[3]}, b = {pk[4], pk[5], pk[6], pk[7]};
    d[0] = a; d[1] = b;
  }
  __syncthreads();
}

__device__ __forceinline__ void phase_prep(KP p, char* smem, const int tid) {
  const int nb = gridDim.x, bid = blockIdx.x;
  const int wave = tid >> 6, lane = tid & 63;
  for (int row = bid * 4 + wave; row < NTOK; row += nb * 4) {
    const float4* src = (const float4*)(p->x + (size_t)row * DM);
    float s = 0.f;
#pragma unroll
    for (int i = 0; i < 4; i++) {
      float4 v = src[lane + 64 * i];
      s += v.x * v.x + v.y * v.y + v.z * v.z + v.w * v.w;
      ((float4*)(p->xf + (size_t)row * DM))[lane + 64 * i] = v;
      u32x2 pk = {pack_bf2(v.x, v.y), pack_bf2(v.z, v.w)};
      ((u32x2*)(p->xb + (size_t)row * DM))[lane + 64 * i] = pk;
    }
    s = wave_sum(s);
    if (lane < 8) p->ss[(size_t)lane * NTOK + row] = (lane == 0) ? s : 0.f;
  }
  for (int i = bid * 256 + tid; i < NTOK * 8; i += nb * 256) {
    int tok = i >> 3, j = i & 7;
    double inv = (j & 4) ? ((j & 2) ? ((j & 1) ? 1.031338537721246e-05 : 5.318295896944988e-05) : ((j & 1) ? 0.0002742481756762073 : 0.001414213562373095))
                         : ((j & 2) ? ((j & 1) ? 0.007292664737217109 : 0.03760603093086393) : ((j & 1) ? 0.19392274474868576 : 1.0));
    double ang = (double)p->pos[tok] * inv;
    float r = reduce_2pi(ang);
    p->cs[2 * i] = cosf(r); p->cs[2 * i + 1] = sinf(r);
  }
  for (int i = bid * 256 + tid; i < 4 * 32 * 64; i += nb * 256) {
    int lg = i >> 6;
    float lr = p->lam_re[i], li = p->lam_im[i];
    float step = expf(p->log_step[lg]);
    float mag = expf(step * lr);
    double angd = (double)step * (double)li;
    float r1 = reduce_2pi(angd);
    float ar = mag * cosf(r1), ai = mag * sinf(r1);
    float den = lr * lr + li * li;
    float fr = ((ar - 1.f) * lr + ai * li) / den;
    float fi = (ai * lr - (ar - 1.f) * li) / den;
    float magT = expf(64.f * step * lr);
    float rT = reduce_2pi(64.0 * angd);
    float* tb = p->s5tab + (size_t)i * 40;
    tb[0] = ar; tb[1] = ai; tb[2] = magT * cosf(rT); tb[3] = magT * sinf(rT);
    for (int c = 0; c < 16; c++) {
      float br = p->b_re[(size_t)i * 16 + c], bi = p->b_im[(size_t)i * 16 + c];
      tb[4 + c] = fr * br - fi * bi;
      tb[20 + c] = fr * bi + fi * br;
    }
  }
  float* lds = (float*)smem;
  for (int job = bid; job < 4 * 3008; job += nb) {
    int layer = job / 3008, t = job % 3008;
    if (t < 512) {
      int a = t >> 4, kt = t & 15;
      transpose_tile(p->w_in + (size_t)layer * 1024 * 2048, 2048, kt * 64, a * 64, p->norm_mix + layer * 1024, 1024,
                     p->WinT + (size_t)layer * 2048 * 1024, 1024, a * 64, lds, tid);
    } else if (t < 640) {
      t -= 512; int a = t >> 3, kt = t & 7;
      transpose_tile(p->w_glu + (size_t)layer * 512 * 1024, 1024, kt * 64, (a & 1) * 512 + (a >> 1) * 64, nullptr, 0,
                     p->WgluT + (size_t)layer * 1024 * 512, 512, a * 64, lds, tid);
    } else if (t < 896) {
      t -= 640; int a = t >> 4, kt = t & 15;
      transpose_tile(p->w_out + (size_t)layer * 1024 * 1024, 1024, kt * 64, a * 64, p->ssm_norm + layer * 512, 512,
                     p->WoutT + (size_t)layer * 1024 * 1024, 1024, a * 64, lds, tid);
    } else if (t < 2304) {
      t -= 896; int a = t >> 4, kt = t & 15;
      transpose_tile(p->w_up + (size_t)layer * 1024 * 5632, 5632, kt * 64, (a & 1) * FFN + (a >> 1) * 64, p->norm_ffn + layer * 1024, 1024,
                     p->WupT + (size_t)layer * 5632 * 1024, 1024, a * 64, lds, tid);
    } else {
      t -= 2304; int a = t / 44, kt = t % 44;
      transpose_tile(p->w_down + (size_t)layer * FFN * 1024, 1024, kt * 64, a * 64, nullptr, 0,
                     p->WdownT + (size_t)layer * 1024 * FFN, FFN, a * 64, lds, tid);
    }
  }
}

enum { G_IN = 0, G_GLU = 1, G_WOUT = 2, G_UP = 3, G_DOWN = 4 };
#define ACC_PIN(tag) _Pragma("unroll") for (int i_ = 0; i_ < 4; i_++) _Pragma("unroll") for (int j_ = 0; j_ < 4; j_++) asm volatile("; pin " tag : "+a"(acc[i_][j_]));


__device__ __forceinline__ void gemm_tile(KP p, const int MODE, int layer, int tile, char* smem, const int tid) {
  const int lane = tid & 63, w = tid >> 6, wm = w >> 1, wn = w & 1, g = lane >> 5, l32 = lane & 31;
  int tn, KT, ldb, rowbase, lda;
  const bf16_t* Bt;
  const bf16_t* A0;
  int upb = 0, upti = 0;
  {
    const int TM = (MODE == G_UP) ? 66 : 64;
    const int TN = (MODE == G_IN) ? 8 : (MODE == G_UP ? 22 : 4);
    const int nfull = TN >> 2, rem = TN & 3;
    int tm;
    if (tile < nfull * 4 * TM) { const int band = tile / (4 * TM), within = tile % (4 * TM); tm = within >> 2; tn = band * 4 + (within & 3); }
    else { const int s2 = tile - nfull * 4 * TM; tm = s2 / rem; tn = nfull * 4 + s2 % rem; }
    rowbase = tm * 256;
    if (MODE == G_UP) { upb = tm / 33; upti = tm % 33; rowbase = upb * SEQL + 254 * upti - 2; }
  }
  if (MODE == G_IN) { KT = 16; ldb = 1024; Bt = p->WinT + (size_t)layer * 2048 * 1024; A0 = p->xb; lda = 1024; }
  else if (MODE == G_GLU) { KT = 8; ldb = 512; Bt = p->WgluT + (size_t)layer * 1024 * 512; A0 = p->gy; lda = 512; }
  else if (MODE == G_WOUT) { KT = 16; ldb = 1024; Bt = p->WoutT + (size_t)layer * 1024 * 1024; A0 = p->outg; lda = 512; }
  else if (MODE == G_UP) { KT = 16; ldb = 1024; Bt = p->WupT + (size_t)layer * 5632 * 1024; A0 = p->xb; lda = 1024; }
  else { KT = 44; ldb = FFN; Bt = p->WdownT + (size_t)layer * 1024 * FFN; A0 = p->act; lda = FFN; }

  u32x4 ra[8], rb[8];
  const int lrow = tid >> 3, lc = tid & 7;
  float arow_sc[8];
#pragma unroll
  for (int i = 0; i < 8; i++) arow_sc[i] = 1.f;
  if (MODE == G_WOUT) {
    const float* ssq = p->ssm_ss + (size_t)layer * 8 * NTOK;
#pragma unroll
    for (int i = 0; i < 8; i++) arow_sc[i] = rsqrtf(ss_sum1(ssq, rowbase + lrow + 32 * i) * (1.f / 512.f) + EPS);
  }
  const bf16_t* bptr = Bt + (size_t)(tn * 256 + lrow) * ldb + lc * 8;
  auto gload = [&](int kt) {
    const bf16_t* abase = A0;
    int kofs = kt * 64;
    if (MODE == G_WOUT && kt >= 8) { abase = p->att; kofs = (kt - 8) * 64; }
#pragma unroll
    for (int i = 0; i < 8; i++) {
      int gr = min(max(rowbase + lrow + 32 * i, 0), NTOK - 1);
      ra[i] = *(const u32x4*)(abase + (size_t)gr * lda + kofs + lc * 8);
      rb[i] = *(const u32x4*)(bptr + (size_t)(32 * i) * ldb + kt * 64);
    }
  };
  auto scaleA = [&](int kt) {
    if (MODE == G_WOUT && kt < 8) {
#pragma unroll
      for (int i = 0; i < 8; i++)
#pragma unroll
        for (int e = 0; e < 4; e++) {
          unsigned v = ra[i][e];
          float lo = __uint_as_float(v << 16) * arow_sc[i], hi = __uint_as_float(v & 0xffff0000u) * arow_sc[i];
          ra[i][e] = pack_bf2(lo, hi);
        }
    }
  };
  const int wr_off = lrow * 128 + ((lc ^ ((lrow >> 1) & 7)) << 4);
  auto lwriteA = [&](int st) {
    char* sa = smem + st * 65536;
#pragma unroll
    for (int i = 0; i < 8; i++) *(u32x4*)(sa + wr_off + i * 4096) = ra[i];
  };
  auto lwriteB = [&](int st) {
    char* sb = smem + st * 65536 + 32768;
#pragma unroll
    for (int i = 0; i < 8; i++) *(u32x4*)(sb + wr_off + i * 4096) = rb[i];
  };

  f32x16 acc[4][4];
#pragma unroll
  for (int i = 0; i < 4; i++)
#pragma unroll
    for (int j = 0; j < 4; j++)
#pragma unroll
      for (int r = 0; r < 16; r++) acc[i][j][r] = 0.f;

  const int swz = (l32 >> 1) & 7;
  const int a_base = (wm * 128 + l32) * 128;
  const int b_base = 32768 + (wn * 128 + l32) * 128;
  bf16x8 af[2][4], bfr[2][4];
  auto lfrag = [&](int buf, const char* st, int ks) {
    const int coff = (((ks * 2 + g) ^ swz) << 4);
#pragma unroll
    for (int i = 0; i < 4; i++) af[buf][i] = *(const bf16x8*)(st + a_base + i * 4096 + coff);
#pragma unroll
    for (int j = 0; j < 4; j++) bfr[buf][j] = *(const bf16x8*)(st + b_base + j * 4096 + coff);
  };
  auto mfma16 = [&](int buf) {
#pragma unroll
    for (int i = 0; i < 4; i++)
#pragma unroll
      for (int j = 0; j < 4; j++) acc[i][j] = MFMA(af[buf][i], bfr[buf][j], acc[i][j]);
  };

  gload(0);
  scaleA(0);
  lwriteA(0);
  lwriteB(0);
  __syncthreads();
  if (KT > 1) gload(1);
  lfrag(0, smem, 0);
  for (int kt = 0; kt < KT; kt++) {
    const char* st = smem + (kt & 1) * 65536;
    const bool has1 = (kt + 1 < KT), has2 = (kt + 2 < KT);
    lfrag(1, st, 1);
    if (has1) { scaleA(kt + 1); lwriteA((kt + 1) & 1); }
    mfma16(0);
    __builtin_amdgcn_sched_barrier(0);
    lfrag(0, st, 2);
    if (has1) lwriteB((kt + 1) & 1);
    mfma16(1);
    __builtin_amdgcn_sched_barrier(0);
    lfrag(1, st, 3);
    if (has2) gload(kt + 2);
    mfma16(0);
    __builtin_amdgcn_sched_barrier(0);
    asm volatile("s_waitcnt lgkmcnt(0)" ::: "memory");
    __builtin_amdgcn_s_barrier();
    __builtin_amdgcn_sched_barrier(0);
    if (has1) lfrag(0, smem + ((kt + 1) & 1) * 65536, 0);
    mfma16(1);
    __builtin_amdgcn_sched_barrier(0);
  }

  int tid2 = tid;
  asm volatile("" : "+v"(tid2));
  {
  const int tid = tid2;
  const int lane = tid & 63, w = tid >> 6, wm = w >> 1, wn = w & 1, g = lane >> 5, l32 = lane & 31;
  if (MODE == G_IN) {
    const float* ssq = p->ss + (size_t)(2 * layer) * 8 * NTOK;
    const int region = tn >> 1;
    const int colb = (tn & 1) * 256 + wn * 128 + l32;
    bf16_t* dst = (region == 1) ? p->q : p->k;
#pragma unroll
    for (int i = 0; i < 4; i++)
#pragma unroll
      for (int rq = 0; rq < 4; rq++) {
        const int row0 = rowbase + wm * 128 + i * 32 + rq * 8 + g * 4;
        float4 s4 = ss_sum4(ssq, row0);
        float sc[4] = {rsqrtf(s4.x * (1.f / 1024.f) + EPS), rsqrtf(s4.y * (1.f / 1024.f) + EPS),
                       rsqrtf(s4.z * (1.f / 1024.f) + EPS), rsqrtf(s4.w * (1.f / 1024.f) + EPS)};
#pragma unroll
        for (int j = 0; j < 4; j++) {
          const int col = colb + j * 32;
          float v[4];
#pragma unroll
          for (int r4 = 0; r4 < 4; r4++) v[r4] = acc[i][j][rq * 4 + r4] * sc[r4];
          if (region == 0) {
#pragma unroll
            for (int r4 = 0; r4 < 4; r4++) p->u[(size_t)(row0 + r4) * 512 + col] = v[r4];
          } else if (region == 3) {
            const int h = col >> 7, d = col & 127;
            const int bb = row0 >> 13, t = row0 & (SEQL - 1);
            const int q4 = (t >> 2) & 3;
            const int pq = ((q4 & 1) << 1) | (q4 >> 1);
            u32x2 pk = {pack_bf2(v[0], v[1]), pack_bf2(v[2], v[3])};
            *(u32x2*)(p->vt + ((size_t)((bb * 4 + h) * 128 + d)) * SEQL + (t & ~15) + pq * 4) = pk;
          } else {
            if ((j & 1) == 0) {
              float other[4];
#pragma unroll
              for (int r4 = 0; r4 < 4; r4++) other[r4] = __shfl_xor(v[r4], 8);
              if (l32 < 16) {
                const float sgn = (l32 < 8) ? -1.f : 1.f;
#pragma unroll
                for (int r4 = 0; r4 < 4; r4++) {
                  const float2 csv = *(const float2*)(p->cs + ((size_t)(row0 + r4) * 8 + (l32 & 7)) * 2);
                  v[r4] = v[r4] * csv.x + sgn * other[r4] * csv.y;
                }
              }
            }
#pragma unroll
            for (int r4 = 0; r4 < 4; r4++) dst[(size_t)(row0 + r4) * 512 + col] = f2bf(v[r4]);
          }
        }
      }
  } else if (MODE == G_GLU) {
    float* ssq = p->ssm_ss + ((size_t)layer * 8 + tn * 2 + wn) * NTOK;
#pragma unroll
    for (int i = 0; i < 4; i++)
#pragma unroll
      for (int rq = 0; rq < 4; rq++) {
        const int row0 = rowbase + wm * 128 + i * 32 + rq * 8 + g * 4;
#pragma unroll
        for (int r4 = 0; r4 < 4; r4++) {
          float sq = 0.f;
#pragma unroll
          for (int j = 0; j < 2; j++) {
            float a = acc[i][j][rq * 4 + r4], b = acc[i][j + 2][rq * 4 + r4];
            float o = a / (1.f + __expf(-b));
            const int col = (tn * 2 + wn) * 64 + j * 32 + l32;
            p->outg[(size_t)(row0 + r4) * 512 + col] = f2bf(o);
            sq += o * o;
          }
#pragma unroll
          for (int o = 16; o; o >>= 1) sq += __shfl_xor(sq, o);
          if (l32 == 0) ssq[row0 + r4] = sq;
        }
      }
  } else if (MODE == G_WOUT || MODE == G_DOWN) {
    float* ssq = p->ss + ((size_t)(MODE == G_WOUT ? 2 * layer + 1 : 2 * layer + 2) * 8 + tn * 2 + wn) * NTOK;
#pragma unroll
    for (int i = 0; i < 4; i++)
#pragma unroll
      for (int rq = 0; rq < 4; rq++) {
        const int row0 = rowbase + wm * 128 + i * 32 + rq * 8 + g * 4;
#pragma unroll
        for (int r4 = 0; r4 < 4; r4++) {
          float sq = 0.f;
#pragma unroll
          for (int j = 0; j < 4; j++) {
            const int col = tn * 256 + wn * 128 + j * 32 + l32;
            const size_t idx = (size_t)(row0 + r4) * 1024 + col;
            float xn = p->xf[idx] + acc[i][j][rq * 4 + r4];
            p->xf[idx] = xn;
            p->xb[idx] = f2bf(xn);
            sq += xn * xn;
          }
#pragma unroll
          for (int o = 16; o; o >>= 1) sq += __shfl_xor(sq, o);
          if (l32 == 0) ssq[row0 + r4] = sq;
        }
      }
  } else {
#pragma unroll
    for (int i = 0; i < 4; i++)
#pragma unroll
      for (int j = 0; j < 4; j++)
#pragma unroll
        for (int r = 0; r < 16; r++) {
          const int lr = wm * 128 + i * 32 + (r >> 2) * 8 + g * 4 + (r & 3);
          const int pc = wn * 128 + j * 32 + l32;
          *(bf16_t*)(smem + lr * 528 + pc * 2) = f2bf(acc[i][j][r]);
        }
    {
      float* rs = (float*)(smem + 135168);
      const int tb = 254 * upti - 2 + tid;
      float sc = 0.f;
      if (tb >= 0) {
        const int gr = min(upb * SEQL + tb, NTOK - 1);
        sc = rsqrtf(ss_sum1(p->ss + (size_t)(2 * layer + 1) * 8 * NTOK, gr) * (1.f / 1024.f) + EPS);
      }
      rs[tid] = sc;
    }
    __syncthreads();
    {
      const int cp = tid & 127, half = tid >> 7;
      const int pg = (cp >> 6) * 128 + (cp & 63), pv = pg + 64;
      const int ocol = tn * 128 + cp;
      const float* wc = p->w_conv + (size_t)layer * 3 * 5632;
      const float* bc = p->b_conv + (size_t)layer * 5632;
      const float wg0 = wc[ocol], wg1 = wc[5632 + ocol], wg2 = wc[2 * 5632 + ocol], bg = bc[ocol];
      const float wv0 = wc[FFN + ocol], wv1 = wc[5632 + FFN + ocol], wv2 = wc[2 * 5632 + FFN + ocol], bv = bc[FFN + ocol];
      const float* rs = (const float*)(smem + 135168);
      const int lr_lo = half ? 129 : 2, lr_hi = half ? 256 : 129;
      auto fetch = [&](int lr, float& gq, float& vq) {
        const float sc = rs[lr];
        gq = sc * bf2f(*(const bf16_t*)(smem + lr * 528 + pg * 2));
        vq = sc * bf2f(*(const bf16_t*)(smem + lr * 528 + pv * 2));
      };
      float g0, v0, g1, v1, g2, v2;
      fetch(lr_lo - 2, g0, v0);
      fetch(lr_lo - 1, g1, v1);
      for (int lr = lr_lo; lr < lr_hi; lr++) {
        fetch(lr, g2, v2);
        const int tb = 254 * upti - 2 + lr;
        if (tb < SEQL) {
          float gate = bg + wg0 * g0 + wg1 * g1 + wg2 * g2;
          float val = bv + wv0 * v0 + wv1 * v1 + wv2 * v2;
          float o = gate / (1.f + __expf(-gate)) * val;
          p->act[(size_t)(upb * SEQL + tb) * FFN + ocol] = f2bf(o);
        }
        g0 = g1; v0 = v1; g1 = g2; v1 = v2;
      }
    }
    __syncthreads();
  }
  }
}

__device__ __forceinline__ void attn_item(KP p, int layer, int b, int h, int qt, float lam, float outscale, char* smem, const int tid) {
  const int lane = tid & 63, w = tid >> 6, g = lane >> 5, l32 = lane & 31;
  const int tok_q = b * SEQL + qt * 128 + w * 32 + l32;
  {
    const int qrow = tid >> 4, qc = tid & 15;
#pragma unroll
    for (int i = 0; i < 8; i++) {
      const int row = qrow + 16 * i;
      u32x4 v = *(const u32x4*)(p->q + (size_t)(b * SEQL + qt * 128 + row) * 512 + h * 128 + qc * 8);
      *(u32x4*)(smem + 65536 + row * 256 + ((qc ^ (row & 15)) << 4)) = v;
    }
  }
  const int q_off = 65536 + (w * 32 + l32) * 256;
  const int q_swz = (l32 & 15);

  const int NT = 2 * qt + 2;
  const int nkt = 2 * qt + 1 + (w >> 1);
  f32x16 O[2][4];
#pragma unroll
  for (int c = 0; c < 2; c++)
#pragma unroll
    for (int dt = 0; dt < 4; dt++)
#pragma unroll
      for (int r = 0; r < 16; r++) O[c][dt][r] = 0.f;
  float mrun[2] = {-1e30f, -1e30f}, lrun[2] = {0.f, 0.f};
  const float c1 = 0.125f * 1.4426950408889634f;

  u32x4 rk[4], rv[4];
  const bf16_t* kbase = p->k + (size_t)(b * SEQL) * 512 + h * 128;
  const bf16_t* vbase = p->vt + (size_t)((b * 4 + h) * 128) * SEQL;
  const int kkey = tid >> 4, kc = tid & 15;
  const int vd = tid >> 3, vc = tid & 7;
  auto gload = [&](int kt) {
#pragma unroll
    for (int i = 0; i < 4; i++) {
      rk[i] = *(const u32x4*)(kbase + (size_t)(kt * 64 + kkey + 16 * i) * 512 + kc * 8);
      rv[i] = *(const u32x4*)(vbase + (size_t)(vd + 32 * i) * SEQL + kt * 64 + vc * 8);
    }
  };
  const int kw_off = kkey * 256 + ((kc ^ (kkey & 15)) << 4);
  const int vw_off = 16384 + vd * 128 + ((vc ^ ((vd >> 1) & 7)) << 4);
  auto lwrite = [&](int st) {
    char* s = smem + st * 32768;
#pragma unroll
    for (int i = 0; i < 4; i++) {
      *(u32x4*)(s + kw_off + i * 4096) = rk[i];
      *(u32x4*)(s + vw_off + i * 4096) = rv[i];
    }
  };

  gload(0);
  lwrite(0);
  __syncthreads();
  for (int kt = 0; kt < NT; kt++) {
    if (kt + 1 < NT) gload(kt + 1);
    if (kt < nkt) {
      const char* st = smem + (kt & 1) * 32768;
      bf16x8 pf[2][2][2];
      bf16x8 kf[8], qfr[4], vf[2][4];
      f32x16 S[1][2];
      auto loadkq = [&](int c) {
#pragma unroll
        for (int kb = 0; kb < 2; kb++)
#pragma unroll
          for (int ks = 0; ks < 4; ks++) {
            const int key = kb * 32 + l32, chunk = c * 8 + ks * 2 + g;
            kf[kb * 4 + ks] = *(const bf16x8*)(st + key * 256 + ((chunk ^ (key & 15)) << 4));
          }
#pragma unroll
        for (int ks = 0; ks < 4; ks++) qfr[ks] = *(const bf16x8*)(smem + q_off + (((c * 8 + ks * 2 + g) ^ q_swz) << 4));
      };
      auto qk = [&](int c) {
#pragma unroll
        for (int kb = 0; kb < 2; kb++) {
#pragma unroll
          for (int r = 0; r < 16; r++) S[0][kb][r] = 0.f;
#pragma unroll
          for (int ks = 0; ks < 4; ks++) S[0][kb] = MFMA(kf[kb * 4 + ks], qfr[ks], S[0][kb]);
        }
      };
      auto loadv = [&](int bi) {
#pragma unroll
        for (int dt = 0; dt < 4; dt++) {
          const int d = dt * 32 + l32, chunk = bi * 2 + g;
          vf[bi & 1][dt] = *(const bf16x8*)(st + 16384 + d * 128 + ((chunk ^ ((d >> 1) & 7)) << 4));
        }
      };
      auto softmax = [&](int c) {
        float mx = S[0][0][0];
#pragma unroll
        for (int r = 1; r < 16; r++) mx = fmaxf(mx, S[0][0][r]);
#pragma unroll
        for (int r = 0; r < 16; r++) mx = fmaxf(mx, S[0][1][r]);
        mx = fmaxf(mx, __shfl_xor(mx, 32));
        const float mcand = fmaxf(mrun[c], mx * c1);
        if (__any(mcand - mrun[c] > 8.f)) {
          const float alpha = fast_exp2(mrun[c] - mcand);
          mrun[c] = mcand;
          lrun[c] *= alpha;
#pragma unroll
          for (int dt = 0; dt < 4; dt++)
#pragma unroll
            for (int r = 0; r < 16; r++) O[c][dt][r] *= alpha;
        }
        const float mref = mrun[c];
        const f2_t c1v = {c1, c1}, mrv = {-mref, -mref};
        f2_t psum2 = {0.f, 0.f};
#pragma unroll
        for (int kb = 0; kb < 2; kb++)
#pragma unroll
          for (int r = 0; r < 16; r += 2) {
            f2_t sv = {S[0][kb][r], S[0][kb][r + 1]};
            f2_t av = __builtin_elementwise_fma(sv, c1v, mrv);
            f2_t ev = {fast_exp2(av[0]), fast_exp2(av[1])};
            S[0][kb][r] = ev[0]; S[0][kb][r + 1] = ev[1];
            psum2 += ev;
          }
        lrun[c] += psum2[0] + psum2[1];
#pragma unroll
        for (int kb = 0; kb < 2; kb++)
#pragma unroll
          for (int m = 0; m < 2; m++) {
            u32x4 pk = {pack_bf2(S[0][kb][8 * m + 0], S[0][kb][8 * m + 1]), pack_bf2(S[0][kb][8 * m + 2], S[0][kb][8 * m + 3]),
                        pack_bf2(S[0][kb][8 * m + 4], S[0][kb][8 * m + 5]), pack_bf2(S[0][kb][8 * m + 6], S[0][kb][8 * m + 7])};
            pf[c][kb][m] = __builtin_bit_cast(bf16x8, pk);
          }
      };
      loadkq(0);
      __builtin_amdgcn_sched_barrier(0);
      qk(0);
      __builtin_amdgcn_sched_barrier(0);
      loadkq(1);
      __builtin_amdgcn_sched_barrier(0);
      softmax(0);
      __builtin_amdgcn_sched_barrier(0);
      qk(1);
      loadv(0);
      __builtin_amdgcn_sched_barrier(0);
      softmax(1);
      __builtin_amdgcn_sched_barrier(0);
#pragma unroll
      for (int bi = 0; bi < 4; bi++) {
        if (bi < 3) loadv(bi + 1);
#pragma unroll
        for (int dt = 0; dt < 4; dt++) {
          O[0][dt] = MFMA(vf[bi & 1][dt], pf[0][bi >> 1][bi & 1], O[0][dt]);
          O[1][dt] = MFMA(vf[bi & 1][dt], pf[1][bi >> 1][bi & 1], O[1][dt]);
        }
        __builtin_amdgcn_sched_barrier(0);
      }
    }
    if (kt + 1 < NT) lwrite((kt + 1) & 1);
    __syncthreads();
  }

  const float l1 = lrun[0] + __shfl_xor(lrun[0], 32);
  const float l2 = lrun[1] + __shfl_xor(lrun[1], 32);
  const float i1 = 1.f / l1, i2 = lam / l2;
  float ssq = 0.f;
#pragma unroll
  for (int dt = 0; dt < 4; dt++)
#pragma unroll
    for (int r = 0; r < 16; r++) {
      float o = O[0][dt][r] * i1 - O[1][dt][r] * i2;
      O[0][dt][r] = o;
      ssq += o * o;
    }
  ssq += __shfl_xor(ssq, 32);
  const float rstd = rsqrtf(ssq * (1.f / 128.f) + EPS) * outscale;
  const float* gsub = p->subln + layer * 128;
#pragma unroll
  for (int dt = 0; dt < 4; dt++)
#pragma unroll
    for (int rq = 0; rq < 4; rq++) {
      const int d0 = dt * 32 + rq * 8 + g * 4;
      float4 gg = *(const float4*)(gsub + d0);
      u32x2 pk = {pack_bf2(O[0][dt][rq * 4 + 0] * rstd * gg.x, O[0][dt][rq * 4 + 1] * rstd * gg.y),
                  pack_bf2(O[0][dt][rq * 4 + 2] * rstd * gg.z, O[0][dt][rq * 4 + 3] * rstd * gg.w)};
      *(u32x2*)(p->att + (size_t)tok_q * 512 + h * 128 + d0) = pk;
    }
}

DI void s5_load_u(KP p, int b, int g, int j, int lane, float* ul) {
  const float4* src = (const float4*)(p->u + (size_t)(b * SEQL + j * 64 + lane) * 512 + g * 16);
  float4 v0 = src[0], v1 = src[1], v2 = src[2], v3 = src[3];
  float4* d = (float4*)(ul + lane * 16);
  d[0] = v0; d[1] = v1; d[2] = v2; d[3] = v3;
}

DI float swap_half(float v, const int which) {
  const unsigned u = __float_as_uint(v);
  auto r = __builtin_amdgcn_permlane32_swap(u, u, false, false);
  return __uint_as_float(which ? r[1] : r[0]);
}

struct S5Coef { float arA, aiA, arB, aiB; };

template <bool STORE>
DI void s5_scan32(const float* ul_sub, const bf16x8 (&bfr)[4], const S5Coef& cf, float& xAr, float& xAi, float& xBr, float& xBi,
                  float* X, const int l32, const int grp) {
  bf16x8 af;
  {
    const float* us = ul_sub + l32 * 16 + grp * 8;
    float4 a = *(const float4*)us, bq = *(const float4*)(us + 4);
    u32x4 pk = {pack_bf2(a.x, a.y), pack_bf2(a.z, a.w), pack_bf2(bq.x, bq.y), pack_bf2(bq.z, bq.w)};
    af = __builtin_bit_cast(bf16x8, pk);
  }
  f32x16 zero;
#pragma unroll
  for (int r = 0; r < 16; r++) zero[r] = 0.f;
  const f32x16 bu0 = MFMA(af, bfr[0], zero), bu1 = MFMA(af, bfr[1], zero), bu2 = MFMA(af, bfr[2], zero), bu3 = MFMA(af, bfr[3], zero);
#pragma unroll
  for (int k = 0; k < 8; k++) {
    float sAr[4], sAi[4], sBr[4], sBi[4];
#pragma unroll
    for (int i = 0; i < 4; i++) {
      const int r = (k >> 1) * 4 + i;
      const float nAr = cf.arA * xAr - cf.aiA * xAi + bu0[r];
      const float nAi = cf.arA * xAi + cf.aiA * xAr + bu2[r];
      const float nBr = cf.arB * xBr - cf.aiB * xBi + bu1[r];
      const float nBi = cf.arB * xBi + cf.aiB * xBr + bu3[r];
      xAr = nAr; xAi = nAi; xBr = nBr; xBi = nBi;
      sAr[i] = nAr; sAi[i] = nAi; sBr[i] = nBr; sBi[i] = nBi;
    }
    if (STORE) {
      if (grp == (k & 1)) {
#pragma unroll
        for (int i = 0; i < 4; i++) {
          float* xr = X + (4 * k + i) * 132;
          xr[l32] = sAr[i]; xr[64 + l32] = sAi[i]; xr[32 + l32] = sBr[i]; xr[96 + l32] = sBi[i];
        }
      }
    }
    xAr = swap_half(xAr, k & 1); xAi = swap_half(xAi, k & 1);
    xBr = swap_half(xBr, k & 1); xBi = swap_half(xBi, k & 1);
  }
}

DI void s5_setup(KP p, int layer, int g, int l32, int grp, S5Coef& cf, bf16x8 (&bfr)[4]) {
  const float* t0 = p->s5tab + (size_t)((layer * 32 + g) * 64) * 40;
  cf.arA = t0[l32 * 40]; cf.aiA = t0[l32 * 40 + 1];
  cf.arB = t0[(32 + l32) * 40]; cf.aiB = t0[(32 + l32) * 40 + 1];
#pragma unroll
  for (int jt = 0; jt < 4; jt++) {
    const float* src = t0 + (l32 + 32 * (jt & 1)) * 40 + 4 + (jt >> 1) * 16 + grp * 8;
    float4 a = *(const float4*)src, bq = *(const float4*)(src + 4);
    u32x4 pk = {pack_bf2(a.x, a.y), pack_bf2(a.z, a.w), pack_bf2(bq.x, bq.y), pack_bf2(bq.z, bq.w)};
    bfr[jt] = __builtin_bit_cast(bf16x8, pk);
  }
}

__device__ __forceinline__ void s5_pass1(KP p, int layer, char* smem, const int tid) {
  const int lane = tid & 63, w = tid >> 6, l32 = lane & 31, grp = lane >> 5;
  float* ul = (float*)(smem + w * 4096);
  for (int wbase = blockIdx.x * 4; wbase < 1024; wbase += gridDim.x * 4) {
    const int wi = wbase + w;
    const int j0 = (wi & 15) * 8, g = (wi >> 4) & 31, b = wi >> 9;
    S5Coef cf; bf16x8 bfr[4];
    s5_setup(p, layer, g, l32, grp, cf, bfr);
    const float4* src = (const float4*)(p->u + (size_t)(b * SEQL + j0 * 64 + lane) * 512 + g * 16);
    float4 v0 = src[0], v1 = src[1], v2 = src[2], v3 = src[3];
    for (int jj = 0; jj < 8; jj++) {
      const int j = j0 + jj;
      {
        float4* d = (float4*)(ul + lane * 16);
        d[0] = v0; d[1] = v1; d[2] = v2; d[3] = v3;
      }
      if (jj < 7) {
        const float4* nsrc = (const float4*)(p->u + (size_t)(b * SEQL + (j + 1) * 64 + lane) * 512 + g * 16);
        v0 = nsrc[0]; v1 = nsrc[1]; v2 = nsrc[2]; v3 = nsrc[3];
      }
      __syncthreads();
      float xAr = 0.f, xAi = 0.f, xBr = 0.f, xBi = 0.f;
      s5_scan32<false>(ul, bfr, cf, xAr, xAi, xBr, xBi, nullptr, l32, grp);
      s5_scan32<false>(ul + 32 * 16, bfr, cf, xAr, xAi, xBr, xBi, nullptr, l32, grp);
      float* so = p->sloc + (size_t)((b * 32 + g) * 128 + j) * 128;
      so[lane] = grp ? xBr : xAr; so[64 + lane] = grp ? xBi : xAi;
      __syncthreads();
    }
  }
}

__device__ __forceinline__ void s5_pass2(KP p, int layer, char* smem, const int tid) {
  const int lane = tid & 63, w = tid >> 6;
  float* ul = (float*)(smem + w * 21504);
  float* X = ul + 1024;
  const int l32 = lane & 31, grp = lane >> 5;
  for (int wbase = blockIdx.x * 4; wbase < 1024; wbase += gridDim.x * 4) {
   const int wi = wbase + w;
   const int j0 = (wi & 15) * 8, g = (wi >> 4) & 31, b = wi >> 9;
   S5Coef cf; bf16x8 bfr[4];
   s5_setup(p, layer, g, l32, grp, cf, bfr);
   bf16x8 cfr[8];
   {
     const int c = l32 & 15;
     const float* cr = p->c_re + (size_t)((layer * 32 + g) * 16 + c) * 64;
     const float* ci = p->c_im + (size_t)((layer * 32 + g) * 16 + c) * 64;
#pragma unroll
     for (int s8 = 0; s8 < 8; s8++) {
       const int k0 = (s8 & 3) * 16 + grp * 8;
       const float* src = (s8 < 4) ? (cr + k0) : (ci + k0);
       const float sg = (l32 < 16) ? ((s8 < 4) ? 1.f : -1.f) : 0.f;
       float4 a = *(const float4*)src, bq = *(const float4*)(src + 4);
       u32x4 pk = {pack_bf2(a.x * sg, a.y * sg), pack_bf2(a.z * sg, a.w * sg), pack_bf2(bq.x * sg, bq.y * sg), pack_bf2(bq.z * sg, bq.w * sg)};
       cfr[s8] = __builtin_bit_cast(bf16x8, pk);
     }
   }
   const float dd = p->ssm_d[(size_t)(layer * 32 + g) * 16 + (l32 & 15)];
   float xAr, xAi, xBr, xBi;
   {
     const float* tb = p->s5tab + (size_t)((layer * 32 + g) * 64 + lane) * 40;
     const float aTr = tb[2], aTi = tb[3];
     float xr = 0.f, xi = 0.f;
     const float* sl = p->sloc + (size_t)((b * 32 + g) * 128) * 128;
     for (int i0 = 0; i0 < j0; i0 += 8) {
       float sr[8], si[8];
#pragma unroll
       for (int q = 0; q < 8; q++) { sr[q] = sl[(i0 + q) * 128 + lane]; si[q] = sl[(i0 + q) * 128 + 64 + lane]; }
#pragma unroll
       for (int q = 0; q < 8; q++) {
         const float nr = aTr * xr - aTi * xi + sr[q];
         const float ni = aTr * xi + aTi * xr + si[q];
         xr = nr; xi = ni;
       }
     }
     xAr = swap_half(xr, 0); xBr = swap_half(xr, 1);
     xAi = swap_half(xi, 0); xBi = swap_half(xi, 1);
   }
   for (int jj = 0; jj < 8; jj++) {
    const int j = j0 + jj;
    s5_load_u(p, b, g, j, lane, ul);
    __syncthreads();
    for (int sub = 0; sub < 2; sub++) {
      s5_scan32<true>(ul + sub * 32 * 16, bfr, cf, xAr, xAi, xBr, xBi, X, l32, grp);
      __syncthreads();
      f32x16 yacc;
#pragma unroll
      for (int r = 0; r < 16; r++) yacc[r] = 0.f;
#pragma unroll
      for (int s8 = 0; s8 < 8; s8++) {
        const float* xs = X + l32 * 132 + ((s8 < 4) ? 0 : 64) + (s8 & 3) * 16 + grp * 8;
        float4 a = *(const float4*)xs, bq = *(const float4*)(xs + 4);
        u32x4 pk = {pack_bf2(a.x, a.y), pack_bf2(a.z, a.w), pack_bf2(bq.x, bq.y), pack_bf2(bq.z, bq.w)};
        yacc = MFMA(__builtin_bit_cast(bf16x8, pk), cfr[s8], yacc);
      }
      if (l32 < 16) {
#pragma unroll
        for (int r = 0; r < 16; r++) {
          const int tl = sub * 32 + (r >> 2) * 8 + grp * 4 + (r & 3);
          const float yv = yacc[r] + dd * ul[tl * 16 + l32];
          p->gy[(size_t)(b * SEQL + j * 64 + tl) * 512 + g * 16 + l32] = f2bf(gelu_tanh(yv));
        }
      }
      __syncthreads();
    }
   }
  }
}

__device__ __forceinline__ void phase_attn(KP p, int layer, char* smem, const int tid) {
  const int lane = tid & 63;
  const float s1 = wave_sum(p->lq1[layer * 64 + lane] * p->lk1[layer * 64 + lane]);
  const float s2 = wave_sum(p->lq2[layer * 64 + lane] * p->lk2[layer * 64 + lane]);
  const float lam_init = 0.8f - 0.6f * expf(-0.3f * (float)layer);
  const float lam = expf(s1) - expf(s2) + lam_init;
  for (int pb = blockIdx.x; pb < 256; pb += gridDim.x) {
    const int pi = (pb & 7) * 32 + (pb >> 3);
    const int b = pi >> 7, h = (pi >> 5) & 3, i = pi & 31;
    attn_item(p, layer, b, h, 63 - i, lam, 1.f - lam_init, smem, tid);
    attn_item(p, layer, b, h, i, lam, 1.f - lam_init, smem, tid);
  }
  s5_pass1(p, layer, smem, tid);
}

__device__ __forceinline__ void phase_final(KP p, const int tid) {
  const int wave = tid >> 6, lane = tid & 63;
  const float* ssq = p->ss + (size_t)8 * 8 * NTOK;
  for (int row = blockIdx.x * 4 + wave; row < NTOK; row += gridDim.x * 4) {
    const float rstd = rsqrtf(ss_sum1(ssq, row) * (1.f / 1024.f) + EPS);
#pragma unroll
    for (int i = 0; i < 4; i++) {
      float4 v = ((const float4*)(p->xf + (size_t)row * DM))[lane + 64 * i];
      float4 gq = ((const float4*)p->norm_final)[lane + 64 * i];
      float4 o = {v.x * rstd * gq.x, v.y * rstd * gq.y, v.z * rstd * gq.z, v.w * rstd * gq.w};
      ((float4*)(p->out + (size_t)row * DM))[lane + 64 * i] = o;
    }
  }
}

__device__ __forceinline__ void run_phase(KP p, int ph, char* smem) {
  const int tid = opaque_tid();
  if (ph == 0) { phase_prep(p, smem, tid); return; }
  if (ph == 29) { phase_final(p, tid); return; }
  const int layer = (ph - 1) / 7, k = (ph - 1) % 7;
  const int nb = gridDim.x, bid = blockIdx.x;
  if (k == 1) { phase_attn(p, layer, smem, tid); return; }
  if (k == 2) { s5_pass2(p, layer, smem, tid); return; }
  if (k == 0) { for (int r = 0; ; r++) { const int t = (r * 8 + (bid & 7)) * (nb >> 3) + (bid >> 3); if (r * nb >= 512) break; if (t < 512) gemm_tile(p, G_IN, layer, t, smem, tid); } }
  else if (k == 3) { for (int r = 0; ; r++) { const int t = (r * 8 + (bid & 7)) * (nb >> 3) + (bid >> 3); if (r * nb >= 256) break; if (t < 256) gemm_tile(p, G_GLU, layer, t, smem, tid); } }
  else if (k == 4) { for (int r = 0; ; r++) { const int t = (r * 8 + (bid & 7)) * (nb >> 3) + (bid >> 3); if (r * nb >= 256) break; if (t < 256) gemm_tile(p, G_WOUT, layer, t, smem, tid); } }
  else if (k == 5) { for (int r = 0; ; r++) { const int t = (r * 8 + (bid & 7)) * (nb >> 3) + (bid >> 3); if (r * nb >= 2 * 33 * 22) break; if (t < 2 * 33 * 22) gemm_tile(p, G_UP, layer, t, smem, tid); } }
  else { for (int r = 0; ; r++) { const int t = (r * 8 + (bid & 7)) * (nb >> 3) + (bid >> 3); if (r * nb >= 256) break; if (t < 256) gemm_tile(p, G_DOWN, layer, t, smem, tid); } }
}

#define PHASE_KERNEL(name, body)                                                      \
  __global__ void __launch_bounds__(256) name(Params p_unused) {                      \
    extern __shared__ __attribute__((aligned(16))) char smem[];                       \
    KP p = (KP)__builtin_amdgcn_kernarg_segment_ptr();                                \
    const int tid = threadIdx.x, nb = gridDim.x, bid = blockIdx.x;                    \
    const int layer = (int)p->phase_lo;                                               \
    (void)nb; (void)bid; (void)layer;                                                 \
    body                                                                              \
  }
PHASE_KERNEL(k_prep, phase_prep(p, smem, tid);)
PHASE_KERNEL(k_gin, for (int r = 0; ; r++) { const int t = (r * 8 + (bid & 7)) * (nb >> 3) + (bid >> 3); if (r * nb >= 512) break; if (t < 512) gemm_tile(p, G_IN, layer, t, smem, tid); })
PHASE_KERNEL(k_attn, phase_attn(p, layer, smem, tid);)
PHASE_KERNEL(k_s5p2, s5_pass2(p, layer, smem, tid);)
PHASE_KERNEL(k_glu, for (int r = 0; ; r++) { const int t = (r * 8 + (bid & 7)) * (nb >> 3) + (bid >> 3); if (r * nb >= 256) break; if (t < 256) gemm_tile(p, G_GLU, layer, t, smem, tid); })
PHASE_KERNEL(k_wout, for (int r = 0; ; r++) { const int t = (r * 8 + (bid & 7)) * (nb >> 3) + (bid >> 3); if (r * nb >= 256) break; if (t < 256) gemm_tile(p, G_WOUT, layer, t, smem, tid); })
PHASE_KERNEL(k_up, for (int r = 0; ; r++) { const int t = (r * 8 + (bid & 7)) * (nb >> 3) + (bid >> 3); if (r * nb >= 2 * 33 * 22) break; if (t < 2 * 33 * 22) gemm_tile(p, G_UP, layer, t, smem, tid); })
PHASE_KERNEL(k_down, for (int r = 0; ; r++) { const int t = (r * 8 + (bid & 7)) * (nb >> 3) + (bid >> 3); if (r * nb >= 256) break; if (t < 256) gemm_tile(p, G_DOWN, layer, t, smem, tid); })
PHASE_KERNEL(k_final, phase_final(p, tid);)

#if COOP
__global__ void __launch_bounds__(256) mega_kernel(Params p_unused) {
  extern __shared__ __attribute__((aligned(16))) char smem[];
  KP p0 = (KP)__builtin_amdgcn_kernarg_segment_ptr();
  const int ph_lo = (int)p0->phase_lo, ph_hi = (int)p0->phase_hi;
#if COOP
  if (ph_hi > 1000) cg::this_grid().sync();
#endif
  for (int ph = ph_lo; ph < ph_hi; ph++) {
    KP p = p0;
    asm volatile("" : "+s"(p));
#if TPROBE
    if (blockIdx.x == 0) p->ts[ph] = (long long)wall_clock64();
#endif
    run_phase(p, ph, smem);
#if COOP
    if (ph + 1 < ph_hi) grid_barrier(p->bar, (unsigned)(ph + 1 - ph_lo) * gridDim.x, opaque_tid());
#endif
  }
#if TPROBE
  grid_barrier(p0->bar, (unsigned)(ph_hi - ph_lo) * gridDim.x, opaque_tid());
  if (blockIdx.x == 0) {
    KP p = p0;
    long long tend = (long long)wall_clock64();
    float a = 0.f, b = 0.f;
    for (int ph = 0; ph < 30; ph++) {
      long long t0 = p->ts[ph], t1 = (ph == 29) ? tend : p->ts[ph + 1];
      int c = (ph == 0) ? 0 : (ph == 29 ? 8 : 1 + (ph - 1) % 7);
      float d = (float)(t1 - t0) * 0.01f;
      if (c == TP_A || TP_A == 9) a += d;
      if (c == TP_B || TP_B == 9) b += d;
    }
    const int t = opaque_tid();
    if (t <= 100) p->out[t] += (t == 0) ? a : b;
  }
#endif
}

#endif

extern "C" void kernel_launch(void* const* d_in, const int* in_sizes, int n_in, void* d_out, int out_size, void* d_ws,
                              size_t ws_size, hipStream_t stream) {
  static int grid_blocks = 0;
  if (!grid_blocks) {
    int dev = 0, cus = 0, per_cu = 0;
    (void)hipGetDevice(&dev);
    (void)hipDeviceGetAttribute(&cus, hipDeviceAttributeMultiprocessorCount, dev);
#if COOP
    (void)hipFuncSetAttribute((const void*)mega_kernel, hipFuncAttributeMaxDynamicSharedMemorySize, LDS_BYTES);
    (void)hipOccupancyMaxActiveBlocksPerMultiprocessor(&per_cu, (const void*)mega_kernel, 256, LDS_BYTES);
    if (per_cu < 1) { fprintf(stderr, "occupancy query returned %d\n", per_cu); per_cu = 1; }
#endif
    grid_blocks = cus;
    (void)hipGetLastError();
  }
  Params p{};
  p.x = (const float*)d_in[0]; p.pos = (const int*)d_in[1];
  p.norm_mix = (const float*)d_in[2]; p.w_in = (const float*)d_in[3];
  p.lam_re = (const float*)d_in[4]; p.lam_im = (const float*)d_in[5]; p.log_step = (const float*)d_in[6];
  p.b_re = (const float*)d_in[7]; p.b_im = (const float*)d_in[8]; p.c_re = (const float*)d_in[9]; p.c_im = (const float*)d_in[10];
  p.ssm_d = (const float*)d_in[11]; p.w_glu = (const float*)d_in[12]; p.ssm_norm = (const float*)d_in[13];
  p.lq1 = (const float*)d_in[14]; p.lk1 = (const float*)d_in[15]; p.lq2 = (const float*)d_in[16]; p.lk2 = (const float*)d_in[17];
  p.subln = (const float*)d_in[18]; p.w_out = (const float*)d_in[19]; p.norm_ffn = (const float*)d_in[20];
  p.w_up = (const float*)d_in[21]; p.w_conv = (const float*)d_in[22]; p.b_conv = (const float*)d_in[23];
  p.w_down = (const float*)d_in[24]; p.norm_final = (const float*)d_in[25];
  p.out = (float*)d_out;
  char* ws = (char*)d_ws;
  size_t off = 0;
  auto take = [&](size_t bytes) { char* r = ws + off; off += (bytes + 255) & ~(size_t)255; return r; };
  p.WinT = (bf16_t*)take((size_t)4 * 2048 * 1024 * 2);
  p.WgluT = (bf16_t*)take((size_t)4 * 1024 * 512 * 2);
  p.WoutT = (bf16_t*)take((size_t)4 * 1024 * 1024 * 2);
  p.WupT = (bf16_t*)take((size_t)4 * 5632 * 1024 * 2);
  p.WdownT = (bf16_t*)take((size_t)4 * 1024 * FFN * 2);
  p.xf = (float*)take((size_t)NTOK * DM * 4);
  p.xb = (bf16_t*)take((size_t)NTOK * DM * 2);
  p.ss = (float*)take((size_t)9 * 8 * NTOK * 4);
  p.ssm_ss = (float*)take((size_t)4 * 8 * NTOK * 4);
  p.cs = (float*)take((size_t)NTOK * 16 * 4);
  p.s5tab = (float*)take((size_t)4 * 32 * 64 * 40 * 4);
  p.sloc = (float*)take((size_t)2 * 32 * 128 * 128 * 4);
  p.ts = (long long*)take(256);
  p.bar = (unsigned*)take(256);
  char* region = take((size_t)134217728);
  p.u = (float*)region;
  p.q = (bf16_t*)(region + 33554432);
  p.k = p.q + (size_t)NTOK * 512;
  p.vt = p.k + (size_t)NTOK * 512;
  p.gy = p.vt + (size_t)NTOK * 512;
  p.outg = p.gy + (size_t)NTOK * 512;
  p.att = p.outg + (size_t)NTOK * 512;
  p.act = (bf16_t*)region;
  if (off > ws_size) { fprintf(stderr, "workspace too small: need %zu have %zu\n", off, ws_size); return; }
#if COOP
  p.phase_lo = 0; p.phase_hi = 30;
  if (hipMemsetAsync(p.bar, 0, 256, stream) != hipSuccess) fprintf(stderr, "barrier memset failed\n");
  void* args[] = {&p};
  hipError_t e = hipLaunchCooperativeKernel((const void*)mega_kernel, dim3(grid_blocks), dim3(256), args, LDS_BYTES, stream);
  if (e != hipSuccess) fprintf(stderr, "cooperative launch failed: %s (grid %d)\n", hipGetErrorString(e), grid_blocks);
#else
  typedef void (*kfn)(Params);
  const kfn seq[7] = {k_gin, k_attn, k_s5p2, k_glu, k_wout, k_up, k_down};
  static bool attr_done = false;
  if (!attr_done) {
    (void)hipFuncSetAttribute((const void*)k_prep, hipFuncAttributeMaxDynamicSharedMemorySize, LDS_BYTES);
    (void)hipFuncSetAttribute((const void*)k_final, hipFuncAttributeMaxDynamicSharedMemorySize, LDS_BYTES);
    for (int i = 0; i < 7; i++) (void)hipFuncSetAttribute((const void*)seq[i], hipFuncAttributeMaxDynamicSharedMemorySize, LDS_BYTES);
    attr_done = true;
  }
  p.phase_lo = 0; p.phase_hi = 0;
  hipLaunchKernelGGL(k_prep, dim3(grid_blocks), dim3(256), LDS_BYTES, stream, p);
  for (int layer = 0; layer < 4; layer++) {
    p.phase_lo = layer;
    for (int i = 0; i < 7; i++) hipLaunchKernelGGL(seq[i], dim3(grid_blocks), dim3(256), LDS_BYTES, stream, p);
  }
  hipLaunchKernelGGL(k_final, dim3(grid_blocks), dim3(256), LDS_BYTES, stream, p);
#endif
}
```

```cpp
#include <hip/hip_runtime.h>
#include <hip/hip_cooperative_groups.h>
#include <cstdio>
namespace cg = cooperative_groups;

#ifndef COOP
#define COOP 1
#endif
#ifndef TPROBE
#define TPROBE 0
#endif
#ifndef TP_A
#define TP_A 1
#endif
#ifndef TP_B
#define TP_B 2
#endif

typedef unsigned short bf16_t;
typedef __attribute__((ext_vector_type(8))) short bf16x8;
typedef __attribute__((ext_vector_type(16))) float f32x16;
typedef __attribute__((ext_vector_type(2))) __bf16 bf2_t;
typedef __attribute__((ext_vector_type(2))) float f2_t;
typedef __attribute__((ext_vector_type(4))) unsigned u32x4;
typedef __attribute__((ext_vector_type(2))) unsigned u32x2;

#define DI __device__ __forceinline__
#define MFMA(a, b, c) __builtin_amdgcn_mfma_f32_32x32x16_bf16((a), (b), (c), 0, 0, 0)

constexpr int NTOK = 16384, DM = 1024, SEQL = 8192, FFN = 2816;
constexpr int LDS_BYTES = 136192;
constexpr float EPS = 1e-6f;

struct Params {
  const float* x; const int* pos;
  const float *norm_mix, *w_in, *lam_re, *lam_im, *log_step, *b_re, *b_im, *c_re, *c_im, *ssm_d, *w_glu, *ssm_norm;
  const float *lq1, *lk1, *lq2, *lk2, *subln, *w_out, *norm_ffn, *w_up, *w_conv, *b_conv, *w_down, *norm_final;
  float* out;
  bf16_t *WinT, *WgluT, *WoutT, *WupT, *WdownT;
  float* xf; bf16_t* xb;
  bf16_t *u, *q, *k, *vt, *gy, *outg, *att, *act;
  float *ss, *ssm_ss, *cs, *s5tab, *sloc;
  long long phase_lo, phase_hi;
  long long* ts;
  unsigned* bar;
};

typedef const __attribute__((address_space(4))) Params* KP;

DI unsigned pack_bf2(float a, float b) { f2_t v = {a, b}; return __builtin_bit_cast(unsigned, __builtin_convertvector(v, bf2_t)); }
DI bf16_t f2bf(float a) { return (bf16_t)(pack_bf2(a, 0.f) & 0xffffu); }
DI float bf2f(bf16_t v) { return __uint_as_float(((unsigned)v) << 16); }
DI void grid_barrier(unsigned* ctr, unsigned target, int tid) {
  asm volatile("s_waitcnt vmcnt(0)" ::: "memory");
  __syncthreads();
  if (tid == 0) {
    __builtin_amdgcn_fence(__ATOMIC_RELEASE, "agent");
    asm volatile("s_waitcnt vmcnt(0)" ::: "memory");
    __hip_atomic_fetch_add(ctr, 1u, __ATOMIC_RELAXED, __HIP_MEMORY_SCOPE_AGENT);
    while (__hip_atomic_load(ctr, __ATOMIC_RELAXED, __HIP_MEMORY_SCOPE_AGENT) < target) __builtin_amdgcn_s_sleep(1);
    __builtin_amdgcn_fence(__ATOMIC_ACQUIRE, "agent");
    asm volatile("s_waitcnt vmcnt(0)" ::: "memory");
  }
  __syncthreads();
}
DI int opaque_tid() { int t = threadIdx.x; asm volatile("" : "+v"(t)); return t; }
DI float4 ss_sum4(const float* base, int row0) {
  float4 a = *(const float4*)(base + row0);
#pragma unroll
  for (int pz = 1; pz < 8; pz++) {
    float4 b = *(const float4*)(base + (size_t)pz * NTOK + row0);
    a.x += b.x; a.y += b.y; a.z += b.z; a.w += b.w;
  }
  return a;
}
DI float ss_sum1(const float* base, int row) {
  float a = base[row];
#pragma unroll
  for (int pz = 1; pz < 8; pz++) a += base[(size_t)pz * NTOK + row];
  return a;
}
DI float wave_sum(float v) { for (int o = 32; o; o >>= 1) v += __shfl_xor(v, o); return v; }
DI float fast_exp2(float x) { return __builtin_amdgcn_exp2f(x); }
DI float gelu_tanh(float x) {
  float z = 0.7978845608028654f * (x + 0.044715f * x * x * x);
  float e = __expf(2.f * z);
  float t = 1.f - 2.f / (1.f + e);
  return 0.5f * x * (1.f + t);
}
DI float reduce_2pi(double a) {
  double n = rint(a * 0.15915494309189535);
  return (float)(a - n * 6.283185307179586);
}

DI void transpose_tile(const float* src, int ldsrc, int k0, int c0, const float* scale, int nscale,
                       bf16_t* dst, int lddst, int n0, float* lds, const int tid) {
#pragma unroll
  for (int i = 0; i < 16; i++) {
    int kk = i * 4 + (tid >> 6), nn = tid & 63;
    float v = src[(size_t)(k0 + kk) * ldsrc + c0 + nn];
    if (scale != nullptr && (k0 + kk) < nscale) v *= scale[k0 + kk];
    lds[kk * 65 + nn] = v;
  }
  __syncthreads();
  {
    int nn = tid >> 2, kq = (tid & 3) * 16;
    unsigned pk[8];
#pragma unroll
    for (int i = 0; i < 8; i++) pk[i] = pack_bf2(lds[(kq + 2 * i) * 65 + nn], lds[(kq + 2 * i + 1) * 65 + nn]);
    u32x4* d = (u32x4*)(dst + (size_t)(n0 + nn) * lddst + k0 + kq);
    u32x4 a = {pk[0], pk[1], pk[2], pk[3]}, b = {pk[4], pk[5], pk[6], pk[7]};
    d[0] = a; d[1] = b;
  }
  __syncthreads();
}

__device__ __forceinline__ void phase_prep(KP p, char* smem, const int tid) {
  const int nb = gridDim.x, bid = blockIdx.x;
  const int wave = tid >> 6, lane = tid & 63;
  for (int row = bid * 4 + wave; row < NTOK; row += nb * 4) {
    const float4* src = (const float4*)(p->x + (size_t)row * DM);
    float s = 0.f;
#pragma unroll
    for (int i = 0; i < 4; i++) {
      float4 v = src[lane + 64 * i];
      s += v.x * v.x + v.y * v.y + v.z * v.z + v.w * v.w;
      ((float4*)(p->xf + (size_t)row * DM))[lane + 64 * i] = v;
      u32x2 pk = {pack_bf2(v.x, v.y), pack_bf2(v.z, v.w)};
      ((u32x2*)(p->xb + (size_t)row * DM))[lane + 64 * i] = pk;
    }
    s = wave_sum(s);
    if (lane < 8) p->ss[(size_t)lane * NTOK + row] = (lane == 0) ? s : 0.f;
  }
  for (int i = bid * 256 + tid; i < NTOK * 8; i += nb * 256) {
    int tok = i >> 3, j = i & 7;
    double inv = (j & 4) ? ((j & 2) ? ((j & 1) ? 1.031338537721246e-05 : 5.318295896944988e-05) : ((j & 1) ? 0.0002742481756762073 : 0.001414213562373095))
                         : ((j & 2) ? ((j & 1) ? 0.007292664737217109 : 0.03760603093086393) : ((j & 1) ? 0.19392274474868576 : 1.0));
    double ang = (double)p->pos[tok] * inv;
    float r = reduce_2pi(ang);
    p->cs[2 * i] = cosf(r); p->cs[2 * i + 1] = sinf(r);
  }
  for (int i = bid * 256 + tid; i < 4 * 32 * 64; i += nb * 256) {
    int lg = i >> 6;
    float lr = p->lam_re[i], li = p->lam_im[i];
    float step = expf(p->log_step[lg]);
    float mag = expf(step * lr);
    double angd = (double)step * (double)li;
    float r1 = reduce_2pi(angd);
    float ar = mag * cosf(r1), ai = mag * sinf(r1);
    float den = lr * lr + li * li;
    float fr = ((ar - 1.f) * lr + ai * li) / den;
    float fi = (ai * lr - (ar - 1.f) * li) / den;
    float magT = expf(64.f * step * lr);
    float rT = reduce_2pi(64.0 * angd);
    float* tb = p->s5tab + (size_t)i * 40;
    tb[0] = ar; tb[1] = ai; tb[2] = magT * cosf(rT); tb[3] = magT * sinf(rT);
    for (int c = 0; c < 16; c++) {
      float br = p->b_re[(size_t)i * 16 + c], bi = p->b_im[(size_t)i * 16 + c];
      tb[4 + c] = fr * br - fi * bi;
      tb[20 + c] = fr * bi + fi * br;
    }
  }
  float* lds = (float*)smem;
  for (int job = bid; job < 4 * 3008; job += nb) {
    int layer = job / 3008, t = job % 3008;
    if (t < 512) {
      int a = t >> 4, kt = t & 15;
      transpose_tile(p->w_in + (size_t)layer * 1024 * 2048, 2048, kt * 64, a * 64, p->norm_mix + layer * 1024, 1024,
                     p->WinT + (size_t)layer * 2048 * 1024, 1024, a * 64, lds, tid);
    } else if (t < 640) {
      t -= 512; int a = t >> 3, kt = t & 7;
      transpose_tile(p->w_glu + (size_t)layer * 512 * 1024, 1024, kt * 64, (a & 1) * 512 + (a >> 1) * 64, nullptr, 0,
                     p->WgluT + (size_t)layer * 1024 * 512, 512, a * 64, lds, tid);
    } else if (t < 896) {
      t -= 640; int a = t >> 4, kt = t & 15;
      transpose_tile(p->w_out + (size_t)layer * 1024 * 1024, 1024, kt * 64, a * 64, p->ssm_norm + layer * 512, 512,
                     p->WoutT + (size_t)layer * 1024 * 1024, 1024, a * 64, lds, tid);
    } else if (t < 2304) {
      t -= 896; int a = t >> 4, kt = t & 15;
      transpose_tile(p->w_up + (size_t)layer * 1024 * 5632, 5632, kt * 64, (a & 1) * FFN + (a >> 1) * 64, p->norm_ffn + layer * 1024, 1024,
                     p->WupT + (size_t)layer * 5632 * 1024, 1024, a * 64, lds, tid);
    } else {
      t -= 2304; int a = t / 44, kt = t % 44;
      transpose_tile(p->w_down + (size_t)layer * FFN * 1024, 1024, kt * 64, a * 64, nullptr, 0,
                     p->WdownT + (size_t)layer * 1024 * FFN, FFN, a * 64, lds, tid);
    }
  }
}

enum { G_IN = 0, G_GLU = 1, G_WOUT = 2, G_UP = 3, G_DOWN = 4 };
#define ACC_PIN(tag) _Pragma("unroll") for (int i_ = 0; i_ < 4; i_++) _Pragma("unroll") for (int j_ = 0; j_ < 4; j_++) asm volatile("; pin " tag : "+a"(acc[i_][j_]));


__device__ __forceinline__ void gemm_tile(KP p, const int MODE, int layer, int tile, char* smem, const int tid) {
  const int lane = tid & 63, w = tid >> 6, wm = w >> 1, wn = w & 1, g = lane >> 5, l32 = lane & 31;
  int tn, KT, ldb, rowbase, lda;
  const bf16_t* Bt;
  const bf16_t* A0;
  int upb = 0, upti = 0;
  {
    const int TM = (MODE == G_UP) ? 66 : 64;
    const int TN = (MODE == G_IN) ? 8 : (MODE == G_UP ? 22 : 4);
    const int nfull = TN >> 2, rem = TN & 3;
    int tm;
    if (tile < nfull * 4 * TM) { const int band = tile / (4 * TM), within = tile % (4 * TM); tm = within >> 2; tn = band * 4 + (within & 3); }
    else { const int s2 = tile - nfull * 4 * TM; tm = s2 / rem; tn = nfull * 4 + s2 % rem; }
    rowbase = tm * 256;
    if (MODE == G_UP) { upb = tm / 33; upti = tm % 33; rowbase = upb * SEQL + 254 * upti - 2; }
  }
  if (MODE == G_IN) { KT = 16; ldb = 1024; Bt = p->WinT + (size_t)layer * 2048 * 1024; A0 = p->xb; lda = 1024; }
  else if (MODE == G_GLU) { KT = 8; ldb = 512; Bt = p->WgluT + (size_t)layer * 1024 * 512; A0 = p->gy; lda = 512; }
  else if (MODE == G_WOUT) { KT = 16; ldb = 1024; Bt = p->WoutT + (size_t)layer * 1024 * 1024; A0 = p->outg; lda = 512; }
  else if (MODE == G_UP) { KT = 16; ldb = 1024; Bt = p->WupT + (size_t)layer * 5632 * 1024; A0 = p->xb; lda = 1024; }
  else { KT = 44; ldb = FFN; Bt = p->WdownT + (size_t)layer * 1024 * FFN; A0 = p->act; lda = FFN; }

  u32x4 ra[8], rb[8];
  const int lrow = tid >> 3, lc = tid & 7;
  float arow_sc[8];
#pragma unroll
  for (int i = 0; i < 8; i++) arow_sc[i] = 1.f;
  if (MODE == G_WOUT) {
    const float* ssq = p->ssm_ss + (size_t)layer * 8 * NTOK;
#pragma unroll
    for (int i = 0; i < 8; i++) arow_sc[i] = rsqrtf(ss_sum1(ssq, rowbase + lrow + 32 * i) * (1.f / 512.f) + EPS);
  }
  const bf16_t* bptr = Bt + (size_t)(tn * 256 + lrow) * ldb + lc * 8;
  auto gload = [&](int kt) {
    const bf16_t* abase = A0;
    int kofs = kt * 64;
    if (MODE == G_WOUT && kt >= 8) { abase = p->att; kofs = (kt - 8) * 64; }
#pragma unroll
    for (int i = 0; i < 8; i++) {
      int gr = min(max(rowbase + lrow + 32 * i, 0), NTOK - 1);
      ra[i] = *(const u32x4*)(abase + (size_t)gr * lda + kofs + lc * 8);
      rb[i] = *(const u32x4*)(bptr + (size_t)(32 * i) * ldb + kt * 64);
    }
  };
  auto scaleA = [&](int kt) {
    if (MODE == G_WOUT && kt < 8) {
#pragma unroll
      for (int i = 0; i < 8; i++)
#pragma unroll
        for (int e = 0; e < 4; e++) {
          unsigned v = ra[i][e];
          float lo = __uint_as_float(v << 16) * arow_sc[i], hi = __uint_as_float(v & 0xffff0000u) * arow_sc[i];
          ra[i][e] = pack_bf2(lo, hi);
        }
    }
  };
  const int wr_off = lrow * 128 + ((lc ^ ((lrow >> 1) & 7)) << 4);
  auto lwriteA = [&](int st) {
    char* sa = smem + st * 65536;
#pragma unroll
    for (int i = 0; i < 8; i++) *(u32x4*)(sa + wr_off + i * 4096) = ra[i];
  };
  auto lwriteB = [&](int st) {
    char* sb = smem + st * 65536 + 32768;
#pragma unroll
    for (int i = 0; i < 8; i++) *(u32x4*)(sb + wr_off + i * 4096) = rb[i];
  };

  f32x16 acc[4][4];
#pragma unroll
  for (int i = 0; i < 4; i++)
#pragma unroll
    for (int j = 0; j < 4; j++)
#pragma unroll
      for (int r = 0; r < 16; r++) acc[i][j][r] = 0.f;

  const int swz = (l32 >> 1) & 7;
  const int a_base = (wm * 128 + l32) * 128;
  const int b_base = 32768 + (wn * 128 + l32) * 128;
  bf16x8 af[2][4], bfr[2][4];
  auto lfrag = [&](int buf, const char* st, int ks) {
    const int coff = (((ks * 2 + g) ^ swz) << 4);
#pragma unroll
    for (int i = 0; i < 4; i++) af[buf][i] = *(const bf16x8*)(st + a_base + i * 4096 + coff);
#pragma unroll
    for (int j = 0; j < 4; j++) bfr[buf][j] = *(const bf16x8*)(st + b_base + j * 4096 + coff);
  };
  auto mfma16 = [&](int buf) {
#pragma unroll
    for (int i = 0; i < 4; i++)
#pragma unroll
      for (int j = 0; j < 4; j++) acc[i][j] = MFMA(af[buf][i], bfr[buf][j], acc[i][j]);
  };

  gload(0);
  scaleA(0);
  lwriteA(0);
  lwriteB(0);
  __syncthreads();
  if (KT > 1) gload(1);
  lfrag(0, smem, 0);
  for (int kt = 0; kt < KT; kt++) {
    const char* st = smem + (kt & 1) * 65536;
    const bool has1 = (kt + 1 < KT), has2 = (kt + 2 < KT);
    lfrag(1, st, 1);
    if (has1) { scaleA(kt + 1); lwriteA((kt + 1) & 1); }
    mfma16(0);
    __builtin_amdgcn_sched_barrier(0);
    lfrag(0, st, 2);
    if (has1) lwriteB((kt + 1) & 1);
    mfma16(1);
    __builtin_amdgcn_sched_barrier(0);
    lfrag(1, st, 3);
    if (has2) gload(kt + 2);
    mfma16(0);
    __builtin_amdgcn_sched_barrier(0);
    asm volatile("s_waitcnt lgkmcnt(0)" ::: "memory");
    __builtin_amdgcn_s_barrier();
    __builtin_amdgcn_sched_barrier(0);
    if (has1) lfrag(0, smem + ((kt + 1) & 1) * 65536, 0);
    mfma16(1);
    __builtin_amdgcn_sched_barrier(0);
  }

  int tid2 = tid;
  asm volatile("" : "+v"(tid2));
  {
  const int tid = tid2;
  const int lane = tid & 63, w = tid >> 6, wm = w >> 1, wn = w & 1, g = lane >> 5, l32 = lane & 31;
  if (MODE == G_IN) {
    const int region = tn >> 1;
    float* rs = (float*)(smem + 135168);
    rs[tid] = rsqrtf(ss_sum1(p->ss + (size_t)(2 * layer) * 8 * NTOK, rowbase + tid) * (1.f / 1024.f) + EPS);
    __syncthreads();
#pragma unroll
    for (int i = 0; i < 4; i++)
#pragma unroll
      for (int rq = 0; rq < 4; rq++) {
        const int lr0 = wm * 128 + i * 32 + rq * 8 + g * 4;
        const float4 s4 = *(const float4*)(rs + lr0);
        const float sc[4] = {s4.x, s4.y, s4.z, s4.w};
#pragma unroll
        for (int j = 0; j < 4; j++) {
          const int lcol = wn * 128 + j * 32 + l32;
          float v[4];
#pragma unroll
          for (int r4 = 0; r4 < 4; r4++) v[r4] = acc[i][j][rq * 4 + r4] * sc[r4];
          if (region == 3) {
            const int q4 = (lr0 >> 2) & 3;
            const int pq = ((q4 & 1) << 1) | (q4 >> 1);
            u32x2 pk = {pack_bf2(v[0], v[1]), pack_bf2(v[2], v[3])};
            *(u32x2*)(smem + lcol * 528 + ((lr0 & ~15) + pq * 4) * 2) = pk;
          } else {
            if (region != 0 && (j & 1) == 0) {
              float other[4];
#pragma unroll
              for (int r4 = 0; r4 < 4; r4++) other[r4] = __shfl_xor(v[r4], 8);
              if (l32 < 16) {
                const float sgn = (l32 < 8) ? -1.f : 1.f;
#pragma unroll
                for (int r4 = 0; r4 < 4; r4++) {
                  const float2 csv = *(const float2*)(p->cs + ((size_t)(rowbase + lr0 + r4) * 8 + (l32 & 7)) * 2);
                  v[r4] = v[r4] * csv.x + sgn * other[r4] * csv.y;
                }
              }
            }
#pragma unroll
            for (int r4 = 0; r4 < 4; r4++) *(bf16_t*)(smem + (lr0 + r4) * 528 + lcol * 2) = f2bf(v[r4]);
          }
        }
      }
    __syncthreads();
    {
      bf16_t* dbase;
      size_t rstride;
      if (region == 3) { dbase = p->vt + (size_t)((rowbase >> 13) * 512 + (tn & 1) * 256) * SEQL + (rowbase & (SEQL - 1)); rstride = SEQL; }
      else { dbase = (region == 0 ? p->u : (region == 1 ? p->q : p->k)) + (size_t)rowbase * 512 + (tn & 1) * 256; rstride = 512; }
#pragma unroll 8
      for (int it = 0; it < 32; it++) {
        const int id = tid + 256 * it, row = id >> 5, c = id & 31;
        const u32x4 vv = *(const u32x4*)(smem + row * 528 + c * 16);
        *(u32x4*)(dbase + (size_t)row * rstride + c * 8) = vv;
      }
    }
    __syncthreads();
  } else if (MODE == G_GLU) {
    float* ssq = p->ssm_ss + ((size_t)layer * 8 + tn * 2 + wn) * NTOK;
#pragma unroll
    for (int i = 0; i < 4; i++)
#pragma unroll
      for (int rq = 0; rq < 4; rq++) {
        const int row0 = rowbase + wm * 128 + i * 32 + rq * 8 + g * 4;
#pragma unroll
        for (int r4 = 0; r4 < 4; r4++) {
          float sq = 0.f;
#pragma unroll
          for (int j = 0; j < 2; j++) {
            float a = acc[i][j][rq * 4 + r4], b = acc[i][j + 2][rq * 4 + r4];
            float o = a / (1.f + __expf(-b));
            const int col = (tn * 2 + wn) * 64 + j * 32 + l32;
            p->outg[(size_t)(row0 + r4) * 512 + col] = f2bf(o);
            sq += o * o;
          }
#pragma unroll
          for (int o = 16; o; o >>= 1) sq += __shfl_xor(sq, o);
          if (l32 == 0) ssq[row0 + r4] = sq;
        }
      }
  } else if (MODE == G_WOUT || MODE == G_DOWN) {
    float* ssq = p->ss + ((size_t)(MODE == G_WOUT ? 2 * layer + 1 : 2 * layer + 2) * 8 + tn * 2 + wn) * NTOK;
#pragma unroll
    for (int i = 0; i < 4; i++)
#pragma unroll
      for (int rq = 0; rq < 4; rq++) {
        const int row0 = rowbase + wm * 128 + i * 32 + rq * 8 + g * 4;
#pragma unroll
        for (int r4 = 0; r4 < 4; r4++) {
          float sq = 0.f;
#pragma unroll
          for (int j = 0; j < 4; j++) {
            const int col = tn * 256 + wn * 128 + j * 32 + l32;
            const size_t idx = (size_t)(row0 + r4) * 1024 + col;
            float xn = p->xf[idx] + acc[i][j][rq * 4 + r4];
            p->xf[idx] = xn;
            p->xb[idx] = f2bf(xn);
            sq += xn * xn;
          }
#pragma unroll
          for (int o = 16; o; o >>= 1) sq += __shfl_xor(sq, o);
          if (l32 == 0) ssq[row0 + r4] = sq;
        }
      }
  } else {
#pragma unroll
    for (int i = 0; i < 4; i++)
#pragma unroll
      for (int j = 0; j < 4; j++)
#pragma unroll
        for (int r = 0; r < 16; r++) {
          const int lr = wm * 128 + i * 32 + (r >> 2) * 8 + g * 4 + (r & 3);
          const int pc = wn * 128 + j * 32 + l32;
          *(bf16_t*)(smem + lr * 528 + pc * 2) = f2bf(acc[i][j][r]);
        }
    {
      float* rs = (float*)(smem + 135168);
      const int tb = 254 * upti - 2 + tid;
      float sc = 0.f;
      if (tb >= 0) {
        const int gr = min(upb * SEQL + tb, NTOK - 1);
        sc = rsqrtf(ss_sum1(p->ss + (size_t)(2 * layer + 1) * 8 * NTOK, gr) * (1.f / 1024.f) + EPS);
      }
      rs[tid] = sc;
    }
    __syncthreads();
    {
      const int cp = tid & 127, half = tid >> 7;
      const int pg = (cp >> 6) * 128 + (cp & 63), pv = pg + 64;
      const int ocol = tn * 128 + cp;
      const float* wc = p->w_conv + (size_t)layer * 3 * 5632;
      const float* bc = p->b_conv + (size_t)layer * 5632;
      const float wg0 = wc[ocol], wg1 = wc[5632 + ocol], wg2 = wc[2 * 5632 + ocol], bg = bc[ocol];
      const float wv0 = wc[FFN + ocol], wv1 = wc[5632 + FFN + ocol], wv2 = wc[2 * 5632 + FFN + ocol], bv = bc[FFN + ocol];
      const float* rs = (const float*)(smem + 135168);
      const int lr_lo = half ? 129 : 2, lr_hi = half ? 256 : 129;
      auto fetch = [&](int lr, float& gq, float& vq) {
        const float sc = rs[lr];
        gq = sc * bf2f(*(const bf16_t*)(smem + lr * 528 + pg * 2));
        vq = sc * bf2f(*(const bf16_t*)(smem + lr * 528 + pv * 2));
      };
      float g0, v0, g1, v1, g2, v2;
      fetch(lr_lo - 2, g0, v0);
      fetch(lr_lo - 1, g1, v1);
      for (int lr = lr_lo; lr < lr_hi; lr++) {
        fetch(lr, g2, v2);
        const int tb = 254 * upti - 2 + lr;
        if (tb < SEQL) {
          float gate = bg + wg0 * g0 + wg1 * g1 + wg2 * g2;
          float val = bv + wv0 * v0 + wv1 * v1 + wv2 * v2;
          float o = gate / (1.f + __expf(-gate)) * val;
          p->act[(size_t)(upb * SEQL + tb) * FFN + ocol] = f2bf(o);
        }
        g0 = g1; v0 = v1; g1 = g2; v1 = v2;
      }
    }
    __syncthreads();
  }
  }
}

__device__ __forceinline__ void attn_item(KP p, int layer, int b, int h, int qt, float lam, float outscale, char* smem, const int tid) {
  const int lane = tid & 63, w = tid >> 6, g = lane >> 5, l32 = lane & 31;
  const int tok_q = b * SEQL + qt * 128 + w * 32 + l32;
  {
    const int qrow = tid >> 4, qc = tid & 15;
#pragma unroll
    for (int i = 0; i < 8; i++) {
      const int row = qrow + 16 * i;
      u32x4 v = *(const u32x4*)(p->q + (size_t)(b * SEQL + qt * 128 + row) * 512 + h * 128 + qc * 8);
      *(u32x4*)(smem + 65536 + row * 256 + ((qc ^ (row & 15)) << 4)) = v;
    }
  }
  const int q_off = 65536 + (w * 32 + l32) * 256;
  const int q_swz = (l32 & 15);

  const int NT = 2 * qt + 2;
  const int nkt = 2 * qt + 1 + (w >> 1);
  f32x16 O[2][4];
#pragma unroll
  for (int c = 0; c < 2; c++)
#pragma unroll
    for (int dt = 0; dt < 4; dt++)
#pragma unroll
      for (int r = 0; r < 16; r++) O[c][dt][r] = 0.f;
  float mrun[2] = {-1e30f, -1e30f}, lrun[2] = {0.f, 0.f};
  const float c1 = 0.125f * 1.4426950408889634f;

  u32x4 rk[4], rv[4];
  const bf16_t* kbase = p->k + (size_t)(b * SEQL) * 512 + h * 128;
  const bf16_t* vbase = p->vt + (size_t)((b * 4 + h) * 128) * SEQL;
  const int kkey = tid >> 4, kc = tid & 15;
  const int vd = tid >> 3, vc = tid & 7;
  auto gload = [&](int kt) {
#pragma unroll
    for (int i = 0; i < 4; i++) {
      rk[i] = *(const u32x4*)(kbase + (size_t)(kt * 64 + kkey + 16 * i) * 512 + kc * 8);
      rv[i] = *(const u32x4*)(vbase + (size_t)(vd + 32 * i) * SEQL + kt * 64 + vc * 8);
    }
  };
  const int kw_off = kkey * 256 + ((kc ^ (kkey & 15)) << 4);
  const int vw_off = 16384 + vd * 128 + ((vc ^ ((vd >> 1) & 7)) << 4);
  auto lwrite = [&](int st) {
    char* s = smem + st * 32768;
#pragma unroll
    for (int i = 0; i < 4; i++) {
      *(u32x4*)(s + kw_off + i * 4096) = rk[i];
      *(u32x4*)(s + vw_off + i * 4096) = rv[i];
    }
  };

  gload(0);
  lwrite(0);
  __syncthreads();
  for (int kt = 0; kt < NT; kt++) {
    if (kt + 1 < NT) gload(kt + 1);
    if (kt < nkt) {
      const char* st = smem + (kt & 1) * 32768;
      bf16x8 pf[2][2][2];
      bf16x8 kf[8], qfr[4], vf[2][4];
      f32x16 S[1][2];
      auto loadkq = [&](int c) {
#pragma unroll
        for (int kb = 0; kb < 2; kb++)
#pragma unroll
          for (int ks = 0; ks < 4; ks++) {
            const int key = kb * 32 + l32, chunk = c * 8 + ks * 2 + g;
            kf[kb * 4 + ks] = *(const bf16x8*)(st + key * 256 + ((chunk ^ (key & 15)) << 4));
          }
#pragma unroll
        for (int ks = 0; ks < 4; ks++) qfr[ks] = *(const bf16x8*)(smem + q_off + (((c * 8 + ks * 2 + g) ^ q_swz) << 4));
      };
      auto qk = [&](int c) {
#pragma unroll
        for (int kb = 0; kb < 2; kb++) {
#pragma unroll
          for (int r = 0; r < 16; r++) S[0][kb][r] = 0.f;
#pragma unroll
          for (int ks = 0; ks < 4; ks++) S[0][kb] = MFMA(kf[kb * 4 + ks], qfr[ks], S[0][kb]);
        }
      };
      auto loadv = [&](int bi) {
#pragma unroll
        for (int dt = 0; dt < 4; dt++) {
          const int d = dt * 32 + l32, chunk = bi * 2 + g;
          vf[bi & 1][dt] = *(const bf16x8*)(st + 16384 + d * 128 + ((chunk ^ ((d >> 1) & 7)) << 4));
        }
      };
      auto softmax = [&](int c) {
        float mx = S[0][0][0];
#pragma unroll
        for (int r = 1; r < 16; r++) mx = fmaxf(mx, S[0][0][r]);
#pragma unroll
        for (int r = 0; r < 16; r++) mx = fmaxf(mx, S[0][1][r]);
        mx = fmaxf(mx, __shfl_xor(mx, 32));
        const float mcand = fmaxf(mrun[c], mx * c1);
        if (__any(mcand - mrun[c] > 8.f)) {
          const float alpha = fast_exp2(mrun[c] - mcand);
          mrun[c] = mcand;
          lrun[c] *= alpha;
#pragma unroll
          for (int dt = 0; dt < 4; dt++)
#pragma unroll
            for (int r = 0; r < 16; r++) O[c][dt][r] *= alpha;
        }
        const float mref = mrun[c];
        const f2_t c1v = {c1, c1}, mrv = {-mref, -mref};
        f2_t psum2 = {0.f, 0.f};
#pragma unroll
        for (int kb = 0; kb < 2; kb++)
#pragma unroll
          for (int r = 0; r < 16; r += 2) {
            f2_t sv = {S[0][kb][r], S[0][kb][r + 1]};
            f2_t av = __builtin_elementwise_fma(sv, c1v, mrv);
            f2_t ev = {fast_exp2(av[0]), fast_exp2(av[1])};
            S[0][kb][r] = ev[0]; S[0][kb][r + 1] = ev[1];
            psum2 += ev;
          }
        lrun[c] += psum2[0] + psum2[1];
#pragma unroll
        for (int kb = 0; kb < 2; kb++)
#pragma unroll
          for (int m = 0; m < 2; m++) {
            u32x4 pk = {pack_bf2(S[0][kb][8 * m + 0], S[0][kb][8 * m + 1]), pack_bf2(S[0][kb][8 * m + 2], S[0][kb][8 * m + 3]),
                        pack_bf2(S[0][kb][8 * m + 4], S[0][kb][8 * m + 5]), pack_bf2(S[0][kb][8 * m + 6], S[0][kb][8 * m + 7])};
            pf[c][kb][m] = __builtin_bit_cast(bf16x8, pk);
          }
      };
      loadkq(0);
      __builtin_amdgcn_sched_barrier(0);
      qk(0);
      __builtin_amdgcn_sched_barrier(0);
      loadkq(1);
      __builtin_amdgcn_sched_barrier(0);
      softmax(0);
      __builtin_amdgcn_sched_barrier(0);
      qk(1);
      loadv(0);
      __builtin_amdgcn_sched_barrier(0);
      softmax(1);
      __builtin_amdgcn_sched_barrier(0);
#pragma unroll
      for (int bi = 0; bi < 4; bi++) {
        if (bi < 3) loadv(bi + 1);
#pragma unroll
        for (int dt = 0; dt < 4; dt++) {
          O[0][dt] = MFMA(vf[bi & 1][dt], pf[0][bi >> 1][bi & 1], O[0][dt]);
          O[1][dt] = MFMA(vf[bi & 1][dt], pf[1][bi >> 1][bi & 1], O[1][dt]);
        }
        __builtin_amdgcn_sched_barrier(0);
      }
    }
    if (kt + 1 < NT) lwrite((kt + 1) & 1);
    __syncthreads();
  }

  const float l1 = lrun[0] + __shfl_xor(lrun[0], 32);
  const float l2 = lrun[1] + __shfl_xor(lrun[1], 32);
  const float i1 = 1.f / l1, i2 = lam / l2;
  float ssq = 0.f;
#pragma unroll
  for (int dt = 0; dt < 4; dt++)
#pragma unroll
    for (int r = 0; r < 16; r++) {
      float o = O[0][dt][r] * i1 - O[1][dt][r] * i2;
      O[0][dt][r] = o;
      ssq += o * o;
    }
  ssq += __shfl_xor(ssq, 32);
  const float rstd = rsqrtf(ssq * (1.f / 128.f) + EPS) * outscale;
  const float* gsub = p->subln + layer * 128;
#pragma unroll
  for (int dt = 0; dt < 4; dt++)
#pragma unroll
    for (int rq = 0; rq < 4; rq++) {
      const int d0 = dt * 32 + rq * 8 + g * 4;
      float4 gg = *(const float4*)(gsub + d0);
      u32x2 pk = {pack_bf2(O[0][dt][rq * 4 + 0] * rstd * gg.x, O[0][dt][rq * 4 + 1] * rstd * gg.y),
                  pack_bf2(O[0][dt][rq * 4 + 2] * rstd * gg.z, O[0][dt][rq * 4 + 3] * rstd * gg.w)};
      *(u32x2*)(p->att + (size_t)tok_q * 512 + h * 128 + d0) = pk;
    }
}

DI void s5_store_u(const u32x4 a, const u32x4 bq, int lane, float* ul) {
  float4* d = (float4*)(ul + lane * 16);
  d[0] = make_float4(__uint_as_float(a[0] << 16), __uint_as_float(a[0] & 0xffff0000u), __uint_as_float(a[1] << 16), __uint_as_float(a[1] & 0xffff0000u));
  d[1] = make_float4(__uint_as_float(a[2] << 16), __uint_as_float(a[2] & 0xffff0000u), __uint_as_float(a[3] << 16), __uint_as_float(a[3] & 0xffff0000u));
  d[2] = make_float4(__uint_as_float(bq[0] << 16), __uint_as_float(bq[0] & 0xffff0000u), __uint_as_float(bq[1] << 16), __uint_as_float(bq[1] & 0xffff0000u));
  d[3] = make_float4(__uint_as_float(bq[2] << 16), __uint_as_float(bq[2] & 0xffff0000u), __uint_as_float(bq[3] << 16), __uint_as_float(bq[3] & 0xffff0000u));
}
DI void s5_load_u(KP p, int b, int g, int j, int lane, float* ul) {
  const u32x4* src = (const u32x4*)(p->u + (size_t)(b * SEQL + j * 64 + lane) * 512 + g * 16);
  const u32x4 a = src[0], bq = src[1];
  s5_store_u(a, bq, lane, ul);
}

DI float swap_half(float v, const int which) {
  const unsigned u = __float_as_uint(v);
  auto r = __builtin_amdgcn_permlane32_swap(u, u, false, false);
  return __uint_as_float(which ? r[1] : r[0]);
}

struct S5Coef { float arA, aiA, arB, aiB; };

template <bool STORE>
DI void s5_scan32(const float* ul_sub, const bf16x8 (&bfr)[4], const S5Coef& cf, float& xAr, float& xAi, float& xBr, float& xBi,
                  float* X, const int l32, const int grp) {
  bf16x8 af;
  {
    const float* us = ul_sub + l32 * 16 + grp * 8;
    float4 a = *(const float4*)us, bq = *(const float4*)(us + 4);
    u32x4 pk = {pack_bf2(a.x, a.y), pack_bf2(a.z, a.w), pack_bf2(bq.x, bq.y), pack_bf2(bq.z, bq.w)};
    af = __builtin_bit_cast(bf16x8, pk);
  }
  f32x16 zero;
#pragma unroll
  for (int r = 0; r < 16; r++) zero[r] = 0.f;
  const f32x16 bu0 = MFMA(af, bfr[0], zero), bu1 = MFMA(af, bfr[1], zero), bu2 = MFMA(af, bfr[2], zero), bu3 = MFMA(af, bfr[3], zero);
#pragma unroll
  for (int k = 0; k < 8; k++) {
    float sAr[4], sAi[4], sBr[4], sBi[4];
#pragma unroll
    for (int i = 0; i < 4; i++) {
      const int r = (k >> 1) * 4 + i;
      const float nAr = cf.arA * xAr - cf.aiA * xAi + bu0[r];
      const float nAi = cf.arA * xAi + cf.aiA * xAr + bu2[r];
      const float nBr = cf.arB * xBr - cf.aiB * xBi + bu1[r];
      const float nBi = cf.arB * xBi + cf.aiB * xBr + bu3[r];
      xAr = nAr; xAi = nAi; xBr = nBr; xBi = nBi;
      sAr[i] = nAr; sAi[i] = nAi; sBr[i] = nBr; sBi[i] = nBi;
    }
    if (STORE) {
      if (grp == (k & 1)) {
#pragma unroll
        for (int i = 0; i < 4; i++) {
          float* xr = X + (4 * k + i) * 132;
          xr[l32] = sAr[i]; xr[64 + l32] = sAi[i]; xr[32 + l32] = sBr[i]; xr[96 + l32] = sBi[i];
        }
      }
    }
    xAr = swap_half(xAr, k & 1); xAi = swap_half(xAi, k & 1);
    xBr = swap_half(xBr, k & 1); xBi = swap_half(xBi, k & 1);
  }
}

DI void s5_setup(KP p, int layer, int g, int l32, int grp, S5Coef& cf, bf16x8 (&bfr)[4]) {
  const float* t0 = p->s5tab + (size_t)((layer * 32 + g) * 64) * 40;
  cf.arA = t0[l32 * 40]; cf.aiA = t0[l32 * 40 + 1];
  cf.arB = t0[(32 + l32) * 40]; cf.aiB = t0[(32 + l32) * 40 + 1];
#pragma unroll
  for (int jt = 0; jt < 4; jt++) {
    const float* src = t0 + (l32 + 32 * (jt & 1)) * 40 + 4 + (jt >> 1) * 16 + grp * 8;
    float4 a = *(const float4*)src, bq = *(const float4*)(src + 4);
    u32x4 pk = {pack_bf2(a.x, a.y), pack_bf2(a.z, a.w), pack_bf2(bq.x, bq.y), pack_bf2(bq.z, bq.w)};
    bfr[jt] = __builtin_bit_cast(bf16x8, pk);
  }
}

__device__ __forceinline__ void s5_pass1(KP p, int layer, char* smem, const int tid) {
  const int lane = tid & 63, w = tid >> 6, l32 = lane & 31, grp = lane >> 5;
  float* ul = (float*)(smem + w * 4096);
  for (int wbase = blockIdx.x * 4; wbase < 1024; wbase += gridDim.x * 4) {
    const int wi = wbase + w;
    const int j0 = (wi & 15) * 8, g = (wi >> 4) & 31, b = wi >> 9;
    S5Coef cf; bf16x8 bfr[4];
    s5_setup(p, layer, g, l32, grp, cf, bfr);
    const u32x4* src = (const u32x4*)(p->u + (size_t)(b * SEQL + j0 * 64 + lane) * 512 + g * 16);
    u32x4 v0 = src[0], v1 = src[1];
    for (int jj = 0; jj < 8; jj++) {
      const int j = j0 + jj;
      s5_store_u(v0, v1, lane, ul);
      if (jj < 7) {
        const u32x4* nsrc = (const u32x4*)(p->u + (size_t)(b * SEQL + (j + 1) * 64 + lane) * 512 + g * 16);
        v0 = nsrc[0]; v1 = nsrc[1];
      }
      __syncthreads();
      float xAr = 0.f, xAi = 0.f, xBr = 0.f, xBi = 0.f;
      s5_scan32<false>(ul, bfr, cf, xAr, xAi, xBr, xBi, nullptr, l32, grp);
      s5_scan32<false>(ul + 32 * 16, bfr, cf, xAr, xAi, xBr, xBi, nullptr, l32, grp);
      float* so = p->sloc + (size_t)((b * 32 + g) * 128 + j) * 128;
      so[lane] = grp ? xBr : xAr; so[64 + lane] = grp ? xBi : xAi;
      __syncthreads();
    }
  }
}

__device__ __forceinline__ void s5_pass2(KP p, int layer, char* smem, const int tid) {
  const int lane = tid & 63, w = tid >> 6;
  float* ul = (float*)(smem + w * 21504);
  float* X = ul + 1024;
  const int l32 = lane & 31, grp = lane >> 5;
  for (int wbase = blockIdx.x * 4; wbase < 1024; wbase += gridDim.x * 4) {
   const int wi = wbase + w;
   const int j0 = (wi & 15) * 8, g = (wi >> 4) & 31, b = wi >> 9;
   S5Coef cf; bf16x8 bfr[4];
   s5_setup(p, layer, g, l32, grp, cf, bfr);
   bf16x8 cfr[8];
   {
     const int c = l32 & 15;
     const float* cr = p->c_re + (size_t)((layer * 32 + g) * 16 + c) * 64;
     const float* ci = p->c_im + (size_t)((layer * 32 + g) * 16 + c) * 64;
#pragma unroll
     for (int s8 = 0; s8 < 8; s8++) {
       const int k0 = (s8 & 3) * 16 + grp * 8;
       const float* src = (s8 < 4) ? (cr + k0) : (ci + k0);
       const float sg = (l32 < 16) ? ((s8 < 4) ? 1.f : -1.f) : 0.f;
       float4 a = *(const float4*)src, bq = *(const float4*)(src + 4);
       u32x4 pk = {pack_bf2(a.x * sg, a.y * sg), pack_bf2(a.z * sg, a.w * sg), pack_bf2(bq.x * sg, bq.y * sg), pack_bf2(bq.z * sg, bq.w * sg)};
       cfr[s8] = __builtin_bit_cast(bf16x8, pk);
     }
   }
   const float dd = p->ssm_d[(size_t)(layer * 32 + g) * 16 + (l32 & 15)];
   float xAr, xAi, xBr, xBi;
   {
     const float* tb = p->s5tab + (size_t)((layer * 32 + g) * 64 + lane) * 40;
     const float aTr = tb[2], aTi = tb[3];
     float xr = 0.f, xi = 0.f;
     const float* sl = p->sloc + (size_t)((b * 32 + g) * 128) * 128;
     for (int i0 = 0; i0 < j0; i0 += 8) {
       float sr[8], si[8];
#pragma unroll
       for (int q = 0; q < 8; q++) { sr[q] = sl[(i0 + q) * 128 + lane]; si[q] = sl[(i0 + q) * 128 + 64 + lane]; }
#pragma unroll
       for (int q = 0; q < 8; q++) {
         const float nr = aTr * xr - aTi * xi + sr[q];
         const float ni = aTr * xi + aTi * xr + si[q];
         xr = nr; xi = ni;
       }
     }
     xAr = swap_half(xr, 0); xBr = swap_half(xr, 1);
     xAi = swap_half(xi, 0); xBi = swap_half(xi, 1);
   }
   for (int jj = 0; jj < 8; jj++) {
    const int j = j0 + jj;
    s5_load_u(p, b, g, j, lane, ul);
    __syncthreads();
    for (int sub = 0; sub < 2; sub++) {
      s5_scan32<true>(ul + sub * 32 * 16, bfr, cf, xAr, xAi, xBr, xBi, X, l32, grp);
      __syncthreads();
      f32x16 yacc;
#pragma unroll
      for (int r = 0; r < 16; r++) yacc[r] = 0.f;
#pragma unroll
      for (int s8 = 0; s8 < 8; s8++) {
        const float* xs = X + l32 * 132 + ((s8 < 4) ? 0 : 64) + (s8 & 3) * 16 + grp * 8;
        float4 a = *(const float4*)xs, bq = *(const float4*)(xs + 4);
        u32x4 pk = {pack_bf2(a.x, a.y), pack_bf2(a.z, a.w), pack_bf2(bq.x, bq.y), pack_bf2(bq.z, bq.w)};
        yacc = MFMA(__builtin_bit_cast(bf16x8, pk), cfr[s8], yacc);
      }
      if (l32 < 16) {
#pragma unroll
        for (int r = 0; r < 16; r++) {
          const int tl = sub * 32 + (r >> 2) * 8 + grp * 4 + (r & 3);
          const float yv = yacc[r] + dd * ul[tl * 16 + l32];
          p->gy[(size_t)(b * SEQL + j * 64 + tl) * 512 + g * 16 + l32] = f2bf(gelu_tanh(yv));
        }
      }
      __syncthreads();
    }
   }
  }
}

__device__ __forceinline__ void phase_attn(KP p, int layer, char* smem, const int tid) {
  const int lane = tid & 63;
  const float s1 = wave_sum(p->lq1[layer * 64 + lane] * p->lk1[layer * 64 + lane]);
  const float s2 = wave_sum(p->lq2[layer * 64 + lane] * p->lk2[layer * 64 + lane]);
  const float lam_init = 0.8f - 0.6f * expf(-0.3f * (float)layer);
  const float lam = expf(s1) - expf(s2) + lam_init;
  for (int pb = blockIdx.x; pb < 256; pb += gridDim.x) {
    const int pi = (pb & 7) * 32 + (pb >> 3);
    const int b = pi >> 7, h = (pi >> 5) & 3, i = pi & 31;
    attn_item(p, layer, b, h, 63 - i, lam, 1.f - lam_init, smem, tid);
    attn_item(p, layer, b, h, i, lam, 1.f - lam_init, smem, tid);
  }
  s5_pass1(p, layer, smem, tid);
}

__device__ __forceinline__ void phase_final(KP p, const int tid) {
  const int wave = tid >> 6, lane = tid & 63;
  const float* ssq = p->ss + (size_t)8 * 8 * NTOK;
  for (int row = blockIdx.x * 4 + wave; row < NTOK; row += gridDim.x * 4) {
    const float rstd = rsqrtf(ss_sum1(ssq, row) * (1.f / 1024.f) + EPS);
#pragma unroll
    for (int i = 0; i < 4; i++) {
      float4 v = ((const float4*)(p->xf + (size_t)row * DM))[lane + 64 * i];
      float4 gq = ((const float4*)p->norm_final)[lane + 64 * i];
      float4 o = {v.x * rstd * gq.x, v.y * rstd * gq.y, v.z * rstd * gq.z, v.w * rstd * gq.w};
      ((float4*)(p->out + (size_t)row * DM))[lane + 64 * i] = o;
    }
  }
}

__device__ __forceinline__ void run_phase(KP p, int ph, char* smem) {
  const int tid = opaque_tid();
  if (ph == 0) { phase_prep(p, smem, tid); return; }
  if (ph == 29) { phase_final(p, tid); return; }
  const int layer = (ph - 1) / 7, k = (ph - 1) % 7;
  const int nb = gridDim.x, bid = blockIdx.x;
  if (k == 1) { phase_attn(p, layer, smem, tid); return; }
  if (k == 2) { s5_pass2(p, layer, smem, tid); return; }
  if (k == 0) { for (int r = 0; ; r++) { const int t = (r * 8 + (bid & 7)) * (nb >> 3) + (bid >> 3); if (r * nb >= 512) break; if (t < 512) gemm_tile(p, G_IN, layer, t, smem, tid); } }
  else if (k == 3) { for (int r = 0; ; r++) { const int t = (r * 8 + (bid & 7)) * (nb >> 3) + (bid >> 3); if (r * nb >= 256) break; if (t < 256) gemm_tile(p, G_GLU, layer, t, smem, tid); } }
  else if (k == 4) { for (int r = 0; ; r++) { const int t = (r * 8 + (bid & 7)) * (nb >> 3) + (bid >> 3); if (r * nb >= 256) break; if (t < 256) gemm_tile(p, G_WOUT, layer, t, smem, tid); } }
  else if (k == 5) { for (int r = 0; ; r++) { const int t = (r * 8 + (bid & 7)) * (nb >> 3) + (bid >> 3); if (r * nb >= 2 * 33 * 22) break; if (t < 2 * 33 * 22) gemm_tile(p, G_UP, layer, t, smem, tid); } }
  else { for (int r = 0; ; r++) { const int t = (r * 8 + (bid & 7)) * (nb >> 3) + (bid >> 3); if (r * nb >= 256) break; if (t < 256) gemm_tile(p, G_DOWN, layer, t, smem, tid); } }
}

#define PHASE_KERNEL(name, body)                                                      \
  __global__ void __launch_bounds__(256) name(Params p_unused) {                      \
    extern __shared__ __attribute__((aligned(16))) char smem[];                       \
    KP p = (KP)__builtin_amdgcn_kernarg_segment_ptr();                                \
    const int tid = threadIdx.x, nb = gridDim.x, bid = blockIdx.x;                    \
    const int layer = (int)p->phase_lo;                                               \
    (void)nb; (void)bid; (void)layer;                                                 \
    body                                                                              \
  }
PHASE_KERNEL(k_prep, phase_prep(p, smem, tid);)
PHASE_KERNEL(k_gin, for (int r = 0; ; r++) { const int t = (r * 8 + (bid & 7)) * (nb >> 3) + (bid >> 3); if (r * nb >= 512) break; if (t < 512) gemm_tile(p, G_IN, layer, t, smem, tid); })
PHASE_KERNEL(k_attn, phase_attn(p, layer, smem, tid);)
PHASE_KERNEL(k_s5p2, s5_pass2(p, layer, smem, tid);)
PHASE_KERNEL(k_glu, for (int r = 0; ; r++) { const int t = (r * 8 + (bid & 7)) * (nb >> 3) + (bid >> 3); if (r * nb >= 256) break; if (t < 256) gemm_tile(p, G_GLU, layer, t, smem, tid); })
PHASE_KERNEL(k_wout, for (int r = 0; ; r++) { const int t = (r * 8 + (bid & 7)) * (nb >> 3) + (bid >> 3); if (r * nb >= 256) break; if (t < 256) gemm_tile(p, G_WOUT, layer, t, smem, tid); })
PHASE_KERNEL(k_up, for (int r = 0; ; r++) { const int t = (r * 8 + (bid & 7)) * (nb >> 3) + (bid >> 3); if (r * nb >= 2 * 33 * 22) break; if (t < 2 * 33 * 22) gemm_tile(p, G_UP, layer, t, smem, tid); })
PHASE_KERNEL(k_down, for (int r = 0; ; r++) { const int t = (r * 8 + (bid & 7)) * (nb >> 3) + (bid >> 3); if (r * nb >= 256) break; if (t < 256) gemm_tile(p, G_DOWN, layer, t, smem, tid); })
PHASE_KERNEL(k_final, phase_final(p, tid);)

#if COOP
__global__ void __launch_bounds__(256) mega_kernel(Params p_unused) {
  extern __shared__ __attribute__((aligned(16))) char smem[];
  KP p0 = (KP)__builtin_amdgcn_kernarg_segment_ptr();
  const int ph_lo = (int)p0->phase_lo, ph_hi = (int)p0->phase_hi;
#if COOP
  if (ph_hi > 1000) cg::this_grid().sync();
#endif
  for (int ph = ph_lo; ph < ph_hi; ph++) {
    KP p = p0;
    asm volatile("" : "+s"(p));
#if TPROBE
    if (blockIdx.x == 0) p->ts[ph] = (long long)wall_clock64();
#endif
    run_phase(p, ph, smem);
#if COOP
    if (ph + 1 < ph_hi) grid_barrier(p->bar, (unsigned)(ph + 1 - ph_lo) * gridDim.x, opaque_tid());
#endif
  }
#if TPROBE
  grid_barrier(p0->bar, (unsigned)(ph_hi - ph_lo) * gridDim.x, opaque_tid());
  if (blockIdx.x == 0) {
    KP p = p0;
    long long tend = (long long)wall_clock64();
    float a = 0.f, b = 0.f;
    for (int ph = 0; ph < 30; ph++) {
      long long t0 = p->ts[ph], t1 = (ph == 29) ? tend : p->ts[ph + 1];
      int c = (ph == 0) ? 0 : (ph == 29 ? 8 : 1 + (ph - 1) % 7);
      float d = (float)(t1 - t0) * 0.01f;
      if (c == TP_A || TP_A == 9) a += d;
      if (c == TP_B || TP_B == 9) b += d;
    }
    const int t = opaque_tid();
    if (t <= 100) p->out[t] += (t == 0) ? a : b;
  }
#endif
}

#endif

extern "C" void kernel_launch(void* const* d_in, const int* in_sizes, int n_in, void* d_out, int out_size, void* d_ws,
                              size_t ws_size, hipStream_t stream) {
  static int grid_blocks = 0;
  if (!grid_blocks) {
    int dev = 0, cus = 0, per_cu = 0;
    (void)hipGetDevice(&dev);
    (void)hipDeviceGetAttribute(&cus, hipDeviceAttributeMultiprocessorCount, dev);
#if COOP
    (void)hipFuncSetAttribute((const void*)mega_kernel, hipFuncAttributeMaxDynamicSharedMemorySize, LDS_BYTES);
    (void)hipOccupancyMaxActiveBlocksPerMultiprocessor(&per_cu, (const void*)mega_kernel, 256, LDS_BYTES);
    if (per_cu < 1) { fprintf(stderr, "occupancy query returned %d\n", per_cu); per_cu = 1; }
#endif
    grid_blocks = cus;
    (void)hipGetLastError();
  }
  Params p{};
  p.x = (const float*)d_in[0]; p.pos = (const int*)d_in[1];
  p.norm_mix = (const float*)d_in[2]; p.w_in = (const float*)d_in[3];
  p.lam_re = (const float*)d_in[4]; p.lam_im = (const float*)d_in[5]; p.log_step = (const float*)d_in[6];
  p.b_re = (const float*)d_in[7]; p.b_im = (const float*)d_in[8]; p.c_re = (const float*)d_in[9]; p.c_im = (const float*)d_in[10];
  p.ssm_d = (const float*)d_in[11]; p.w_glu = (const float*)d_in[12]; p.ssm_norm = (const float*)d_in[13];
  p.lq1 = (const float*)d_in[14]; p.lk1 = (const float*)d_in[15]; p.lq2 = (const float*)d_in[16]; p.lk2 = (const float*)d_in[17];
  p.subln = (const float*)d_in[18]; p.w_out = (const float*)d_in[19]; p.norm_ffn = (const float*)d_in[20];
  p.w_up = (const float*)d_in[21]; p.w_conv = (const float*)d_in[22]; p.b_conv = (const float*)d_in[23];
  p.w_down = (const float*)d_in[24]; p.norm_final = (const float*)d_in[25];
  p.out = (float*)d_out;
  char* ws = (char*)d_ws;
  size_t off = 0;
  auto take = [&](size_t bytes) { char* r = ws + off; off += (bytes + 255) & ~(size_t)255; return r; };
  p.WinT = (bf16_t*)take((size_t)4 * 2048 * 1024 * 2);
  p.WgluT = (bf16_t*)take((size_t)4 * 1024 * 512 * 2);
  p.WoutT = (bf16_t*)take((size_t)4 * 1024 * 1024 * 2);
  p.WupT = (bf16_t*)take((size_t)4 * 5632 * 1024 * 2);
  p.WdownT = (bf16_t*)take((size_t)4 * 1024 * FFN * 2);
  p.xf = (float*)take((size_t)NTOK * DM * 4);
  p.xb = (bf16_t*)take((size_t)NTOK * DM * 2);
  p.ss = (float*)take((size_t)9 * 8 * NTOK * 4);
  p.ssm_ss = (float*)take((size_t)4 * 8 * NTOK * 4);
  p.cs = (float*)take((size_t)NTOK * 16 * 4);
  p.s5tab = (float*)take((size_t)4 * 32 * 64 * 40 * 4);
  p.sloc = (float*)take((size_t)2 * 32 * 128 * 128 * 4);
  p.ts = (long long*)take(256);
  p.bar = (unsigned*)take(256);
  char* region = take((size_t)134217728);
  p.u = (bf16_t*)region;
  p.q = (bf16_t*)(region + 33554432);
  p.k = p.q + (size_t)NTOK * 512;
  p.vt = p.k + (size_t)NTOK * 512;
  p.gy = p.vt + (size_t)NTOK * 512;
  p.outg = p.gy + (size_t)NTOK * 512;
  p.att = p.outg + (size_t)NTOK * 512;
  p.act = (bf16_t*)region;
  if (off > ws_size) { fprintf(stderr, "workspace too small: need %zu have %zu\n", off, ws_size); return; }
#if COOP
  p.phase_lo = 0; p.phase_hi = 30;
  if (hipMemsetAsync(p.bar, 0, 256, stream) != hipSuccess) fprintf(stderr, "barrier memset failed\n");
  void* args[] = {&p};
  hipError_t e = hipLaunchCooperativeKernel((const void*)mega_kernel, dim3(grid_blocks), dim3(256), args, LDS_BYTES, stream);
  if (e != hipSuccess) fprintf(stderr, "cooperative launch failed: %s (grid %d)\n", hipGetErrorString(e), grid_blocks);
#else
  typedef void (*kfn)(Params);
  const kfn seq[7] = {k_gin, k_attn, k_s5p2, k_glu, k_wout, k_up, k_down};
  static bool attr_done = false;
  if (!attr_done) {
    (void)hipFuncSetAttribute((const void*)k_prep, hipFuncAttributeMaxDynamicSharedMemorySize, LDS_BYTES);
    (void)hipFuncSetAttribute((const void*)k_final, hipFuncAttributeMaxDynamicSharedMemorySize, LDS_BYTES);
    for (int i = 0; i < 7; i++) (void)hipFuncSetAttribute((const void*)seq[i], hipFuncAttributeMaxDynamicSharedMemorySize, LDS_BYTES);
    attr_done = true;
  }
  p.phase_lo = 0; p.phase_hi = 0;
  hipLaunchKernelGGL(k_prep, dim3(grid_blocks), dim3(256), LDS_BYTES, stream, p);
  for (int layer = 0; layer < 4; layer++) {
    p.phase_lo = layer;
    for (int i = 0; i < 7; i++) hipLaunchKernelGGL(seq[i], dim3(grid_blocks), dim3(256), LDS_BYTES, stream, p);
  }
  hipLaunchKernelGGL(k_final, dim3(grid_blocks), dim3(256), LDS_BYTES, stream, p);
#endif
}
```

```cpp
#include <hip/hip_runtime.h>
#include <hip/hip_cooperative_groups.h>
#include <cstdio>
namespace cg = cooperative_groups;

#ifndef COOP
#define COOP 1
#endif
#ifndef TPROBE
#define TPROBE 0
#endif
#ifndef TP_A
#define TP_A 1
#endif
#ifndef TP_B
#define TP_B 2
#endif

typedef unsigned short bf16_t;
typedef __attribute__((ext_vector_type(8))) short bf16x8;
typedef __attribute__((ext_vector_type(16))) float f32x16;
typedef __attribute__((ext_vector_type(2))) __bf16 bf2_t;
typedef __attribute__((ext_vector_type(2))) float f2_t;
typedef __attribute__((ext_vector_type(4))) unsigned u32x4;
typedef __attribute__((ext_vector_type(2))) unsigned u32x2;

#define DI __device__ __forceinline__
#define MFMA(a, b, c) __builtin_amdgcn_mfma_f32_32x32x16_bf16((a), (b), (c), 0, 0, 0)

constexpr int NTOK = 16384, DM = 1024, SEQL = 8192, FFN = 2816;
constexpr int LDS_BYTES = 136192;
constexpr float EPS = 1e-6f;

struct Params {
  const float* x; const int* pos;
  const float *norm_mix, *w_in, *lam_re, *lam_im, *log_step, *b_re, *b_im, *c_re, *c_im, *ssm_d, *w_glu, *ssm_norm;
  const float *lq1, *lk1, *lq2, *lk2, *subln, *w_out, *norm_ffn, *w_up, *w_conv, *b_conv, *w_down, *norm_final;
  float* out;
  bf16_t *WinT, *WgluT, *WoutT, *WupT, *WdownT;
  float* xf; bf16_t* xb;
  bf16_t *u, *q, *k, *vt, *gy, *outg, *att, *act;
  float *ss, *ssm_ss, *cs, *s5tab, *sloc;
  long long phase_lo, phase_hi;
  long long* ts;
  unsigned* bar;
};

typedef const __attribute__((address_space(4))) Params* KP;

DI unsigned pack_bf2(float a, float b) { f2_t v = {a, b}; return __builtin_bit_cast(unsigned, __builtin_convertvector(v, bf2_t)); }
DI bf16_t f2bf(float a) { return (bf16_t)(pack_bf2(a, 0.f) & 0xffffu); }
DI float bf2f(bf16_t v) { return __uint_as_float(((unsigned)v) << 16); }
DI void grid_barrier(unsigned* ctr, unsigned target, int tid) {
  asm volatile("s_waitcnt vmcnt(0)" ::: "memory");
  __syncthreads();
  if (tid == 0) {
    __builtin_amdgcn_fence(__ATOMIC_RELEASE, "agent");
    asm volatile("s_waitcnt vmcnt(0)" ::: "memory");
    __hip_atomic_fetch_add(ctr, 1u, __ATOMIC_RELAXED, __HIP_MEMORY_SCOPE_AGENT);
    while (__hip_atomic_load(ctr, __ATOMIC_RELAXED, __HIP_MEMORY_SCOPE_AGENT) < target) __builtin_amdgcn_s_sleep(1);
    __builtin_amdgcn_fence(__ATOMIC_ACQUIRE, "agent");
    asm volatile("s_waitcnt vmcnt(0)" ::: "memory");
  }
  __syncthreads();
}
DI int opaque_tid() { int t = threadIdx.x; asm volatile("" : "+v"(t)); return t; }
DI float4 ss_sum4(const float* base, int row0) {
  float4 a = *(const float4*)(base + row0);
#pragma unroll
  for (int pz = 1; pz < 8; pz++) {
    float4 b = *(const float4*)(base + (size_t)pz * NTOK + row0);
    a.x += b.x; a.y += b.y; a.z += b.z; a.w += b.w;
  }
  return a;
}
DI float ss_sum1(const float* base, int row) {
  float a = base[row];
#pragma unroll
  for (int pz = 1; pz < 8; pz++) a += base[(size_t)pz * NTOK + row];
  return a;
}
DI float wave_sum(float v) { for (int o = 32; o; o >>= 1) v += __shfl_xor(v, o); return v; }
DI float fast_exp2(float x) { return __builtin_amdgcn_exp2f(x); }
DI float gelu_tanh(float x) {
  float z = 0.7978845608028654f * (x + 0.044715f * x * x * x);
  float e = __expf(2.f * z);
  float t = 1.f - 2.f / (1.f + e);
  return 0.5f * x * (1.f + t);
}
DI float reduce_2pi(double a) {
  double n = rint(a * 0.15915494309189535);
  return (float)(a - n * 6.283185307179586);
}

DI void transpose_tile(const float* src, int ldsrc, int k0, int c0, const float* scale, int nscale,
                       bf16_t* dst, int lddst, int n0, float* lds, const int tid) {
#pragma unroll
  for (int i = 0; i < 16; i++) {
    int kk = i * 4 + (tid >> 6), nn = tid & 63;
    float v = src[(size_t)(k0 + kk) * ldsrc + c0 + nn];
    if (scale != nullptr && (k0 + kk) < nscale) v *= scale[k0 + kk];
    lds[kk * 65 + nn] = v;
  }
  __syncthreads();
  {
    int nn = tid >> 2, kq = (tid & 3) * 16;
    unsigned pk[8];
#pragma unroll
    for (int i = 0; i < 8; i++) pk[i] = pack_bf2(lds[(kq + 2 * i) * 65 + nn], lds[(kq + 2 * i + 1) * 65 + nn]);
    u32x4* d = (u32x4*)(dst + (size_t)(n0 + nn) * lddst + k0 + kq);
    u32x4 a = {pk[0], pk[1], pk[2], pk[3]}, b = {pk[4], pk[5], pk[6], pk[7]};
    d[0] = a; d[1] = b;
  }
  __syncthreads();
}

__device__ __forceinline__ void phase_prep(KP p, char* smem, const int tid) {
  const int nb = gridDim.x, bid = blockIdx.x;
  const int wave = tid >> 6, lane = tid & 63;
  for (int row = bid * 4 + wave; row < NTOK; row += nb * 4) {
    const float4* src = (const float4*)(p->x + (size_t)row * DM);
    float s = 0.f;
#pragma unroll
    for (int i = 0; i < 4; i++) {
      float4 v = src[lane + 64 * i];
      s += v.x * v.x + v.y * v.y + v.z * v.z + v.w * v.w;
      ((float4*)(p->xf + (size_t)row * DM))[lane + 64 * i] = v;
      u32x2 pk = {pack_bf2(v.x, v.y), pack_bf2(v.z, v.w)};
      ((u32x2*)(p->xb + (size_t)row * DM))[lane + 64 * i] = pk;
    }
    s = wave_sum(s);
    if (lane < 8) p->ss[(size_t)lane * NTOK + row] = (lane == 0) ? s : 0.f;
  }
  for (int i = bid * 256 + tid; i < NTOK * 8; i += nb * 256) {
    int tok = i >> 3, j = i & 7;
    double inv = (j & 4) ? ((j & 2) ? ((j & 1) ? 1.031338537721246e-05 : 5.318295896944988e-05) : ((j & 1) ? 0.0002742481756762073 : 0.001414213562373095))
                         : ((j & 2) ? ((j & 1) ? 0.007292664737217109 : 0.03760603093086393) : ((j & 1) ? 0.19392274474868576 : 1.0));
    double ang = (double)p->pos[tok] * inv;
    float r = reduce_2pi(ang);
    p->cs[2 * i] = cosf(r); p->cs[2 * i + 1] = sinf(r);
  }
  for (int i = bid * 256 + tid; i < 4 * 32 * 64; i += nb * 256) {
    int lg = i >> 6;
    float lr = p->lam_re[i], li = p->lam_im[i];
    float step = expf(p->log_step[lg]);
    float mag = expf(step * lr);
    double angd = (double)step * (double)li;
    float r1 = reduce_2pi(angd);
    float ar = mag * cosf(r1), ai = mag * sinf(r1);
    float den = lr * lr + li * li;
    float fr = ((ar - 1.f) * lr + ai * li) / den;
    float fi = (ai * lr - (ar - 1.f) * li) / den;
    float magT = expf(64.f * step * lr);
    float rT = reduce_2pi(64.0 * angd);
    float* tb = p->s5tab + (size_t)i * 40;
    tb[0] = ar; tb[1] = ai; tb[2] = magT * cosf(rT); tb[3] = magT * sinf(rT);
    for (int c = 0; c < 16; c++) {
      float br = p->b_re[(size_t)i * 16 + c], bi = p->b_im[(size_t)i * 16 + c];
      tb[4 + c] = fr * br - fi * bi;
      tb[20 + c] = fr * bi + fi * br;
    }
  }
  float* lds = (float*)smem;
  for (int job = bid; job < 4 * 3008; job += nb) {
    int layer = job / 3008, t = job % 3008;
    if (t < 512) {
      int a = t >> 4, kt = t & 15;
      transpose_tile(p->w_in + (size_t)layer * 1024 * 2048, 2048, kt * 64, a * 64, p->norm_mix + layer * 1024, 1024,
                     p->WinT + (size_t)layer * 2048 * 1024, 1024, a * 64, lds, tid);
    } else if (t < 640) {
      t -= 512; int a = t >> 3, kt = t & 7;
      transpose_tile(p->w_glu + (size_t)layer * 512 * 1024, 1024, kt * 64, (a & 1) * 512 + (a >> 1) * 64, nullptr, 0,
                     p->WgluT + (size_t)layer * 1024 * 512, 512, a * 64, lds, tid);
    } else if (t < 896) {
      t -= 640; int a = t >> 4, kt = t & 15;
      transpose_tile(p->w_out + (size_t)layer * 1024 * 1024, 1024, kt * 64, a * 64, p->ssm_norm + layer * 512, 512,
                     p->WoutT + (size_t)layer * 1024 * 1024, 1024, a * 64, lds, tid);
    } else if (t < 2304) {
      t -= 896; int a = t >> 4, kt = t & 15;
      transpose_tile(p->w_up + (size_t)layer * 1024 * 5632, 5632, kt * 64, (a & 1) * FFN + (a >> 1) * 64, p->norm_ffn + layer * 1024, 1024,
                     p->WupT + (size_t)layer * 5632 * 1024, 1024, a * 64, lds, tid);
    } else {
      t -= 2304; int a = t / 44, kt = t % 44;
      transpose_tile(p->w_down + (size_t)layer * FFN * 1024, 1024, kt * 64, a * 64, nullptr, 0,
                     p->WdownT + (size_t)layer * 1024 * FFN, FFN, a * 64, lds, tid);
    }
  }
}

enum { G_IN = 0, G_GLU = 1, G_WOUT = 2, G_UP = 3, G_DOWN = 4 };
#define ACC_PIN(tag) _Pragma("unroll") for (int i_ = 0; i_ < 4; i_++) _Pragma("unroll") for (int j_ = 0; j_ < 4; j_++) asm volatile("; pin " tag : "+a"(acc[i_][j_]));


__device__ __forceinline__ void gemm_tile(KP p, const int MODE, int layer, int tile, char* smem, const int tid) {
  const int lane = tid & 63, w = tid >> 6, wm = w >> 1, wn = w & 1, g = lane >> 5, l32 = lane & 31;
  int tn, KT, ldb, rowbase, lda;
  const bf16_t* Bt;
  const bf16_t* A0;
  int upb = 0, upti = 0;
  {
    const int TM = (MODE == G_UP) ? 66 : 64;
    const int TN = (MODE == G_IN) ? 8 : (MODE == G_UP ? 22 : 4);
    const int nfull = TN >> 2, rem = TN & 3;
    int tm;
    if (tile < nfull * 4 * TM) { const int band = tile / (4 * TM), within = tile % (4 * TM); tm = within >> 2; tn = band * 4 + (within & 3); }
    else { const int s2 = tile - nfull * 4 * TM; tm = s2 / rem; tn = nfull * 4 + s2 % rem; }
    rowbase = tm * 256;
    if (MODE == G_UP) { upb = tm / 33; upti = tm % 33; rowbase = upb * SEQL + 254 * upti - 2; }
  }
  if (MODE == G_IN) { KT = 16; ldb = 1024; Bt = p->WinT + (size_t)layer * 2048 * 1024; A0 = p->xb; lda = 1024; }
  else if (MODE == G_GLU) { KT = 8; ldb = 512; Bt = p->WgluT + (size_t)layer * 1024 * 512; A0 = p->gy; lda = 512; }
  else if (MODE == G_WOUT) { KT = 16; ldb = 1024; Bt = p->WoutT + (size_t)layer * 1024 * 1024; A0 = p->outg; lda = 512; }
  else if (MODE == G_UP) { KT = 16; ldb = 1024; Bt = p->WupT + (size_t)layer * 5632 * 1024; A0 = p->xb; lda = 1024; }
  else { KT = 44; ldb = FFN; Bt = p->WdownT + (size_t)layer * 1024 * FFN; A0 = p->act; lda = FFN; }

  u32x4 ra[8], rb[8];
  const int lrow = tid >> 3, lc = tid & 7;
  float arow_sc[8];
#pragma unroll
  for (int i = 0; i < 8; i++) arow_sc[i] = 1.f;
  if (MODE == G_WOUT) {
    const float* ssq = p->ssm_ss + (size_t)layer * 8 * NTOK;
#pragma unroll
    for (int i = 0; i < 8; i++) arow_sc[i] = rsqrtf(ss_sum1(ssq, rowbase + lrow + 32 * i) * (1.f / 512.f) + EPS);
  }
  const bf16_t* bptr = Bt + (size_t)(tn * 256 + lrow) * ldb + lc * 8;
  auto gload = [&](int kt) {
    const bf16_t* abase = A0;
    int kofs = kt * 64;
    if (MODE == G_WOUT && kt >= 8) { abase = p->att; kofs = (kt - 8) * 64; }
#pragma unroll
    for (int i = 0; i < 8; i++) {
      int gr = min(max(rowbase + lrow + 32 * i, 0), NTOK - 1);
      ra[i] = *(const u32x4*)(abase + (size_t)gr * lda + kofs + lc * 8);
      rb[i] = *(const u32x4*)(bptr + (size_t)(32 * i) * ldb + kt * 64);
    }
  };
  auto scaleA = [&](int kt) {
    if (MODE == G_WOUT && kt < 8) {
#pragma unroll
      for (int i = 0; i < 8; i++)
#pragma unroll
        for (int e = 0; e < 4; e++) {
          unsigned v = ra[i][e];
          float lo = __uint_as_float(v << 16) * arow_sc[i], hi = __uint_as_float(v & 0xffff0000u) * arow_sc[i];
          ra[i][e] = pack_bf2(lo, hi);
        }
    }
  };
  const int wr_off = lrow * 128 + ((lc ^ ((lrow >> 1) & 7)) << 4);
  auto lwriteA = [&](int st) {
    char* sa = smem + st * 65536;
#pragma unroll
    for (int i = 0; i < 8; i++) *(u32x4*)(sa + wr_off + i * 4096) = ra[i];
  };
  auto lwriteB = [&](int st) {
    char* sb = smem + st * 65536 + 32768;
#pragma unroll
    for (int i = 0; i < 8; i++) *(u32x4*)(sb + wr_off + i * 4096) = rb[i];
  };

  f32x16 acc[4][4];
#pragma unroll
  for (int i = 0; i < 4; i++)
#pragma unroll
    for (int j = 0; j < 4; j++)
#pragma unroll
      for (int r = 0; r < 16; r++) acc[i][j][r] = 0.f;

  const int swz = (l32 >> 1) & 7;
  const int a_base = (wm * 128 + l32) * 128;
  const int b_base = 32768 + (wn * 128 + l32) * 128;
  bf16x8 af[2][4], bfr[2][4];
  auto lfrag = [&](int buf, const char* st, int ks) {
    const int coff = (((ks * 2 + g) ^ swz) << 4);
#pragma unroll
    for (int i = 0; i < 4; i++) af[buf][i] = *(const bf16x8*)(st + a_base + i * 4096 + coff);
#pragma unroll
    for (int j = 0; j < 4; j++) bfr[buf][j] = *(const bf16x8*)(st + b_base + j * 4096 + coff);
  };
  auto mfma16 = [&](int buf) {
#pragma unroll
    for (int i = 0; i < 4; i++)
#pragma unroll
      for (int j = 0; j < 4; j++) acc[i][j] = MFMA(af[buf][i], bfr[buf][j], acc[i][j]);
  };

  gload(0);
  scaleA(0);
  lwriteA(0);
  lwriteB(0);
  __syncthreads();
  if (KT > 1) gload(1);
  lfrag(0, smem, 0);
  for (int kt = 0; kt < KT; kt++) {
    const char* st = smem + (kt & 1) * 65536;
    const bool has1 = (kt + 1 < KT), has2 = (kt + 2 < KT);
    lfrag(1, st, 1);
    if (has1) { scaleA(kt + 1); lwriteA((kt + 1) & 1); }
    mfma16(0);
    __builtin_amdgcn_sched_barrier(0);
    lfrag(0, st, 2);
    if (has1) lwriteB((kt + 1) & 1);
    mfma16(1);
    __builtin_amdgcn_sched_barrier(0);
    lfrag(1, st, 3);
    if (has2) gload(kt + 2);
    mfma16(0);
    __builtin_amdgcn_sched_barrier(0);
    asm volatile("s_waitcnt lgkmcnt(0)" ::: "memory");
    __builtin_amdgcn_s_barrier();
    __builtin_amdgcn_sched_barrier(0);
    if (has1) lfrag(0, smem + ((kt + 1) & 1) * 65536, 0);
    mfma16(1);
    __builtin_amdgcn_sched_barrier(0);
  }

  int tid2 = tid;
  asm volatile("" : "+v"(tid2));
  {
  const int tid = tid2;
  const int lane = tid & 63, w = tid >> 6, wm = w >> 1, wn = w & 1, g = lane >> 5, l32 = lane & 31;
  if (MODE == G_IN) {
    const int region = tn >> 1;
    float* rs = (float*)(smem + 135168);
    rs[tid] = rsqrtf(ss_sum1(p->ss + (size_t)(2 * layer) * 8 * NTOK, rowbase + tid) * (1.f / 1024.f) + EPS);
    __syncthreads();
#pragma unroll
    for (int i = 0; i < 4; i++)
#pragma unroll
      for (int rq = 0; rq < 4; rq++) {
        const int lr0 = wm * 128 + i * 32 + rq * 8 + g * 4;
        const float4 s4 = *(const float4*)(rs + lr0);
        const float sc[4] = {s4.x, s4.y, s4.z, s4.w};
#pragma unroll
        for (int j = 0; j < 4; j++) {
          const int lcol = wn * 128 + j * 32 + l32;
          float v[4];
#pragma unroll
          for (int r4 = 0; r4 < 4; r4++) v[r4] = acc[i][j][rq * 4 + r4] * sc[r4];
          if (region == 3) {
            const int q4 = (lr0 >> 2) & 3;
            const int pq = ((q4 & 1) << 1) | (q4 >> 1);
            u32x2 pk = {pack_bf2(v[0], v[1]), pack_bf2(v[2], v[3])};
            *(u32x2*)(smem + lcol * 528 + ((lr0 & ~15) + pq * 4) * 2) = pk;
          } else {
            if (region != 0 && (j & 1) == 0) {
              float other[4];
#pragma unroll
              for (int r4 = 0; r4 < 4; r4++) other[r4] = __shfl_xor(v[r4], 8);
              if (l32 < 16) {
                const float sgn = (l32 < 8) ? -1.f : 1.f;
#pragma unroll
                for (int r4 = 0; r4 < 4; r4++) {
                  const float2 csv = *(const float2*)(p->cs + ((size_t)(rowbase + lr0 + r4) * 8 + (l32 & 7)) * 2);
                  v[r4] = v[r4] * csv.x + sgn * other[r4] * csv.y;
                }
              }
            }
#pragma unroll
            for (int r4 = 0; r4 < 4; r4++) *(bf16_t*)(smem + (lr0 + r4) * 528 + lcol * 2) = f2bf(v[r4]);
          }
        }
      }
    __syncthreads();
    {
      bf16_t* dbase;
      size_t rstride;
      if (region == 3) { dbase = p->vt + (size_t)((rowbase >> 13) * 512 + (tn & 1) * 256) * SEQL + (rowbase & (SEQL - 1)); rstride = SEQL; }
      else { dbase = (region == 0 ? p->u : (region == 1 ? p->q : p->k)) + (size_t)rowbase * 512 + (tn & 1) * 256; rstride = 512; }
#pragma unroll 8
      for (int it = 0; it < 32; it++) {
        const int id = tid + 256 * it, row = id >> 5, c = id & 31;
        const u32x4 vv = *(const u32x4*)(smem + row * 528 + c * 16);
        *(u32x4*)(dbase + (size_t)row * rstride + c * 8) = vv;
      }
    }
    __syncthreads();
  } else if (MODE == G_GLU) {
    float* ssq = p->ssm_ss + ((size_t)layer * 8 + tn * 2 + wn) * NTOK;
#pragma unroll
    for (int i = 0; i < 4; i++)
#pragma unroll
      for (int rq = 0; rq < 4; rq++) {
        const int row0 = rowbase + wm * 128 + i * 32 + rq * 8 + g * 4;
#pragma unroll
        for (int r4 = 0; r4 < 4; r4++) {
          float sq = 0.f;
#pragma unroll
          for (int j = 0; j < 2; j++) {
            float a = acc[i][j][rq * 4 + r4], b = acc[i][j + 2][rq * 4 + r4];
            float o = a / (1.f + __expf(-b));
            const int col = (tn * 2 + wn) * 64 + j * 32 + l32;
            p->outg[(size_t)(row0 + r4) * 512 + col] = f2bf(o);
            sq += o * o;
          }
#pragma unroll
          for (int o = 16; o; o >>= 1) sq += __shfl_xor(sq, o);
          if (l32 == 0) ssq[row0 + r4] = sq;
        }
      }
  } else if (MODE == G_WOUT || MODE == G_DOWN) {
    float* ssq = p->ss + ((size_t)(MODE == G_WOUT ? 2 * layer + 1 : 2 * layer + 2) * 8 + tn * 2 + wn) * NTOK;
#pragma unroll
    for (int i = 0; i < 4; i++)
#pragma unroll
      for (int rq = 0; rq < 4; rq++) {
        const int row0 = rowbase + wm * 128 + i * 32 + rq * 8 + g * 4;
#pragma unroll
        for (int r4 = 0; r4 < 4; r4++) {
          float sq = 0.f;
#pragma unroll
          for (int j = 0; j < 4; j++) {
            const int col = tn * 256 + wn * 128 + j * 32 + l32;
            const size_t idx = (size_t)(row0 + r4) * 1024 + col;
            float xn = p->xf[idx] + acc[i][j][rq * 4 + r4];
            p->xf[idx] = xn;
            p->xb[idx] = f2bf(xn);
            sq += xn * xn;
          }
#pragma unroll
          for (int o = 16; o; o >>= 1) sq += __shfl_xor(sq, o);
          if (l32 == 0) ssq[row0 + r4] = sq;
        }
      }
  } else {
#pragma unroll
    for (int i = 0; i < 4; i++)
#pragma unroll
      for (int rq = 0; rq < 4; rq++) {
        const int lr0 = wm * 128 + i * 32 + rq * 8 + g * 4;
#pragma unroll
        for (int j = 0; j < 4; j++) {
          const int pc = wn * 128 + j * 32 + l32;
          u32x2 pk = {pack_bf2(acc[i][j][rq * 4 + 0], acc[i][j][rq * 4 + 1]), pack_bf2(acc[i][j][rq * 4 + 2], acc[i][j][rq * 4 + 3])};
          *(u32x2*)(smem + pc * 528 + lr0 * 2) = pk;
        }
      }
    {
      float* rs = (float*)(smem + 135168);
      const int tb = 254 * upti - 2 + tid;
      float sc = 0.f;
      if (tb >= 0) {
        const int gr = min(upb * SEQL + tb, NTOK - 1);
        sc = rsqrtf(ss_sum1(p->ss + (size_t)(2 * layer + 1) * 8 * NTOK, gr) * (1.f / 1024.f) + EPS);
      }
      rs[tid] = sc;
    }
    __syncthreads();
    {
      const int cp = tid & 127, half = tid >> 7;
      const int pg = (cp >> 6) * 128 + (cp & 63), pv = pg + 64;
      const int ocol = tn * 128 + cp;
      const float* wc = p->w_conv + (size_t)layer * 3 * 5632;
      const float* bc = p->b_conv + (size_t)layer * 5632;
      const float wg0 = wc[ocol], wg1 = wc[5632 + ocol], wg2 = wc[2 * 5632 + ocol], bg = bc[ocol];
      const float wv0 = wc[FFN + ocol], wv1 = wc[5632 + FFN + ocol], wv2 = wc[2 * 5632 + FFN + ocol], bv = bc[FFN + ocol];
      const float* rs = (const float*)(smem + 135168);
      const char* gcol = smem + pg * 528;
      const char* vcol = smem + pv * 528;
      float g0 = 0.f, v0 = 0.f, g1 = 0.f, v1 = 0.f;
      if (half) {
        g0 = rs[126] * bf2f(*(const bf16_t*)(gcol + 126 * 2)); v0 = rs[126] * bf2f(*(const bf16_t*)(vcol + 126 * 2));
        g1 = rs[127] * bf2f(*(const bf16_t*)(gcol + 127 * 2)); v1 = rs[127] * bf2f(*(const bf16_t*)(vcol + 127 * 2));
      }
      for (int grp8 = 0; grp8 < 16; grp8++) {
        const int lrb = half * 128 + grp8 * 8;
        const u32x4 gq = *(const u32x4*)(gcol + lrb * 2);
        const u32x4 vq = *(const u32x4*)(vcol + lrb * 2);
        const float4 r0 = *(const float4*)(rs + lrb), r1 = *(const float4*)(rs + lrb + 4);
        const float rsv[8] = {r0.x, r0.y, r0.z, r0.w, r1.x, r1.y, r1.z, r1.w};
#pragma unroll
        for (int e = 0; e < 8; e++) {
          const unsigned gw = gq[e >> 1], vw = vq[e >> 1];
          const float g2 = rsv[e] * ((e & 1) ? __uint_as_float(gw & 0xffff0000u) : __uint_as_float(gw << 16));
          const float v2 = rsv[e] * ((e & 1) ? __uint_as_float(vw & 0xffff0000u) : __uint_as_float(vw << 16));
          const int lr = lrb + e;
          const int tb = 254 * upti - 2 + lr;
          if (lr >= 2 && tb < SEQL) {
            const float gate = bg + wg0 * g0 + wg1 * g1 + wg2 * g2;
            const float val = bv + wv0 * v0 + wv1 * v1 + wv2 * v2;
            const float o = gate / (1.f + __expf(-gate)) * val;
            p->act[(size_t)(upb * SEQL + tb) * FFN + ocol] = f2bf(o);
          }
          g0 = g1; v0 = v1; g1 = g2; v1 = v2;
        }
      }
    }
    __syncthreads();
  }
  }
}

__device__ __forceinline__ void attn_item(KP p, int layer, int b, int h, int qt, float lam, float outscale, char* smem, const int tid) {
  const int lane = tid & 63, w = tid >> 6, g = lane >> 5, l32 = lane & 31;
  const int tok_q = b * SEQL + qt * 128 + w * 32 + l32;
  {
    const int qrow = tid >> 4, qc = tid & 15;
#pragma unroll
    for (int i = 0; i < 8; i++) {
      const int row = qrow + 16 * i;
      u32x4 v = *(const u32x4*)(p->q + (size_t)(b * SEQL + qt * 128 + row) * 512 + h * 128 + qc * 8);
      *(u32x4*)(smem + 65536 + row * 256 + ((qc ^ (row & 15)) << 4)) = v;
    }
  }
  const int q_off = 65536 + (w * 32 + l32) * 256;
  const int q_swz = (l32 & 15);

  const int NT = 2 * qt + 2;
  const int nkt = 2 * qt + 1 + (w >> 1);
  f32x16 O[2][4];
#pragma unroll
  for (int c = 0; c < 2; c++)
#pragma unroll
    for (int dt = 0; dt < 4; dt++)
#pragma unroll
      for (int r = 0; r < 16; r++) O[c][dt][r] = 0.f;
  float mrun[2] = {-1e30f, -1e30f}, lrun[2] = {0.f, 0.f};
  const float c1 = 0.125f * 1.4426950408889634f;

  u32x4 rk[4], rv[4];
  const bf16_t* kbase = p->k + (size_t)(b * SEQL) * 512 + h * 128;
  const bf16_t* vbase = p->vt + (size_t)((b * 4 + h) * 128) * SEQL;
  const int kkey = tid >> 4, kc = tid & 15;
  const int vd = tid >> 3, vc = tid & 7;
  auto gload = [&](int kt) {
#pragma unroll
    for (int i = 0; i < 4; i++) {
      rk[i] = *(const u32x4*)(kbase + (size_t)(kt * 64 + kkey + 16 * i) * 512 + kc * 8);
      rv[i] = *(const u32x4*)(vbase + (size_t)(vd + 32 * i) * SEQL + kt * 64 + vc * 8);
    }
  };
  const int kw_off = kkey * 256 + ((kc ^ (kkey & 15)) << 4);
  const int vw_off = 16384 + vd * 128 + ((vc ^ ((vd >> 1) & 7)) << 4);
  auto lwrite = [&](int st) {
    char* s = smem + st * 32768;
#pragma unroll
    for (int i = 0; i < 4; i++) {
      *(u32x4*)(s + kw_off + i * 4096) = rk[i];
      *(u32x4*)(s + vw_off + i * 4096) = rv[i];
    }
  };

  gload(0);
  lwrite(0);
  __syncthreads();
  for (int kt = 0; kt < NT; kt++) {
    if (kt + 1 < NT) gload(kt + 1);
    if (kt < nkt) {
      const char* st = smem + (kt & 1) * 32768;
      bf16x8 pf[2][2][2];
      bf16x8 kf[8], qfr[4], vf[2][4];
      f32x16 S[1][2];
      auto loadkq = [&](int c) {
#pragma unroll
        for (int kb = 0; kb < 2; kb++)
#pragma unroll
          for (int ks = 0; ks < 4; ks++) {
            const int key = kb * 32 + l32, chunk = c * 8 + ks * 2 + g;
            kf[kb * 4 + ks] = *(const bf16x8*)(st + key * 256 + ((chunk ^ (key & 15)) << 4));
          }
#pragma unroll
        for (int ks = 0; ks < 4; ks++) qfr[ks] = *(const bf16x8*)(smem + q_off + (((c * 8 + ks * 2 + g) ^ q_swz) << 4));
      };
      auto qk = [&](int c) {
#pragma unroll
        for (int kb = 0; kb < 2; kb++) {
#pragma unroll
          for (int r = 0; r < 16; r++) S[0][kb][r] = 0.f;
#pragma unroll
          for (int ks = 0; ks < 4; ks++) S[0][kb] = MFMA(kf[kb * 4 + ks], qfr[ks], S[0][kb]);
        }
      };
      auto loadv = [&](int bi) {
#pragma unroll
        for (int dt = 0; dt < 4; dt++) {
          const int d = dt * 32 + l32, chunk = bi * 2 + g;
          vf[bi & 1][dt] = *(const bf16x8*)(st + 16384 + d * 128 + ((chunk ^ ((d >> 1) & 7)) << 4));
        }
      };
      auto softmax = [&](int c) {
        float mx = S[0][0][0];
#pragma unroll
        for (int r = 1; r < 16; r++) mx = fmaxf(mx, S[0][0][r]);
#pragma unroll
        for (int r = 0; r < 16; r++) mx = fmaxf(mx, S[0][1][r]);
        mx = fmaxf(mx, __shfl_xor(mx, 32));
        const float mcand = fmaxf(mrun[c], mx * c1);
        if (__any(mcand - mrun[c] > 8.f)) {
          const float alpha = fast_exp2(mrun[c] - mcand);
          mrun[c] = mcand;
          lrun[c] *= alpha;
#pragma unroll
          for (int dt = 0; dt < 4; dt++)
#pragma unroll
            for (int r = 0; r < 16; r++) O[c][dt][r] *= alpha;
        }
        const float mref = mrun[c];
        const f2_t c1v = {c1, c1}, mrv = {-mref, -mref};
        f2_t psum2 = {0.f, 0.f};
#pragma unroll
        for (int kb = 0; kb < 2; kb++)
#pragma unroll
          for (int r = 0; r < 16; r += 2) {
            f2_t sv = {S[0][kb][r], S[0][kb][r + 1]};
            f2_t av = __builtin_elementwise_fma(sv, c1v, mrv);
            f2_t ev = {fast_exp2(av[0]), fast_exp2(av[1])};
            S[0][kb][r] = ev[0]; S[0][kb][r + 1] = ev[1];
            psum2 += ev;
          }
        lrun[c] += psum2[0] + psum2[1];
#pragma unroll
        for (int kb = 0; kb < 2; kb++)
#pragma unroll
          for (int m = 0; m < 2; m++) {
            u32x4 pk = {pack_bf2(S[0][kb][8 * m + 0], S[0][kb][8 * m + 1]), pack_bf2(S[0][kb][8 * m + 2], S[0][kb][8 * m + 3]),
                        pack_bf2(S[0][kb][8 * m + 4], S[0][kb][8 * m + 5]), pack_bf2(S[0][kb][8 * m + 6], S[0][kb][8 * m + 7])};
            pf[c][kb][m] = __builtin_bit_cast(bf16x8, pk);
          }
      };
      loadkq(0);
      __builtin_amdgcn_sched_barrier(0);
      qk(0);
      __builtin_amdgcn_sched_barrier(0);
      loadkq(1);
      __builtin_amdgcn_sched_barrier(0);
      softmax(0);
      __builtin_amdgcn_sched_barrier(0);
      qk(1);
      loadv(0);
      __builtin_amdgcn_sched_barrier(0);
      softmax(1);
      __builtin_amdgcn_sched_barrier(0);
#pragma unroll
      for (int bi = 0; bi < 4; bi++) {
        if (bi < 3) loadv(bi + 1);
#pragma unroll
        for (int dt = 0; dt < 4; dt++) {
          O[0][dt] = MFMA(vf[bi & 1][dt], pf[0][bi >> 1][bi & 1], O[0][dt]);
          O[1][dt] = MFMA(vf[bi & 1][dt], pf[1][bi >> 1][bi & 1], O[1][dt]);
        }
        __builtin_amdgcn_sched_barrier(0);
      }
    }
    if (kt + 1 < NT) lwrite((kt + 1) & 1);
    __syncthreads();
  }

  const float l1 = lrun[0] + __shfl_xor(lrun[0], 32);
  const float l2 = lrun[1] + __shfl_xor(lrun[1], 32);
  const float i1 = 1.f / l1, i2 = lam / l2;
  float ssq = 0.f;
#pragma unroll
  for (int dt = 0; dt < 4; dt++)
#pragma unroll
    for (int r = 0; r < 16; r++) {
      float o = O[0][dt][r] * i1 - O[1][dt][r] * i2;
      O[0][dt][r] = o;
      ssq += o * o;
    }
  ssq += __shfl_xor(ssq, 32);
  const float rstd = rsqrtf(ssq * (1.f / 128.f) + EPS) * outscale;
  const float* gsub = p->subln + layer * 128;
#pragma unroll
  for (int dt = 0; dt < 4; dt++)
#pragma unroll
    for (int rq = 0; rq < 4; rq++) {
      const int d0 = dt * 32 + rq * 8 + g * 4;
      float4 gg = *(const float4*)(gsub + d0);
      u32x2 pk = {pack_bf2(O[0][dt][rq * 4 + 0] * rstd * gg.x, O[0][dt][rq * 4 + 1] * rstd * gg.y),
                  pack_bf2(O[0][dt][rq * 4 + 2] * rstd * gg.z, O[0][dt][rq * 4 + 3] * rstd * gg.w)};
      *(u32x2*)(p->att + (size_t)tok_q * 512 + h * 128 + d0) = pk;
    }
}

DI void s5_store_u(const u32x4 a, const u32x4 bq, int lane, float* ul) {
  float4* d = (float4*)(ul + lane * 16);
  d[0] = make_float4(__uint_as_float(a[0] << 16), __uint_as_float(a[0] & 0xffff0000u), __uint_as_float(a[1] << 16), __uint_as_float(a[1] & 0xffff0000u));
  d[1] = make_float4(__uint_as_float(a[2] << 16), __uint_as_float(a[2] & 0xffff0000u), __uint_as_float(a[3] << 16), __uint_as_float(a[3] & 0xffff0000u));
  d[2] = make_float4(__uint_as_float(bq[0] << 16), __uint_as_float(bq[0] & 0xffff0000u), __uint_as_float(bq[1] << 16), __uint_as_float(bq[1] & 0xffff0000u));
  d[3] = make_float4(__uint_as_float(bq[2] << 16), __uint_as_float(bq[2] & 0xffff0000u), __uint_as_float(bq[3] << 16), __uint_as_float(bq[3] & 0xffff0000u));
}
DI void s5_load_u(KP p, int b, int g, int j, int lane, float* ul) {
  const u32x4* src = (const u32x4*)(p->u + (size_t)(b * SEQL + j * 64 + lane) * 512 + g * 16);
  const u32x4 a = src[0], bq = src[1];
  s5_store_u(a, bq, lane, ul);
}

DI float swap_half(float v, const int which) {
  const unsigned u = __float_as_uint(v);
  auto r = __builtin_amdgcn_permlane32_swap(u, u, false, false);
  return __uint_as_float(which ? r[1] : r[0]);
}

struct S5Coef { float arA, aiA, arB, aiB; };

template <bool STORE>
DI void s5_scan32(const float* ul_sub, const bf16x8 (&bfr)[4], const S5Coef& cf, float& xAr, float& xAi, float& xBr, float& xBi,
                  float* X, const int l32, const int grp) {
  bf16x8 af;
  {
    const float* us = ul_sub + l32 * 16 + grp * 8;
    float4 a = *(const float4*)us, bq = *(const float4*)(us + 4);
    u32x4 pk = {pack_bf2(a.x, a.y), pack_bf2(a.z, a.w), pack_bf2(bq.x, bq.y), pack_bf2(bq.z, bq.w)};
    af = __builtin_bit_cast(bf16x8, pk);
  }
  f32x16 zero;
#pragma unroll
  for (int r = 0; r < 16; r++) zero[r] = 0.f;
  const f32x16 bu0 = MFMA(af, bfr[0], zero), bu1 = MFMA(af, bfr[1], zero), bu2 = MFMA(af, bfr[2], zero), bu3 = MFMA(af, bfr[3], zero);
#pragma unroll
  for (int k = 0; k < 8; k++) {
    float sAr[4], sAi[4], sBr[4], sBi[4];
#pragma unroll
    for (int i = 0; i < 4; i++) {
      const int r = (k >> 1) * 4 + i;
      const float nAr = cf.arA * xAr - cf.aiA * xAi + bu0[r];
      const float nAi = cf.arA * xAi + cf.aiA * xAr + bu2[r];
      const float nBr = cf.arB * xBr - cf.aiB * xBi + bu1[r];
      const float nBi = cf.arB * xBi + cf.aiB * xBr + bu3[r];
      xAr = nAr; xAi = nAi; xBr = nBr; xBi = nBi;
      sAr[i] = nAr; sAi[i] = nAi; sBr[i] = nBr; sBi[i] = nBi;
    }
    if (STORE) {
      if (grp == (k & 1)) {
#pragma unroll
        for (int i = 0; i < 4; i++) {
          float* xr = X + (4 * k + i) * 132;
          xr[l32] = sAr[i]; xr[64 + l32] = sAi[i]; xr[32 + l32] = sBr[i]; xr[96 + l32] = sBi[i];
        }
      }
    }
    xAr = swap_half(xAr, k & 1); xAi = swap_half(xAi, k & 1);
    xBr = swap_half(xBr, k & 1); xBi = swap_half(xBi, k & 1);
  }
}

DI void s5_setup(KP p, int layer, int g, int l32, int grp, S5Coef& cf, bf16x8 (&bfr)[4]) {
  const float* t0 = p->s5tab + (size_t)((layer * 32 + g) * 64) * 40;
  cf.arA = t0[l32 * 40]; cf.aiA = t0[l32 * 40 + 1];
  cf.arB = t0[(32 + l32) * 40]; cf.aiB = t0[(32 + l32) * 40 + 1];
#pragma unroll
  for (int jt = 0; jt < 4; jt++) {
    const float* src = t0 + (l32 + 32 * (jt & 1)) * 40 + 4 + (jt >> 1) * 16 + grp * 8;
    float4 a = *(const float4*)src, bq = *(const float4*)(src + 4);
    u32x4 pk = {pack_bf2(a.x, a.y), pack_bf2(a.z, a.w), pack_bf2(bq.x, bq.y), pack_bf2(bq.z, bq.w)};
    bfr[jt] = __builtin_bit_cast(bf16x8, pk);
  }
}

__device__ __forceinline__ void s5_pass1(KP p, int layer, char* smem, const int tid) {
  const int lane = tid & 63, w = tid >> 6, l32 = lane & 31, grp = lane >> 5;
  float* ul = (float*)(smem + w * 4096);
  for (int wbase = blockIdx.x * 4; wbase < 1024; wbase += gridDim.x * 4) {
    const int wi = wbase + w;
    const int j0 = (wi & 15) * 8, g = (wi >> 4) & 31, b = wi >> 9;
    S5Coef cf; bf16x8 bfr[4];
    s5_setup(p, layer, g, l32, grp, cf, bfr);
    const u32x4* src = (const u32x4*)(p->u + (size_t)(b * SEQL + j0 * 64 + lane) * 512 + g * 16);
    u32x4 v0 = src[0], v1 = src[1];
    for (int jj = 0; jj < 8; jj++) {
      const int j = j0 + jj;
      s5_store_u(v0, v1, lane, ul);
      if (jj < 7) {
        const u32x4* nsrc = (const u32x4*)(p->u + (size_t)(b * SEQL + (j + 1) * 64 + lane) * 512 + g * 16);
        v0 = nsrc[0]; v1 = nsrc[1];
      }
      __syncthreads();
      float xAr = 0.f, xAi = 0.f, xBr = 0.f, xBi = 0.f;
      s5_scan32<false>(ul, bfr, cf, xAr, xAi, xBr, xBi, nullptr, l32, grp);
      s5_scan32<false>(ul + 32 * 16, bfr, cf, xAr, xAi, xBr, xBi, nullptr, l32, grp);
      float* so = p->sloc + (size_t)((b * 32 + g) * 128 + j) * 128;
      so[lane] = grp ? xBr : xAr; so[64 + lane] = grp ? xBi : xAi;
      __syncthreads();
    }
  }
}

__device__ __forceinline__ void s5_pass2(KP p, int layer, char* smem, const int tid) {
  const int lane = tid & 63, w = tid >> 6;
  float* ul = (float*)(smem + w * 21504);
  float* X = ul + 1024;
  const int l32 = lane & 31, grp = lane >> 5;
  for (int wbase = blockIdx.x * 4; wbase < 1024; wbase += gridDim.x * 4) {
   const int wi = wbase + w;
   const int j0 = (wi & 15) * 8, g = (wi >> 4) & 31, b = wi >> 9;
   S5Coef cf; bf16x8 bfr[4];
   s5_setup(p, layer, g, l32, grp, cf, bfr);
   bf16x8 cfr[8];
   {
     const int c = l32 & 15;
     const float* cr = p->c_re + (size_t)((layer * 32 + g) * 16 + c) * 64;
     const float* ci = p->c_im + (size_t)((layer * 32 + g) * 16 + c) * 64;
#pragma unroll
     for (int s8 = 0; s8 < 8; s8++) {
       const int k0 = (s8 & 3) * 16 + grp * 8;
       const float* src = (s8 < 4) ? (cr + k0) : (ci + k0);
       const float sg = (l32 < 16) ? ((s8 < 4) ? 1.f : -1.f) : 0.f;
       float4 a = *(const float4*)src, bq = *(const float4*)(src + 4);
       u32x4 pk = {pack_bf2(a.x * sg, a.y * sg), pack_bf2(a.z * sg, a.w * sg), pack_bf2(bq.x * sg, bq.y * sg), pack_bf2(bq.z * sg, bq.w * sg)};
       cfr[s8] = __builtin_bit_cast(bf16x8, pk);
     }
   }
   const float dd = p->ssm_d[(size_t)(layer * 32 + g) * 16 + (l32 & 15)];
   float xAr, xAi, xBr, xBi;
   {
     const float* tb = p->s5tab + (size_t)((layer * 32 + g) * 64 + lane) * 40;
     const float aTr = tb[2], aTi = tb[3];
     float xr = 0.f, xi = 0.f;
     const float* sl = p->sloc + (size_t)((b * 32 + g) * 128) * 128;
     for (int i0 = 0; i0 < j0; i0 += 8) {
       float sr[8], si[8];
#pragma unroll
       for (int q = 0; q < 8; q++) { sr[q] = sl[(i0 + q) * 128 + lane]; si[q] = sl[(i0 + q) * 128 + 64 + lane]; }
#pragma unroll
       for (int q = 0; q < 8; q++) {
         const float nr = aTr * xr - aTi * xi + sr[q];
         const float ni = aTr * xi + aTi * xr + si[q];
         xr = nr; xi = ni;
       }
     }
     xAr = swap_half(xr, 0); xBr = swap_half(xr, 1);
     xAi = swap_half(xi, 0); xBi = swap_half(xi, 1);
   }
   for (int jj = 0; jj < 8; jj++) {
    const int j = j0 + jj;
    s5_load_u(p, b, g, j, lane, ul);
    __syncthreads();
    for (int sub = 0; sub < 2; sub++) {
      s5_scan32<true>(ul + sub * 32 * 16, bfr, cf, xAr, xAi, xBr, xBi, X, l32, grp);
      __syncthreads();
      f32x16 yacc;
#pragma unroll
      for (int r = 0; r < 16; r++) yacc[r] = 0.f;
#pragma unroll
      for (int s8 = 0; s8 < 8; s8++) {
        const float* xs = X + l32 * 132 + ((s8 < 4) ? 0 : 64) + (s8 & 3) * 16 + grp * 8;
        float4 a = *(const float4*)xs, bq = *(const float4*)(xs + 4);
        u32x4 pk = {pack_bf2(a.x, a.y), pack_bf2(a.z, a.w), pack_bf2(bq.x, bq.y), pack_bf2(bq.z, bq.w)};
        yacc = MFMA(__builtin_bit_cast(bf16x8, pk), cfr[s8], yacc);
      }
      if (l32 < 16) {
#pragma unroll
        for (int r = 0; r < 16; r++) {
          const int tl = sub * 32 + (r >> 2) * 8 + grp * 4 + (r & 3);
          const float yv = yacc[r] + dd * ul[tl * 16 + l32];
          p->gy[(size_t)(b * SEQL + j * 64 + tl) * 512 + g * 16 + l32] = f2bf(gelu_tanh(yv));
        }
      }
      __syncthreads();
    }
   }
  }
}

__device__ __forceinline__ void phase_attn(KP p, int layer, char* smem, const int tid) {
  const int lane = tid & 63;
  const float s1 = wave_sum(p->lq1[layer * 64 + lane] * p->lk1[layer * 64 + lane]);
  const float s2 = wave_sum(p->lq2[layer * 64 + lane] * p->lk2[layer * 64 + lane]);
  const float lam_init = 0.8f - 0.6f * expf(-0.3f * (float)layer);
  const float lam = expf(s1) - expf(s2) + lam_init;
  for (int pb = blockIdx.x; pb < 256; pb += gridDim.x) {
    const int pi = (pb & 7) * 32 + (pb >> 3);
    const int b = pi >> 7, h = (pi >> 5) & 3, i = pi & 31;
    attn_item(p, layer, b, h, 63 - i, lam, 1.f - lam_init, smem, tid);
    attn_item(p, layer, b, h, i, lam, 1.f - lam_init, smem, tid);
  }
  s5_pass1(p, layer, smem, tid);
}

__device__ __forceinline__ void phase_final(KP p, const int tid) {
  const int wave = tid >> 6, lane = tid & 63;
  const float* ssq = p->ss + (size_t)8 * 8 * NTOK;
  for (int row = blockIdx.x * 4 + wave; row < NTOK; row += gridDim.x * 4) {
    const float rstd = rsqrtf(ss_sum1(ssq, row) * (1.f / 1024.f) + EPS);
#pragma unroll
    for (int i = 0; i < 4; i++) {
      float4 v = ((const float4*)(p->xf + (size_t)row * DM))[lane + 64 * i];
      float4 gq = ((const float4*)p->norm_final)[lane + 64 * i];
      float4 o = {v.x * rstd * gq.x, v.y * rstd * gq.y, v.z * rstd * gq.z, v.w * rstd * gq.w};
      ((float4*)(p->out + (size_t)row * DM))[lane + 64 * i] = o;
    }
  }
}

__device__ __forceinline__ void run_phase(KP p, int ph, char* smem) {
  const int tid = opaque_tid();
  if (ph == 0) { phase_prep(p, smem, tid); return; }
  if (ph == 29) { phase_final(p, tid); return; }
  const int layer = (ph - 1) / 7, k = (ph - 1) % 7;
  const int nb = gridDim.x, bid = blockIdx.x;
  if (k == 1) { phase_attn(p, layer, smem, tid); return; }
  if (k == 2) { s5_pass2(p, layer, smem, tid); return; }
  if (k == 0) { for (int r = 0; ; r++) { const int t = (r * 8 + (bid & 7)) * (nb >> 3) + (bid >> 3); if (r * nb >= 512) break; if (t < 512) gemm_tile(p, G_IN, layer, t, smem, tid); } }
  else if (k == 3) { for (int r = 0; ; r++) { const int t = (r * 8 + (bid & 7)) * (nb >> 3) + (bid >> 3); if (r * nb >= 256) break; if (t < 256) gemm_tile(p, G_GLU, layer, t, smem, tid); } }
  else if (k == 4) { for (int r = 0; ; r++) { const int t = (r * 8 + (bid & 7)) * (nb >> 3) + (bid >> 3); if (r * nb >= 256) break; if (t < 256) gemm_tile(p, G_WOUT, layer, t, smem, tid); } }
  else if (k == 5) { for (int r = 0; ; r++) { const int t = (r * 8 + (bid & 7)) * (nb >> 3) + (bid >> 3); if (r * nb >= 2 * 33 * 22) break; if (t < 2 * 33 * 22) gemm_tile(p, G_UP, layer, t, smem, tid); } }
  else { for (int r = 0; ; r++) { const int t = (r * 8 + (bid & 7)) * (nb >> 3) + (bid >> 3); if (r * nb >= 256) break; if (t < 256) gemm_tile(p, G_DOWN, layer, t, smem, tid); } }
}

#define PHASE_KERNEL(name, body)                                                      \
  __global__ void __launch_bounds__(256) name(Params p_unused) {                      \
    extern __shared__ __attribute__((aligned(16))) char smem[];                       \
    KP p = (KP)__builtin_amdgcn_kernarg_segment_ptr();                                \
    const int tid = threadIdx.x, nb = gridDim.x, bid = blockIdx.x;                    \
    const int layer = (int)p->phase_lo;                                               \
    (void)nb; (void)bid; (void)layer;                                                 \
    body                                                                              \
  }
PHASE_KERNEL(k_prep, phase_prep(p, smem, tid);)
PHASE_KERNEL(k_gin, for (int r = 0; ; r++) { const int t = (r * 8 + (bid & 7)) * (nb >> 3) + (bid >> 3); if (r * nb >= 512) break; if (t < 512) gemm_tile(p, G_IN, layer, t, smem, tid); })
PHASE_KERNEL(k_attn, phase_attn(p, layer, smem, tid);)
PHASE_KERNEL(k_s5p2, s5_pass2(p, layer, smem, tid);)
PHASE_KERNEL(k_glu, for (int r = 0; ; r++) { const int t = (r * 8 + (bid & 7)) * (nb >> 3) + (bid >> 3); if (r * nb >= 256) break; if (t < 256) gemm_tile(p, G_GLU, layer, t, smem, tid); })
PHASE_KERNEL(k_wout, for (int r = 0; ; r++) { const int t = (r * 8 + (bid & 7)) * (nb >> 3) + (bid >> 3); if (r * nb >= 256) break; if (t < 256) gemm_tile(p, G_WOUT, layer, t, smem, tid); })
PHASE_KERNEL(k_up, for (int r = 0; ; r++) { const int t = (r * 8 + (bid & 7)) * (nb >> 3) + (bid >> 3); if (r * nb >= 2 * 33 * 22) break; if (t < 2 * 33 * 22) gemm_tile(p, G_UP, layer, t, smem, tid); })
PHASE_KERNEL(k_down, for (int r = 0; ; r++) { const int t = (r * 8 + (bid & 7)) * (nb >> 3) + (bid >> 3); if (r * nb >= 256) break; if (t < 256) gemm_tile(p, G_DOWN, layer, t, smem, tid); })
PHASE_KERNEL(k_final, phase_final(p, tid);)

#if COOP
__global__ void __launch_bounds__(256) mega_kernel(Params p_unused) {
  extern __shared__ __attribute__((aligned(16))) char smem[];
  KP p0 = (KP)__builtin_amdgcn_kernarg_segment_ptr();
  const int ph_lo = (int)p0->phase_lo, ph_hi = (int)p0->phase_hi;
#if COOP
  if (ph_hi > 1000) cg::this_grid().sync();
#endif
  for (int ph = ph_lo; ph < ph_hi; ph++) {
    KP p = p0;
    asm volatile("" : "+s"(p));
#if TPROBE
    if (blockIdx.x == 0) p->ts[ph] = (long long)wall_clock64();
#endif
    run_phase(p, ph, smem);
#if COOP
    if (ph + 1 < ph_hi) grid_barrier(p->bar, (unsigned)(ph + 1 - ph_lo) * gridDim.x, opaque_tid());
#endif
  }
#if TPROBE
  grid_barrier(p0->bar, (unsigned)(ph_hi - ph_lo) * gridDim.x, opaque_tid());
  if (blockIdx.x == 0) {
    KP p = p0;
    long long tend = (long long)wall_clock64();
    float a = 0.f, b = 0.f;
    for (int ph = 0; ph < 30; ph++) {
      long long t0 = p->ts[ph], t1 = (ph == 29) ? tend : p->ts[ph + 1];
      int c = (ph == 0) ? 0 : (ph == 29 ? 8 : 1 + (ph - 1) % 7);
      float d = (float)(t1 - t0) * 0.01f;
      if (c == TP_A || TP_A == 9) a += d;
      if (c == TP_B || TP_B == 9) b += d;
    }
    const int t = opaque_tid();
    if (t <= 100) p->out[t] += (t == 0) ? a : b;
  }
#endif
}

#endif

extern "C" void kernel_launch(void* const* d_in, const int* in_sizes, int n_in, void* d_out, int out_size, void* d_ws,
                              size_t ws_size, hipStream_t stream) {
  static int grid_blocks = 0;
  if (!grid_blocks) {
    int dev = 0, cus = 0, per_cu = 0;
    (void)hipGetDevice(&dev);
    (void)hipDeviceGetAttribute(&cus, hipDeviceAttributeMultiprocessorCount, dev);
#if COOP
    (void)hipFuncSetAttribute((const void*)mega_kernel, hipFuncAttributeMaxDynamicSharedMemorySize, LDS_BYTES);
    (void)hipOccupancyMaxActiveBlocksPerMultiprocessor(&per_cu, (const void*)mega_kernel, 256, LDS_BYTES);
    if (per_cu < 1) { fprintf(stderr, "occupancy query returned %d\n", per_cu); per_cu = 1; }
#endif
    grid_blocks = cus;
    (void)hipGetLastError();
  }
  Params p{};
  p.x = (const float*)d_in[0]; p.pos = (const int*)d_in[1];
  p.norm_mix = (const float*)d_in[2]; p.w_in = (const float*)d_in[3];
  p.lam_re = (const float*)d_in[4]; p.lam_im = (const float*)d_in[5]; p.log_step = (const float*)d_in[6];
  p.b_re = (const float*)d_in[7]; p.b_im = (const float*)d_in[8]; p.c_re = (const float*)d_in[9]; p.c_im = (const float*)d_in[10];
  p.ssm_d = (const float*)d_in[11]; p.w_glu = (const float*)d_in[12]; p.ssm_norm = (const float*)d_in[13];
  p.lq1 = (const float*)d_in[14]; p.lk1 = (const float*)d_in[15]; p.lq2 = (const float*)d_in[16]; p.lk2 = (const float*)d_in[17];
  p.subln = (const float*)d_in[18]; p.w_out = (const float*)d_in[19]; p.norm_ffn = (const float*)d_in[20];
  p.w_up = (const float*)d_in[21]; p.w_conv = (const float*)d_in[22]; p.b_conv = (const float*)d_in[23];
  p.w_down = (const float*)d_in[24]; p.norm_final = (const float*)d_in[25];
  p.out = (float*)d_out;
  char* ws = (char*)d_ws;
  size_t off = 0;
  auto take = [&](size_t bytes) { char* r = ws + off; off += (bytes + 255) & ~(size_t)255; return r; };
  p.WinT = (bf16_t*)take((size_t)4 * 2048 * 1024 * 2);
  p.WgluT = (bf16_t*)take((size_t)4 * 1024 * 512 * 2);
  p.WoutT = (bf16_t*)take((size_t)4 * 1024 * 1024 * 2);
  p.WupT = (bf16_t*)take((size_t)4 * 5632 * 1024 * 2);
  p.WdownT = (bf16_t*)take((size_t)4 * 1024 * FFN * 2);
  p.xf = (float*)take((size_t)NTOK * DM * 4);
  p.xb = (bf16_t*)take((size_t)NTOK * DM * 2);
  p.ss = (float*)take((size_t)9 * 8 * NTOK * 4);
  p.ssm_ss = (float*)take((size_t)4 * 8 * NTOK * 4);
  p.cs = (float*)take((size_t)NTOK * 16 * 4);
  p.s5tab = (float*)take((size_t)4 * 32 * 64 * 40 * 4);
  p.sloc = (float*)take((size_t)2 * 32 * 128 * 128 * 4);
  p.ts = (long long*)take(256);
  p.bar = (unsigned*)take(256);
  char* region = take((size_t)134217728);
  p.u = (bf16_t*)region;
  p.q = (bf16_t*)(region + 33554432);
  p.k = p.q + (size_t)NTOK * 512;
  p.vt = p.k + (size_t)NTOK * 512;
  p.gy = p.vt + (size_t)NTOK * 512;
  p.outg = p.gy + (size_t)NTOK * 512;
  p.att = p.outg + (size_t)NTOK * 512;
  p.act = (bf16_t*)region;
  if (off > ws_size) { fprintf(stderr, "workspace too small: need %zu have %zu\n", off, ws_size); return; }
#if COOP
  p.phase_lo = 0; p.phase_hi = 30;
  if (hipMemsetAsync(p.bar, 0, 256, stream) != hipSuccess) fprintf(stderr, "barrier memset failed\n");
  void* args[] = {&p};
  hipError_t e = hipLaunchCooperativeKernel((const void*)mega_kernel, dim3(grid_blocks), dim3(256), args, LDS_BYTES, stream);
  if (e != hipSuccess) fprintf(stderr, "cooperative launch failed: %s (grid %d)\n", hipGetErrorString(e), grid_blocks);
#else
  typedef void (*kfn)(Params);
  const kfn seq[7] = {k_gin, k_attn, k_s5p2, k_glu, k_wout, k_up, k_down};
  static bool attr_done = false;
  if (!attr_done) {
    (void)hipFuncSetAttribute((const void*)k_prep, hipFuncAttributeMaxDynamicSharedMemorySize, LDS_BYTES);
    (void)hipFuncSetAttribute((const void*)k_final, hipFuncAttributeMaxDynamicSharedMemorySize, LDS_BYTES);
    for (int i = 0; i < 7; i++) (void)hipFuncSetAttribute((const void*)seq[i], hipFuncAttributeMaxDynamicSharedMemorySize, LDS_BYTES);
    attr_done = true;
  }
  p.phase_lo = 0; p.phase_hi = 0;
  hipLaunchKernelGGL(k_prep, dim3(grid_blocks), dim3(256), LDS_BYTES, stream, p);
  for (int layer = 0; layer < 4; layer++) {
    p.phase_lo = layer;
    for (int i = 0; i < 7; i++) hipLaunchKernelGGL(seq[i], dim3(grid_blocks), dim3(256), LDS_BYTES, stream, p);
  }
  hipLaunchKernelGGL(k_final, dim3(grid_blocks), dim3(256), LDS_BYTES, stream, p);
#endif
}
```

```cpp
#include <hip/hip_runtime.h>
#include <hip/hip_cooperative_groups.h>
#include <cstdio>
namespace cg = cooperative_groups;

#ifndef COOP
#define COOP 1
#endif
#ifndef TPROBE
#define TPROBE 0
#endif
#ifndef TP_A
#define TP_A 1
#endif
#ifndef TP_B
#define TP_B 2
#endif

typedef unsigned short bf16_t;
typedef __attribute__((ext_vector_type(8))) short bf16x8;
typedef __attribute__((ext_vector_type(16))) float f32x16;
typedef __attribute__((ext_vector_type(2))) __bf16 bf2_t;
typedef __attribute__((ext_vector_type(2))) float f2_t;
typedef __attribute__((ext_vector_type(4))) unsigned u32x4;
typedef __attribute__((ext_vector_type(2))) unsigned u32x2;

#define DI __device__ __forceinline__
#define MFMA(a, b, c) __builtin_amdgcn_mfma_f32_32x32x16_bf16((a), (b), (c), 0, 0, 0)

constexpr int NTOK = 16384, DM = 1024, SEQL = 8192, FFN = 2816;
constexpr int LDS_BYTES = 136192;
constexpr float EPS = 1e-6f;

struct Params {
  const float* x; const int* pos;
  const float *norm_mix, *w_in, *lam_re, *lam_im, *log_step, *b_re, *b_im, *c_re, *c_im, *ssm_d, *w_glu, *ssm_norm;
  const float *lq1, *lk1, *lq2, *lk2, *subln, *w_out, *norm_ffn, *w_up, *w_conv, *b_conv, *w_down, *norm_final;
  float* out;
  bf16_t *WinT, *WgluT, *WoutT, *WupT, *WdownT;
  float* xf; bf16_t* xb;
  bf16_t *u, *q, *k, *vt, *gy, *outg, *att, *act;
  float *ss, *ssm_ss, *cs, *s5tab, *sloc;
  long long phase_lo, phase_hi;
  long long* ts;
  unsigned* bar;
};

typedef const __attribute__((address_space(4))) Params* KP;

DI unsigned pack_bf2(float a, float b) { f2_t v = {a, b}; return __builtin_bit_cast(unsigned, __builtin_convertvector(v, bf2_t)); }
DI bf16_t f2bf(float a) { return (bf16_t)(pack_bf2(a, 0.f) & 0xffffu); }
DI float bf2f(bf16_t v) { return __uint_as_float(((unsigned)v) << 16); }
DI void grid_barrier(unsigned* ctr, unsigned target, int tid) {
  asm volatile("s_waitcnt vmcnt(0)" ::: "memory");
  __syncthreads();
  if (tid == 0) {
    __builtin_amdgcn_fence(__ATOMIC_RELEASE, "agent");
    asm volatile("s_waitcnt vmcnt(0)" ::: "memory");
    __hip_atomic_fetch_add(ctr, 1u, __ATOMIC_RELAXED, __HIP_MEMORY_SCOPE_AGENT);
    while (__hip_atomic_load(ctr, __ATOMIC_RELAXED, __HIP_MEMORY_SCOPE_AGENT) < target) __builtin_amdgcn_s_sleep(1);
    __builtin_amdgcn_fence(__ATOMIC_ACQUIRE, "agent");
    asm volatile("s_waitcnt vmcnt(0)" ::: "memory");
  }
  __syncthreads();
}
DI int opaque_tid() { int t = threadIdx.x; asm volatile("" : "+v"(t)); return t; }
DI float4 ss_sum4(const float* base, int row0) {
  float4 a = *(const float4*)(base + row0);
#pragma unroll
  for (int pz = 1; pz < 8; pz++) {
    float4 b = *(const float4*)(base + (size_t)pz * NTOK + row0);
    a.x += b.x; a.y += b.y; a.z += b.z; a.w += b.w;
  }
  return a;
}
DI float ss_sum1(const float* base, int row) {
  float a = base[row];
#pragma unroll
  for (int pz = 1; pz < 8; pz++) a += base[(size_t)pz * NTOK + row];
  return a;
}
DI float wave_sum(float v) { for (int o = 32; o; o >>= 1) v += __shfl_xor(v, o); return v; }
DI float fast_exp2(float x) { return __builtin_amdgcn_exp2f(x); }
DI float gelu_tanh(float x) {
  float z = 0.7978845608028654f * (x + 0.044715f * x * x * x);
  float e = __expf(2.f * z);
  float t = 1.f - 2.f / (1.f + e);
  return 0.5f * x * (1.f + t);
}
DI float reduce_2pi(double a) {
  double n = rint(a * 0.15915494309189535);
  return (float)(a - n * 6.283185307179586);
}

DI void transpose_tile(const float* src, int ldsrc, int k0, int c0, const float* scale, int nscale,
                       bf16_t* dst, int lddst, int n0, float* lds, const int tid) {
#pragma unroll
  for (int i = 0; i < 16; i++) {
    int kk = i * 4 + (tid >> 6), nn = tid & 63;
    float v = src[(size_t)(k0 + kk) * ldsrc + c0 + nn];
    if (scale != nullptr && (k0 + kk) < nscale) v *= scale[k0 + kk];
    lds[kk * 65 + nn] = v;
  }
  __syncthreads();
  {
    int nn = tid >> 2, kq = (tid & 3) * 16;
    unsigned pk[8];
#pragma unroll
    for (int i = 0; i < 8; i++) pk[i] = pack_bf2(lds[(kq + 2 * i) * 65 + nn], lds[(kq + 2 * i + 1) * 65 + nn]);
    u32x4* d = (u32x4*)(dst + (size_t)(n0 + nn) * lddst + k0 + kq);
    u32x4 a = {pk[0], pk[1], pk[2], pk[3]}, b = {pk[4], pk[5], pk[6], pk[7]};
    d[0] = a; d[1] = b;
  }
  __syncthreads();
}

DI void wtask(const float* src, int ldsrc, int k0, int c0, const float* scale, int nscale, bf16_t* dst, int lddst, int n0, int lane) {
  float v[32];
  const float* sp = src + (size_t)k0 * ldsrc + c0 + lane;
#pragma unroll
  for (int i = 0; i < 32; i++) v[i] = sp[(size_t)i * ldsrc];
  if (k0 < nscale) {
#pragma unroll
    for (int i = 0; i < 32; i++) v[i] *= scale[k0 + i];
  }
  u32x4* d = (u32x4*)(dst + (size_t)(n0 + lane) * lddst + k0);
#pragma unroll
  for (int q = 0; q < 4; q++) {
    u32x4 o = {pack_bf2(v[8 * q], v[8 * q + 1]), pack_bf2(v[8 * q + 2], v[8 * q + 3]), pack_bf2(v[8 * q + 4], v[8 * q + 5]), pack_bf2(v[8 * q + 6], v[8 * q + 7])};
    d[q] = o;
  }
}

__device__ __forceinline__ void phase_prep(KP p, char* smem, const int tid) {
  const int nb = gridDim.x, bid = blockIdx.x;
  const int wave = tid >> 6, lane = tid & 63;
  for (int row = bid * 4 + wave; row < NTOK; row += nb * 4) {
    const float4* src = (const float4*)(p->x + (size_t)row * DM);
    float s = 0.f;
#pragma unroll
    for (int i = 0; i < 4; i++) {
      float4 v = src[lane + 64 * i];
      s += v.x * v.x + v.y * v.y + v.z * v.z + v.w * v.w;
      ((float4*)(p->xf + (size_t)row * DM))[lane + 64 * i] = v;
      u32x2 pk = {pack_bf2(v.x, v.y), pack_bf2(v.z, v.w)};
      ((u32x2*)(p->xb + (size_t)row * DM))[lane + 64 * i] = pk;
    }
    s = wave_sum(s);
    if (lane < 8) p->ss[(size_t)lane * NTOK + row] = (lane == 0) ? s : 0.f;
  }
  for (int i = bid * 256 + tid; i < NTOK * 8; i += nb * 256) {
    int tok = i >> 3, j = i & 7;
    double inv = (j & 4) ? ((j & 2) ? ((j & 1) ? 1.031338537721246e-05 : 5.318295896944988e-05) : ((j & 1) ? 0.0002742481756762073 : 0.001414213562373095))
                         : ((j & 2) ? ((j & 1) ? 0.007292664737217109 : 0.03760603093086393) : ((j & 1) ? 0.19392274474868576 : 1.0));
    double ang = (double)p->pos[tok] * inv;
    float r = reduce_2pi(ang);
    p->cs[2 * i] = cosf(r); p->cs[2 * i + 1] = sinf(r);
  }
  for (int i = bid * 256 + tid; i < 4 * 32 * 64; i += nb * 256) {
    int lg = i >> 6;
    float lr = p->lam_re[i], li = p->lam_im[i];
    float step = expf(p->log_step[lg]);
    float mag = expf(step * lr);
    double angd = (double)step * (double)li;
    float r1 = reduce_2pi(angd);
    float ar = mag * cosf(r1), ai = mag * sinf(r1);
    float den = lr * lr + li * li;
    float fr = ((ar - 1.f) * lr + ai * li) / den;
    float fi = (ai * lr - (ar - 1.f) * li) / den;
    float magT = expf(64.f * step * lr);
    float rT = reduce_2pi(64.0 * angd);
    float* tb = p->s5tab + (size_t)i * 40;
    tb[0] = ar; tb[1] = ai; tb[2] = magT * cosf(rT); tb[3] = magT * sinf(rT);
    for (int c = 0; c < 16; c++) {
      float br = p->b_re[(size_t)i * 16 + c], bi = p->b_im[(size_t)i * 16 + c];
      tb[4 + c] = fr * br - fi * bi;
      tb[20 + c] = fr * bi + fi * br;
    }
  }
  {
    const int NTASK = 4 * 6016;
    const int gw = bid * 4 + wave, nw = nb * 4;
    const int per = (NTASK + nw - 1) / nw;
    const int t_lo = gw * per, t_hi = min(t_lo + per, NTASK);
    for (int task = t_lo; task < t_hi; task++) {
      const int layer = task / 6016;
      int t = task % 6016;
      if (t < 1024) {
        const int a = t >> 5, kb = t & 31;
        wtask(p->w_in + (size_t)layer * 1024 * 2048, 2048, kb * 32, a * 64, p->norm_mix + layer * 1024, 1024,
              p->WinT + (size_t)layer * 2048 * 1024, 1024, a * 64, lane);
      } else if (t < 1280) {
        t -= 1024; const int a = t >> 4, kb = t & 15;
        wtask(p->w_glu + (size_t)layer * 512 * 1024, 1024, kb * 32, (a & 1) * 512 + (a >> 1) * 64, p->norm_mix, 0,
              p->WgluT + (size_t)layer * 1024 * 512, 512, a * 64, lane);
      } else if (t < 1792) {
        t -= 1280; const int a = t >> 5, kb = t & 31;
        wtask(p->w_out + (size_t)layer * 1024 * 1024, 1024, kb * 32, a * 64, p->ssm_norm + layer * 512, 512,
              p->WoutT + (size_t)layer * 1024 * 1024, 1024, a * 64, lane);
      } else if (t < 4608) {
        t -= 1792; const int a = t >> 5, kb = t & 31;
        wtask(p->w_up + (size_t)layer * 1024 * 5632, 5632, kb * 32, (a & 1) * FFN + (a >> 1) * 64, p->norm_ffn + layer * 1024, 1024,
              p->WupT + (size_t)layer * 5632 * 1024, 1024, a * 64, lane);
      } else {
        t -= 4608; const int a = t / 88, kb = t % 88;
        wtask(p->w_down + (size_t)layer * FFN * 1024, 1024, kb * 32, a * 64, p->norm_mix, 0,
              p->WdownT + (size_t)layer * 1024 * FFN, FFN, a * 64, lane);
      }
    }
  }
}

enum { G_IN = 0, G_GLU = 1, G_WOUT = 2, G_UP = 3, G_DOWN = 4 };
#define ACC_PIN(tag) _Pragma("unroll") for (int i_ = 0; i_ < 4; i_++) _Pragma("unroll") for (int j_ = 0; j_ < 4; j_++) asm volatile("; pin " tag : "+a"(acc[i_][j_]));


__device__ __forceinline__ void gemm_tile(KP p, const int MODE, int layer, int tile, char* smem, const int tid) {
  const int lane = tid & 63, w = tid >> 6, wm = w >> 1, wn = w & 1, g = lane >> 5, l32 = lane & 31;
  int tn, KT, ldb, rowbase, lda;
  const bf16_t* Bt;
  const bf16_t* A0;
  int upb = 0, upti = 0;
  {
    const int TM = (MODE == G_UP) ? 66 : 64;
    const int TN = (MODE == G_IN) ? 8 : (MODE == G_UP ? 22 : 4);
    const int nfull = TN >> 2, rem = TN & 3;
    int tm;
    if (tile < nfull * 4 * TM) { const int band = tile / (4 * TM), within = tile % (4 * TM); tm = within >> 2; tn = band * 4 + (within & 3); }
    else { const int s2 = tile - nfull * 4 * TM; tm = s2 / rem; tn = nfull * 4 + s2 % rem; }
    rowbase = tm * 256;
    if (MODE == G_UP) { upb = tm / 33; upti = tm % 33; rowbase = upb * SEQL + 254 * upti - 2; }
  }
  if (MODE == G_IN) { KT = 16; ldb = 1024; Bt = p->WinT + (size_t)layer * 2048 * 1024; A0 = p->xb; lda = 1024; }
  else if (MODE == G_GLU) { KT = 8; ldb = 512; Bt = p->WgluT + (size_t)layer * 1024 * 512; A0 = p->gy; lda = 512; }
  else if (MODE == G_WOUT) { KT = 16; ldb = 1024; Bt = p->WoutT + (size_t)layer * 1024 * 1024; A0 = p->outg; lda = 512; }
  else if (MODE == G_UP) { KT = 16; ldb = 1024; Bt = p->WupT + (size_t)layer * 5632 * 1024; A0 = p->xb; lda = 1024; }
  else { KT = 44; ldb = FFN; Bt = p->WdownT + (size_t)layer * 1024 * FFN; A0 = p->act; lda = FFN; }

  u32x4 ra[8], rb[8];
  const int lrow = tid >> 3, lc = tid & 7;
  float arow_sc[8];
#pragma unroll
  for (int i = 0; i < 8; i++) arow_sc[i] = 1.f;
  if (MODE == G_WOUT) {
    const float* ssq = p->ssm_ss + (size_t)layer * 8 * NTOK;
#pragma unroll
    for (int i = 0; i < 8; i++) arow_sc[i] = rsqrtf(ss_sum1(ssq, rowbase + lrow + 32 * i) * (1.f / 512.f) + EPS);
  }
  const bf16_t* bptr = Bt + (size_t)(tn * 256 + lrow) * ldb + lc * 8;
  auto gload = [&](int kt) {
    const bf16_t* abase = A0;
    int kofs = kt * 64;
    if (MODE == G_WOUT && kt >= 8) { abase = p->att; kofs = (kt - 8) * 64; }
#pragma unroll
    for (int i = 0; i < 8; i++) {
      int gr = min(max(rowbase + lrow + 32 * i, 0), NTOK - 1);
      ra[i] = *(const u32x4*)(abase + (size_t)gr * lda + kofs + lc * 8);
      rb[i] = *(const u32x4*)(bptr + (size_t)(32 * i) * ldb + kt * 64);
    }
  };
  auto scaleA = [&](int kt) {
    if (MODE == G_WOUT && kt < 8) {
#pragma unroll
      for (int i = 0; i < 8; i++)
#pragma unroll
        for (int e = 0; e < 4; e++) {
          unsigned v = ra[i][e];
          float lo = __uint_as_float(v << 16) * arow_sc[i], hi = __uint_as_float(v & 0xffff0000u) * arow_sc[i];
          ra[i][e] = pack_bf2(lo, hi);
        }
    }
  };
  const int wr_off = lrow * 128 + ((lc ^ ((lrow >> 1) & 7)) << 4);
  auto lwriteA = [&](int st) {
    char* sa = smem + st * 65536;
#pragma unroll
    for (int i = 0; i < 8; i++) *(u32x4*)(sa + wr_off + i * 4096) = ra[i];
  };
  auto lwriteB = [&](int st) {
    char* sb = smem + st * 65536 + 32768;
#pragma unroll
    for (int i = 0; i < 8; i++) *(u32x4*)(sb + wr_off + i * 4096) = rb[i];
  };

  f32x16 acc[4][4];
#pragma unroll
  for (int i = 0; i < 4; i++)
#pragma unroll
    for (int j = 0; j < 4; j++)
#pragma unroll
      for (int r = 0; r < 16; r++) acc[i][j][r] = 0.f;

  const int swz = (l32 >> 1) & 7;
  const int a_base = (wm * 128 + l32) * 128;
  const int b_base = 32768 + (wn * 128 + l32) * 128;
  bf16x8 af[2][4], bfr[2][4];
  auto lfrag = [&](int buf, const char* st, int ks) {
    const int coff = (((ks * 2 + g) ^ swz) << 4);
#pragma unroll
    for (int i = 0; i < 4; i++) af[buf][i] = *(const bf16x8*)(st + a_base + i * 4096 + coff);
#pragma unroll
    for (int j = 0; j < 4; j++) bfr[buf][j] = *(const bf16x8*)(st + b_base + j * 4096 + coff);
  };
  auto mfma16 = [&](int buf) {
#pragma unroll
    for (int i = 0; i < 4; i++)
#pragma unroll
      for (int j = 0; j < 4; j++) acc[i][j] = MFMA(af[buf][i], bfr[buf][j], acc[i][j]);
  };

  gload(0);
  scaleA(0);
  lwriteA(0);
  lwriteB(0);
  __syncthreads();
  if (KT > 1) gload(1);
  lfrag(0, smem, 0);
  for (int kt = 0; kt < KT; kt++) {
    const char* st = smem + (kt & 1) * 65536;
    const bool has1 = (kt + 1 < KT), has2 = (kt + 2 < KT);
    lfrag(1, st, 1);
    if (has1) { scaleA(kt + 1); lwriteA((kt + 1) & 1); }
    mfma16(0);
    __builtin_amdgcn_sched_barrier(0);
    lfrag(0, st, 2);
    if (has1) lwriteB((kt + 1) & 1);
    mfma16(1);
    __builtin_amdgcn_sched_barrier(0);
    lfrag(1, st, 3);
    if (has2) gload(kt + 2);
    mfma16(0);
    __builtin_amdgcn_sched_barrier(0);
    asm volatile("s_waitcnt lgkmcnt(0)" ::: "memory");
    __builtin_amdgcn_s_barrier();
    __builtin_amdgcn_sched_barrier(0);
    if (has1) lfrag(0, smem + ((kt + 1) & 1) * 65536, 0);
    mfma16(1);
    __builtin_amdgcn_sched_barrier(0);
  }

  int tid2 = tid;
  asm volatile("" : "+v"(tid2));
  {
  const int tid = tid2;
  const int lane = tid & 63, w = tid >> 6, wm = w >> 1, wn = w & 1, g = lane >> 5, l32 = lane & 31;
  if (MODE == G_IN) {
    const int region = tn >> 1;
    float* rs = (float*)(smem + 135168);
    rs[tid] = rsqrtf(ss_sum1(p->ss + (size_t)(2 * layer) * 8 * NTOK, rowbase + tid) * (1.f / 1024.f) + EPS);
    __syncthreads();
#pragma unroll
    for (int i = 0; i < 4; i++)
#pragma unroll
      for (int rq = 0; rq < 4; rq++) {
        const int lr0 = wm * 128 + i * 32 + rq * 8 + g * 4;
        const float4 s4 = *(const float4*)(rs + lr0);
        const float sc[4] = {s4.x, s4.y, s4.z, s4.w};
#pragma unroll
        for (int j = 0; j < 4; j++) {
          const int lcol = wn * 128 + j * 32 + l32;
          float v[4];
#pragma unroll
          for (int r4 = 0; r4 < 4; r4++) v[r4] = acc[i][j][rq * 4 + r4] * sc[r4];
          if (region == 3) {
            const int q4 = (lr0 >> 2) & 3;
            const int pq = ((q4 & 1) << 1) | (q4 >> 1);
            u32x2 pk = {pack_bf2(v[0], v[1]), pack_bf2(v[2], v[3])};
            *(u32x2*)(smem + lcol * 528 + ((lr0 & ~15) + pq * 4) * 2) = pk;
          } else {
            if (region != 0 && (j & 1) == 0) {
              float other[4];
#pragma unroll
              for (int r4 = 0; r4 < 4; r4++) other[r4] = __shfl_xor(v[r4], 8);
              if (l32 < 16) {
                const float sgn = (l32 < 8) ? -1.f : 1.f;
#pragma unroll
                for (int r4 = 0; r4 < 4; r4++) {
                  const float2 csv = *(const float2*)(p->cs + ((size_t)(rowbase + lr0 + r4) * 8 + (l32 & 7)) * 2);
                  v[r4] = v[r4] * csv.x + sgn * other[r4] * csv.y;
                }
              }
            }
#pragma unroll
            for (int r4 = 0; r4 < 4; r4++) *(bf16_t*)(smem + (lr0 + r4) * 528 + lcol * 2) = f2bf(v[r4]);
          }
        }
      }
    __syncthreads();
    {
      bf16_t* dbase;
      size_t rstride;
      if (region == 3) { dbase = p->vt + (size_t)((rowbase >> 13) * 512 + (tn & 1) * 256) * SEQL + (rowbase & (SEQL - 1)); rstride = SEQL; }
      else { dbase = (region == 0 ? p->u : (region == 1 ? p->q : p->k)) + (size_t)rowbase * 512 + (tn & 1) * 256; rstride = 512; }
#pragma unroll 8
      for (int it = 0; it < 32; it++) {
        const int id = tid + 256 * it, row = id >> 5, c = id & 31;
        const u32x4 vv = *(const u32x4*)(smem + row * 528 + c * 16);
        *(u32x4*)(dbase + (size_t)row * rstride + c * 8) = vv;
      }
    }
    __syncthreads();
  } else if (MODE == G_GLU) {
    float* ssq = p->ssm_ss + ((size_t)layer * 8 + tn * 2 + wn) * NTOK;
#pragma unroll
    for (int i = 0; i < 4; i++)
#pragma unroll
      for (int rq = 0; rq < 4; rq++) {
        const int row0 = rowbase + wm * 128 + i * 32 + rq * 8 + g * 4;
#pragma unroll
        for (int r4 = 0; r4 < 4; r4++) {
          float sq = 0.f;
#pragma unroll
          for (int j = 0; j < 2; j++) {
            float a = acc[i][j][rq * 4 + r4], b = acc[i][j + 2][rq * 4 + r4];
            float o = a / (1.f + __expf(-b));
            const int col = (tn * 2 + wn) * 64 + j * 32 + l32;
            p->outg[(size_t)(row0 + r4) * 512 + col] = f2bf(o);
            sq += o * o;
          }
#pragma unroll
          for (int o = 16; o; o >>= 1) sq += __shfl_xor(sq, o);
          if (l32 == 0) ssq[row0 + r4] = sq;
        }
      }
  } else if (MODE == G_WOUT || MODE == G_DOWN) {
    float* ssq = p->ss + ((size_t)(MODE == G_WOUT ? 2 * layer + 1 : 2 * layer + 2) * 8 + tn * 2 + wn) * NTOK;
#pragma unroll
    for (int i = 0; i < 4; i++)
#pragma unroll
      for (int rq = 0; rq < 4; rq++) {
        const int row0 = rowbase + wm * 128 + i * 32 + rq * 8 + g * 4;
#pragma unroll
        for (int r4 = 0; r4 < 4; r4++) {
          float sq = 0.f;
#pragma unroll
          for (int j = 0; j < 4; j++) {
            const int col = tn * 256 + wn * 128 + j * 32 + l32;
            const size_t idx = (size_t)(row0 + r4) * 1024 + col;
            float xn = p->xf[idx] + acc[i][j][rq * 4 + r4];
            p->xf[idx] = xn;
            p->xb[idx] = f2bf(xn);
            sq += xn * xn;
          }
#pragma unroll
          for (int o = 16; o; o >>= 1) sq += __shfl_xor(sq, o);
          if (l32 == 0) ssq[row0 + r4] = sq;
        }
      }
  } else {
#pragma unroll
    for (int i = 0; i < 4; i++)
#pragma unroll
      for (int rq = 0; rq < 4; rq++) {
        const int lr0 = wm * 128 + i * 32 + rq * 8 + g * 4;
#pragma unroll
        for (int j = 0; j < 4; j++) {
          const int pc = wn * 128 + j * 32 + l32;
          u32x2 pk = {pack_bf2(acc[i][j][rq * 4 + 0], acc[i][j][rq * 4 + 1]), pack_bf2(acc[i][j][rq * 4 + 2], acc[i][j][rq * 4 + 3])};
          *(u32x2*)(smem + pc * 528 + lr0 * 2) = pk;
        }
      }
    {
      float* rs = (float*)(smem + 135168);
      const int tb = 254 * upti - 2 + tid;
      float sc = 0.f;
      if (tb >= 0) {
        const int gr = min(upb * SEQL + tb, NTOK - 1);
        sc = rsqrtf(ss_sum1(p->ss + (size_t)(2 * layer + 1) * 8 * NTOK, gr) * (1.f / 1024.f) + EPS);
      }
      rs[tid] = sc;
    }
    __syncthreads();
    {
      const int cp = tid & 127, half = tid >> 7;
      const int pg = (cp >> 6) * 128 + (cp & 63), pv = pg + 64;
      const int ocol = tn * 128 + cp;
      const float* wc = p->w_conv + (size_t)layer * 3 * 5632;
      const float* bc = p->b_conv + (size_t)layer * 5632;
      const float wg0 = wc[ocol], wg1 = wc[5632 + ocol], wg2 = wc[2 * 5632 + ocol], bg = bc[ocol];
      const float wv0 = wc[FFN + ocol], wv1 = wc[5632 + FFN + ocol], wv2 = wc[2 * 5632 + FFN + ocol], bv = bc[FFN + ocol];
      const float* rs = (const float*)(smem + 135168);
      const char* gcol = smem + pg * 528;
      const char* vcol = smem + pv * 528;
      float g0 = 0.f, v0 = 0.f, g1 = 0.f, v1 = 0.f;
      if (half) {
        g0 = rs[126] * bf2f(*(const bf16_t*)(gcol + 126 * 2)); v0 = rs[126] * bf2f(*(const bf16_t*)(vcol + 126 * 2));
        g1 = rs[127] * bf2f(*(const bf16_t*)(gcol + 127 * 2)); v1 = rs[127] * bf2f(*(const bf16_t*)(vcol + 127 * 2));
      }
      for (int grp8 = 0; grp8 < 16; grp8++) {
        const int lrb = half * 128 + grp8 * 8;
        const u32x4 gq = *(const u32x4*)(gcol + lrb * 2);
        const u32x4 vq = *(const u32x4*)(vcol + lrb * 2);
        const float4 r0 = *(const float4*)(rs + lrb), r1 = *(const float4*)(rs + lrb + 4);
        const float rsv[8] = {r0.x, r0.y, r0.z, r0.w, r1.x, r1.y, r1.z, r1.w};
#pragma unroll
        for (int e = 0; e < 8; e++) {
          const unsigned gw = gq[e >> 1], vw = vq[e >> 1];
          const float g2 = rsv[e] * ((e & 1) ? __uint_as_float(gw & 0xffff0000u) : __uint_as_float(gw << 16));
          const float v2 = rsv[e] * ((e & 1) ? __uint_as_float(vw & 0xffff0000u) : __uint_as_float(vw << 16));
          const int lr = lrb + e;
          const int tb = 254 * upti - 2 + lr;
          if (lr >= 2 && tb < SEQL) {
            const float gate = bg + wg0 * g0 + wg1 * g1 + wg2 * g2;
            const float val = bv + wv0 * v0 + wv1 * v1 + wv2 * v2;
            const float o = gate / (1.f + __expf(-gate)) * val;
            p->act[(size_t)(upb * SEQL + tb) * FFN + ocol] = f2bf(o);
          }
          g0 = g1; v0 = v1; g1 = g2; v1 = v2;
        }
      }
    }
    __syncthreads();
  }
  }
}

__device__ __forceinline__ void attn_item(KP p, int layer, int b, int h, int qt, float lam, float outscale, char* smem, const int tid) {
  const int lane = tid & 63, w = tid >> 6, g = lane >> 5, l32 = lane & 31;
  const int tok_q = b * SEQL + qt * 128 + w * 32 + l32;
  {
    const int qrow = tid >> 4, qc = tid & 15;
#pragma unroll
    for (int i = 0; i < 8; i++) {
      const int row = qrow + 16 * i;
      u32x4 v = *(const u32x4*)(p->q + (size_t)(b * SEQL + qt * 128 + row) * 512 + h * 128 + qc * 8);
      *(u32x4*)(smem + 65536 + row * 256 + ((qc ^ (row & 15)) << 4)) = v;
    }
  }
  const int q_off = 65536 + (w * 32 + l32) * 256;
  const int q_swz = (l32 & 15);

  const int NT = 2 * qt + 2;
  const int nkt = 2 * qt + 1 + (w >> 1);
  f32x16 O[2][4];
#pragma unroll
  for (int c = 0; c < 2; c++)
#pragma unroll
    for (int dt = 0; dt < 4; dt++)
#pragma unroll
      for (int r = 0; r < 16; r++) O[c][dt][r] = 0.f;
  float mrun[2] = {-1e30f, -1e30f}, lrun[2] = {0.f, 0.f};
  const float c1 = 0.125f * 1.4426950408889634f;

  u32x4 rk[4], rv[4];
  const bf16_t* kbase = p->k + (size_t)(b * SEQL) * 512 + h * 128;
  const bf16_t* vbase = p->vt + (size_t)((b * 4 + h) * 128) * SEQL;
  const int kkey = tid >> 4, kc = tid & 15;
  const int vd = tid >> 3, vc = tid & 7;
  auto gload = [&](int kt) {
#pragma unroll
    for (int i = 0; i < 4; i++) {
      rk[i] = *(const u32x4*)(kbase + (size_t)(kt * 64 + kkey + 16 * i) * 512 + kc * 8);
      rv[i] = *(const u32x4*)(vbase + (size_t)(vd + 32 * i) * SEQL + kt * 64 + vc * 8);
    }
  };
  const int kw_off = kkey * 256 + ((kc ^ (kkey & 15)) << 4);
  const int vw_off = 16384 + vd * 128 + ((vc ^ ((vd >> 1) & 7)) << 4);
  auto lwrite = [&](int st) {
    char* s = smem + st * 32768;
#pragma unroll
    for (int i = 0; i < 4; i++) {
      *(u32x4*)(s + kw_off + i * 4096) = rk[i];
      *(u32x4*)(s + vw_off + i * 4096) = rv[i];
    }
  };

  gload(0);
  lwrite(0);
  __syncthreads();
  for (int kt = 0; kt < NT; kt++) {
    if (kt + 1 < NT) gload(kt + 1);
    if (kt < nkt) {
      const char* st = smem + (kt & 1) * 32768;
      bf16x8 pf[2][2][2];
      bf16x8 kf[8], qfr[4], vf[2][4];
      f32x16 S[1][2];
      auto loadkq = [&](int c) {
#pragma unroll
        for (int kb = 0; kb < 2; kb++)
#pragma unroll
          for (int ks = 0; ks < 4; ks++) {
            const int key = kb * 32 + l32, chunk = c * 8 + ks * 2 + g;
            kf[kb * 4 + ks] = *(const bf16x8*)(st + key * 256 + ((chunk ^ (key & 15)) << 4));
          }
#pragma unroll
        for (int ks = 0; ks < 4; ks++) qfr[ks] = *(const bf16x8*)(smem + q_off + (((c * 8 + ks * 2 + g) ^ q_swz) << 4));
      };
      auto qk = [&](int c) {
        f32x16 zero;
#pragma unroll
        for (int r = 0; r < 16; r++) zero[r] = 0.f;
#pragma unroll
        for (int kb = 0; kb < 2; kb++) {
          S[0][kb] = MFMA(kf[kb * 4], qfr[0], zero);
#pragma unroll
          for (int ks = 1; ks < 4; ks++) S[0][kb] = MFMA(kf[kb * 4 + ks], qfr[ks], S[0][kb]);
        }
      };
      auto loadv = [&](int bi) {
#pragma unroll
        for (int dt = 0; dt < 4; dt++) {
          const int d = dt * 32 + l32, chunk = bi * 2 + g;
          vf[bi & 1][dt] = *(const bf16x8*)(st + 16384 + d * 128 + ((chunk ^ ((d >> 1) & 7)) << 4));
        }
      };
      auto softmax = [&](int c) {
        float mx = S[0][0][0];
#pragma unroll
        for (int r = 1; r < 16; r++) mx = fmaxf(mx, S[0][0][r]);
#pragma unroll
        for (int r = 0; r < 16; r++) mx = fmaxf(mx, S[0][1][r]);
        {
          const unsigned mu = __float_as_uint(mx);
          auto sw = __builtin_amdgcn_permlane32_swap(mu, mu, false, false);
          mx = fmaxf(__uint_as_float(sw[0]), __uint_as_float(sw[1]));
        }
        const float mcand = fmaxf(mrun[c], mx * c1);
        if (__any(mcand - mrun[c] > 8.f)) {
          const float alpha = fast_exp2(mrun[c] - mcand);
          mrun[c] = mcand;
          lrun[c] *= alpha;
#pragma unroll
          for (int dt = 0; dt < 4; dt++)
#pragma unroll
            for (int r = 0; r < 16; r++) O[c][dt][r] *= alpha;
        }
        const float mref = mrun[c];
        const f2_t c1v = {c1, c1}, mrv = {-mref, -mref};
        f2_t psum2 = {0.f, 0.f};
#pragma unroll
        for (int kb = 0; kb < 2; kb++)
#pragma unroll
          for (int r = 0; r < 16; r += 2) {
            f2_t sv = {S[0][kb][r], S[0][kb][r + 1]};
            f2_t av = __builtin_elementwise_fma(sv, c1v, mrv);
            f2_t ev = {fast_exp2(av[0]), fast_exp2(av[1])};
            S[0][kb][r] = ev[0]; S[0][kb][r + 1] = ev[1];
            psum2 += ev;
          }
        lrun[c] += psum2[0] + psum2[1];
#pragma unroll
        for (int kb = 0; kb < 2; kb++)
#pragma unroll
          for (int m = 0; m < 2; m++) {
            u32x4 pk = {pack_bf2(S[0][kb][8 * m + 0], S[0][kb][8 * m + 1]), pack_bf2(S[0][kb][8 * m + 2], S[0][kb][8 * m + 3]),
                        pack_bf2(S[0][kb][8 * m + 4], S[0][kb][8 * m + 5]), pack_bf2(S[0][kb][8 * m + 6], S[0][kb][8 * m + 7])};
            pf[c][kb][m] = __builtin_bit_cast(bf16x8, pk);
          }
      };
      loadkq(0);
      __builtin_amdgcn_sched_barrier(0);
      qk(0);
      __builtin_amdgcn_sched_barrier(0);
      loadkq(1);
      __builtin_amdgcn_sched_barrier(0);
      softmax(0);
      __builtin_amdgcn_sched_barrier(0);
      qk(1);
      loadv(0);
      __builtin_amdgcn_sched_barrier(0);
      softmax(1);
      __builtin_amdgcn_sched_barrier(0);
#pragma unroll
      for (int bi = 0; bi < 4; bi++) {
        if (bi < 3) loadv(bi + 1);
#pragma unroll
        for (int dt = 0; dt < 4; dt++) {
          O[0][dt] = MFMA(vf[bi & 1][dt], pf[0][bi >> 1][bi & 1], O[0][dt]);
          O[1][dt] = MFMA(vf[bi & 1][dt], pf[1][bi >> 1][bi & 1], O[1][dt]);
        }
        __builtin_amdgcn_sched_barrier(0);
      }
    }
    if (kt + 1 < NT) lwrite((kt + 1) & 1);
    __syncthreads();
  }

  const float l1 = lrun[0] + __shfl_xor(lrun[0], 32);
  const float l2 = lrun[1] + __shfl_xor(lrun[1], 32);
  const float i1 = 1.f / l1, i2 = lam / l2;
  float ssq = 0.f;
#pragma unroll
  for (int dt = 0; dt < 4; dt++)
#pragma unroll
    for (int r = 0; r < 16; r++) {
      float o = O[0][dt][r] * i1 - O[1][dt][r] * i2;
      O[0][dt][r] = o;
      ssq += o * o;
    }
  ssq += __shfl_xor(ssq, 32);
  const float rstd = rsqrtf(ssq * (1.f / 128.f) + EPS) * outscale;
  const float* gsub = p->subln + layer * 128;
#pragma unroll
  for (int dt = 0; dt < 4; dt++)
#pragma unroll
    for (int rq = 0; rq < 4; rq++) {
      const int d0 = dt * 32 + rq * 8 + g * 4;
      float4 gg = *(const float4*)(gsub + d0);
      u32x2 pk = {pack_bf2(O[0][dt][rq * 4 + 0] * rstd * gg.x, O[0][dt][rq * 4 + 1] * rstd * gg.y),
                  pack_bf2(O[0][dt][rq * 4 + 2] * rstd * gg.z, O[0][dt][rq * 4 + 3] * rstd * gg.w)};
      *(u32x2*)(p->att + (size_t)tok_q * 512 + h * 128 + d0) = pk;
    }
}

DI void s5_store_u(const u32x4 a, const u32x4 bq, int lane, float* ul) {
  float4* d = (float4*)(ul + lane * 16);
  d[0] = make_float4(__uint_as_float(a[0] << 16), __uint_as_float(a[0] & 0xffff0000u), __uint_as_float(a[1] << 16), __uint_as_float(a[1] & 0xffff0000u));
  d[1] = make_float4(__uint_as_float(a[2] << 16), __uint_as_float(a[2] & 0xffff0000u), __uint_as_float(a[3] << 16), __uint_as_float(a[3] & 0xffff0000u));
  d[2] = make_float4(__uint_as_float(bq[0] << 16), __uint_as_float(bq[0] & 0xffff0000u), __uint_as_float(bq[1] << 16), __uint_as_float(bq[1] & 0xffff0000u));
  d[3] = make_float4(__uint_as_float(bq[2] << 16), __uint_as_float(bq[2] & 0xffff0000u), __uint_as_float(bq[3] << 16), __uint_as_float(bq[3] & 0xffff0000u));
}
DI void s5_load_u(KP p, int b, int g, int j, int lane, float* ul) {
  const u32x4* src = (const u32x4*)(p->u + (size_t)(b * SEQL + j * 64 + lane) * 512 + g * 16);
  const u32x4 a = src[0], bq = src[1];
  s5_store_u(a, bq, lane, ul);
}

DI float swap_half(float v, const int which) {
  const unsigned u = __float_as_uint(v);
  auto r = __builtin_amdgcn_permlane32_swap(u, u, false, false);
  return __uint_as_float(which ? r[1] : r[0]);
}

struct S5Coef { float arA, aiA, arB, aiB; };

template <bool STORE>
DI void s5_scan32(const float* ul_sub, const bf16x8 (&bfr)[4], const S5Coef& cf, float& xAr, float& xAi, float& xBr, float& xBi,
                  float* X, const int l32, const int grp) {
  bf16x8 af;
  {
    const float* us = ul_sub + l32 * 16 + grp * 8;
    float4 a = *(const float4*)us, bq = *(const float4*)(us + 4);
    u32x4 pk = {pack_bf2(a.x, a.y), pack_bf2(a.z, a.w), pack_bf2(bq.x, bq.y), pack_bf2(bq.z, bq.w)};
    af = __builtin_bit_cast(bf16x8, pk);
  }
  f32x16 zero;
#pragma unroll
  for (int r = 0; r < 16; r++) zero[r] = 0.f;
  const f32x16 bu0 = MFMA(af, bfr[0], zero), bu1 = MFMA(af, bfr[1], zero), bu2 = MFMA(af, bfr[2], zero), bu3 = MFMA(af, bfr[3], zero);
#pragma unroll
  for (int k = 0; k < 8; k++) {
    float sAr[4], sAi[4], sBr[4], sBi[4];
#pragma unroll
    for (int i = 0; i < 4; i++) {
      const int r = (k >> 1) * 4 + i;
      const float nAr = cf.arA * xAr - cf.aiA * xAi + bu0[r];
      const float nAi = cf.arA * xAi + cf.aiA * xAr + bu2[r];
      const float nBr = cf.arB * xBr - cf.aiB * xBi + bu1[r];
      const float nBi = cf.arB * xBi + cf.aiB * xBr + bu3[r];
      xAr = nAr; xAi = nAi; xBr = nBr; xBi = nBi;
      sAr[i] = nAr; sAi[i] = nAi; sBr[i] = nBr; sBi[i] = nBi;
    }
    if (STORE) {
      if (grp == (k & 1)) {
#pragma unroll
        for (int i = 0; i < 4; i++) {
          float* xr = X + (4 * k + i) * 132;
          xr[l32] = sAr[i]; xr[64 + l32] = sAi[i]; xr[32 + l32] = sBr[i]; xr[96 + l32] = sBi[i];
        }
      }
    }
    xAr = swap_half(xAr, k & 1); xAi = swap_half(xAi, k & 1);
    xBr = swap_half(xBr, k & 1); xBi = swap_half(xBi, k & 1);
  }
}

DI void s5_setup(KP p, int layer, int g, int l32, int grp, S5Coef& cf, bf16x8 (&bfr)[4]) {
  const float* t0 = p->s5tab + (size_t)((layer * 32 + g) * 64) * 40;
  cf.arA = t0[l32 * 40]; cf.aiA = t0[l32 * 40 + 1];
  cf.arB = t0[(32 + l32) * 40]; cf.aiB = t0[(32 + l32) * 40 + 1];
#pragma unroll
  for (int jt = 0; jt < 4; jt++) {
    const float* src = t0 + (l32 + 32 * (jt & 1)) * 40 + 4 + (jt >> 1) * 16 + grp * 8;
    float4 a = *(const float4*)src, bq = *(const float4*)(src + 4);
    u32x4 pk = {pack_bf2(a.x, a.y), pack_bf2(a.z, a.w), pack_bf2(bq.x, bq.y), pack_bf2(bq.z, bq.w)};
    bfr[jt] = __builtin_bit_cast(bf16x8, pk);
  }
}

__device__ __forceinline__ void s5_pass1(KP p, int layer, char* smem, const int tid) {
  const int lane = tid & 63, w = tid >> 6, l32 = lane & 31, grp = lane >> 5;
  float* ul = (float*)(smem + w * 4096);
  for (int wbase = blockIdx.x * 4; wbase < 1024; wbase += gridDim.x * 4) {
    const int wi = wbase + w;
    const int j0 = (wi & 15) * 8, g = (wi >> 4) & 31, b = wi >> 9;
    S5Coef cf; bf16x8 bfr[4];
    s5_setup(p, layer, g, l32, grp, cf, bfr);
    const u32x4* src = (const u32x4*)(p->u + (size_t)(b * SEQL + j0 * 64 + lane) * 512 + g * 16);
    u32x4 v0 = src[0], v1 = src[1];
    for (int jj = 0; jj < 8; jj++) {
      const int j = j0 + jj;
      s5_store_u(v0, v1, lane, ul);
      if (jj < 7) {
        const u32x4* nsrc = (const u32x4*)(p->u + (size_t)(b * SEQL + (j + 1) * 64 + lane) * 512 + g * 16);
        v0 = nsrc[0]; v1 = nsrc[1];
      }
      __syncthreads();
      float xAr = 0.f, xAi = 0.f, xBr = 0.f, xBi = 0.f;
      s5_scan32<false>(ul, bfr, cf, xAr, xAi, xBr, xBi, nullptr, l32, grp);
      s5_scan32<false>(ul + 32 * 16, bfr, cf, xAr, xAi, xBr, xBi, nullptr, l32, grp);
      float* so = p->sloc + (size_t)((b * 32 + g) * 128 + j) * 128;
      so[lane] = grp ? xBr : xAr; so[64 + lane] = grp ? xBi : xAi;
      __syncthreads();
    }
  }
}

__device__ __forceinline__ void s5_pass2(KP p, int layer, char* smem, const int tid) {
  const int lane = tid & 63, w = tid >> 6;
  float* ul = (float*)(smem + w * 21504);
  float* X = ul + 1024;
  const int l32 = lane & 31, grp = lane >> 5;
  for (int wbase = blockIdx.x * 4; wbase < 1024; wbase += gridDim.x * 4) {
   const int wi = wbase + w;
   const int j0 = (wi & 15) * 8, g = (wi >> 4) & 31, b = wi >> 9;
   S5Coef cf; bf16x8 bfr[4];
   s5_setup(p, layer, g, l32, grp, cf, bfr);
   bf16x8 cfr[8];
   {
     const int c = l32 & 15;
     const float* cr = p->c_re + (size_t)((layer * 32 + g) * 16 + c) * 64;
     const float* ci = p->c_im + (size_t)((layer * 32 + g) * 16 + c) * 64;
#pragma unroll
     for (int s8 = 0; s8 < 8; s8++) {
       const int k0 = (s8 & 3) * 16 + grp * 8;
       const float* src = (s8 < 4) ? (cr + k0) : (ci + k0);
       const float sg = (l32 < 16) ? ((s8 < 4) ? 1.f : -1.f) : 0.f;
       float4 a = *(const float4*)src, bq = *(const float4*)(src + 4);
       u32x4 pk = {pack_bf2(a.x * sg, a.y * sg), pack_bf2(a.z * sg, a.w * sg), pack_bf2(bq.x * sg, bq.y * sg), pack_bf2(bq.z * sg, bq.w * sg)};
       cfr[s8] = __builtin_bit_cast(bf16x8, pk);
     }
   }
   const float dd = p->ssm_d[(size_t)(layer * 32 + g) * 16 + (l32 & 15)];
   float xAr, xAi, xBr, xBi;
   {
     const float* tb = p->s5tab + (size_t)((layer * 32 + g) * 64 + lane) * 40;
     const float aTr = tb[2], aTi = tb[3];
     float xr = 0.f, xi = 0.f;
     const float* sl = p->sloc + (size_t)((b * 32 + g) * 128) * 128;
     for (int i0 = 0; i0 < j0; i0 += 8) {
       float sr[8], si[8];
#pragma unroll
       for (int q = 0; q < 8; q++) { sr[q] = sl[(i0 + q) * 128 + lane]; si[q] = sl[(i0 + q) * 128 + 64 + lane]; }
#pragma unroll
       for (int q = 0; q < 8; q++) {
         const float nr = aTr * xr - aTi * xi + sr[q];
         const float ni = aTr * xi + aTi * xr + si[q];
         xr = nr; xi = ni;
       }
     }
     xAr = swap_half(xr, 0); xBr = swap_half(xr, 1);
     xAi = swap_half(xi, 0); xBi = swap_half(xi, 1);
   }
   for (int jj = 0; jj < 8; jj++) {
    const int j = j0 + jj;
    s5_load_u(p, b, g, j, lane, ul);
    __syncthreads();
    for (int sub = 0; sub < 2; sub++) {
      s5_scan32<true>(ul + sub * 32 * 16, bfr, cf, xAr, xAi, xBr, xBi, X, l32, grp);
      __syncthreads();
      f32x16 yacc;
#pragma unroll
      for (int r = 0; r < 16; r++) yacc[r] = 0.f;
#pragma unroll
      for (int s8 = 0; s8 < 8; s8++) {
        const float* xs = X + l32 * 132 + ((s8 < 4) ? 0 : 64) + (s8 & 3) * 16 + grp * 8;
        float4 a = *(const float4*)xs, bq = *(const float4*)(xs + 4);
        u32x4 pk = {pack_bf2(a.x, a.y), pack_bf2(a.z, a.w), pack_bf2(bq.x, bq.y), pack_bf2(bq.z, bq.w)};
        yacc = MFMA(__builtin_bit_cast(bf16x8, pk), cfr[s8], yacc);
      }
      if (l32 < 16) {
#pragma unroll
        for (int r = 0; r < 16; r++) {
          const int tl = sub * 32 + (r >> 2) * 8 + grp * 4 + (r & 3);
          const float yv = yacc[r] + dd * ul[tl * 16 + l32];
          p->gy[(size_t)(b * SEQL + j * 64 + tl) * 512 + g * 16 + l32] = f2bf(gelu_tanh(yv));
        }
      }
      __syncthreads();
    }
   }
  }
}

__device__ __forceinline__ void phase_attn(KP p, int layer, char* smem, const int tid) {
  const int lane = tid & 63;
  const float s1 = wave_sum(p->lq1[layer * 64 + lane] * p->lk1[layer * 64 + lane]);
  const float s2 = wave_sum(p->lq2[layer * 64 + lane] * p->lk2[layer * 64 + lane]);
  const float lam_init = 0.8f - 0.6f * expf(-0.3f * (float)layer);
  const float lam = expf(s1) - expf(s2) + lam_init;
  for (int pb = blockIdx.x; pb < 256; pb += gridDim.x) {
    const int pi = (pb & 7) * 32 + (pb >> 3);
    const int b = pi >> 7, h = (pi >> 5) & 3, i = pi & 31;
    attn_item(p, layer, b, h, 63 - i, lam, 1.f - lam_init, smem, tid);
    attn_item(p, layer, b, h, i, lam, 1.f - lam_init, smem, tid);
  }
  s5_pass1(p, layer, smem, tid);
}

__device__ __forceinline__ void phase_final(KP p, const int tid) {
  const int wave = tid >> 6, lane = tid & 63;
  const float* ssq = p->ss + (size_t)8 * 8 * NTOK;
  for (int row = blockIdx.x * 4 + wave; row < NTOK; row += gridDim.x * 4) {
    const float rstd = rsqrtf(ss_sum1(ssq, row) * (1.f / 1024.f) + EPS);
#pragma unroll
    for (int i = 0; i < 4; i++) {
      float4 v = ((const float4*)(p->xf + (size_t)row * DM))[lane + 64 * i];
      float4 gq = ((const float4*)p->norm_final)[lane + 64 * i];
      float4 o = {v.x * rstd * gq.x, v.y * rstd * gq.y, v.z * rstd * gq.z, v.w * rstd * gq.w};
      ((float4*)(p->out + (size_t)row * DM))[lane + 64 * i] = o;
    }
  }
}

__device__ __forceinline__ void run_phase(KP p, int ph, char* smem) {
  const int tid = opaque_tid();
  if (ph == 0) { phase_prep(p, smem, tid); return; }
  if (ph == 29) { phase_final(p, tid); return; }
  const int layer = (ph - 1) / 7, k = (ph - 1) % 7;
  const int nb = gridDim.x, bid = blockIdx.x;
  if (k == 1) { phase_attn(p, layer, smem, tid); return; }
  if (k == 2) { s5_pass2(p, layer, smem, tid); return; }
  if (k == 0) { for (int r = 0; ; r++) { const int t = (r * 8 + (bid & 7)) * (nb >> 3) + (bid >> 3); if (r * nb >= 512) break; if (t < 512) gemm_tile(p, G_IN, layer, t, smem, tid); } }
  else if (k == 3) { for (int r = 0; ; r++) { const int t = (r * 8 + (bid & 7)) * (nb >> 3) + (bid >> 3); if (r * nb >= 256) break; if (t < 256) gemm_tile(p, G_GLU, layer, t, smem, tid); } }
  else if (k == 4) { for (int r = 0; ; r++) { const int t = (r * 8 + (bid & 7)) * (nb >> 3) + (bid >> 3); if (r * nb >= 256) break; if (t < 256) gemm_tile(p, G_WOUT, layer, t, smem, tid); } }
  else if (k == 5) { for (int r = 0; ; r++) { const int t = (r * 8 + (bid & 7)) * (nb >> 3) + (bid >> 3); if (r * nb >= 2 * 33 * 22) break; if (t < 2 * 33 * 22) gemm_tile(p, G_UP, layer, t, smem, tid); } }
  else { for (int r = 0; ; r++) { const int t = (r * 8 + (bid & 7)) * (nb >> 3) + (bid >> 3); if (r * nb >= 256) break; if (t < 256) gemm_tile(p, G_DOWN, layer, t, smem, tid); } }
}

#define PHASE_KERNEL(name, body)                                                      \
  __global__ void __launch_bounds__(256) name(Params p_unused) {                      \
    extern __shared__ __attribute__((aligned(16))) char smem[];                       \
    KP p = (KP)__builtin_amdgcn_kernarg_segment_ptr();                                \
    const int tid = threadIdx.x, nb = gridDim.x, bid = blockIdx.x;                    \
    const int layer = (int)p->phase_lo;                                               \
    (void)nb; (void)bid; (void)layer;                                                 \
    body                                                                              \
  }
PHASE_KERNEL(k_prep, phase_prep(p, smem, tid);)
PHASE_KERNEL(k_gin, for (int r = 0; ; r++) { const int t = (r * 8 + (bid & 7)) * (nb >> 3) + (bid >> 3); if (r * nb >= 512) break; if (t < 512) gemm_tile(p, G_IN, layer, t, smem, tid); })
PHASE_KERNEL(k_attn, phase_attn(p, layer, smem, tid);)
PHASE_KERNEL(k_s5p2, s5_pass2(p, layer, smem, tid);)
PHASE_KERNEL(k_glu, for (int r = 0; ; r++) { const int t = (r * 8 + (bid & 7)) * (nb >> 3) + (bid >> 3); if (r * nb >= 256) break; if (t < 256) gemm_tile(p, G_GLU, layer, t, smem, tid); })
PHASE_KERNEL(k_wout, for (int r = 0; ; r++) { const int t = (r * 8 + (bid & 7)) * (nb >> 3) + (bid >> 3); if (r * nb >= 256) break; if (t < 256) gemm_tile(p, G_WOUT, layer, t, smem, tid); })
PHASE_KERNEL(k_up, for (int r = 0; ; r++) { const int t = (r * 8 + (bid & 7)) * (nb >> 3) + (bid >> 3); if (r * nb >= 2 * 33 * 22) break; if (t < 2 * 33 * 22) gemm_tile(p, G_UP, layer, t, smem, tid); })
PHASE_KERNEL(k_down, for (int r = 0; ; r++) { const int t = (r * 8 + (bid & 7)) * (nb >> 3) + (bid >> 3); if (r * nb >= 256) break; if (t < 256) gemm_tile(p, G_DOWN, layer, t, smem, tid); })
PHASE_KERNEL(k_final, phase_final(p, tid);)

#if COOP
__global__ void __launch_bounds__(256) mega_kernel(Params p_unused) {
  extern __shared__ __attribute__((aligned(16))) char smem[];
  KP p0 = (KP)__builtin_amdgcn_kernarg_segment_ptr();
  const int ph_lo = (int)p0->phase_lo, ph_hi = (int)p0->phase_hi;
#if COOP
  if (ph_hi > 1000) cg::this_grid().sync();
#endif
  for (int ph = ph_lo; ph < ph_hi; ph++) {
    KP p = p0;
    asm volatile("" : "+s"(p));
#if TPROBE
    if (blockIdx.x == 0) p->ts[ph] = (long long)wall_clock64();
#endif
    run_phase(p, ph, smem);
#if COOP
    if (ph + 1 < ph_hi) grid_barrier(p->bar, (unsigned)(ph + 1 - ph_lo) * gridDim.x, opaque_tid());
#endif
  }
#if TPROBE
  grid_barrier(p0->bar, (unsigned)(ph_hi - ph_lo) * gridDim.x, opaque_tid());
  if (blockIdx.x == 0) {
    KP p = p0;
    long long tend = (long long)wall_clock64();
    float a = 0.f, b = 0.f;
    for (int ph = 0; ph < 30; ph++) {
      long long t0 = p->ts[ph], t1 = (ph == 29) ? tend : p->ts[ph + 1];
      int c = (ph == 0) ? 0 : (ph == 29 ? 8 : 1 + (ph - 1) % 7);
      float d = (float)(t1 - t0) * 0.01f;
      if (c == TP_A || TP_A == 9) a += d;
      if (c == TP_B || TP_B == 9) b += d;
    }
    const int t = opaque_tid();
    if (t <= 100) p->out[t] += (t == 0) ? a : b;
  }
#endif
}

#endif

extern "C" void kernel_launch(void* const* d_in, const int* in_sizes, int n_in, void* d_out, int out_size, void* d_ws,
                              size_t ws_size, hipStream_t stream) {
  static int grid_blocks = 0;
  if (!grid_blocks) {
    int dev = 0, cus = 0, per_cu = 0;
    (void)hipGetDevice(&dev);
    (void)hipDeviceGetAttribute(&cus, hipDeviceAttributeMultiprocessorCount, dev);
#if COOP
    (void)hipFuncSetAttribute((const void*)mega_kernel, hipFuncAttributeMaxDynamicSharedMemorySize, LDS_BYTES);
    (void)hipOccupancyMaxActiveBlocksPerMultiprocessor(&per_cu, (const void*)mega_kernel, 256, LDS_BYTES);
    if (per_cu < 1) { fprintf(stderr, "occupancy query returned %d\n", per_cu); per_cu = 1; }
#endif
    grid_blocks = cus;
    (void)hipGetLastError();
  }
  Params p{};
  p.x = (const float*)d_in[0]; p.pos = (const int*)d_in[1];
  p.norm_mix = (const float*)d_in[2]; p.w_in = (const float*)d_in[3];
  p.lam_re = (const float*)d_in[4]; p.lam_im = (const float*)d_in[5]; p.log_step = (const float*)d_in[6];
  p.b_re = (const float*)d_in[7]; p.b_im = (const float*)d_in[8]; p.c_re = (const float*)d_in[9]; p.c_im = (const float*)d_in[10];
  p.ssm_d = (const float*)d_in[11]; p.w_glu = (const float*)d_in[12]; p.ssm_norm = (const float*)d_in[13];
  p.lq1 = (const float*)d_in[14]; p.lk1 = (const float*)d_in[15]; p.lq2 = (const float*)d_in[16]; p.lk2 = (const float*)d_in[17];
  p.subln = (const float*)d_in[18]; p.w_out = (const float*)d_in[19]; p.norm_ffn = (const float*)d_in[20];
  p.w_up = (const float*)d_in[21]; p.w_conv = (const float*)d_in[22]; p.b_conv = (const float*)d_in[23];
  p.w_down = (const float*)d_in[24]; p.norm_final = (const float*)d_in[25];
  p.out = (float*)d_out;
  char* ws = (char*)d_ws;
  size_t off = 0;
  auto take = [&](size_t bytes) { char* r = ws + off; off += (bytes + 255) & ~(size_t)255; return r; };
  p.WinT = (bf16_t*)take((size_t)4 * 2048 * 1024 * 2);
  p.WgluT = (bf16_t*)take((size_t)4 * 1024 * 512 * 2);
  p.WoutT = (bf16_t*)take((size_t)4 * 1024 * 1024 * 2);
  p.WupT = (bf16_t*)take((size_t)4 * 5632 * 1024 * 2);
  p.WdownT = (bf16_t*)take((size_t)4 * 1024 * FFN * 2);
  p.xf = (float*)take((size_t)NTOK * DM * 4);
  p.xb = (bf16_t*)take((size_t)NTOK * DM * 2);
  p.ss = (float*)take((size_t)9 * 8 * NTOK * 4);
  p.ssm_ss = (float*)take((size_t)4 * 8 * NTOK * 4);
  p.cs = (float*)take((size_t)NTOK * 16 * 4);
  p.s5tab = (float*)take((size_t)4 * 32 * 64 * 40 * 4);
  p.sloc = (float*)take((size_t)2 * 32 * 128 * 128 * 4);
  p.ts = (long long*)take(256);
  p.bar = (unsigned*)take(256);
  char* region = take((size_t)134217728);
  p.u = (bf16_t*)region;
  p.q = (bf16_t*)(region + 33554432);
  p.k = p.q + (size_t)NTOK * 512;
  p.vt = p.k + (size_t)NTOK * 512;
  p.gy = p.vt + (size_t)NTOK * 512;
  p.outg = p.gy + (size_t)NTOK * 512;
  p.att = p.outg + (size_t)NTOK * 512;
  p.act = (bf16_t*)region;
  if (off > ws_size) { fprintf(stderr, "workspace too small: need %zu have %zu\n", off, ws_size); return; }
#if COOP
  p.phase_lo = 0; p.phase_hi = 30;
  if (hipMemsetAsync(p.bar, 0, 256, stream) != hipSuccess) fprintf(stderr, "barrier memset failed\n");
  void* args[] = {&p};
  hipError_t e = hipLaunchCooperativeKernel((const void*)mega_kernel, dim3(grid_blocks), dim3(256), args, LDS_BYTES, stream);
  if (e != hipSuccess) fprintf(stderr, "cooperative launch failed: %s (grid %d)\n", hipGetErrorString(e), grid_blocks);
#else
  typedef void (*kfn)(Params);
  const kfn seq[7] = {k_gin, k_attn, k_s5p2, k_glu, k_wout, k_up, k_down};
  static bool attr_done = false;
  if (!attr_done) {
    (void)hipFuncSetAttribute((const void*)k_prep, hipFuncAttributeMaxDynamicSharedMemorySize, LDS_BYTES);
    (void)hipFuncSetAttribute((const void*)k_final, hipFuncAttributeMaxDynamicSharedMemorySize, LDS_BYTES);
    for (int i = 0; i < 7; i++) (void)hipFuncSetAttribute((const void*)seq[i], hipFuncAttributeMaxDynamicSharedMemorySize, LDS_BYTES);
    attr_done = true;
  }
  p.phase_lo = 0; p.phase_hi = 0;
  hipLaunchKernelGGL(k_prep, dim3(grid_blocks), dim3(256), LDS_BYTES, stream, p);
  for (int layer = 0; layer < 4; layer++) {
    p.phase_lo = layer;
    for (int i = 0; i < 7; i++) hipLaunchKernelGGL(seq[i], dim3(grid_blocks), dim3(256), LDS_BYTES, stream, p);
  }
  hipLaunchKernelGGL(k_final, dim3(grid_blocks), dim3(256), LDS_BYTES, stream, p);
#endif
}
```

```cpp
#include <hip/hip_runtime.h>
#include <hip/hip_cooperative_groups.h>
#include <cstdio>
namespace cg = cooperative_groups;

#ifndef COOP
#define COOP 1
#endif
#ifndef TPROBE
#define TPROBE 0
#endif
#ifndef TP_A
#define TP_A 1
#endif
#ifndef TP_B
#define TP_B 2
#endif

typedef unsigned short bf16_t;
typedef __attribute__((ext_vector_type(8))) short bf16x8;
typedef __attribute__((ext_vector_type(16))) float f32x16;
typedef __attribute__((ext_vector_type(2))) __bf16 bf2_t;
typedef __attribute__((ext_vector_type(2))) float f2_t;
typedef __attribute__((ext_vector_type(4))) unsigned u32x4;
typedef __attribute__((ext_vector_type(2))) unsigned u32x2;

#define DI __device__ __forceinline__
#define MFMA(a, b, c) __builtin_amdgcn_mfma_f32_32x32x16_bf16((a), (b), (c), 0, 0, 0)

constexpr int NTOK = 16384, DM = 1024, SEQL = 8192, FFN = 2816;
constexpr int LDS_BYTES = 136208;
constexpr float EPS = 1e-6f;

struct Params {
  const float* x; const int* pos;
  const float *norm_mix, *w_in, *lam_re, *lam_im, *log_step, *b_re, *b_im, *c_re, *c_im, *ssm_d, *w_glu, *ssm_norm;
  const float *lq1, *lk1, *lq2, *lk2, *subln, *w_out, *norm_ffn, *w_up, *w_conv, *b_conv, *w_down, *norm_final;
  float* out;
  bf16_t *WinT, *WgluT, *WoutT, *WupT, *WdownT;
  float* xf; bf16_t* xb;
  bf16_t *u, *q, *k, *vt, *gy, *outg, *att, *act;
  float *ss, *ssm_ss, *cs, *s5tab, *sloc;
  long long phase_lo, phase_hi;
  long long* ts;
  unsigned* bar;
};

typedef const __attribute__((address_space(4))) Params* KP;

DI unsigned pack_bf2(float a, float b) { f2_t v = {a, b}; return __builtin_bit_cast(unsigned, __builtin_convertvector(v, bf2_t)); }
DI bf16_t f2bf(float a) { return (bf16_t)(pack_bf2(a, 0.f) & 0xffffu); }
DI float bf2f(bf16_t v) { return __uint_as_float(((unsigned)v) << 16); }
DI void grid_barrier(unsigned* ctr, unsigned target, int tid) {
  asm volatile("s_waitcnt vmcnt(0)" ::: "memory");
  __syncthreads();
  if (tid == 0) {
    __builtin_amdgcn_fence(__ATOMIC_RELEASE, "agent");
    asm volatile("s_waitcnt vmcnt(0)" ::: "memory");
    __hip_atomic_fetch_add(ctr, 1u, __ATOMIC_RELAXED, __HIP_MEMORY_SCOPE_AGENT);
    while (__hip_atomic_load(ctr, __ATOMIC_RELAXED, __HIP_MEMORY_SCOPE_AGENT) < target) __builtin_amdgcn_s_sleep(1);
    __builtin_amdgcn_fence(__ATOMIC_ACQUIRE, "agent");
    asm volatile("s_waitcnt vmcnt(0)" ::: "memory");
  }
  __syncthreads();
}
#define XB_CNT(j)  (64 + 64 * (j))
#define XB_SUB(j)  (1088 + 64 * (j))
#define XB_GEN(j)  (2112 + 64 * (j))
#define XB_TOP     3136
#define XB_TOPGEN  3200
#define XB_WORDS   3264
DI unsigned xb_ld(unsigned* q) { return __hip_atomic_load(q, __ATOMIC_RELAXED, __HIP_MEMORY_SCOPE_AGENT); }
DI unsigned xb_add(unsigned* q, unsigned v) { return __hip_atomic_fetch_add(q, v, __ATOMIC_RELAXED, __HIP_MEMORY_SCOPE_AGENT); }
DI unsigned xb_xcc_id() { return (unsigned)__builtin_amdgcn_s_getreg((3 << 11) | 20) & 0xFu; }
DI void xcd_barrier(unsigned* bar, volatile unsigned* st, int tid) {
  asm volatile("s_waitcnt vmcnt(0)" ::: "memory");
  __syncthreads();
  if (tid == 0) {
    const unsigned x = xb_xcc_id();
    unsigned nloc = st[0], nx = st[1];
    if (nloc == 0u) {
      unsigned cnt = 0u, mine = 1u;
#pragma unroll
      for (unsigned j = 0; j < 16; ++j) { const unsigned c = xb_ld(&bar[XB_CNT(j)]); cnt += (c > 0u) ? 1u : 0u; mine = (j == x) ? c : mine; }
      nloc = mine > 0u ? mine : 1u; nx = cnt > 0u ? cnt : 1u;
      st[0] = nloc; st[1] = nx;
    }
    const unsigned old = xb_add(&bar[XB_SUB(x)], 1u);
    const unsigned gen = old / nloc;
    if (old + 1u == (gen + 1u) * nloc) {
      __builtin_amdgcn_fence(__ATOMIC_RELEASE, "agent");
      asm volatile("s_waitcnt vmcnt(0)" ::: "memory");
      const unsigned og = xb_add(&bar[XB_TOP], 1u);
      const unsigned tg = og / nx;
      if (og + 1u == (tg + 1u) * nx) xb_add(&bar[XB_TOPGEN], 1u);
      else { while (xb_ld(&bar[XB_TOPGEN]) == tg) __builtin_amdgcn_s_sleep(1); }
      __builtin_amdgcn_fence(__ATOMIC_ACQUIRE, "agent");
      xb_add(&bar[XB_GEN(x)], 1u);
      asm volatile("s_waitcnt vmcnt(0)" ::: "memory");
    } else {
      while (xb_ld(&bar[XB_GEN(x)]) == gen) __builtin_amdgcn_s_sleep(1);
      __builtin_amdgcn_fence(__ATOMIC_ACQUIRE, "agent");
      asm volatile("s_waitcnt vmcnt(0)" ::: "memory");
    }
  }
  __syncthreads();
}
DI int opaque_tid() { int t = threadIdx.x; asm volatile("" : "+v"(t)); return t; }
DI float4 ss_sum4(const float* base, int row0) {
  float4 a = *(const float4*)(base + row0);
#pragma unroll
  for (int pz = 1; pz < 8; pz++) {
    float4 b = *(const float4*)(base + (size_t)pz * NTOK + row0);
    a.x += b.x; a.y += b.y; a.z += b.z; a.w += b.w;
  }
  return a;
}
DI float ss_sum1(const float* base, int row) {
  float a = base[row];
#pragma unroll
  for (int pz = 1; pz < 8; pz++) a += base[(size_t)pz * NTOK + row];
  return a;
}
DI float wave_sum(float v) { for (int o = 32; o; o >>= 1) v += __shfl_xor(v, o); return v; }
DI float fast_exp2(float x) { return __builtin_amdgcn_exp2f(x); }
DI float gelu_tanh(float x) {
  float z = 0.7978845608028654f * (x + 0.044715f * x * x * x);
  float e = __expf(2.f * z);
  float t = 1.f - 2.f / (1.f + e);
  return 0.5f * x * (1.f + t);
}
DI float reduce_2pi(double a) {
  double n = rint(a * 0.15915494309189535);
  return (float)(a - n * 6.283185307179586);
}

DI void transpose_tile(const float* src, int ldsrc, int k0, int c0, const float* scale, int nscale,
                       bf16_t* dst, int lddst, int n0, float* lds, const int tid) {
#pragma unroll
  for (int i = 0; i < 16; i++) {
    int kk = i * 4 + (tid >> 6), nn = tid & 63;
    float v = src[(size_t)(k0 + kk) * ldsrc + c0 + nn];
    if (scale != nullptr && (k0 + kk) < nscale) v *= scale[k0 + kk];
    lds[kk * 65 + nn] = v;
  }
  __syncthreads();
  {
    int nn = tid >> 2, kq = (tid & 3) * 16;
    unsigned pk[8];
#pragma unroll
    for (int i = 0; i < 8; i++) pk[i] = pack_bf2(lds[(kq + 2 * i) * 65 + nn], lds[(kq + 2 * i + 1) * 65 + nn]);
    u32x4* d = (u32x4*)(dst + (size_t)(n0 + nn) * lddst + k0 + kq);
    u32x4 a = {pk[0], pk[1], pk[2], pk[3]}, b = {pk[4], pk[5], pk[6], pk[7]};
    d[0] = a; d[1] = b;
  }
  __syncthreads();
}

DI void wtask(const float* src, int ldsrc, int k0, int c0, const float* scale, int nscale, bf16_t* dst, int lddst, int n0, int lane) {
  float v[32];
  const float* sp = src + (size_t)k0 * ldsrc + c0 + lane;
#pragma unroll
  for (int i = 0; i < 32; i++) v[i] = sp[(size_t)i * ldsrc];
  if (k0 < nscale) {
#pragma unroll
    for (int i = 0; i < 32; i++) v[i] *= scale[k0 + i];
  }
  u32x4* d = (u32x4*)(dst + (size_t)(n0 + lane) * lddst + k0);
#pragma unroll
  for (int q = 0; q < 4; q++) {
    u32x4 o = {pack_bf2(v[8 * q], v[8 * q + 1]), pack_bf2(v[8 * q + 2], v[8 * q + 3]), pack_bf2(v[8 * q + 4], v[8 * q + 5]), pack_bf2(v[8 * q + 6], v[8 * q + 7])};
    d[q] = o;
  }
}

__device__ __forceinline__ void phase_prep(KP p, char* smem, const int tid) {
  const int nb = gridDim.x, bid = blockIdx.x;
  const int wave = tid >> 6, lane = tid & 63;
  for (int row = bid * 4 + wave; row < NTOK; row += nb * 4) {
    const float4* src = (const float4*)(p->x + (size_t)row * DM);
    float s = 0.f;
#pragma unroll
    for (int i = 0; i < 4; i++) {
      float4 v = src[lane + 64 * i];
      s += v.x * v.x + v.y * v.y + v.z * v.z + v.w * v.w;
      ((float4*)(p->xf + (size_t)row * DM))[lane + 64 * i] = v;
      u32x2 pk = {pack_bf2(v.x, v.y), pack_bf2(v.z, v.w)};
      ((u32x2*)(p->xb + (size_t)row * DM))[lane + 64 * i] = pk;
    }
    s = wave_sum(s);
    if (lane < 8) p->ss[(size_t)lane * NTOK + row] = (lane == 0) ? s : 0.f;
  }
  for (int i = bid * 256 + tid; i < NTOK * 8; i += nb * 256) {
    int tok = i >> 3, j = i & 7;
    double inv = (j & 4) ? ((j & 2) ? ((j & 1) ? 1.031338537721246e-05 : 5.318295896944988e-05) : ((j & 1) ? 0.0002742481756762073 : 0.001414213562373095))
                         : ((j & 2) ? ((j & 1) ? 0.007292664737217109 : 0.03760603093086393) : ((j & 1) ? 0.19392274474868576 : 1.0));
    double ang = (double)p->pos[tok] * inv;
    float r = reduce_2pi(ang);
    p->cs[2 * i] = cosf(r); p->cs[2 * i + 1] = sinf(r);
  }
  for (int i = bid * 256 + tid; i < 4 * 32 * 64; i += nb * 256) {
    int lg = i >> 6;
    float lr = p->lam_re[i], li = p->lam_im[i];
    float step = expf(p->log_step[lg]);
    float mag = expf(step * lr);
    double angd = (double)step * (double)li;
    float r1 = reduce_2pi(angd);
    float ar = mag * cosf(r1), ai = mag * sinf(r1);
    float den = lr * lr + li * li;
    float fr = ((ar - 1.f) * lr + ai * li) / den;
    float fi = (ai * lr - (ar - 1.f) * li) / den;
    float magT = expf(64.f * step * lr);
    float rT = reduce_2pi(64.0 * angd);
    float* tb = p->s5tab + (size_t)i * 40;
    tb[0] = ar; tb[1] = ai; tb[2] = magT * cosf(rT); tb[3] = magT * sinf(rT);
    for (int c = 0; c < 16; c++) {
      float br = p->b_re[(size_t)i * 16 + c], bi = p->b_im[(size_t)i * 16 + c];
      tb[4 + c] = fr * br - fi * bi;
      tb[20 + c] = fr * bi + fi * br;
    }
  }
  {
    const int NTASK = 4 * 6016;
    const int gw = bid * 4 + wave, nw = nb * 4;
    const int per = (NTASK + nw - 1) / nw;
    const int t_lo = gw * per, t_hi = min(t_lo + per, NTASK);
    for (int task = t_lo; task < t_hi; task++) {
      const int layer = task / 6016;
      int t = task % 6016;
      if (t < 1024) {
        const int a = t >> 5, kb = t & 31;
        wtask(p->w_in + (size_t)layer * 1024 * 2048, 2048, kb * 32, a * 64, p->norm_mix + layer * 1024, 1024,
              p->WinT + (size_t)layer * 2048 * 1024, 1024, a * 64, lane);
      } else if (t < 1280) {
        t -= 1024; const int a = t >> 4, kb = t & 15;
        wtask(p->w_glu + (size_t)layer * 512 * 1024, 1024, kb * 32, (a & 1) * 512 + (a >> 1) * 64, p->norm_mix, 0,
              p->WgluT + (size_t)layer * 1024 * 512, 512, a * 64, lane);
      } else if (t < 1792) {
        t -= 1280; const int a = t >> 5, kb = t & 31;
        wtask(p->w_out + (size_t)layer * 1024 * 1024, 1024, kb * 32, a * 64, p->ssm_norm + layer * 512, 512,
              p->WoutT + (size_t)layer * 1024 * 1024, 1024, a * 64, lane);
      } else if (t < 4608) {
        t -= 1792; const int a = t >> 5, kb = t & 31;
        wtask(p->w_up + (size_t)layer * 1024 * 5632, 5632, kb * 32, (a & 1) * FFN + (a >> 1) * 64, p->norm_ffn + layer * 1024, 1024,
              p->WupT + (size_t)layer * 5632 * 1024, 1024, a * 64, lane);
      } else {
        t -= 4608; const int a = t / 88, kb = t % 88;
        wtask(p->w_down + (size_t)layer * FFN * 1024, 1024, kb * 32, a * 64, p->norm_mix, 0,
              p->WdownT + (size_t)layer * 1024 * FFN, FFN, a * 64, lane);
      }
    }
  }
}

enum { G_IN = 0, G_GLU = 1, G_WOUT = 2, G_UP = 3, G_DOWN = 4 };
#define ACC_PIN(tag) _Pragma("unroll") for (int i_ = 0; i_ < 4; i_++) _Pragma("unroll") for (int j_ = 0; j_ < 4; j_++) asm volatile("; pin " tag : "+a"(acc[i_][j_]));


__device__ __forceinline__ void gemm_tile(KP p, const int MODE, int layer, int tile, char* smem, const int tid) {
  const int lane = tid & 63, w = tid >> 6, wm = w >> 1, wn = w & 1, g = lane >> 5, l32 = lane & 31;
  int tn, KT, ldb, rowbase, lda;
  const bf16_t* Bt;
  const bf16_t* A0;
  int upb = 0, upti = 0;
  {
    const int TM = (MODE == G_UP) ? 66 : 64;
    const int TN = (MODE == G_IN) ? 8 : (MODE == G_UP ? 22 : 4);
    const int nfull = TN >> 2, rem = TN & 3;
    int tm;
    if (tile < nfull * 4 * TM) { const int band = tile / (4 * TM), within = tile % (4 * TM); tm = within >> 2; tn = band * 4 + (within & 3); }
    else { const int s2 = tile - nfull * 4 * TM; tm = s2 / rem; tn = nfull * 4 + s2 % rem; }
    rowbase = tm * 256;
    if (MODE == G_UP) { upb = tm / 33; upti = tm % 33; rowbase = upb * SEQL + 254 * upti - 2; }
  }
  if (MODE == G_IN) { KT = 16; ldb = 1024; Bt = p->WinT + (size_t)layer * 2048 * 1024; A0 = p->xb; lda = 1024; }
  else if (MODE == G_GLU) { KT = 8; ldb = 512; Bt = p->WgluT + (size_t)layer * 1024 * 512; A0 = p->gy; lda = 512; }
  else if (MODE == G_WOUT) { KT = 16; ldb = 1024; Bt = p->WoutT + (size_t)layer * 1024 * 1024; A0 = p->outg; lda = 512; }
  else if (MODE == G_UP) { KT = 16; ldb = 1024; Bt = p->WupT + (size_t)layer * 5632 * 1024; A0 = p->xb; lda = 1024; }
  else { KT = 44; ldb = FFN; Bt = p->WdownT + (size_t)layer * 1024 * FFN; A0 = p->act; lda = FFN; }

  u32x4 ra[8], rb[8];
  const int lrow = tid >> 3, lc = tid & 7;
  float arow_sc[8];
#pragma unroll
  for (int i = 0; i < 8; i++) arow_sc[i] = 1.f;
  if (MODE == G_WOUT) {
    const float* ssq = p->ssm_ss + (size_t)layer * 8 * NTOK;
#pragma unroll
    for (int i = 0; i < 8; i++) arow_sc[i] = rsqrtf(ss_sum1(ssq, rowbase + lrow + 32 * i) * (1.f / 512.f) + EPS);
  }
  const bf16_t* bptr = Bt + (size_t)(tn * 256 + lrow) * ldb + lc * 8;
  auto gload = [&](int kt) {
    const bf16_t* abase = A0;
    int kofs = kt * 64;
    if (MODE == G_WOUT && kt >= 8) { abase = p->att; kofs = (kt - 8) * 64; }
#pragma unroll
    for (int i = 0; i < 8; i++) {
      int gr = min(max(rowbase + lrow + 32 * i, 0), NTOK - 1);
      ra[i] = *(const u32x4*)(abase + (size_t)gr * lda + kofs + lc * 8);
      rb[i] = *(const u32x4*)(bptr + (size_t)(32 * i) * ldb + kt * 64);
    }
  };
  auto scaleA = [&](int kt) {
    if (MODE == G_WOUT && kt < 8) {
#pragma unroll
      for (int i = 0; i < 8; i++)
#pragma unroll
        for (int e = 0; e < 4; e++) {
          unsigned v = ra[i][e];
          float lo = __uint_as_float(v << 16) * arow_sc[i], hi = __uint_as_float(v & 0xffff0000u) * arow_sc[i];
          ra[i][e] = pack_bf2(lo, hi);
        }
    }
  };
  const int wr_off = lrow * 128 + ((lc ^ ((lrow >> 1) & 7)) << 4);
  auto lwriteA = [&](int st) {
    char* sa = smem + st * 65536;
#pragma unroll
    for (int i = 0; i < 8; i++) *(u32x4*)(sa + wr_off + i * 4096) = ra[i];
  };
  auto lwriteB = [&](int st) {
    char* sb = smem + st * 65536 + 32768;
#pragma unroll
    for (int i = 0; i < 8; i++) *(u32x4*)(sb + wr_off + i * 4096) = rb[i];
  };

  f32x16 acc[4][4];
#pragma unroll
  for (int i = 0; i < 4; i++)
#pragma unroll
    for (int j = 0; j < 4; j++)
#pragma unroll
      for (int r = 0; r < 16; r++) acc[i][j][r] = 0.f;

  const int swz = (l32 >> 1) & 7;
  const int a_base = (wm * 128 + l32) * 128;
  const int b_base = 32768 + (wn * 128 + l32) * 128;
  bf16x8 af[2][4], bfr[2][4];
  auto lfrag = [&](int buf, const char* st, int ks) {
    const int coff = (((ks * 2 + g) ^ swz) << 4);
#pragma unroll
    for (int i = 0; i < 4; i++) af[buf][i] = *(const bf16x8*)(st + a_base + i * 4096 + coff);
#pragma unroll
    for (int j = 0; j < 4; j++) bfr[buf][j] = *(const bf16x8*)(st + b_base + j * 4096 + coff);
  };
  auto mfma16 = [&](int buf) {
#pragma unroll
    for (int i = 0; i < 4; i++)
#pragma unroll
      for (int j = 0; j < 4; j++) acc[i][j] = MFMA(af[buf][i], bfr[buf][j], acc[i][j]);
  };

  gload(0);
  scaleA(0);
  lwriteA(0);
  lwriteB(0);
  __syncthreads();
  if (KT > 1) gload(1);
  lfrag(0, smem, 0);
  for (int kt = 0; kt < KT; kt++) {
    const char* st = smem + (kt & 1) * 65536;
    const bool has1 = (kt + 1 < KT), has2 = (kt + 2 < KT);
    lfrag(1, st, 1);
    if (has1) { scaleA(kt + 1); lwriteA((kt + 1) & 1); }
    mfma16(0);
    __builtin_amdgcn_sched_barrier(0);
    lfrag(0, st, 2);
    if (has1) lwriteB((kt + 1) & 1);
    mfma16(1);
    __builtin_amdgcn_sched_barrier(0);
    lfrag(1, st, 3);
    if (has2) gload(kt + 2);
    mfma16(0);
    __builtin_amdgcn_sched_barrier(0);
    asm volatile("s_waitcnt lgkmcnt(0)" ::: "memory");
    __builtin_amdgcn_s_barrier();
    __builtin_amdgcn_sched_barrier(0);
    if (has1) lfrag(0, smem + ((kt + 1) & 1) * 65536, 0);
    mfma16(1);
    __builtin_amdgcn_sched_barrier(0);
  }

  int tid2 = tid;
  asm volatile("" : "+v"(tid2));
  {
  const int tid = tid2;
  const int lane = tid & 63, w = tid >> 6, wm = w >> 1, wn = w & 1, g = lane >> 5, l32 = lane & 31;
  if (MODE == G_IN) {
    const int region = tn >> 1;
    float* rs = (float*)(smem + 135168);
    rs[tid] = rsqrtf(ss_sum1(p->ss + (size_t)(2 * layer) * 8 * NTOK, rowbase + tid) * (1.f / 1024.f) + EPS);
    __syncthreads();
#pragma unroll
    for (int i = 0; i < 4; i++)
#pragma unroll
      for (int rq = 0; rq < 4; rq++) {
        const int lr0 = wm * 128 + i * 32 + rq * 8 + g * 4;
        const float4 s4 = *(const float4*)(rs + lr0);
        const float sc[4] = {s4.x, s4.y, s4.z, s4.w};
#pragma unroll
        for (int j = 0; j < 4; j++) {
          const int lcol = wn * 128 + j * 32 + l32;
          float v[4];
#pragma unroll
          for (int r4 = 0; r4 < 4; r4++) v[r4] = acc[i][j][rq * 4 + r4] * sc[r4];
          if (region == 3) {
            const int q4 = (lr0 >> 2) & 3;
            const int pq = ((q4 & 1) << 1) | (q4 >> 1);
            u32x2 pk = {pack_bf2(v[0], v[1]), pack_bf2(v[2], v[3])};
            *(u32x2*)(smem + lcol * 528 + ((lr0 & ~15) + pq * 4) * 2) = pk;
          } else {
            if (region != 0 && (j & 1) == 0) {
              float other[4];
#pragma unroll
              for (int r4 = 0; r4 < 4; r4++) other[r4] = __shfl_xor(v[r4], 8);
              if (l32 < 16) {
                const float sgn = (l32 < 8) ? -1.f : 1.f;
#pragma unroll
                for (int r4 = 0; r4 < 4; r4++) {
                  const float2 csv = *(const float2*)(p->cs + ((size_t)(rowbase + lr0 + r4) * 8 + (l32 & 7)) * 2);
                  v[r4] = v[r4] * csv.x + sgn * other[r4] * csv.y;
                }
              }
            }
#pragma unroll
            for (int r4 = 0; r4 < 4; r4++) *(bf16_t*)(smem + (lr0 + r4) * 528 + lcol * 2) = f2bf(v[r4]);
          }
        }
      }
    __syncthreads();
    {
      bf16_t* dbase;
      size_t rstride;
      if (region == 3) { dbase = p->vt + (size_t)((rowbase >> 13) * 512 + (tn & 1) * 256) * SEQL + (rowbase & (SEQL - 1)); rstride = SEQL; }
      else { dbase = (region == 0 ? p->u : (region == 1 ? p->q : p->k)) + (size_t)rowbase * 512 + (tn & 1) * 256; rstride = 512; }
#pragma unroll 8
      for (int it = 0; it < 32; it++) {
        const int id = tid + 256 * it, row = id >> 5, c = id & 31;
        const u32x4 vv = *(const u32x4*)(smem + row * 528 + c * 16);
        *(u32x4*)(dbase + (size_t)row * rstride + c * 8) = vv;
      }
    }
    __syncthreads();
  } else if (MODE == G_GLU) {
    float* ssq = p->ssm_ss + ((size_t)layer * 8 + tn * 2 + wn) * NTOK;
#pragma unroll
    for (int i = 0; i < 4; i++)
#pragma unroll
      for (int rq = 0; rq < 4; rq++) {
        const int row0 = rowbase + wm * 128 + i * 32 + rq * 8 + g * 4;
#pragma unroll
        for (int r4 = 0; r4 < 4; r4++) {
          float sq = 0.f;
#pragma unroll
          for (int j = 0; j < 2; j++) {
            float a = acc[i][j][rq * 4 + r4], b = acc[i][j + 2][rq * 4 + r4];
            float o = a / (1.f + __expf(-b));
            const int col = (tn * 2 + wn) * 64 + j * 32 + l32;
            p->outg[(size_t)(row0 + r4) * 512 + col] = f2bf(o);
            sq += o * o;
          }
#pragma unroll
          for (int o = 16; o; o >>= 1) sq += __shfl_xor(sq, o);
          if (l32 == 0) ssq[row0 + r4] = sq;
        }
      }
  } else if (MODE == G_WOUT || MODE == G_DOWN) {
    float* ssq = p->ss + ((size_t)(MODE == G_WOUT ? 2 * layer + 1 : 2 * layer + 2) * 8 + tn * 2 + wn) * NTOK;
#pragma unroll
    for (int i = 0; i < 4; i++)
#pragma unroll
      for (int rq = 0; rq < 4; rq++) {
        const int row0 = rowbase + wm * 128 + i * 32 + rq * 8 + g * 4;
#pragma unroll
        for (int r4 = 0; r4 < 4; r4++) {
          float sq = 0.f;
#pragma unroll
          for (int j = 0; j < 4; j++) {
            const int col = tn * 256 + wn * 128 + j * 32 + l32;
            const size_t idx = (size_t)(row0 + r4) * 1024 + col;
            float xn = p->xf[idx] + acc[i][j][rq * 4 + r4];
            p->xf[idx] = xn;
            p->xb[idx] = f2bf(xn);
            sq += xn * xn;
          }
#pragma unroll
          for (int o = 16; o; o >>= 1) sq += __shfl_xor(sq, o);
          if (l32 == 0) ssq[row0 + r4] = sq;
        }
      }
  } else {
#pragma unroll
    for (int i = 0; i < 4; i++)
#pragma unroll
      for (int rq = 0; rq < 4; rq++) {
        const int lr0 = wm * 128 + i * 32 + rq * 8 + g * 4;
#pragma unroll
        for (int j = 0; j < 4; j++) {
          const int pc = wn * 128 + j * 32 + l32;
          u32x2 pk = {pack_bf2(acc[i][j][rq * 4 + 0], acc[i][j][rq * 4 + 1]), pack_bf2(acc[i][j][rq * 4 + 2], acc[i][j][rq * 4 + 3])};
          *(u32x2*)(smem + pc * 528 + lr0 * 2) = pk;
        }
      }
    {
      float* rs = (float*)(smem + 135168);
      const int tb = 254 * upti - 2 + tid;
      float sc = 0.f;
      if (tb >= 0) {
        const int gr = min(upb * SEQL + tb, NTOK - 1);
        sc = rsqrtf(ss_sum1(p->ss + (size_t)(2 * layer + 1) * 8 * NTOK, gr) * (1.f / 1024.f) + EPS);
      }
      rs[tid] = sc;
    }
    __syncthreads();
    {
      const int cp = tid & 127, half = tid >> 7;
      const int pg = (cp >> 6) * 128 + (cp & 63), pv = pg + 64;
      const int ocol = tn * 128 + cp;
      const float* wc = p->w_conv + (size_t)layer * 3 * 5632;
      const float* bc = p->b_conv + (size_t)layer * 5632;
      const float wg0 = wc[ocol], wg1 = wc[5632 + ocol], wg2 = wc[2 * 5632 + ocol], bg = bc[ocol];
      const float wv0 = wc[FFN + ocol], wv1 = wc[5632 + FFN + ocol], wv2 = wc[2 * 5632 + FFN + ocol], bv = bc[FFN + ocol];
      const float* rs = (const float*)(smem + 135168);
      const char* gcol = smem + pg * 528;
      const char* vcol = smem + pv * 528;
      float g0 = 0.f, v0 = 0.f, g1 = 0.f, v1 = 0.f;
      if (half) {
        g0 = rs[126] * bf2f(*(const bf16_t*)(gcol + 126 * 2)); v0 = rs[126] * bf2f(*(const bf16_t*)(vcol + 126 * 2));
        g1 = rs[127] * bf2f(*(const bf16_t*)(gcol + 127 * 2)); v1 = rs[127] * bf2f(*(const bf16_t*)(vcol + 127 * 2));
      }
      for (int grp8 = 0; grp8 < 16; grp8++) {
        const int lrb = half * 128 + grp8 * 8;
        const u32x4 gq = *(const u32x4*)(gcol + lrb * 2);
        const u32x4 vq = *(const u32x4*)(vcol + lrb * 2);
        const float4 r0 = *(const float4*)(rs + lrb), r1 = *(const float4*)(rs + lrb + 4);
        const float rsv[8] = {r0.x, r0.y, r0.z, r0.w, r1.x, r1.y, r1.z, r1.w};
#pragma unroll
        for (int e = 0; e < 8; e++) {
          const unsigned gw = gq[e >> 1], vw = vq[e >> 1];
          const float g2 = rsv[e] * ((e & 1) ? __uint_as_float(gw & 0xffff0000u) : __uint_as_float(gw << 16));
          const float v2 = rsv[e] * ((e & 1) ? __uint_as_float(vw & 0xffff0000u) : __uint_as_float(vw << 16));
          const int lr = lrb + e;
          const int tb = 254 * upti - 2 + lr;
          if (lr >= 2 && tb < SEQL) {
            const float gate = bg + wg0 * g0 + wg1 * g1 + wg2 * g2;
            const float val = bv + wv0 * v0 + wv1 * v1 + wv2 * v2;
            const float o = gate / (1.f + __expf(-gate)) * val;
            p->act[(size_t)(upb * SEQL + tb) * FFN + ocol] = f2bf(o);
          }
          g0 = g1; v0 = v1; g1 = g2; v1 = v2;
        }
      }
    }
    __syncthreads();
  }
  }
}

__device__ __forceinline__ void attn_item(KP p, int layer, int b, int h, int qt, float lam, float outscale, char* smem, const int tid) {
  const int lane = tid & 63, w = tid >> 6, g = lane >> 5, l32 = lane & 31;
  const int tok_q = b * SEQL + qt * 128 + w * 32 + l32;
  {
    const int qrow = tid >> 4, qc = tid & 15;
#pragma unroll
    for (int i = 0; i < 8; i++) {
      const int row = qrow + 16 * i;
      u32x4 v = *(const u32x4*)(p->q + (size_t)(b * SEQL + qt * 128 + row) * 512 + h * 128 + qc * 8);
      *(u32x4*)(smem + 65536 + row * 256 + ((qc ^ (row & 15)) << 4)) = v;
    }
  }
  const int q_off = 65536 + (w * 32 + l32) * 256;
  const int q_swz = (l32 & 15);

  const int NT = 2 * qt + 2;
  const int nkt = 2 * qt + 1 + (w >> 1);
  f32x16 O[2][4];
#pragma unroll
  for (int c = 0; c < 2; c++)
#pragma unroll
    for (int dt = 0; dt < 4; dt++)
#pragma unroll
      for (int r = 0; r < 16; r++) O[c][dt][r] = 0.f;
  float mrun[2] = {-1e30f, -1e30f}, lrun[2] = {0.f, 0.f};
  const float c1 = 0.125f * 1.4426950408889634f;

  u32x4 rk[4], rv[4];
  const bf16_t* kbase = p->k + (size_t)(b * SEQL) * 512 + h * 128;
  const bf16_t* vbase = p->vt + (size_t)((b * 4 + h) * 128) * SEQL;
  const int kkey = tid >> 4, kc = tid & 15;
  const int vd = tid >> 3, vc = tid & 7;
  auto gload = [&](int kt) {
#pragma unroll
    for (int i = 0; i < 4; i++) {
      rk[i] = *(const u32x4*)(kbase + (size_t)(kt * 64 + kkey + 16 * i) * 512 + kc * 8);
      rv[i] = *(const u32x4*)(vbase + (size_t)(vd + 32 * i) * SEQL + kt * 64 + vc * 8);
    }
  };
  const int kw_off = kkey * 256 + ((kc ^ (kkey & 15)) << 4);
  const int vw_off = 16384 + vd * 128 + ((vc ^ ((vd >> 1) & 7)) << 4);
  auto lwrite = [&](int st) {
    char* s = smem + st * 32768;
#pragma unroll
    for (int i = 0; i < 4; i++) {
      *(u32x4*)(s + kw_off + i * 4096) = rk[i];
      *(u32x4*)(s + vw_off + i * 4096) = rv[i];
    }
  };

  gload(0);
  lwrite(0);
  __syncthreads();
  for (int kt = 0; kt < NT; kt++) {
    if (kt + 1 < NT) gload(kt + 1);
    if (kt < nkt) {
      const char* st = smem + (kt & 1) * 32768;
      bf16x8 pf[2][2][2];
      bf16x8 kf[8], qfr[4], vf[2][4];
      f32x16 S[1][2];
      auto loadkq = [&](int c) {
#pragma unroll
        for (int kb = 0; kb < 2; kb++)
#pragma unroll
          for (int ks = 0; ks < 4; ks++) {
            const int key = kb * 32 + l32, chunk = c * 8 + ks * 2 + g;
            kf[kb * 4 + ks] = *(const bf16x8*)(st + key * 256 + ((chunk ^ (key & 15)) << 4));
          }
#pragma unroll
        for (int ks = 0; ks < 4; ks++) qfr[ks] = *(const bf16x8*)(smem + q_off + (((c * 8 + ks * 2 + g) ^ q_swz) << 4));
      };
      auto qk = [&](int c) {
        f32x16 zero;
#pragma unroll
        for (int r = 0; r < 16; r++) zero[r] = 0.f;
#pragma unroll
        for (int kb = 0; kb < 2; kb++) {
          S[0][kb] = MFMA(kf[kb * 4], qfr[0], zero);
#pragma unroll
          for (int ks = 1; ks < 4; ks++) S[0][kb] = MFMA(kf[kb * 4 + ks], qfr[ks], S[0][kb]);
        }
      };
      auto loadv = [&](int bi) {
#pragma unroll
        for (int dt = 0; dt < 4; dt++) {
          const int d = dt * 32 + l32, chunk = bi * 2 + g;
          vf[bi & 1][dt] = *(const bf16x8*)(st + 16384 + d * 128 + ((chunk ^ ((d >> 1) & 7)) << 4));
        }
      };
      auto softmax = [&](int c) {
        float mx = S[0][0][0];
#pragma unroll
        for (int r = 1; r < 16; r++) mx = fmaxf(mx, S[0][0][r]);
#pragma unroll
        for (int r = 0; r < 16; r++) mx = fmaxf(mx, S[0][1][r]);
        {
          const unsigned mu = __float_as_uint(mx);
          auto sw = __builtin_amdgcn_permlane32_swap(mu, mu, false, false);
          mx = fmaxf(__uint_as_float(sw[0]), __uint_as_float(sw[1]));
        }
        const float mcand = fmaxf(mrun[c], mx * c1);
        if (__any(mcand - mrun[c] > 8.f)) {
          const float alpha = fast_exp2(mrun[c] - mcand);
          mrun[c] = mcand;
          lrun[c] *= alpha;
#pragma unroll
          for (int dt = 0; dt < 4; dt++)
#pragma unroll
            for (int r = 0; r < 16; r++) O[c][dt][r] *= alpha;
        }
        const float mref = mrun[c];
        const f2_t c1v = {c1, c1}, mrv = {-mref, -mref};
        f2_t psum2 = {0.f, 0.f};
#pragma unroll
        for (int kb = 0; kb < 2; kb++)
#pragma unroll
          for (int r = 0; r < 16; r += 2) {
            f2_t sv = {S[0][kb][r], S[0][kb][r + 1]};
            f2_t av = __builtin_elementwise_fma(sv, c1v, mrv);
            f2_t ev = {fast_exp2(av[0]), fast_exp2(av[1])};
            S[0][kb][r] = ev[0]; S[0][kb][r + 1] = ev[1];
            psum2 += ev;
          }
        lrun[c] += psum2[0] + psum2[1];
#pragma unroll
        for (int kb = 0; kb < 2; kb++)
#pragma unroll
          for (int m = 0; m < 2; m++) {
            u32x4 pk = {pack_bf2(S[0][kb][8 * m + 0], S[0][kb][8 * m + 1]), pack_bf2(S[0][kb][8 * m + 2], S[0][kb][8 * m + 3]),
                        pack_bf2(S[0][kb][8 * m + 4], S[0][kb][8 * m + 5]), pack_bf2(S[0][kb][8 * m + 6], S[0][kb][8 * m + 7])};
            pf[c][kb][m] = __builtin_bit_cast(bf16x8, pk);
          }
      };
      loadkq(0);
      __builtin_amdgcn_sched_barrier(0);
      qk(0);
      __builtin_amdgcn_sched_barrier(0);
      loadkq(1);
      __builtin_amdgcn_sched_barrier(0);
      softmax(0);
      __builtin_amdgcn_sched_barrier(0);
      qk(1);
      loadv(0);
      __builtin_amdgcn_sched_barrier(0);
      softmax(1);
      __builtin_amdgcn_sched_barrier(0);
#pragma unroll
      for (int bi = 0; bi < 4; bi++) {
        if (bi < 3) loadv(bi + 1);
#pragma unroll
        for (int dt = 0; dt < 4; dt++) {
          O[0][dt] = MFMA(vf[bi & 1][dt], pf[0][bi >> 1][bi & 1], O[0][dt]);
          O[1][dt] = MFMA(vf[bi & 1][dt], pf[1][bi >> 1][bi & 1], O[1][dt]);
        }
        __builtin_amdgcn_sched_barrier(0);
      }
    }
    if (kt + 1 < NT) lwrite((kt + 1) & 1);
    __syncthreads();
  }

  const float l1 = lrun[0] + __shfl_xor(lrun[0], 32);
  const float l2 = lrun[1] + __shfl_xor(lrun[1], 32);
  const float i1 = 1.f / l1, i2 = lam / l2;
  float ssq = 0.f;
#pragma unroll
  for (int dt = 0; dt < 4; dt++)
#pragma unroll
    for (int r = 0; r < 16; r++) {
      float o = O[0][dt][r] * i1 - O[1][dt][r] * i2;
      O[0][dt][r] = o;
      ssq += o * o;
    }
  ssq += __shfl_xor(ssq, 32);
  const float rstd = rsqrtf(ssq * (1.f / 128.f) + EPS) * outscale;
  const float* gsub = p->subln + layer * 128;
#pragma unroll
  for (int dt = 0; dt < 4; dt++)
#pragma unroll
    for (int rq = 0; rq < 4; rq++) {
      const int d0 = dt * 32 + rq * 8 + g * 4;
      float4 gg = *(const float4*)(gsub + d0);
      u32x2 pk = {pack_bf2(O[0][dt][rq * 4 + 0] * rstd * gg.x, O[0][dt][rq * 4 + 1] * rstd * gg.y),
                  pack_bf2(O[0][dt][rq * 4 + 2] * rstd * gg.z, O[0][dt][rq * 4 + 3] * rstd * gg.w)};
      *(u32x2*)(p->att + (size_t)tok_q * 512 + h * 128 + d0) = pk;
    }
}

DI void s5_store_u(const u32x4 a, const u32x4 bq, int lane, float* ul) {
  float4* d = (float4*)(ul + lane * 16);
  d[0] = make_float4(__uint_as_float(a[0] << 16), __uint_as_float(a[0] & 0xffff0000u), __uint_as_float(a[1] << 16), __uint_as_float(a[1] & 0xffff0000u));
  d[1] = make_float4(__uint_as_float(a[2] << 16), __uint_as_float(a[2] & 0xffff0000u), __uint_as_float(a[3] << 16), __uint_as_float(a[3] & 0xffff0000u));
  d[2] = make_float4(__uint_as_float(bq[0] << 16), __uint_as_float(bq[0] & 0xffff0000u), __uint_as_float(bq[1] << 16), __uint_as_float(bq[1] & 0xffff0000u));
  d[3] = make_float4(__uint_as_float(bq[2] << 16), __uint_as_float(bq[2] & 0xffff0000u), __uint_as_float(bq[3] << 16), __uint_as_float(bq[3] & 0xffff0000u));
}
DI void s5_load_u(KP p, int b, int g, int j, int lane, float* ul) {
  const u32x4* src = (const u32x4*)(p->u + (size_t)(b * SEQL + j * 64 + lane) * 512 + g * 16);
  const u32x4 a = src[0], bq = src[1];
  s5_store_u(a, bq, lane, ul);
}

DI float swap_half(float v, const int which) {
  const unsigned u = __float_as_uint(v);
  auto r = __builtin_amdgcn_permlane32_swap(u, u, false, false);
  return __uint_as_float(which ? r[1] : r[0]);
}

struct S5Coef { float arA, aiA, arB, aiB; };

template <bool STORE>
DI void s5_scan32(const float* ul_sub, const bf16x8 (&bfr)[4], const S5Coef& cf, float& xAr, float& xAi, float& xBr, float& xBi,
                  float* X, const int l32, const int grp) {
  bf16x8 af;
  {
    const float* us = ul_sub + l32 * 16 + grp * 8;
    float4 a = *(const float4*)us, bq = *(const float4*)(us + 4);
    u32x4 pk = {pack_bf2(a.x, a.y), pack_bf2(a.z, a.w), pack_bf2(bq.x, bq.y), pack_bf2(bq.z, bq.w)};
    af = __builtin_bit_cast(bf16x8, pk);
  }
  f32x16 zero;
#pragma unroll
  for (int r = 0; r < 16; r++) zero[r] = 0.f;
  const f32x16 bu0 = MFMA(af, bfr[0], zero), bu1 = MFMA(af, bfr[1], zero), bu2 = MFMA(af, bfr[2], zero), bu3 = MFMA(af, bfr[3], zero);
#pragma unroll
  for (int k = 0; k < 8; k++) {
    float sAr[4], sAi[4], sBr[4], sBi[4];
#pragma unroll
    for (int i = 0; i < 4; i++) {
      const int r = (k >> 1) * 4 + i;
      const float nAr = cf.arA * xAr - cf.aiA * xAi + bu0[r];
      const float nAi = cf.arA * xAi + cf.aiA * xAr + bu2[r];
      const float nBr = cf.arB * xBr - cf.aiB * xBi + bu1[r];
      const float nBi = cf.arB * xBi + cf.aiB * xBr + bu3[r];
      xAr = nAr; xAi = nAi; xBr = nBr; xBi = nBi;
      sAr[i] = nAr; sAi[i] = nAi; sBr[i] = nBr; sBi[i] = nBi;
    }
    if (STORE) {
      if (grp == (k & 1)) {
#pragma unroll
        for (int i = 0; i < 4; i++) {
          float* xr = X + (4 * k + i) * 132;
          xr[l32] = sAr[i]; xr[64 + l32] = sAi[i]; xr[32 + l32] = sBr[i]; xr[96 + l32] = sBi[i];
        }
      }
    }
    xAr = swap_half(xAr, k & 1); xAi = swap_half(xAi, k & 1);
    xBr = swap_half(xBr, k & 1); xBi = swap_half(xBi, k & 1);
  }
}

DI void s5_setup(KP p, int layer, int g, int l32, int grp, S5Coef& cf, bf16x8 (&bfr)[4]) {
  const float* t0 = p->s5tab + (size_t)((layer * 32 + g) * 64) * 40;
  cf.arA = t0[l32 * 40]; cf.aiA = t0[l32 * 40 + 1];
  cf.arB = t0[(32 + l32) * 40]; cf.aiB = t0[(32 + l32) * 40 + 1];
#pragma unroll
  for (int jt = 0; jt < 4; jt++) {
    const float* src = t0 + (l32 + 32 * (jt & 1)) * 40 + 4 + (jt >> 1) * 16 + grp * 8;
    float4 a = *(const float4*)src, bq = *(const float4*)(src + 4);
    u32x4 pk = {pack_bf2(a.x, a.y), pack_bf2(a.z, a.w), pack_bf2(bq.x, bq.y), pack_bf2(bq.z, bq.w)};
    bfr[jt] = __builtin_bit_cast(bf16x8, pk);
  }
}

__device__ __forceinline__ void s5_pass1(KP p, int layer, char* smem, const int tid) {
  const int lane = tid & 63, w = tid >> 6, l32 = lane & 31, grp = lane >> 5;
  float* ul = (float*)(smem + w * 4096);
  for (int wbase = blockIdx.x * 4; wbase < 1024; wbase += gridDim.x * 4) {
    const int wi = wbase + w;
    const int j0 = (wi & 15) * 8, g = (wi >> 4) & 31, b = wi >> 9;
    S5Coef cf; bf16x8 bfr[4];
    s5_setup(p, layer, g, l32, grp, cf, bfr);
    const u32x4* src = (const u32x4*)(p->u + (size_t)(b * SEQL + j0 * 64 + lane) * 512 + g * 16);
    u32x4 v0 = src[0], v1 = src[1];
    for (int jj = 0; jj < 8; jj++) {
      const int j = j0 + jj;
      s5_store_u(v0, v1, lane, ul);
      if (jj < 7) {
        const u32x4* nsrc = (const u32x4*)(p->u + (size_t)(b * SEQL + (j + 1) * 64 + lane) * 512 + g * 16);
        v0 = nsrc[0]; v1 = nsrc[1];
      }
      __syncthreads();
      float xAr = 0.f, xAi = 0.f, xBr = 0.f, xBi = 0.f;
      s5_scan32<false>(ul, bfr, cf, xAr, xAi, xBr, xBi, nullptr, l32, grp);
      s5_scan32<false>(ul + 32 * 16, bfr, cf, xAr, xAi, xBr, xBi, nullptr, l32, grp);
      float* so = p->sloc + (size_t)((b * 32 + g) * 128 + j) * 128;
      so[lane] = grp ? xBr : xAr; so[64 + lane] = grp ? xBi : xAi;
      __syncthreads();
    }
  }
}

__device__ __forceinline__ void s5_pass2(KP p, int layer, char* smem, const int tid) {
  const int lane = tid & 63, w = tid >> 6;
  float* ul = (float*)(smem + w * 21504);
  float* X = ul + 1024;
  const int l32 = lane & 31, grp = lane >> 5;
  for (int wbase = blockIdx.x * 4; wbase < 1024; wbase += gridDim.x * 4) {
   const int wi = wbase + w;
   const int j0 = (wi & 15) * 8, g = (wi >> 4) & 31, b = wi >> 9;
   S5Coef cf; bf16x8 bfr[4];
   s5_setup(p, layer, g, l32, grp, cf, bfr);
   bf16x8 cfr[8];
   {
     const int c = l32 & 15;
     const float* cr = p->c_re + (size_t)((layer * 32 + g) * 16 + c) * 64;
     const float* ci = p->c_im + (size_t)((layer * 32 + g) * 16 + c) * 64;
#pragma unroll
     for (int s8 = 0; s8 < 8; s8++) {
       const int k0 = (s8 & 3) * 16 + grp * 8;
       const float* src = (s8 < 4) ? (cr + k0) : (ci + k0);
       const float sg = (l32 < 16) ? ((s8 < 4) ? 1.f : -1.f) : 0.f;
       float4 a = *(const float4*)src, bq = *(const float4*)(src + 4);
       u32x4 pk = {pack_bf2(a.x * sg, a.y * sg), pack_bf2(a.z * sg, a.w * sg), pack_bf2(bq.x * sg, bq.y * sg), pack_bf2(bq.z * sg, bq.w * sg)};
       cfr[s8] = __builtin_bit_cast(bf16x8, pk);
     }
   }
   const float dd = p->ssm_d[(size_t)(layer * 32 + g) * 16 + (l32 & 15)];
   float xAr, xAi, xBr, xBi;
   {
     const float* tb = p->s5tab + (size_t)((layer * 32 + g) * 64 + lane) * 40;
     const float aTr = tb[2], aTi = tb[3];
     float xr = 0.f, xi = 0.f;
     const float* sl = p->sloc + (size_t)((b * 32 + g) * 128) * 128;
     for (int i0 = 0; i0 < j0; i0 += 8) {
       float sr[8], si[8];
#pragma unroll
       for (int q = 0; q < 8; q++) { sr[q] = sl[(i0 + q) * 128 + lane]; si[q] = sl[(i0 + q) * 128 + 64 + lane]; }
#pragma unroll
       for (int q = 0; q < 8; q++) {
         const float nr = aTr * xr - aTi * xi + sr[q];
         const float ni = aTr * xi + aTi * xr + si[q];
         xr = nr; xi = ni;
       }
     }
     xAr = swap_half(xr, 0); xBr = swap_half(xr, 1);
     xAi = swap_half(xi, 0); xBi = swap_half(xi, 1);
   }
   for (int jj = 0; jj < 8; jj++) {
    const int j = j0 + jj;
    s5_load_u(p, b, g, j, lane, ul);
    __syncthreads();
    for (int sub = 0; sub < 2; sub++) {
      s5_scan32<true>(ul + sub * 32 * 16, bfr, cf, xAr, xAi, xBr, xBi, X, l32, grp);
      __syncthreads();
      f32x16 yacc;
#pragma unroll
      for (int r = 0; r < 16; r++) yacc[r] = 0.f;
#pragma unroll
      for (int s8 = 0; s8 < 8; s8++) {
        const float* xs = X + l32 * 132 + ((s8 < 4) ? 0 : 64) + (s8 & 3) * 16 + grp * 8;
        float4 a = *(const float4*)xs, bq = *(const float4*)(xs + 4);
        u32x4 pk = {pack_bf2(a.x, a.y), pack_bf2(a.z, a.w), pack_bf2(bq.x, bq.y), pack_bf2(bq.z, bq.w)};
        yacc = MFMA(__builtin_bit_cast(bf16x8, pk), cfr[s8], yacc);
      }
      if (l32 < 16) {
#pragma unroll
        for (int r = 0; r < 16; r++) {
          const int tl = sub * 32 + (r >> 2) * 8 + grp * 4 + (r & 3);
          const float yv = yacc[r] + dd * ul[tl * 16 + l32];
          p->gy[(size_t)(b * SEQL + j * 64 + tl) * 512 + g * 16 + l32] = f2bf(gelu_tanh(yv));
        }
      }
      __syncthreads();
    }
   }
  }
}

__device__ __forceinline__ void phase_attn(KP p, int layer, char* smem, const int tid) {
  const int lane = tid & 63;
  const float s1 = wave_sum(p->lq1[layer * 64 + lane] * p->lk1[layer * 64 + lane]);
  const float s2 = wave_sum(p->lq2[layer * 64 + lane] * p->lk2[layer * 64 + lane]);
  const float lam_init = 0.8f - 0.6f * expf(-0.3f * (float)layer);
  const float lam = expf(s1) - expf(s2) + lam_init;
  for (int pb = blockIdx.x; pb < 256; pb += gridDim.x) {
    const int pi = (pb & 7) * 32 + (pb >> 3);
    const int b = pi >> 7, h = (pi >> 5) & 3, i = pi & 31;
    attn_item(p, layer, b, h, 63 - i, lam, 1.f - lam_init, smem, tid);
    attn_item(p, layer, b, h, i, lam, 1.f - lam_init, smem, tid);
  }
  s5_pass1(p, layer, smem, tid);
}

__device__ __forceinline__ void phase_final(KP p, const int tid) {
  const int wave = tid >> 6, lane = tid & 63;
  const float* ssq = p->ss + (size_t)8 * 8 * NTOK;
  for (int row = blockIdx.x * 4 + wave; row < NTOK; row += gridDim.x * 4) {
    const float rstd = rsqrtf(ss_sum1(ssq, row) * (1.f / 1024.f) + EPS);
#pragma unroll
    for (int i = 0; i < 4; i++) {
      float4 v = ((const float4*)(p->xf + (size_t)row * DM))[lane + 64 * i];
      float4 gq = ((const float4*)p->norm_final)[lane + 64 * i];
      float4 o = {v.x * rstd * gq.x, v.y * rstd * gq.y, v.z * rstd * gq.z, v.w * rstd * gq.w};
      ((float4*)(p->out + (size_t)row * DM))[lane + 64 * i] = o;
    }
  }
}

__device__ __forceinline__ void run_phase(KP p, int ph, char* smem) {
  const int tid = opaque_tid();
  if (ph == 0) { phase_prep(p, smem, tid); return; }
  if (ph == 29) { phase_final(p, tid); return; }
  const int layer = (ph - 1) / 7, k = (ph - 1) % 7;
  const int nb = gridDim.x, bid = blockIdx.x;
  if (k == 1) { phase_attn(p, layer, smem, tid); return; }
  if (k == 2) { s5_pass2(p, layer, smem, tid); return; }
  if (k == 0) { for (int r = 0; ; r++) { const int t = (r * 8 + (bid & 7)) * (nb >> 3) + (bid >> 3); if (r * nb >= 512) break; if (t < 512) gemm_tile(p, G_IN, layer, t, smem, tid); } }
  else if (k == 3) { for (int r = 0; ; r++) { const int t = (r * 8 + (bid & 7)) * (nb >> 3) + (bid >> 3); if (r * nb >= 256) break; if (t < 256) gemm_tile(p, G_GLU, layer, t, smem, tid); } }
  else if (k == 4) { for (int r = 0; ; r++) { const int t = (r * 8 + (bid & 7)) * (nb >> 3) + (bid >> 3); if (r * nb >= 256) break; if (t < 256) gemm_tile(p, G_WOUT, layer, t, smem, tid); } }
  else if (k == 5) { for (int r = 0; ; r++) { const int t = (r * 8 + (bid & 7)) * (nb >> 3) + (bid >> 3); if (r * nb >= 2 * 33 * 22) break; if (t < 2 * 33 * 22) gemm_tile(p, G_UP, layer, t, smem, tid); } }
  else { for (int r = 0; ; r++) { const int t = (r * 8 + (bid & 7)) * (nb >> 3) + (bid >> 3); if (r * nb >= 256) break; if (t < 256) gemm_tile(p, G_DOWN, layer, t, smem, tid); } }
}

#define PHASE_KERNEL(name, body)                                                      \
  __global__ void __launch_bounds__(256) name(Params p_unused) {                      \
    extern __shared__ __attribute__((aligned(16))) char smem[];                       \
    KP p = (KP)__builtin_amdgcn_kernarg_segment_ptr();                                \
    const int tid = threadIdx.x, nb = gridDim.x, bid = blockIdx.x;                    \
    const int layer = (int)p->phase_lo;                                               \
    (void)nb; (void)bid; (void)layer;                                                 \
    body                                                                              \
  }
PHASE_KERNEL(k_prep, phase_prep(p, smem, tid);)
PHASE_KERNEL(k_gin, for (int r = 0; ; r++) { const int t = (r * 8 + (bid & 7)) * (nb >> 3) + (bid >> 3); if (r * nb >= 512) break; if (t < 512) gemm_tile(p, G_IN, layer, t, smem, tid); })
PHASE_KERNEL(k_attn, phase_attn(p, layer, smem, tid);)
PHASE_KERNEL(k_s5p2, s5_pass2(p, layer, smem, tid);)
PHASE_KERNEL(k_glu, for (int r = 0; ; r++) { const int t = (r * 8 + (bid & 7)) * (nb >> 3) + (bid >> 3); if (r * nb >= 256) break; if (t < 256) gemm_tile(p, G_GLU, layer, t, smem, tid); })
PHASE_KERNEL(k_wout, for (int r = 0; ; r++) { const int t = (r * 8 + (bid & 7)) * (nb >> 3) + (bid >> 3); if (r * nb >= 256) break; if (t < 256) gemm_tile(p, G_WOUT, layer, t, smem, tid); })
PHASE_KERNEL(k_up, for (int r = 0; ; r++) { const int t = (r * 8 + (bid & 7)) * (nb >> 3) + (bid >> 3); if (r * nb >= 2 * 33 * 22) break; if (t < 2 * 33 * 22) gemm_tile(p, G_UP, layer, t, smem, tid); })
PHASE_KERNEL(k_down, for (int r = 0; ; r++) { const int t = (r * 8 + (bid & 7)) * (nb >> 3) + (bid >> 3); if (r * nb >= 256) break; if (t < 256) gemm_tile(p, G_DOWN, layer, t, smem, tid); })
PHASE_KERNEL(k_final, phase_final(p, tid);)

#if COOP
__global__ void __launch_bounds__(256) mega_kernel(Params p_unused) {
  extern __shared__ __attribute__((aligned(16))) char smem[];
  KP p0 = (KP)__builtin_amdgcn_kernarg_segment_ptr();
  const int ph_lo = (int)p0->phase_lo, ph_hi = (int)p0->phase_hi;
#if COOP
  if (ph_hi > 1000) cg::this_grid().sync();
#endif
#if COOP
  {
    volatile unsigned* st = (volatile unsigned*)(smem + 136192);
    if (threadIdx.x == 0) { st[0] = 0u; st[1] = 0u; xb_add(&p0->bar[XB_CNT(xb_xcc_id())], 1u); }
  }
#endif
  for (int ph = ph_lo; ph < ph_hi; ph++) {
    KP p = p0;
    asm volatile("" : "+s"(p));
#if TPROBE
    if (blockIdx.x == 0) p->ts[ph] = (long long)wall_clock64();
#endif
    run_phase(p, ph, smem);
#if COOP
    if (ph + 1 < ph_hi) {
      if (ph == ph_lo) grid_barrier(p->bar, gridDim.x, opaque_tid());
      else xcd_barrier(p->bar, (volatile unsigned*)(smem + 136192), opaque_tid());
    }
#endif
  }
#if TPROBE
  grid_barrier(p0->bar, (unsigned)(ph_hi - ph_lo) * gridDim.x, opaque_tid());
  if (blockIdx.x == 0) {
    KP p = p0;
    long long tend = (long long)wall_clock64();
    float a = 0.f, b = 0.f;
    for (int ph = 0; ph < 30; ph++) {
      long long t0 = p->ts[ph], t1 = (ph == 29) ? tend : p->ts[ph + 1];
      int c = (ph == 0) ? 0 : (ph == 29 ? 8 : 1 + (ph - 1) % 7);
      float d = (float)(t1 - t0) * 0.01f;
      if (c == TP_A || TP_A == 9) a += d;
      if (c == TP_B || TP_B == 9) b += d;
    }
    const int t = opaque_tid();
    if (t <= 100) p->out[t] += (t == 0) ? a : b;
  }
#endif
}

#endif

extern "C" void kernel_launch(void* const* d_in, const int* in_sizes, int n_in, void* d_out, int out_size, void* d_ws,
                              size_t ws_size, hipStream_t stream) {
  static int grid_blocks = 0;
  if (!grid_blocks) {
    int dev = 0, cus = 0, per_cu = 0;
    (void)hipGetDevice(&dev);
    (void)hipDeviceGetAttribute(&cus, hipDeviceAttributeMultiprocessorCount, dev);
#if COOP
    (void)hipFuncSetAttribute((const void*)mega_kernel, hipFuncAttributeMaxDynamicSharedMemorySize, LDS_BYTES);
    (void)hipOccupancyMaxActiveBlocksPerMultiprocessor(&per_cu, (const void*)mega_kernel, 256, LDS_BYTES);
    if (per_cu < 1) { fprintf(stderr, "occupancy query returned %d\n", per_cu); per_cu = 1; }
#endif
    grid_blocks = cus;
    (void)hipGetLastError();
  }
  Params p{};
  p.x = (const float*)d_in[0]; p.pos = (const int*)d_in[1];
  p.norm_mix = (const float*)d_in[2]; p.w_in = (const float*)d_in[3];
  p.lam_re = (const float*)d_in[4]; p.lam_im = (const float*)d_in[5]; p.log_step = (const float*)d_in[6];
  p.b_re = (const float*)d_in[7]; p.b_im = (const float*)d_in[8]; p.c_re = (const float*)d_in[9]; p.c_im = (const float*)d_in[10];
  p.ssm_d = (const float*)d_in[11]; p.w_glu = (const float*)d_in[12]; p.ssm_norm = (const float*)d_in[13];
  p.lq1 = (const float*)d_in[14]; p.lk1 = (const float*)d_in[15]; p.lq2 = (const float*)d_in[16]; p.lk2 = (const float*)d_in[17];
  p.subln = (const float*)d_in[18]; p.w_out = (const float*)d_in[19]; p.norm_ffn = (const float*)d_in[20];
  p.w_up = (const float*)d_in[21]; p.w_conv = (const float*)d_in[22]; p.b_conv = (const float*)d_in[23];
  p.w_down = (const float*)d_in[24]; p.norm_final = (const float*)d_in[25];
  p.out = (float*)d_out;
  char* ws = (char*)d_ws;
  size_t off = 0;
  auto take = [&](size_t bytes) { char* r = ws + off; off += (bytes + 255) & ~(size_t)255; return r; };
  p.WinT = (bf16_t*)take((size_t)4 * 2048 * 1024 * 2);
  p.WgluT = (bf16_t*)take((size_t)4 * 1024 * 512 * 2);
  p.WoutT = (bf16_t*)take((size_t)4 * 1024 * 1024 * 2);
  p.WupT = (bf16_t*)take((size_t)4 * 5632 * 1024 * 2);
  p.WdownT = (bf16_t*)take((size_t)4 * 1024 * FFN * 2);
  p.xf = (float*)take((size_t)NTOK * DM * 4);
  p.xb = (bf16_t*)take((size_t)NTOK * DM * 2);
  p.ss = (float*)take((size_t)9 * 8 * NTOK * 4);
  p.ssm_ss = (float*)take((size_t)4 * 8 * NTOK * 4);
  p.cs = (float*)take((size_t)NTOK * 16 * 4);
  p.s5tab = (float*)take((size_t)4 * 32 * 64 * 40 * 4);
  p.sloc = (float*)take((size_t)2 * 32 * 128 * 128 * 4);
  p.ts = (long long*)take(256);
  p.bar = (unsigned*)take(XB_WORDS * 4);
  char* region = take((size_t)134217728);
  p.u = (bf16_t*)region;
  p.q = (bf16_t*)(region + 33554432);
  p.k = p.q + (size_t)NTOK * 512;
  p.vt = p.k + (size_t)NTOK * 512;
  p.gy = p.vt + (size_t)NTOK * 512;
  p.outg = p.gy + (size_t)NTOK * 512;
  p.att = p.outg + (size_t)NTOK * 512;
  p.act = (bf16_t*)region;
  if (off > ws_size) { fprintf(stderr, "workspace too small: need %zu have %zu\n", off, ws_size); return; }
#if COOP
  p.phase_lo = 0; p.phase_hi = 30;
  if (hipMemsetAsync(p.bar, 0, XB_WORDS * 4, stream) != hipSuccess) fprintf(stderr, "barrier memset failed\n");
  void* args[] = {&p};
  hipError_t e = hipLaunchCooperativeKernel((const void*)mega_kernel, dim3(grid_blocks), dim3(256), args, LDS_BYTES, stream);
  if (e != hipSuccess) fprintf(stderr, "cooperative launch failed: %s (grid %d)\n", hipGetErrorString(e), grid_blocks);
#else
  typedef void (*kfn)(Params);
  const kfn seq[7] = {k_gin, k_attn, k_s5p2, k_glu, k_wout, k_up, k_down};
  static bool attr_done = false;
  if (!attr_done) {
    (void)hipFuncSetAttribute((const void*)k_prep, hipFuncAttributeMaxDynamicSharedMemorySize, LDS_BYTES);
    (void)hipFuncSetAttribute((const void*)k_final, hipFuncAttributeMaxDynamicSharedMemorySize, LDS_BYTES);
    for (int i = 0; i < 7; i++) (void)hipFuncSetAttribute((const void*)seq[i], hipFuncAttributeMaxDynamicSharedMemorySize, LDS_BYTES);
    attr_done = true;
  }
  p.phase_lo = 0; p.phase_hi = 0;
  hipLaunchKernelGGL(k_prep, dim3(grid_blocks), dim3(256), LDS_BYTES, stream, p);
  for (int layer = 0; layer < 4; layer++) {
    p.phase_lo = layer;
    for (int i = 0; i < 7; i++) hipLaunchKernelGGL(seq[i], dim3(grid_blocks), dim3(256), LDS_BYTES, stream, p);
  }
  hipLaunchKernelGGL(k_final, dim3(grid_blocks), dim3(256), LDS_BYTES, stream, p);
#endif
}
```

```cpp
#include <hip/hip_runtime.h>
#include <hip/hip_cooperative_groups.h>
#include <cstdio>
namespace cg = cooperative_groups;

#ifndef COOP
#define COOP 1
#endif
#ifndef TPROBE
#define TPROBE 0
#endif
#ifndef TP_A
#define TP_A 1
#endif
#ifndef TP_B
#define TP_B 2
#endif

typedef unsigned short bf16_t;
typedef __attribute__((ext_vector_type(8))) short bf16x8;
typedef __attribute__((ext_vector_type(16))) float f32x16;
typedef __attribute__((ext_vector_type(2))) __bf16 bf2_t;
typedef __attribute__((ext_vector_type(2))) float f2_t;
typedef __attribute__((ext_vector_type(4))) unsigned u32x4;
typedef __attribute__((ext_vector_type(2))) unsigned u32x2;

#define DI __device__ __forceinline__
#define MFMA(a, b, c) __builtin_amdgcn_mfma_f32_32x32x16_bf16((a), (b), (c), 0, 0, 0)

constexpr int NTOK = 16384, DM = 1024, SEQL = 8192, FFN = 2816;
constexpr int LDS_BYTES = 136208;
constexpr float EPS = 1e-6f;

struct Params {
  const float* x; const int* pos;
  const float *norm_mix, *w_in, *lam_re, *lam_im, *log_step, *b_re, *b_im, *c_re, *c_im, *ssm_d, *w_glu, *ssm_norm;
  const float *lq1, *lk1, *lq2, *lk2, *subln, *w_out, *norm_ffn, *w_up, *w_conv, *b_conv, *w_down, *norm_final;
  float* out;
  bf16_t *WinT, *WgluT, *WoutT, *WupT, *WdownT;
  float* xf; bf16_t* xb;
  bf16_t *u, *q, *k, *vt, *gy, *outg, *att, *act;
  float *ss, *ssm_ss, *cs, *s5tab, *sloc;
  long long phase_lo, phase_hi;
  long long* ts;
  unsigned* bar;
};

typedef const __attribute__((address_space(4))) Params* KP;

DI unsigned pack_bf2(float a, float b) { f2_t v = {a, b}; return __builtin_bit_cast(unsigned, __builtin_convertvector(v, bf2_t)); }
DI bf16_t f2bf(float a) { return (bf16_t)(pack_bf2(a, 0.f) & 0xffffu); }
DI float bf2f(bf16_t v) { return __uint_as_float(((unsigned)v) << 16); }
DI void grid_barrier(unsigned* ctr, unsigned target, int tid) {
  asm volatile("s_waitcnt vmcnt(0)" ::: "memory");
  __syncthreads();
  if (tid == 0) {
    __builtin_amdgcn_fence(__ATOMIC_RELEASE, "agent");
    asm volatile("s_waitcnt vmcnt(0)" ::: "memory");
    __hip_atomic_fetch_add(ctr, 1u, __ATOMIC_RELAXED, __HIP_MEMORY_SCOPE_AGENT);
    while (__hip_atomic_load(ctr, __ATOMIC_RELAXED, __HIP_MEMORY_SCOPE_AGENT) < target) __builtin_amdgcn_s_sleep(1);
    __builtin_amdgcn_fence(__ATOMIC_ACQUIRE, "agent");
    asm volatile("s_waitcnt vmcnt(0)" ::: "memory");
  }
  __syncthreads();
}
#define XB_CNT(j)  (64 + 64 * (j))
#define XB_SUB(j)  (1088 + 64 * (j))
#define XB_GEN(j)  (2112 + 64 * (j))
#define XB_TOP     3136
#define XB_TOPGEN  3200
#define XB_WORDS   3264
DI unsigned xb_ld(unsigned* q) { return __hip_atomic_load(q, __ATOMIC_RELAXED, __HIP_MEMORY_SCOPE_AGENT); }
DI unsigned xb_add(unsigned* q, unsigned v) { return __hip_atomic_fetch_add(q, v, __ATOMIC_RELAXED, __HIP_MEMORY_SCOPE_AGENT); }
DI unsigned xb_xcc_id() { return (unsigned)__builtin_amdgcn_s_getreg((3 << 11) | 20) & 0xFu; }
DI void xcd_barrier(unsigned* bar, volatile unsigned* st, int tid) {
  asm volatile("s_waitcnt vmcnt(0)" ::: "memory");
  __syncthreads();
  if (tid == 0) {
    const unsigned x = xb_xcc_id();
    unsigned nloc = st[0], nx = st[1];
    if (nloc == 0u) {
      unsigned cnt = 0u, mine = 1u;
#pragma unroll
      for (unsigned j = 0; j < 16; ++j) { const unsigned c = xb_ld(&bar[XB_CNT(j)]); cnt += (c > 0u) ? 1u : 0u; mine = (j == x) ? c : mine; }
      nloc = mine > 0u ? mine : 1u; nx = cnt > 0u ? cnt : 1u;
      st[0] = nloc; st[1] = nx;
    }
    const unsigned old = xb_add(&bar[XB_SUB(x)], 1u);
    const unsigned gen = old / nloc;
    if (old + 1u == (gen + 1u) * nloc) {
      __builtin_amdgcn_fence(__ATOMIC_RELEASE, "agent");
      asm volatile("s_waitcnt vmcnt(0)" ::: "memory");
      const unsigned og = xb_add(&bar[XB_TOP], 1u);
      const unsigned tg = og / nx;
      if (og + 1u == (tg + 1u) * nx) xb_add(&bar[XB_TOPGEN], 1u);
      else { while (xb_ld(&bar[XB_TOPGEN]) == tg) __builtin_amdgcn_s_sleep(1); }
      __builtin_amdgcn_fence(__ATOMIC_ACQUIRE, "agent");
      xb_add(&bar[XB_GEN(x)], 1u);
      asm volatile("s_waitcnt vmcnt(0)" ::: "memory");
    } else {
      while (xb_ld(&bar[XB_GEN(x)]) == gen) __builtin_amdgcn_s_sleep(1);
      __builtin_amdgcn_fence(__ATOMIC_ACQUIRE, "agent");
      asm volatile("s_waitcnt vmcnt(0)" ::: "memory");
    }
  }
  __syncthreads();
}
DI int opaque_tid() { int t = threadIdx.x; asm volatile("" : "+v"(t)); return t; }
DI float4 ss_sum4(const float* base, int row0) {
  float4 a = *(const float4*)(base + row0);
#pragma unroll
  for (int pz = 1; pz < 8; pz++) {
    float4 b = *(const float4*)(base + (size_t)pz * NTOK + row0);
    a.x += b.x; a.y += b.y; a.z += b.z; a.w += b.w;
  }
  return a;
}
DI float ss_sum1(const float* base, int row) {
  float a = base[row];
#pragma unroll
  for (int pz = 1; pz < 8; pz++) a += base[(size_t)pz * NTOK + row];
  return a;
}
DI float wave_sum(float v) { for (int o = 32; o; o >>= 1) v += __shfl_xor(v, o); return v; }
DI float fast_exp2(float x) { return __builtin_amdgcn_exp2f(x); }
DI float gelu_tanh(float x) {
  float z = 0.7978845608028654f * (x + 0.044715f * x * x * x);
  float e = __expf(2.f * z);
  float t = 1.f - 2.f / (1.f + e);
  return 0.5f * x * (1.f + t);
}
DI float reduce_2pi(double a) {
  double n = rint(a * 0.15915494309189535);
  return (float)(a - n * 6.283185307179586);
}

DI void transpose_tile(const float* src, int ldsrc, int k0, int c0, const float* scale, int nscale,
                       bf16_t* dst, int lddst, int n0, float* lds, const int tid) {
#pragma unroll
  for (int i = 0; i < 16; i++) {
    int kk = i * 4 + (tid >> 6), nn = tid & 63;
    float v = src[(size_t)(k0 + kk) * ldsrc + c0 + nn];
    if (scale != nullptr && (k0 + kk) < nscale) v *= scale[k0 + kk];
    lds[kk * 65 + nn] = v;
  }
  __syncthreads();
  {
    int nn = tid >> 2, kq = (tid & 3) * 16;
    unsigned pk[8];
#pragma unroll
    for (int i = 0; i < 8; i++) pk[i] = pack_bf2(lds[(kq + 2 * i) * 65 + nn], lds[(kq + 2 * i + 1) * 65 + nn]);
    u32x4* d = (u32x4*)(dst + (size_t)(n0 + nn) * lddst + k0 + kq);
    u32x4 a = {pk[0], pk[1], pk[2], pk[3]}, b = {pk[4], pk[5], pk[6], pk[7]};
    d[0] = a; d[1] = b;
  }
  __syncthreads();
}

DI void wtask(const float* src, int ldsrc, int k0, int c0, const float* scale, int nscale, bf16_t* dst, int lddst, int n0, int lane) {
  float v[32];
  const float* sp = src + (size_t)k0 * ldsrc + c0 + lane;
#pragma unroll
  for (int i = 0; i < 32; i++) v[i] = sp[(size_t)i * ldsrc];
  if (k0 < nscale) {
#pragma unroll
    for (int i = 0; i < 32; i++) v[i] *= scale[k0 + i];
  }
  u32x4* d = (u32x4*)(dst + (size_t)(n0 + lane) * lddst + k0);
#pragma unroll
  for (int q = 0; q < 4; q++) {
    u32x4 o = {pack_bf2(v[8 * q], v[8 * q + 1]), pack_bf2(v[8 * q + 2], v[8 * q + 3]), pack_bf2(v[8 * q + 4], v[8 * q + 5]), pack_bf2(v[8 * q + 6], v[8 * q + 7])};
    d[q] = o;
  }
}

__device__ __forceinline__ void phase_prep(KP p, char* smem, const int tid) {
  const int nb = gridDim.x, bid = blockIdx.x;
  const int wave = tid >> 6, lane = tid & 63;
  for (int row = bid * 4 + wave; row < NTOK; row += nb * 4) {
    const float4* src = (const float4*)(p->x + (size_t)row * DM);
    float s = 0.f;
#pragma unroll
    for (int i = 0; i < 4; i++) {
      float4 v = src[lane + 64 * i];
      s += v.x * v.x + v.y * v.y + v.z * v.z + v.w * v.w;
      ((float4*)(p->xf + (size_t)row * DM))[lane + 64 * i] = v;
      u32x2 pk = {pack_bf2(v.x, v.y), pack_bf2(v.z, v.w)};
      ((u32x2*)(p->xb + (size_t)row * DM))[lane + 64 * i] = pk;
    }
    s = wave_sum(s);
    if (lane < 8) p->ss[(size_t)lane * NTOK + row] = (lane == 0) ? s : 0.f;
  }
  for (int i = bid * 256 + tid; i < NTOK * 8; i += nb * 256) {
    int tok = i >> 3, j = i & 7;
    double inv = (j & 4) ? ((j & 2) ? ((j & 1) ? 1.031338537721246e-05 : 5.318295896944988e-05) : ((j & 1) ? 0.0002742481756762073 : 0.001414213562373095))
                         : ((j & 2) ? ((j & 1) ? 0.007292664737217109 : 0.03760603093086393) : ((j & 1) ? 0.19392274474868576 : 1.0));
    double ang = (double)p->pos[tok] * inv;
    float r = reduce_2pi(ang);
    p->cs[2 * i] = cosf(r); p->cs[2 * i + 1] = sinf(r);
  }
  for (int i = bid * 256 + tid; i < 4 * 32 * 64; i += nb * 256) {
    int lg = i >> 6;
    float lr = p->lam_re[i], li = p->lam_im[i];
    float step = expf(p->log_step[lg]);
    float mag = expf(step * lr);
    double angd = (double)step * (double)li;
    float r1 = reduce_2pi(angd);
    float ar = mag * cosf(r1), ai = mag * sinf(r1);
    float den = lr * lr + li * li;
    float fr = ((ar - 1.f) * lr + ai * li) / den;
    float fi = (ai * lr - (ar - 1.f) * li) / den;
    float magT = expf(64.f * step * lr);
    float rT = reduce_2pi(64.0 * angd);
    float* tb = p->s5tab + (size_t)i * 40;
    tb[0] = ar; tb[1] = ai; tb[2] = magT * cosf(rT); tb[3] = magT * sinf(rT);
    for (int c = 0; c < 16; c++) {
      float br = p->b_re[(size_t)i * 16 + c], bi = p->b_im[(size_t)i * 16 + c];
      tb[4 + c] = fr * br - fi * bi;
      tb[20 + c] = fr * bi + fi * br;
    }
  }
  {
    const int NTASK = 4 * 6016;
    const int gw = bid * 4 + wave, nw = nb * 4;
    const int per = (NTASK + nw - 1) / nw;
    const int t_lo = gw * per, t_hi = min(t_lo + per, NTASK);
    for (int task = t_lo; task < t_hi; task++) {
      const int layer = task / 6016;
      int t = task % 6016;
      if (t < 1024) {
        const int a = t >> 5, kb = t & 31;
        wtask(p->w_in + (size_t)layer * 1024 * 2048, 2048, kb * 32, a * 64, p->norm_mix + layer * 1024, 1024,
              p->WinT + (size_t)layer * 2048 * 1024, 1024, a * 64, lane);
      } else if (t < 1280) {
        t -= 1024; const int a = t >> 4, kb = t & 15;
        wtask(p->w_glu + (size_t)layer * 512 * 1024, 1024, kb * 32, (a & 1) * 512 + (a >> 1) * 64, p->norm_mix, 0,
              p->WgluT + (size_t)layer * 1024 * 512, 512, a * 64, lane);
      } else if (t < 1792) {
        t -= 1280; const int a = t >> 5, kb = t & 31;
        wtask(p->w_out + (size_t)layer * 1024 * 1024, 1024, kb * 32, a * 64, p->ssm_norm + layer * 512, 512,
              p->WoutT + (size_t)layer * 1024 * 1024, 1024, a * 64, lane);
      } else if (t < 4608) {
        t -= 1792; const int a = t >> 5, kb = t & 31;
        wtask(p->w_up + (size_t)layer * 1024 * 5632, 5632, kb * 32, (a & 1) * FFN + (a >> 1) * 64, p->norm_ffn + layer * 1024, 1024,
              p->WupT + (size_t)layer * 5632 * 1024, 1024, a * 64, lane);
      } else {
        t -= 4608; const int a = t / 88, kb = t % 88;
        wtask(p->w_down + (size_t)layer * FFN * 1024, 1024, kb * 32, a * 64, p->norm_mix, 0,
              p->WdownT + (size_t)layer * 1024 * FFN, FFN, a * 64, lane);
      }
    }
  }
}

enum { G_IN = 0, G_GLU = 1, G_WOUT = 2, G_UP = 3, G_DOWN = 4 };
#define ACC_PIN(tag) _Pragma("unroll") for (int i_ = 0; i_ < 4; i_++) _Pragma("unroll") for (int j_ = 0; j_ < 4; j_++) asm volatile("; pin " tag : "+a"(acc[i_][j_]));


__device__ __forceinline__ void gemm_tile(KP p, const int MODE, int layer, int tile, char* smem, const int tid) {
  const int lane = tid & 63, w = tid >> 6, wm = w >> 1, wn = w & 1, g = lane >> 5, l32 = lane & 31;
  int tn, KT, ldb, rowbase, lda;
  const bf16_t* Bt;
  const bf16_t* A0;
  int upb = 0, upti = 0;
  {
    const int TM = (MODE == G_UP) ? 66 : 64;
    const int TN = (MODE == G_IN) ? 8 : (MODE == G_UP ? 22 : 4);
    const int nfull = TN >> 2, rem = TN & 3;
    int tm;
    if (tile < nfull * 4 * TM) { const int band = tile / (4 * TM), within = tile % (4 * TM); tm = within >> 2; tn = band * 4 + (within & 3); }
    else { const int s2 = tile - nfull * 4 * TM; tm = s2 / rem; tn = nfull * 4 + s2 % rem; }
    rowbase = tm * 256;
    if (MODE == G_UP) { upb = tm / 33; upti = tm % 33; rowbase = upb * SEQL + 254 * upti - 2; }
  }
  if (MODE == G_IN) { KT = 16; ldb = 1024; Bt = p->WinT + (size_t)layer * 2048 * 1024; A0 = p->xb; lda = 1024; }
  else if (MODE == G_GLU) { KT = 8; ldb = 512; Bt = p->WgluT + (size_t)layer * 1024 * 512; A0 = p->gy; lda = 512; }
  else if (MODE == G_WOUT) { KT = 16; ldb = 1024; Bt = p->WoutT + (size_t)layer * 1024 * 1024; A0 = p->outg; lda = 512; }
  else if (MODE == G_UP) { KT = 16; ldb = 1024; Bt = p->WupT + (size_t)layer * 5632 * 1024; A0 = p->xb; lda = 1024; }
  else { KT = 44; ldb = FFN; Bt = p->WdownT + (size_t)layer * 1024 * FFN; A0 = p->act; lda = FFN; }

  u32x4 ra[8], rb[8];
  const int lrow = tid >> 3, lc = tid & 7;
  float arow_sc[8];
#pragma unroll
  for (int i = 0; i < 8; i++) arow_sc[i] = 1.f;
  if (MODE == G_WOUT) {
    const float* ssq = p->ssm_ss + (size_t)layer * 8 * NTOK;
#pragma unroll
    for (int i = 0; i < 8; i++) arow_sc[i] = rsqrtf(ss_sum1(ssq, rowbase + lrow + 32 * i) * (1.f / 512.f) + EPS);
  }
  const bf16_t* bptr = Bt + (size_t)(tn * 256 + lrow) * ldb + lc * 8;
  auto gload = [&](int kt) {
    const bf16_t* abase = A0;
    int kofs = kt * 64;
    if (MODE == G_WOUT && kt >= 8) { abase = p->att; kofs = (kt - 8) * 64; }
#pragma unroll
    for (int i = 0; i < 8; i++) {
      int gr = min(max(rowbase + lrow + 32 * i, 0), NTOK - 1);
      ra[i] = *(const u32x4*)(abase + (size_t)gr * lda + kofs + lc * 8);
      rb[i] = *(const u32x4*)(bptr + (size_t)(32 * i) * ldb + kt * 64);
    }
  };
  auto scaleA = [&](int kt) {
    if (MODE == G_WOUT && kt < 8) {
#pragma unroll
      for (int i = 0; i < 8; i++)
#pragma unroll
        for (int e = 0; e < 4; e++) {
          unsigned v = ra[i][e];
          float lo = __uint_as_float(v << 16) * arow_sc[i], hi = __uint_as_float(v & 0xffff0000u) * arow_sc[i];
          ra[i][e] = pack_bf2(lo, hi);
        }
    }
  };
  const int wr_off = lrow * 128 + ((lc ^ ((lrow >> 1) & 7)) << 4);
  auto lwriteA = [&](int st) {
    char* sa = smem + st * 65536;
#pragma unroll
    for (int i = 0; i < 8; i++) *(u32x4*)(sa + wr_off + i * 4096) = ra[i];
  };
  auto lwriteB = [&](int st) {
    char* sb = smem + st * 65536 + 32768;
#pragma unroll
    for (int i = 0; i < 8; i++) *(u32x4*)(sb + wr_off + i * 4096) = rb[i];
  };

  f32x16 acc[4][4];
#pragma unroll
  for (int i = 0; i < 4; i++)
#pragma unroll
    for (int j = 0; j < 4; j++)
#pragma unroll
      for (int r = 0; r < 16; r++) acc[i][j][r] = 0.f;

  const int swz = (l32 >> 1) & 7;
  const int a_base = (wm * 128 + l32) * 128;
  const int b_base = 32768 + (wn * 128 + l32) * 128;
  bf16x8 af[2][4], bfr[2][4];
  auto lfrag = [&](int buf, const char* st, int ks) {
    const int coff = (((ks * 2 + g) ^ swz) << 4);
#pragma unroll
    for (int i = 0; i < 4; i++) af[buf][i] = *(const bf16x8*)(st + a_base + i * 4096 + coff);
#pragma unroll
    for (int j = 0; j < 4; j++) bfr[buf][j] = *(const bf16x8*)(st + b_base + j * 4096 + coff);
  };
  auto mfma16 = [&](int buf) {
#pragma unroll
    for (int i = 0; i < 4; i++)
#pragma unroll
      for (int j = 0; j < 4; j++) acc[i][j] = MFMA(af[buf][i], bfr[buf][j], acc[i][j]);
  };

  gload(0);
  scaleA(0);
  lwriteA(0);
  lwriteB(0);
  __syncthreads();
  if (KT > 1) gload(1);
  lfrag(0, smem, 0);
  for (int kt = 0; kt < KT; kt++) {
    const char* st = smem + (kt & 1) * 65536;
    const bool has1 = (kt + 1 < KT), has2 = (kt + 2 < KT);
    lfrag(1, st, 1);
    if (has1) { scaleA(kt + 1); lwriteA((kt + 1) & 1); }
    mfma16(0);
    __builtin_amdgcn_sched_barrier(0);
    lfrag(0, st, 2);
    if (has1) lwriteB((kt + 1) & 1);
    mfma16(1);
    __builtin_amdgcn_sched_barrier(0);
    lfrag(1, st, 3);
    if (has2) gload(kt + 2);
    mfma16(0);
    __builtin_amdgcn_sched_barrier(0);
    asm volatile("s_waitcnt lgkmcnt(0)" ::: "memory");
    __builtin_amdgcn_s_barrier();
    __builtin_amdgcn_sched_barrier(0);
    if (has1) lfrag(0, smem + ((kt + 1) & 1) * 65536, 0);
    mfma16(1);
    __builtin_amdgcn_sched_barrier(0);
  }

  int tid2 = tid;
  asm volatile("" : "+v"(tid2));
  {
  const int tid = tid2;
  const int lane = tid & 63, w = tid >> 6, wm = w >> 1, wn = w & 1, g = lane >> 5, l32 = lane & 31;
  if (MODE == G_IN) {
    const int region = tn >> 1;
    float* rs = (float*)(smem + 135168);
    rs[tid] = rsqrtf(ss_sum1(p->ss + (size_t)(2 * layer) * 8 * NTOK, rowbase + tid) * (1.f / 1024.f) + EPS);
    __syncthreads();
#pragma unroll
    for (int i = 0; i < 4; i++)
#pragma unroll
      for (int rq = 0; rq < 4; rq++) {
        const int lr0 = wm * 128 + i * 32 + rq * 8 + g * 4;
        const float4 s4 = *(const float4*)(rs + lr0);
        const float sc[4] = {s4.x, s4.y, s4.z, s4.w};
#pragma unroll
        for (int j = 0; j < 4; j++) {
          const int lcol = wn * 128 + j * 32 + l32;
          float v[4];
#pragma unroll
          for (int r4 = 0; r4 < 4; r4++) v[r4] = acc[i][j][rq * 4 + r4] * sc[r4];
          if (region == 3) {
            const int q4 = (lr0 >> 2) & 3;
            const int pq = ((q4 & 1) << 1) | (q4 >> 1);
            u32x2 pk = {pack_bf2(v[0], v[1]), pack_bf2(v[2], v[3])};
            *(u32x2*)(smem + lcol * 528 + ((lr0 & ~15) + pq * 4) * 2) = pk;
          } else {
            if (region != 0 && (j & 1) == 0) {
              float other[4];
#pragma unroll
              for (int r4 = 0; r4 < 4; r4++) other[r4] = __shfl_xor(v[r4], 8);
              if (l32 < 16) {
                const float sgn = (l32 < 8) ? -1.f : 1.f;
#pragma unroll
                for (int r4 = 0; r4 < 4; r4++) {
                  const float2 csv = *(const float2*)(p->cs + ((size_t)(rowbase + lr0 + r4) * 8 + (l32 & 7)) * 2);
                  v[r4] = v[r4] * csv.x + sgn * other[r4] * csv.y;
                }
              }
            }
#pragma unroll
            for (int r4 = 0; r4 < 4; r4++) *(bf16_t*)(smem + (lr0 + r4) * 528 + lcol * 2) = f2bf(v[r4]);
          }
        }
      }
    __syncthreads();
    {
      bf16_t* dbase;
      size_t rstride;
      if (region == 3) { dbase = p->vt + (size_t)((rowbase >> 13) * 512 + (tn & 1) * 256) * SEQL + (rowbase & (SEQL - 1)); rstride = SEQL; }
      else { dbase = (region == 0 ? p->u : (region == 1 ? p->q : p->k)) + (size_t)rowbase * 512 + (tn & 1) * 256; rstride = 512; }
#pragma unroll 8
      for (int it = 0; it < 32; it++) {
        const int id = tid + 256 * it, row = id >> 5, c = id & 31;
        const u32x4 vv = *(const u32x4*)(smem + row * 528 + c * 16);
        *(u32x4*)(dbase + (size_t)row * rstride + c * 8) = vv;
      }
    }
    __syncthreads();
  } else if (MODE == G_GLU) {
    float* ssq = p->ssm_ss + ((size_t)layer * 8 + tn * 2 + wn) * NTOK;
#pragma unroll
    for (int i = 0; i < 4; i++)
#pragma unroll
      for (int rq = 0; rq < 4; rq++) {
        const int row0 = rowbase + wm * 128 + i * 32 + rq * 8 + g * 4;
#pragma unroll
        for (int r4 = 0; r4 < 4; r4++) {
          float sq = 0.f;
#pragma unroll
          for (int j = 0; j < 2; j++) {
            float a = acc[i][j][rq * 4 + r4], b = acc[i][j + 2][rq * 4 + r4];
            float o = a / (1.f + __expf(-b));
            const int col = (tn * 2 + wn) * 64 + j * 32 + l32;
            p->outg[(size_t)(row0 + r4) * 512 + col] = f2bf(o);
            sq += o * o;
          }
#pragma unroll
          for (int o = 16; o; o >>= 1) sq += __shfl_xor(sq, o);
          if (l32 == 0) ssq[row0 + r4] = sq;
        }
      }
  } else if (MODE == G_WOUT || MODE == G_DOWN) {
#pragma unroll
    for (int i = 0; i < 4; i++)
#pragma unroll
      for (int j = 0; j < 4; j++)
#pragma unroll
        for (int r = 0; r < 16; r++) {
          const int lr = wm * 128 + i * 32 + (r >> 2) * 8 + g * 4 + (r & 3);
          *(bf16_t*)(smem + lr * 528 + (wn * 128 + j * 32 + l32) * 2) = f2bf(acc[i][j][r]);
        }
    __syncthreads();
    {
      float* ssq = p->ss + ((size_t)(MODE == G_WOUT ? 2 * layer + 1 : 2 * layer + 2) * 8 + tn * 2) * NTOK;
#pragma unroll 4
      for (int it = 0; it < 32; it++) {
        const int id = tid + 256 * it, row = id >> 5, c = id & 31;
        const u32x4 dv = *(const u32x4*)(smem + row * 528 + c * 16);
        const size_t idx = (size_t)(rowbase + row) * 1024 + tn * 256 + c * 8;
        float4 x0 = *(const float4*)(p->xf + idx), x1 = *(const float4*)(p->xf + idx + 4);
        x0.x += __uint_as_float(dv[0] << 16); x0.y += __uint_as_float(dv[0] & 0xffff0000u);
        x0.z += __uint_as_float(dv[1] << 16); x0.w += __uint_as_float(dv[1] & 0xffff0000u);
        x1.x += __uint_as_float(dv[2] << 16); x1.y += __uint_as_float(dv[2] & 0xffff0000u);
        x1.z += __uint_as_float(dv[3] << 16); x1.w += __uint_as_float(dv[3] & 0xffff0000u);
        *(float4*)(p->xf + idx) = x0; *(float4*)(p->xf + idx + 4) = x1;
        u32x4 xbv = {pack_bf2(x0.x, x0.y), pack_bf2(x0.z, x0.w), pack_bf2(x1.x, x1.y), pack_bf2(x1.z, x1.w)};
        *(u32x4*)(p->xb + idx) = xbv;
        float sq = x0.x * x0.x + x0.y * x0.y + x0.z * x0.z + x0.w * x0.w + x1.x * x1.x + x1.y * x1.y + x1.z * x1.z + x1.w * x1.w;
#pragma unroll
        for (int o = 8; o; o >>= 1) sq += __shfl_xor(sq, o);
        if ((c & 15) == 0) ssq[(size_t)(c >> 4) * NTOK + rowbase + row] = sq;
      }
    }
    __syncthreads();
  } else {
#pragma unroll
    for (int i = 0; i < 4; i++)
#pragma unroll
      for (int rq = 0; rq < 4; rq++) {
        const int lr0 = wm * 128 + i * 32 + rq * 8 + g * 4;
#pragma unroll
        for (int j = 0; j < 4; j++) {
          const int pc = wn * 128 + j * 32 + l32;
          u32x2 pk = {pack_bf2(acc[i][j][rq * 4 + 0], acc[i][j][rq * 4 + 1]), pack_bf2(acc[i][j][rq * 4 + 2], acc[i][j][rq * 4 + 3])};
          *(u32x2*)(smem + pc * 528 + lr0 * 2) = pk;
        }
      }
    {
      float* rs = (float*)(smem + 135168);
      const int tb = 254 * upti - 2 + tid;
      float sc = 0.f;
      if (tb >= 0) {
        const int gr = min(upb * SEQL + tb, NTOK - 1);
        sc = rsqrtf(ss_sum1(p->ss + (size_t)(2 * layer + 1) * 8 * NTOK, gr) * (1.f / 1024.f) + EPS);
      }
      rs[tid] = sc;
    }
    __syncthreads();
    {
      const int cp = tid & 127, half = tid >> 7;
      const int pg = (cp >> 6) * 128 + (cp & 63), pv = pg + 64;
      const int ocol = tn * 128 + cp;
      const float* wc = p->w_conv + (size_t)layer * 3 * 5632;
      const float* bc = p->b_conv + (size_t)layer * 5632;
      const float wg0 = wc[ocol], wg1 = wc[5632 + ocol], wg2 = wc[2 * 5632 + ocol], bg = bc[ocol];
      const float wv0 = wc[FFN + ocol], wv1 = wc[5632 + FFN + ocol], wv2 = wc[2 * 5632 + FFN + ocol], bv = bc[FFN + ocol];
      const float* rs = (const float*)(smem + 135168);
      const char* gcol = smem + pg * 528;
      const char* vcol = smem + pv * 528;
      float g0 = 0.f, v0 = 0.f, g1 = 0.f, v1 = 0.f;
      if (half) {
        g0 = rs[126] * bf2f(*(const bf16_t*)(gcol + 126 * 2)); v0 = rs[126] * bf2f(*(const bf16_t*)(vcol + 126 * 2));
        g1 = rs[127] * bf2f(*(const bf16_t*)(gcol + 127 * 2)); v1 = rs[127] * bf2f(*(const bf16_t*)(vcol + 127 * 2));
      }
      for (int grp8 = 0; grp8 < 16; grp8++) {
        const int lrb = half * 128 + grp8 * 8;
        const u32x4 gq = *(const u32x4*)(gcol + lrb * 2);
        const u32x4 vq = *(const u32x4*)(vcol + lrb * 2);
        const float4 r0 = *(const float4*)(rs + lrb), r1 = *(const float4*)(rs + lrb + 4);
        const float rsv[8] = {r0.x, r0.y, r0.z, r0.w, r1.x, r1.y, r1.z, r1.w};
#pragma unroll
        for (int e = 0; e < 8; e++) {
          const unsigned gw = gq[e >> 1], vw = vq[e >> 1];
          const float g2 = rsv[e] * ((e & 1) ? __uint_as_float(gw & 0xffff0000u) : __uint_as_float(gw << 16));
          const float v2 = rsv[e] * ((e & 1) ? __uint_as_float(vw & 0xffff0000u) : __uint_as_float(vw << 16));
          const int lr = lrb + e;
          const int tb = 254 * upti - 2 + lr;
          if (lr >= 2 && tb < SEQL) {
            const float gate = bg + wg0 * g0 + wg1 * g1 + wg2 * g2;
            const float val = bv + wv0 * v0 + wv1 * v1 + wv2 * v2;
            const float o = gate / (1.f + __expf(-gate)) * val;
            p->act[(size_t)(upb * SEQL + tb) * FFN + ocol] = f2bf(o);
          }
          g0 = g1; v0 = v1; g1 = g2; v1 = v2;
        }
      }
    }
    __syncthreads();
  }
  }
}

__device__ __forceinline__ void attn_item(KP p, int layer, int b, int h, int qt, float lam, float outscale, char* smem, const int tid) {
  const int lane = tid & 63, w = tid >> 6, g = lane >> 5, l32 = lane & 31;
  const int tok_q = b * SEQL + qt * 128 + w * 32 + l32;
  {
    const int qrow = tid >> 4, qc = tid & 15;
#pragma unroll
    for (int i = 0; i < 8; i++) {
      const int row = qrow + 16 * i;
      u32x4 v = *(const u32x4*)(p->q + (size_t)(b * SEQL + qt * 128 + row) * 512 + h * 128 + qc * 8);
      *(u32x4*)(smem + 65536 + row * 256 + ((qc ^ (row & 15)) << 4)) = v;
    }
  }
  const int q_off = 65536 + (w * 32 + l32) * 256;
  const int q_swz = (l32 & 15);

  const int NT = 2 * qt + 2;
  const int nkt = 2 * qt + 1 + (w >> 1);
  f32x16 O[2][4];
#pragma unroll
  for (int c = 0; c < 2; c++)
#pragma unroll
    for (int dt = 0; dt < 4; dt++)
#pragma unroll
      for (int r = 0; r < 16; r++) O[c][dt][r] = 0.f;
  float mrun[2] = {-1e30f, -1e30f}, lrun[2] = {0.f, 0.f};
  const float c1 = 0.125f * 1.4426950408889634f;

  u32x4 rk[4], rv[4];
  const bf16_t* kbase = p->k + (size_t)(b * SEQL) * 512 + h * 128;
  const bf16_t* vbase = p->vt + (size_t)((b * 4 + h) * 128) * SEQL;
  const int kkey = tid >> 4, kc = tid & 15;
  const int vd = tid >> 3, vc = tid & 7;
  auto gload = [&](int kt) {
#pragma unroll
    for (int i = 0; i < 4; i++) {
      rk[i] = *(const u32x4*)(kbase + (size_t)(kt * 64 + kkey + 16 * i) * 512 + kc * 8);
      rv[i] = *(const u32x4*)(vbase + (size_t)(vd + 32 * i) * SEQL + kt * 64 + vc * 8);
    }
  };
  const int kw_off = kkey * 256 + ((kc ^ (kkey & 15)) << 4);
  const int vw_off = 16384 + vd * 128 + ((vc ^ ((vd >> 1) & 7)) << 4);
  auto lwrite = [&](int st) {
    char* s = smem + st * 32768;
#pragma unroll
    for (int i = 0; i < 4; i++) {
      *(u32x4*)(s + kw_off + i * 4096) = rk[i];
      *(u32x4*)(s + vw_off + i * 4096) = rv[i];
    }
  };

  gload(0);
  lwrite(0);
  __syncthreads();
  for (int kt = 0; kt < NT; kt++) {
    if (kt + 1 < NT) gload(kt + 1);
    if (kt < nkt) {
      const char* st = smem + (kt & 1) * 32768;
      bf16x8 pf[2][2][2];
      bf16x8 kf[8], qfr[4], vf[2][4];
      f32x16 S[1][2];
      auto loadkq = [&](int c) {
#pragma unroll
        for (int kb = 0; kb < 2; kb++)
#pragma unroll
          for (int ks = 0; ks < 4; ks++) {
            const int key = kb * 32 + l32, chunk = c * 8 + ks * 2 + g;
            kf[kb * 4 + ks] = *(const bf16x8*)(st + key * 256 + ((chunk ^ (key & 15)) << 4));
          }
#pragma unroll
        for (int ks = 0; ks < 4; ks++) qfr[ks] = *(const bf16x8*)(smem + q_off + (((c * 8 + ks * 2 + g) ^ q_swz) << 4));
      };
      auto qk = [&](int c) {
        f32x16 zero;
#pragma unroll
        for (int r = 0; r < 16; r++) zero[r] = 0.f;
#pragma unroll
        for (int kb = 0; kb < 2; kb++) {
          S[0][kb] = MFMA(kf[kb * 4], qfr[0], zero);
#pragma unroll
          for (int ks = 1; ks < 4; ks++) S[0][kb] = MFMA(kf[kb * 4 + ks], qfr[ks], S[0][kb]);
        }
      };
      auto loadv = [&](int bi) {
#pragma unroll
        for (int dt = 0; dt < 4; dt++) {
          const int d = dt * 32 + l32, chunk = bi * 2 + g;
          vf[bi & 1][dt] = *(const bf16x8*)(st + 16384 + d * 128 + ((chunk ^ ((d >> 1) & 7)) << 4));
        }
      };
      auto softmax = [&](int c) {
        float mx = S[0][0][0];
#pragma unroll
        for (int r = 1; r < 16; r++) mx = fmaxf(mx, S[0][0][r]);
#pragma unroll
        for (int r = 0; r < 16; r++) mx = fmaxf(mx, S[0][1][r]);
        {
          const unsigned mu = __float_as_uint(mx);
          auto sw = __builtin_amdgcn_permlane32_swap(mu, mu, false, false);
          mx = fmaxf(__uint_as_float(sw[0]), __uint_as_float(sw[1]));
        }
        const float mcand = fmaxf(mrun[c], mx * c1);
        if (__any(mcand - mrun[c] > 8.f)) {
          const float alpha = fast_exp2(mrun[c] - mcand);
          mrun[c] = mcand;
          lrun[c] *= alpha;
#pragma unroll
          for (int dt = 0; dt < 4; dt++)
#pragma unroll
            for (int r = 0; r < 16; r++) O[c][dt][r] *= alpha;
        }
        const float mref = mrun[c];
        const f2_t c1v = {c1, c1}, mrv = {-mref, -mref};
        f2_t psum2 = {0.f, 0.f};
#pragma unroll
        for (int kb = 0; kb < 2; kb++)
#pragma unroll
          for (int r = 0; r < 16; r += 2) {
            f2_t sv = {S[0][kb][r], S[0][kb][r + 1]};
            f2_t av = __builtin_elementwise_fma(sv, c1v, mrv);
            f2_t ev = {fast_exp2(av[0]), fast_exp2(av[1])};
            S[0][kb][r] = ev[0]; S[0][kb][r + 1] = ev[1];
            psum2 += ev;
          }
        lrun[c] += psum2[0] + psum2[1];
#pragma unroll
        for (int kb = 0; kb < 2; kb++)
#pragma unroll
          for (int m = 0; m < 2; m++) {
            u32x4 pk = {pack_bf2(S[0][kb][8 * m + 0], S[0][kb][8 * m + 1]), pack_bf2(S[0][kb][8 * m + 2], S[0][kb][8 * m + 3]),
                        pack_bf2(S[0][kb][8 * m + 4], S[0][kb][8 * m + 5]), pack_bf2(S[0][kb][8 * m + 6], S[0][kb][8 * m + 7])};
            pf[c][kb][m] = __builtin_bit_cast(bf16x8, pk);
          }
      };
      loadkq(0);
      __builtin_amdgcn_sched_barrier(0);
      qk(0);
      __builtin_amdgcn_sched_barrier(0);
      loadkq(1);
      __builtin_amdgcn_sched_barrier(0);
      softmax(0);
      __builtin_amdgcn_sched_barrier(0);
      qk(1);
      loadv(0);
      __builtin_amdgcn_sched_barrier(0);
      softmax(1);
      __builtin_amdgcn_sched_barrier(0);
#pragma unroll
      for (int bi = 0; bi < 4; bi++) {
        if (bi < 3) loadv(bi + 1);
#pragma unroll
        for (int dt = 0; dt < 4; dt++) {
          O[0][dt] = MFMA(vf[bi & 1][dt], pf[0][bi >> 1][bi & 1], O[0][dt]);
          O[1][dt] = MFMA(vf[bi & 1][dt], pf[1][bi >> 1][bi & 1], O[1][dt]);
        }
        __builtin_amdgcn_sched_barrier(0);
      }
    }
    if (kt + 1 < NT) lwrite((kt + 1) & 1);
    __syncthreads();
  }

  const float l1 = lrun[0] + __shfl_xor(lrun[0], 32);
  const float l2 = lrun[1] + __shfl_xor(lrun[1], 32);
  const float i1 = 1.f / l1, i2 = lam / l2;
  float ssq = 0.f;
#pragma unroll
  for (int dt = 0; dt < 4; dt++)
#pragma unroll
    for (int r = 0; r < 16; r++) {
      float o = O[0][dt][r] * i1 - O[1][dt][r] * i2;
      O[0][dt][r] = o;
      ssq += o * o;
    }
  ssq += __shfl_xor(ssq, 32);
  const float rstd = rsqrtf(ssq * (1.f / 128.f) + EPS) * outscale;
  const float* gsub = p->subln + layer * 128;
#pragma unroll
  for (int dt = 0; dt < 4; dt++)
#pragma unroll
    for (int rq = 0; rq < 4; rq++) {
      const int d0 = dt * 32 + rq * 8 + g * 4;
      float4 gg = *(const float4*)(gsub + d0);
      u32x2 pk = {pack_bf2(O[0][dt][rq * 4 + 0] * rstd * gg.x, O[0][dt][rq * 4 + 1] * rstd * gg.y),
                  pack_bf2(O[0][dt][rq * 4 + 2] * rstd * gg.z, O[0][dt][rq * 4 + 3] * rstd * gg.w)};
      *(u32x2*)(p->att + (size_t)tok_q * 512 + h * 128 + d0) = pk;
    }
}

DI void s5_store_u(const u32x4 a, const u32x4 bq, int lane, float* ul) {
  float4* d = (float4*)(ul + lane * 16);
  d[0] = make_float4(__uint_as_float(a[0] << 16), __uint_as_float(a[0] & 0xffff0000u), __uint_as_float(a[1] << 16), __uint_as_float(a[1] & 0xffff0000u));
  d[1] = make_float4(__uint_as_float(a[2] << 16), __uint_as_float(a[2] & 0xffff0000u), __uint_as_float(a[3] << 16), __uint_as_float(a[3] & 0xffff0000u));
  d[2] = make_float4(__uint_as_float(bq[0] << 16), __uint_as_float(bq[0] & 0xffff0000u), __uint_as_float(bq[1] << 16), __uint_as_float(bq[1] & 0xffff0000u));
  d[3] = make_float4(__uint_as_float(bq[2] << 16), __uint_as_float(bq[2] & 0xffff0000u), __uint_as_float(bq[3] << 16), __uint_as_float(bq[3] & 0xffff0000u));
}
DI void s5_load_u(KP p, int b, int g, int j, int lane, float* ul) {
  const u32x4* src = (const u32x4*)(p->u + (size_t)(b * SEQL + j * 64 + lane) * 512 + g * 16);
  const u32x4 a = src[0], bq = src[1];
  s5_store_u(a, bq, lane, ul);
}

DI float swap_half(float v, const int which) {
  const unsigned u = __float_as_uint(v);
  auto r = __builtin_amdgcn_permlane32_swap(u, u, false, false);
  return __uint_as_float(which ? r[1] : r[0]);
}

struct S5Coef { float arA, aiA, arB, aiB; };

template <bool STORE>
DI void s5_scan32(const float* ul_sub, const bf16x8 (&bfr)[4], const S5Coef& cf, float& xAr, float& xAi, float& xBr, float& xBi,
                  float* X, const int l32, const int grp) {
  bf16x8 af;
  {
    const float* us = ul_sub + l32 * 16 + grp * 8;
    float4 a = *(const float4*)us, bq = *(const float4*)(us + 4);
    u32x4 pk = {pack_bf2(a.x, a.y), pack_bf2(a.z, a.w), pack_bf2(bq.x, bq.y), pack_bf2(bq.z, bq.w)};
    af = __builtin_bit_cast(bf16x8, pk);
  }
  f32x16 zero;
#pragma unroll
  for (int r = 0; r < 16; r++) zero[r] = 0.f;
  const f32x16 bu0 = MFMA(af, bfr[0], zero), bu1 = MFMA(af, bfr[1], zero), bu2 = MFMA(af, bfr[2], zero), bu3 = MFMA(af, bfr[3], zero);
#pragma unroll
  for (int k = 0; k < 8; k++) {
    float sAr[4], sAi[4], sBr[4], sBi[4];
#pragma unroll
    for (int i = 0; i < 4; i++) {
      const int r = (k >> 1) * 4 + i;
      const float nAr = cf.arA * xAr - cf.aiA * xAi + bu0[r];
      const float nAi = cf.arA * xAi + cf.aiA * xAr + bu2[r];
      const float nBr = cf.arB * xBr - cf.aiB * xBi + bu1[r];
      const float nBi = cf.arB * xBi + cf.aiB * xBr + bu3[r];
      xAr = nAr; xAi = nAi; xBr = nBr; xBi = nBi;
      sAr[i] = nAr; sAi[i] = nAi; sBr[i] = nBr; sBi[i] = nBi;
    }
    if (STORE) {
      if (grp == (k & 1)) {
#pragma unroll
        for (int i = 0; i < 4; i++) {
          float* xr = X + (4 * k + i) * 132;
          xr[l32] = sAr[i]; xr[64 + l32] = sAi[i]; xr[32 + l32] = sBr[i]; xr[96 + l32] = sBi[i];
        }
      }
    }
    xAr = swap_half(xAr, k & 1); xAi = swap_half(xAi, k & 1);
    xBr = swap_half(xBr, k & 1); xBi = swap_half(xBi, k & 1);
  }
}

DI void s5_setup(KP p, int layer, int g, int l32, int grp, S5Coef& cf, bf16x8 (&bfr)[4]) {
  const float* t0 = p->s5tab + (size_t)((layer * 32 + g) * 64) * 40;
  cf.arA = t0[l32 * 40]; cf.aiA = t0[l32 * 40 + 1];
  cf.arB = t0[(32 + l32) * 40]; cf.aiB = t0[(32 + l32) * 40 + 1];
#pragma unroll
  for (int jt = 0; jt < 4; jt++) {
    const float* src = t0 + (l32 + 32 * (jt & 1)) * 40 + 4 + (jt >> 1) * 16 + grp * 8;
    float4 a = *(const float4*)src, bq = *(const float4*)(src + 4);
    u32x4 pk = {pack_bf2(a.x, a.y), pack_bf2(a.z, a.w), pack_bf2(bq.x, bq.y), pack_bf2(bq.z, bq.w)};
    bfr[jt] = __builtin_bit_cast(bf16x8, pk);
  }
}

__device__ __forceinline__ void s5_pass1(KP p, int layer, char* smem, const int tid) {
  const int lane = tid & 63, w = tid >> 6, l32 = lane & 31, grp = lane >> 5;
  float* ul = (float*)(smem + w * 4096);
  for (int wbase = blockIdx.x * 4; wbase < 1024; wbase += gridDim.x * 4) {
    const int wi = wbase + w;
    const int j0 = (wi & 15) * 8, g = (wi >> 4) & 31, b = wi >> 9;
    S5Coef cf; bf16x8 bfr[4];
    s5_setup(p, layer, g, l32, grp, cf, bfr);
    const u32x4* src = (const u32x4*)(p->u + (size_t)(b * SEQL + j0 * 64 + lane) * 512 + g * 16);
    u32x4 v0 = src[0], v1 = src[1];
    for (int jj = 0; jj < 8; jj++) {
      const int j = j0 + jj;
      s5_store_u(v0, v1, lane, ul);
      if (jj < 7) {
        const u32x4* nsrc = (const u32x4*)(p->u + (size_t)(b * SEQL + (j + 1) * 64 + lane) * 512 + g * 16);
        v0 = nsrc[0]; v1 = nsrc[1];
      }
      __syncthreads();
      float xAr = 0.f, xAi = 0.f, xBr = 0.f, xBi = 0.f;
      s5_scan32<false>(ul, bfr, cf, xAr, xAi, xBr, xBi, nullptr, l32, grp);
      s5_scan32<false>(ul + 32 * 16, bfr, cf, xAr, xAi, xBr, xBi, nullptr, l32, grp);
      float* so = p->sloc + (size_t)((b * 32 + g) * 128 + j) * 128;
      so[lane] = grp ? xBr : xAr; so[64 + lane] = grp ? xBi : xAi;
      __syncthreads();
    }
  }
}

__device__ __forceinline__ void s5_pass2(KP p, int layer, char* smem, const int tid) {
  const int lane = tid & 63, w = tid >> 6;
  float* ul = (float*)(smem + w * 21504);
  float* X = ul + 1024;
  const int l32 = lane & 31, grp = lane >> 5;
  for (int wbase = blockIdx.x * 4; wbase < 1024; wbase += gridDim.x * 4) {
   const int wi = wbase + w;
   const int j0 = (wi & 15) * 8, g = (wi >> 4) & 31, b = wi >> 9;
   S5Coef cf; bf16x8 bfr[4];
   s5_setup(p, layer, g, l32, grp, cf, bfr);
   bf16x8 cfr[8];
   {
     const int c = l32 & 15;
     const float* cr = p->c_re + (size_t)((layer * 32 + g) * 16 + c) * 64;
     const float* ci = p->c_im + (size_t)((layer * 32 + g) * 16 + c) * 64;
#pragma unroll
     for (int s8 = 0; s8 < 8; s8++) {
       const int k0 = (s8 & 3) * 16 + grp * 8;
       const float* src = (s8 < 4) ? (cr + k0) : (ci + k0);
       const float sg = (l32 < 16) ? ((s8 < 4) ? 1.f : -1.f) : 0.f;
       float4 a = *(const float4*)src, bq = *(const float4*)(src + 4);
       u32x4 pk = {pack_bf2(a.x * sg, a.y * sg), pack_bf2(a.z * sg, a.w * sg), pack_bf2(bq.x * sg, bq.y * sg), pack_bf2(bq.z * sg, bq.w * sg)};
       cfr[s8] = __builtin_bit_cast(bf16x8, pk);
     }
   }
   const float dd = p->ssm_d[(size_t)(layer * 32 + g) * 16 + (l32 & 15)];
   float xAr, xAi, xBr, xBi;
   {
     const float* tb = p->s5tab + (size_t)((layer * 32 + g) * 64 + lane) * 40;
     const float aTr = tb[2], aTi = tb[3];
     float xr = 0.f, xi = 0.f;
     const float* sl = p->sloc + (size_t)((b * 32 + g) * 128) * 128;
     for (int i0 = 0; i0 < j0; i0 += 8) {
       float sr[8], si[8];
#pragma unroll
       for (int q = 0; q < 8; q++) { sr[q] = sl[(i0 + q) * 128 + lane]; si[q] = sl[(i0 + q) * 128 + 64 + lane]; }
#pragma unroll
       for (int q = 0; q < 8; q++) {
         const float nr = aTr * xr - aTi * xi + sr[q];
         const float ni = aTr * xi + aTi * xr + si[q];
         xr = nr; xi = ni;
       }
     }
     xAr = swap_half(xr, 0); xBr = swap_half(xr, 1);
     xAi = swap_half(xi, 0); xBi = swap_half(xi, 1);
   }
   for (int jj = 0; jj < 8; jj++) {
    const int j = j0 + jj;
    s5_load_u(p, b, g, j, lane, ul);
    __syncthreads();
    for (int sub = 0; sub < 2; sub++) {
      s5_scan32<true>(ul + sub * 32 * 16, bfr, cf, xAr, xAi, xBr, xBi, X, l32, grp);
      __syncthreads();
      f32x16 yacc;
#pragma unroll
      for (int r = 0; r < 16; r++) yacc[r] = 0.f;
#pragma unroll
      for (int s8 = 0; s8 < 8; s8++) {
        const float* xs = X + l32 * 132 + ((s8 < 4) ? 0 : 64) + (s8 & 3) * 16 + grp * 8;
        float4 a = *(const float4*)xs, bq = *(const float4*)(xs + 4);
        u32x4 pk = {pack_bf2(a.x, a.y), pack_bf2(a.z, a.w), pack_bf2(bq.x, bq.y), pack_bf2(bq.z, bq.w)};
        yacc = MFMA(__builtin_bit_cast(bf16x8, pk), cfr[s8], yacc);
      }
      if (l32 < 16) {
#pragma unroll
        for (int r = 0; r < 16; r++) {
          const int tl = sub * 32 + (r >> 2) * 8 + grp * 4 + (r & 3);
          const float yv = yacc[r] + dd * ul[tl * 16 + l32];
          p->gy[(size_t)(b * SEQL + j * 64 + tl) * 512 + g * 16 + l32] = f2bf(gelu_tanh(yv));
        }
      }
      __syncthreads();
    }
   }
  }
}

__device__ __forceinline__ void phase_attn(KP p, int layer, char* smem, const int tid) {
  const int lane = tid & 63;
  const float s1 = wave_sum(p->lq1[layer * 64 + lane] * p->lk1[layer * 64 + lane]);
  const float s2 = wave_sum(p->lq2[layer * 64 + lane] * p->lk2[layer * 64 + lane]);
  const float lam_init = 0.8f - 0.6f * expf(-0.3f * (float)layer);
  const float lam = expf(s1) - expf(s2) + lam_init;
  for (int pb = blockIdx.x; pb < 256; pb += gridDim.x) {
    const int pi = (pb & 7) * 32 + (pb >> 3);
    const int b = pi >> 7, h = (pi >> 5) & 3, i = pi & 31;
    attn_item(p, layer, b, h, 63 - i, lam, 1.f - lam_init, smem, tid);
    attn_item(p, layer, b, h, i, lam, 1.f - lam_init, smem, tid);
  }
  s5_pass1(p, layer, smem, tid);
}

__device__ __forceinline__ void phase_final(KP p, const int tid) {
  const int wave = tid >> 6, lane = tid & 63;
  const float* ssq = p->ss + (size_t)8 * 8 * NTOK;
  for (int row = blockIdx.x * 4 + wave; row < NTOK; row += gridDim.x * 4) {
    const float rstd = rsqrtf(ss_sum1(ssq, row) * (1.f / 1024.f) + EPS);
#pragma unroll
    for (int i = 0; i < 4; i++) {
      float4 v = ((const float4*)(p->xf + (size_t)row * DM))[lane + 64 * i];
      float4 gq = ((const float4*)p->norm_final)[lane + 64 * i];
      float4 o = {v.x * rstd * gq.x, v.y * rstd * gq.y, v.z * rstd * gq.z, v.w * rstd * gq.w};
      ((float4*)(p->out + (size_t)row * DM))[lane + 64 * i] = o;
    }
  }
}

__device__ __forceinline__ void run_phase(KP p, int ph, char* smem) {
  const int tid = opaque_tid();
  if (ph == 0) { phase_prep(p, smem, tid); return; }
  if (ph == 29) { phase_final(p, tid); return; }
  const int layer = (ph - 1) / 7, k = (ph - 1) % 7;
  const int nb = gridDim.x, bid = blockIdx.x;
  if (k == 1) { phase_attn(p, layer, smem, tid); return; }
  if (k == 2) { s5_pass2(p, layer, smem, tid); return; }
  if (k == 0) { for (int r = 0; ; r++) { const int t = (r * 8 + (bid & 7)) * (nb >> 3) + (bid >> 3); if (r * nb >= 512) break; if (t < 512) gemm_tile(p, G_IN, layer, t, smem, tid); } }
  else if (k == 3) { for (int r = 0; ; r++) { const int t = (r * 8 + (bid & 7)) * (nb >> 3) + (bid >> 3); if (r * nb >= 256) break; if (t < 256) gemm_tile(p, G_GLU, layer, t, smem, tid); } }
  else if (k == 4) { for (int r = 0; ; r++) { const int t = (r * 8 + (bid & 7)) * (nb >> 3) + (bid >> 3); if (r * nb >= 256) break; if (t < 256) gemm_tile(p, G_WOUT, layer, t, smem, tid); } }
  else if (k == 5) { for (int r = 0; ; r++) { const int t = (r * 8 + (bid & 7)) * (nb >> 3) + (bid >> 3); if (r * nb >= 2 * 33 * 22) break; if (t < 2 * 33 * 22) gemm_tile(p, G_UP, layer, t, smem, tid); } }
  else { for (int r = 0; ; r++) { const int t = (r * 8 + (bid & 7)) * (nb >> 3) + (bid >> 3); if (r * nb >= 256) break; if (t < 256) gemm_tile(p, G_DOWN, layer, t, smem, tid); } }
}

#define PHASE_KERNEL(name, body)                                                      \
  __global__ void __launch_bounds__(256) name(Params p_unused) {                      \
    extern __shared__ __attribute__((aligned(16))) char smem[];                       \
    KP p = (KP)__builtin_amdgcn_kernarg_segment_ptr();                                \
    const int tid = threadIdx.x, nb = gridDim.x, bid = blockIdx.x;                    \
    const int layer = (int)p->phase_lo;                                               \
    (void)nb; (void)bid; (void)layer;                                                 \
    body                                                                              \
  }
PHASE_KERNEL(k_prep, phase_prep(p, smem, tid);)
PHASE_KERNEL(k_gin, for (int r = 0; ; r++) { const int t = (r * 8 + (bid & 7)) * (nb >> 3) + (bid >> 3); if (r * nb >= 512) break; if (t < 512) gemm_tile(p, G_IN, layer, t, smem, tid); })
PHASE_KERNEL(k_attn, phase_attn(p, layer, smem, tid);)
PHASE_KERNEL(k_s5p2, s5_pass2(p, layer, smem, tid);)
PHASE_KERNEL(k_glu, for (int r = 0; ; r++) { const int t = (r * 8 + (bid & 7)) * (nb >> 3) + (bid >> 3); if (r * nb >= 256) break; if (t < 256) gemm_tile(p, G_GLU, layer, t, smem, tid); })
PHASE_KERNEL(k_wout, for (int r = 0; ; r++) { const int t = (r * 8 + (bid & 7)) * (nb >> 3) + (bid >> 3); if (r * nb >= 256) break; if (t < 256) gemm_tile(p, G_WOUT, layer, t, smem, tid); })
PHASE_KERNEL(k_up, for (int r = 0; ; r++) { const int t = (r * 8 + (bid & 7)) * (nb >> 3) + (bid >> 3); if (r * nb >= 2 * 33 * 22) break; if (t < 2 * 33 * 22) gemm_tile(p, G_UP, layer, t, smem, tid); })
PHASE_KERNEL(k_down, for (int r = 0; ; r++) { const int t = (r * 8 + (bid & 7)) * (nb >> 3) + (bid >> 3); if (r * nb >= 256) break; if (t < 256) gemm_tile(p, G_DOWN, layer, t, smem, tid); })
PHASE_KERNEL(k_final, phase_final(p, tid);)

#if COOP
__global__ void __launch_bounds__(256) mega_kernel(Params p_unused) {
  extern __shared__ __attribute__((aligned(16))) char smem[];
  KP p0 = (KP)__builtin_amdgcn_kernarg_segment_ptr();
  const int ph_lo = (int)p0->phase_lo, ph_hi = (int)p0->phase_hi;
#if COOP
  if (ph_hi > 1000) cg::this_grid().sync();
#endif
#if COOP
  {
    volatile unsigned* st = (volatile unsigned*)(smem + 136192);
    if (threadIdx.x == 0) { st[0] = 0u; st[1] = 0u; xb_add(&p0->bar[XB_CNT(xb_xcc_id())], 1u); }
  }
#endif
  for (int ph = ph_lo; ph < ph_hi; ph++) {
    KP p = p0;
    asm volatile("" : "+s"(p));
#if TPROBE
    if (blockIdx.x == 0) p->ts[ph] = (long long)wall_clock64();
#endif
    run_phase(p, ph, smem);
#if COOP
    if (ph + 1 < ph_hi) {
      if (ph == ph_lo) grid_barrier(p->bar, gridDim.x, opaque_tid());
      else xcd_barrier(p->bar, (volatile unsigned*)(smem + 136192), opaque_tid());
    }
#endif
  }
#if TPROBE
  grid_barrier(p0->bar, (unsigned)(ph_hi - ph_lo) * gridDim.x, opaque_tid());
  if (blockIdx.x == 0) {
    KP p = p0;
    long long tend = (long long)wall_clock64();
    float a = 0.f, b = 0.f;
    for (int ph = 0; ph < 30; ph++) {
      long long t0 = p->ts[ph], t1 = (ph == 29) ? tend : p->ts[ph + 1];
      int c = (ph == 0) ? 0 : (ph == 29 ? 8 : 1 + (ph - 1) % 7);
      float d = (float)(t1 - t0) * 0.01f;
      if (c == TP_A || TP_A == 9) a += d;
      if (c == TP_B || TP_B == 9) b += d;
    }
    const int t = opaque_tid();
    if (t <= 100) p->out[t] += (t == 0) ? a : b;
  }
#endif
}

#endif

extern "C" void kernel_launch(void* const* d_in, const int* in_sizes, int n_in, void* d_out, int out_size, void* d_ws,
                              size_t ws_size, hipStream_t stream) {
  static int grid_blocks = 0;
  if (!grid_blocks) {
    int dev = 0, cus = 0, per_cu = 0;
    (void)hipGetDevice(&dev);
    (void)hipDeviceGetAttribute(&cus, hipDeviceAttributeMultiprocessorCount, dev);
#if COOP
    (void)hipFuncSetAttribute((const void*)mega_kernel, hipFuncAttributeMaxDynamicSharedMemorySize, LDS_BYTES);
    (void)hipOccupancyMaxActiveBlocksPerMultiprocessor(&per_cu, (const void*)mega_kernel, 256, LDS_BYTES);
    if (per_cu < 1) { fprintf(stderr, "occupancy query returned %d\n", per_cu); per_cu = 1; }
#endif
    grid_blocks = cus;
    (void)hipGetLastError();
  }
  Params p{};
  p.x = (const float*)d_in[0]; p.pos = (const int*)d_in[1];
  p.norm_mix = (const float*)d_in[2]; p.w_in = (const float*)d_in[3];
  p.lam_re = (const float*)d_in[4]; p.lam_im = (const float*)d_in[5]; p.log_step = (const float*)d_in[6];
  p.b_re = (const float*)d_in[7]; p.b_im = (const float*)d_in[8]; p.c_re = (const float*)d_in[9]; p.c_im = (const float*)d_in[10];
  p.ssm_d = (const float*)d_in[11]; p.w_glu = (const float*)d_in[12]; p.ssm_norm = (const float*)d_in[13];
  p.lq1 = (const float*)d_in[14]; p.lk1 = (const float*)d_in[15]; p.lq2 = (const float*)d_in[16]; p.lk2 = (const float*)d_in[17];
  p.subln = (const float*)d_in[18]; p.w_out = (const float*)d_in[19]; p.norm_ffn = (const float*)d_in[20];
  p.w_up = (const float*)d_in[21]; p.w_conv = (const float*)d_in[22]; p.b_conv = (const float*)d_in[23];
  p.w_down = (const float*)d_in[24]; p.norm_final = (const float*)d_in[25];
  p.out = (float*)d_out;
  char* ws = (char*)d_ws;
  size_t off = 0;
  auto take = [&](size_t bytes) { char* r = ws + off; off += (bytes + 255) & ~(size_t)255; return r; };
  p.WinT = (bf16_t*)take((size_t)4 * 2048 * 1024 * 2);
  p.WgluT = (bf16_t*)take((size_t)4 * 1024 * 512 * 2);
  p.WoutT = (bf16_t*)take((size_t)4 * 1024 * 1024 * 2);
  p.WupT = (bf16_t*)take((size_t)4 * 5632 * 1024 * 2);
  p.WdownT = (bf16_t*)take((size_t)4 * 1024 * FFN * 2);
  p.xf = (float*)take((size_t)NTOK * DM * 4);
  p.xb = (bf16_t*)take((size_t)NTOK * DM * 2);
  p.ss = (float*)take((size_t)9 * 8 * NTOK * 4);
  p.ssm_ss = (float*)take((size_t)4 * 8 * NTOK * 4);
  p.cs = (float*)take((size_t)NTOK * 16 * 4);
  p.s5tab = (float*)take((size_t)4 * 32 * 64 * 40 * 4);
  p.sloc = (float*)take((size_t)2 * 32 * 128 * 128 * 4);
  p.ts = (long long*)take(256);
  p.bar = (unsigned*)take(XB_WORDS * 4);
  char* region = take((size_t)134217728);
  p.u = (bf16_t*)region;
  p.q = (bf16_t*)(region + 33554432);
  p.k = p.q + (size_t)NTOK * 512;
  p.vt = p.k + (size_t)NTOK * 512;
  p.gy = p.vt + (size_t)NTOK * 512;
  p.outg = p.gy + (size_t)NTOK * 512;
  p.att = p.outg + (size_t)NTOK * 512;
  p.act = (bf16_t*)region;
  if (off > ws_size) { fprintf(stderr, "workspace too small: need %zu have %zu\n", off, ws_size); return; }
#if COOP
  p.phase_lo = 0; p.phase_hi = 30;
  if (hipMemsetAsync(p.bar, 0, XB_WORDS * 4, stream) != hipSuccess) fprintf(stderr, "barrier memset failed\n");
  void* args[] = {&p};
  hipError_t e = hipLaunchCooperativeKernel((const void*)mega_kernel, dim3(grid_blocks), dim3(256), args, LDS_BYTES, stream);
  if (e != hipSuccess) fprintf(stderr, "cooperative launch failed: %s (grid %d)\n", hipGetErrorString(e), grid_blocks);
#else
  typedef void (*kfn)(Params);
  const kfn seq[7] = {k_gin, k_attn, k_s5p2, k_glu, k_wout, k_up, k_down};
  static bool attr_done = false;
  if (!attr_done) {
    (void)hipFuncSetAttribute((const void*)k_prep, hipFuncAttributeMaxDynamicSharedMemorySize, LDS_BYTES);
    (void)hipFuncSetAttribute((const void*)k_final, hipFuncAttributeMaxDynamicSharedMemorySize, LDS_BYTES);
    for (int i = 0; i < 7; i++) (void)hipFuncSetAttribute((const void*)seq[i], hipFuncAttributeMaxDynamicSharedMemorySize, LDS_BYTES);
    attr_done = true;
  }
  p.phase_lo = 0; p.phase_hi = 0;
  hipLaunchKernelGGL(k_prep, dim3(grid_blocks), dim3(256), LDS_BYTES, stream, p);
  for (int layer = 0; layer < 4; layer++) {
    p.phase_lo = layer;
    for (int i = 0; i < 7; i++) hipLaunchKernelGGL(seq[i], dim3(grid_blocks), dim3(256), LDS_BYTES, stream, p);
  }
  hipLaunchKernelGGL(k_final, dim3(grid_blocks), dim3(256), LDS_BYTES, stream, p);
#endif
}
```

```cpp
#include <hip/hip_runtime.h>
#include <hip/hip_cooperative_groups.h>
#include <cstdio>
namespace cg = cooperative_groups;

#ifndef COOP
#define COOP 1
#endif
#ifndef TPROBE
#define TPROBE 0
#endif
#ifndef TP_A
#define TP_A 1
#endif
#ifndef TP_B
#define TP_B 2
#endif

typedef unsigned short bf16_t;
typedef __attribute__((ext_vector_type(8))) short bf16x8;
typedef __attribute__((ext_vector_type(16))) float f32x16;
typedef __attribute__((ext_vector_type(2))) __bf16 bf2_t;
typedef __attribute__((ext_vector_type(2))) float f2_t;
typedef __attribute__((ext_vector_type(4))) unsigned u32x4;
typedef __attribute__((ext_vector_type(2))) unsigned u32x2;

#define DI __device__ __forceinline__
#define MFMA(a, b, c) __builtin_amdgcn_mfma_f32_32x32x16_bf16((a), (b), (c), 0, 0, 0)

constexpr int NTOK = 16384, DM = 1024, SEQL = 8192, FFN = 2816;
constexpr int LDS_BYTES = 136208;
constexpr float EPS = 1e-6f;

struct Params {
  const float* x; const int* pos;
  const float *norm_mix, *w_in, *lam_re, *lam_im, *log_step, *b_re, *b_im, *c_re, *c_im, *ssm_d, *w_glu, *ssm_norm;
  const float *lq1, *lk1, *lq2, *lk2, *subln, *w_out, *norm_ffn, *w_up, *w_conv, *b_conv, *w_down, *norm_final;
  float* out;
  bf16_t *WinT, *WgluT, *WoutT, *WupT, *WdownT;
  float* xf; bf16_t* xb;
  bf16_t *u, *q, *k, *vt, *gy, *outg, *att, *act;
  float *ss, *ssm_ss, *cs, *s5tab, *sloc;
  long long phase_lo, phase_hi;
  long long* ts;
  unsigned* bar;
};

typedef const __attribute__((address_space(4))) Params* KP;

DI unsigned pack_bf2(float a, float b) { f2_t v = {a, b}; return __builtin_bit_cast(unsigned, __builtin_convertvector(v, bf2_t)); }
DI bf16_t f2bf(float a) { return (bf16_t)(pack_bf2(a, 0.f) & 0xffffu); }
DI float bf2f(bf16_t v) { return __uint_as_float(((unsigned)v) << 16); }
DI void grid_barrier(unsigned* ctr, unsigned target, int tid) {
  asm volatile("s_waitcnt vmcnt(0)" ::: "memory");
  __syncthreads();
  if (tid == 0) {
    __builtin_amdgcn_fence(__ATOMIC_RELEASE, "agent");
    asm volatile("s_waitcnt vmcnt(0)" ::: "memory");
    __hip_atomic_fetch_add(ctr, 1u, __ATOMIC_RELAXED, __HIP_MEMORY_SCOPE_AGENT);
    while (__hip_atomic_load(ctr, __ATOMIC_RELAXED, __HIP_MEMORY_SCOPE_AGENT) < target) __builtin_amdgcn_s_sleep(1);
    __builtin_amdgcn_fence(__ATOMIC_ACQUIRE, "agent");
    asm volatile("s_waitcnt vmcnt(0)" ::: "memory");
  }
  __syncthreads();
}
#define XB_CNT(j)  (64 + 64 * (j))
#define XB_SUB(j)  (1088 + 64 * (j))
#define XB_GEN(j)  (2112 + 64 * (j))
#define XB_TOP     3136
#define XB_TOPGEN  3200
#define XB_WORDS   3264
DI unsigned xb_ld(unsigned* q) { return __hip_atomic_load(q, __ATOMIC_RELAXED, __HIP_MEMORY_SCOPE_AGENT); }
DI unsigned xb_add(unsigned* q, unsigned v) { return __hip_atomic_fetch_add(q, v, __ATOMIC_RELAXED, __HIP_MEMORY_SCOPE_AGENT); }
DI unsigned xb_xcc_id() { return (unsigned)__builtin_amdgcn_s_getreg((3 << 11) | 20) & 0xFu; }
DI void xcd_barrier(unsigned* bar, volatile unsigned* st, int tid) {
  asm volatile("s_waitcnt vmcnt(0)" ::: "memory");
  __syncthreads();
  if (tid == 0) {
    const unsigned x = xb_xcc_id();
    unsigned nloc = st[0], nx = st[1];
    if (nloc == 0u) {
      unsigned cnt = 0u, mine = 1u;
#pragma unroll
      for (unsigned j = 0; j < 16; ++j) { const unsigned c = xb_ld(&bar[XB_CNT(j)]); cnt += (c > 0u) ? 1u : 0u; mine = (j == x) ? c : mine; }
      nloc = mine > 0u ? mine : 1u; nx = cnt > 0u ? cnt : 1u;
      st[0] = nloc; st[1] = nx;
    }
    const unsigned old = xb_add(&bar[XB_SUB(x)], 1u);
    const unsigned gen = old / nloc;
    if (old + 1u == (gen + 1u) * nloc) {
      __builtin_amdgcn_fence(__ATOMIC_RELEASE, "agent");
      asm volatile("s_waitcnt vmcnt(0)" ::: "memory");
      const unsigned og = xb_add(&bar[XB_TOP], 1u);
      const unsigned tg = og / nx;
      if (og + 1u == (tg + 1u) * nx) xb_add(&bar[XB_TOPGEN], 1u);
      else { while (xb_ld(&bar[XB_TOPGEN]) == tg) __builtin_amdgcn_s_sleep(1); }
      __builtin_amdgcn_fence(__ATOMIC_ACQUIRE, "agent");
      xb_add(&bar[XB_GEN(x)], 1u);
      asm volatile("s_waitcnt vmcnt(0)" ::: "memory");
    } else {
      while (xb_ld(&bar[XB_GEN(x)]) == gen) __builtin_amdgcn_s_sleep(1);
      __builtin_amdgcn_fence(__ATOMIC_ACQUIRE, "agent");
      asm volatile("s_waitcnt vmcnt(0)" ::: "memory");
    }
  }
  __syncthreads();
}
DI int opaque_tid() { int t = threadIdx.x; asm volatile("" : "+v"(t)); return t; }
DI float4 ss_sum4(const float* base, int row0) {
  float4 a = *(const float4*)(base + row0);
#pragma unroll
  for (int pz = 1; pz < 8; pz++) {
    float4 b = *(const float4*)(base + (size_t)pz * NTOK + row0);
    a.x += b.x; a.y += b.y; a.z += b.z; a.w += b.w;
  }
  return a;
}
DI float ss_sum1(const float* base, int row) {
  float a = base[row];
#pragma unroll
  for (int pz = 1; pz < 8; pz++) a += base[(size_t)pz * NTOK + row];
  return a;
}
DI float wave_sum(float v) { for (int o = 32; o; o >>= 1) v += __shfl_xor(v, o); return v; }
DI float fast_exp2(float x) { return __builtin_amdgcn_exp2f(x); }
DI float gelu_tanh(float x) {
  float z = 0.7978845608028654f * (x + 0.044715f * x * x * x);
  float e = __expf(2.f * z);
  float t = 1.f - 2.f / (1.f + e);
  return 0.5f * x * (1.f + t);
}
DI float reduce_2pi(double a) {
  double n = rint(a * 0.15915494309189535);
  return (float)(a - n * 6.283185307179586);
}

DI void transpose_tile(const float* src, int ldsrc, int k0, int c0, const float* scale, int nscale,
                       bf16_t* dst, int lddst, int n0, float* lds, const int tid) {
#pragma unroll
  for (int i = 0; i < 16; i++) {
    int kk = i * 4 + (tid >> 6), nn = tid & 63;
    float v = src[(size_t)(k0 + kk) * ldsrc + c0 + nn];
    if (scale != nullptr && (k0 + kk) < nscale) v *= scale[k0 + kk];
    lds[kk * 65 + nn] = v;
  }
  __syncthreads();
  {
    int nn = tid >> 2, kq = (tid & 3) * 16;
    unsigned pk[8];
#pragma unroll
    for (int i = 0; i < 8; i++) pk[i] = pack_bf2(lds[(kq + 2 * i) * 65 + nn], lds[(kq + 2 * i + 1) * 65 + nn]);
    u32x4* d = (u32x4*)(dst + (size_t)(n0 + nn) * lddst + k0 + kq);
    u32x4 a = {pk[0], pk[1], pk[2], pk[3]}, b = {pk[4], pk[5], pk[6], pk[7]};
    d[0] = a; d[1] = b;
  }
  __syncthreads();
}

DI void wtask(const float* src, int ldsrc, int k0, int c0, const float* scale, int nscale, bf16_t* dst, int lddst, int n0, int lane) {
  float v[32];
  const float* sp = src + (size_t)k0 * ldsrc + c0 + lane;
#pragma unroll
  for (int i = 0; i < 32; i++) v[i] = sp[(size_t)i * ldsrc];
  if (k0 < nscale) {
#pragma unroll
    for (int i = 0; i < 32; i++) v[i] *= scale[k0 + i];
  }
  u32x4* d = (u32x4*)(dst + (size_t)(n0 + lane) * lddst + k0);
#pragma unroll
  for (int q = 0; q < 4; q++) {
    u32x4 o = {pack_bf2(v[8 * q], v[8 * q + 1]), pack_bf2(v[8 * q + 2], v[8 * q + 3]), pack_bf2(v[8 * q + 4], v[8 * q + 5]), pack_bf2(v[8 * q + 6], v[8 * q + 7])};
    d[q] = o;
  }
}

__device__ __forceinline__ void phase_prep(KP p, char* smem, const int tid) {
  const int nb = gridDim.x, bid = blockIdx.x;
  const int wave = tid >> 6, lane = tid & 63;
  for (int row = bid * 4 + wave; row < NTOK; row += nb * 4) {
    const float4* src = (const float4*)(p->x + (size_t)row * DM);
    float s = 0.f;
#pragma unroll
    for (int i = 0; i < 4; i++) {
      float4 v = src[lane + 64 * i];
      s += v.x * v.x + v.y * v.y + v.z * v.z + v.w * v.w;
      ((float4*)(p->xf + (size_t)row * DM))[lane + 64 * i] = v;
      u32x2 pk = {pack_bf2(v.x, v.y), pack_bf2(v.z, v.w)};
      ((u32x2*)(p->xb + (size_t)row * DM))[lane + 64 * i] = pk;
    }
    s = wave_sum(s);
    if (lane < 8) p->ss[(size_t)lane * NTOK + row] = (lane == 0) ? s : 0.f;
  }
  for (int i = bid * 256 + tid; i < NTOK * 8; i += nb * 256) {
    int tok = i >> 3, j = i & 7;
    double inv = (j & 4) ? ((j & 2) ? ((j & 1) ? 1.031338537721246e-05 : 5.318295896944988e-05) : ((j & 1) ? 0.0002742481756762073 : 0.001414213562373095))
                         : ((j & 2) ? ((j & 1) ? 0.007292664737217109 : 0.03760603093086393) : ((j & 1) ? 0.19392274474868576 : 1.0));
    double ang = (double)p->pos[tok] * inv;
    float r = reduce_2pi(ang);
    p->cs[2 * i] = cosf(r); p->cs[2 * i + 1] = sinf(r);
  }
  for (int i = bid * 256 + tid; i < 4 * 32 * 64; i += nb * 256) {
    int lg = i >> 6;
    float lr = p->lam_re[i], li = p->lam_im[i];
    float step = expf(p->log_step[lg]);
    float mag = expf(step * lr);
    double angd = (double)step * (double)li;
    float r1 = reduce_2pi(angd);
    float ar = mag * cosf(r1), ai = mag * sinf(r1);
    float den = lr * lr + li * li;
    float fr = ((ar - 1.f) * lr + ai * li) / den;
    float fi = (ai * lr - (ar - 1.f) * li) / den;
    float magT = expf(64.f * step * lr);
    float rT = reduce_2pi(64.0 * angd);
    float* tb = p->s5tab + (size_t)i * 40;
    tb[0] = ar; tb[1] = ai; tb[2] = magT * cosf(rT); tb[3] = magT * sinf(rT);
    for (int c = 0; c < 16; c++) {
      float br = p->b_re[(size_t)i * 16 + c], bi = p->b_im[(size_t)i * 16 + c];
      tb[4 + c] = fr * br - fi * bi;
      tb[20 + c] = fr * bi + fi * br;
    }
  }
  {
    const int NTASK = 4 * 6016;
    const int gw = bid * 4 + wave, nw = nb * 4;
    const int per = (NTASK + nw - 1) / nw;
    const int t_lo = gw * per, t_hi = min(t_lo + per, NTASK);
    for (int task = t_lo; task < t_hi; task++) {
      const int layer = task / 6016;
      int t = task % 6016;
      if (t < 1024) {
        const int a = t >> 5, kb = t & 31;
        wtask(p->w_in + (size_t)layer * 1024 * 2048, 2048, kb * 32, a * 64, p->norm_mix + layer * 1024, 1024,
              p->WinT + (size_t)layer * 2048 * 1024, 1024, a * 64, lane);
      } else if (t < 1280) {
        t -= 1024; const int a = t >> 4, kb = t & 15;
        wtask(p->w_glu + (size_t)layer * 512 * 1024, 1024, kb * 32, (a & 1) * 512 + (a >> 1) * 64, p->norm_mix, 0,
              p->WgluT + (size_t)layer * 1024 * 512, 512, a * 64, lane);
      } else if (t < 1792) {
        t -= 1280; const int a = t >> 5, kb = t & 31;
        wtask(p->w_out + (size_t)layer * 1024 * 1024, 1024, kb * 32, a * 64, p->ssm_norm + layer * 512, 512,
              p->WoutT + (size_t)layer * 1024 * 1024, 1024, a * 64, lane);
      } else if (t < 4608) {
        t -= 1792; const int a = t >> 5, kb = t & 31;
        wtask(p->w_up + (size_t)layer * 1024 * 5632, 5632, kb * 32, (a & 1) * FFN + (a >> 1) * 64, p->norm_ffn + layer * 1024, 1024,
              p->WupT + (size_t)layer * 5632 * 1024, 1024, a * 64, lane);
      } else {
        t -= 4608; const int a = t / 88, kb = t % 88;
        wtask(p->w_down + (size_t)layer * FFN * 1024, 1024, kb * 32, a * 64, p->norm_mix, 0,
              p->WdownT + (size_t)layer * 1024 * FFN, FFN, a * 64, lane);
      }
    }
  }
}

enum { G_IN = 0, G_GLU = 1, G_WOUT = 2, G_UP = 3, G_DOWN = 4 };
#define ACC_PIN(tag) _Pragma("unroll") for (int i_ = 0; i_ < 4; i_++) _Pragma("unroll") for (int j_ = 0; j_ < 4; j_++) asm volatile("; pin " tag : "+a"(acc[i_][j_]));


__device__ __forceinline__ void gemm_tile(KP p, const int MODE, int layer, int tile, char* smem, const int tid) {
  const int lane = tid & 63, w = tid >> 6, wm = w >> 1, wn = w & 1, g = lane >> 5, l32 = lane & 31;
  int tn, KT, ldb, rowbase, lda;
  const bf16_t* Bt;
  const bf16_t* A0;
  int upb = 0, upti = 0;
  {
    const int TM = (MODE == G_UP) ? 66 : 64;
    const int TN = (MODE == G_IN) ? 8 : (MODE == G_UP ? 22 : 4);
    const int nfull = TN >> 2, rem = TN & 3;
    int tm;
    if (tile < nfull * 4 * TM) { const int band = tile / (4 * TM), within = tile % (4 * TM); tm = within >> 2; tn = band * 4 + (within & 3); }
    else { const int s2 = tile - nfull * 4 * TM; tm = s2 / rem; tn = nfull * 4 + s2 % rem; }
    rowbase = tm * 256;
    if (MODE == G_UP) { upb = tm / 33; upti = tm % 33; rowbase = upb * SEQL + 254 * upti - 2; }
  }
  if (MODE == G_IN) { KT = 16; ldb = 1024; Bt = p->WinT + (size_t)layer * 2048 * 1024; A0 = p->xb; lda = 1024; }
  else if (MODE == G_GLU) { KT = 8; ldb = 512; Bt = p->WgluT + (size_t)layer * 1024 * 512; A0 = p->gy; lda = 512; }
  else if (MODE == G_WOUT) { KT = 16; ldb = 1024; Bt = p->WoutT + (size_t)layer * 1024 * 1024; A0 = p->outg; lda = 512; }
  else if (MODE == G_UP) { KT = 16; ldb = 1024; Bt = p->WupT + (size_t)layer * 5632 * 1024; A0 = p->xb; lda = 1024; }
  else { KT = 44; ldb = FFN; Bt = p->WdownT + (size_t)layer * 1024 * FFN; A0 = p->act; lda = FFN; }

  u32x4 ra[8], rb[8];
  const int lrow = tid >> 3, lc = tid & 7;
  float arow_sc[8];
#pragma unroll
  for (int i = 0; i < 8; i++) arow_sc[i] = 1.f;
  if (MODE == G_WOUT) {
    const float* ssq = p->ssm_ss + (size_t)layer * 8 * NTOK;
#pragma unroll
    for (int i = 0; i < 8; i++) arow_sc[i] = rsqrtf(ss_sum1(ssq, rowbase + lrow + 32 * i) * (1.f / 512.f) + EPS);
  }
  const bf16_t* bptr = Bt + (size_t)(tn * 256 + lrow) * ldb + lc * 8;
  auto gload = [&](int kt) {
    const bf16_t* abase = A0;
    int kofs = kt * 64;
    if (MODE == G_WOUT && kt >= 8) { abase = p->att; kofs = (kt - 8) * 64; }
#pragma unroll
    for (int i = 0; i < 8; i++) {
      int gr = min(max(rowbase + lrow + 32 * i, 0), NTOK - 1);
      ra[i] = *(const u32x4*)(abase + (size_t)gr * lda + kofs + lc * 8);
      rb[i] = *(const u32x4*)(bptr + (size_t)(32 * i) * ldb + kt * 64);
    }
  };
  auto scaleA = [&](int kt) {
    if (MODE == G_WOUT && kt < 8) {
#pragma unroll
      for (int i = 0; i < 8; i++)
#pragma unroll
        for (int e = 0; e < 4; e++) {
          unsigned v = ra[i][e];
          float lo = __uint_as_float(v << 16) * arow_sc[i], hi = __uint_as_float(v & 0xffff0000u) * arow_sc[i];
          ra[i][e] = pack_bf2(lo, hi);
        }
    }
  };
  const int wr_off = lrow * 128 + ((lc ^ ((lrow >> 1) & 7)) << 4);
  auto lwriteA = [&](int st) {
    char* sa = smem + st * 65536;
#pragma unroll
    for (int i = 0; i < 8; i++) *(u32x4*)(sa + wr_off + i * 4096) = ra[i];
  };
  auto lwriteB = [&](int st) {
    char* sb = smem + st * 65536 + 32768;
#pragma unroll
    for (int i = 0; i < 8; i++) *(u32x4*)(sb + wr_off + i * 4096) = rb[i];
  };

  f32x16 acc[4][4];
#pragma unroll
  for (int i = 0; i < 4; i++)
#pragma unroll
    for (int j = 0; j < 4; j++)
#pragma unroll
      for (int r = 0; r < 16; r++) acc[i][j][r] = 0.f;

  const int swz = (l32 >> 1) & 7;
  const int a_base = (wm * 128 + l32) * 128;
  const int b_base = 32768 + (wn * 128 + l32) * 128;
  bf16x8 af[2][4], bfr[2][4];
  auto lfrag = [&](int buf, const char* st, int ks) {
    const int coff = (((ks * 2 + g) ^ swz) << 4);
#pragma unroll
    for (int i = 0; i < 4; i++) af[buf][i] = *(const bf16x8*)(st + a_base + i * 4096 + coff);
#pragma unroll
    for (int j = 0; j < 4; j++) bfr[buf][j] = *(const bf16x8*)(st + b_base + j * 4096 + coff);
  };
  auto mfma16 = [&](int buf) {
#pragma unroll
    for (int i = 0; i < 4; i++)
#pragma unroll
      for (int j = 0; j < 4; j++) acc[i][j] = MFMA(af[buf][i], bfr[buf][j], acc[i][j]);
  };

  gload(0);
  scaleA(0);
  lwriteA(0);
  lwriteB(0);
  __syncthreads();
  if (KT > 1) gload(1);
  lfrag(0, smem, 0);
  for (int kt = 0; kt < KT; kt++) {
    const char* st = smem + (kt & 1) * 65536;
    const bool has1 = (kt + 1 < KT), has2 = (kt + 2 < KT);
    lfrag(1, st, 1);
    if (has1) { scaleA(kt + 1); lwriteA((kt + 1) & 1); }
    mfma16(0);
    __builtin_amdgcn_sched_barrier(0);
    lfrag(0, st, 2);
    if (has1) lwriteB((kt + 1) & 1);
    mfma16(1);
    __builtin_amdgcn_sched_barrier(0);
    lfrag(1, st, 3);
    if (has2) gload(kt + 2);
    mfma16(0);
    __builtin_amdgcn_sched_barrier(0);
    asm volatile("s_waitcnt lgkmcnt(0)" ::: "memory");
    __builtin_amdgcn_s_barrier();
    __builtin_amdgcn_sched_barrier(0);
    if (has1) lfrag(0, smem + ((kt + 1) & 1) * 65536, 0);
    mfma16(1);
    __builtin_amdgcn_sched_barrier(0);
  }

  int tid2 = tid;
  asm volatile("" : "+v"(tid2));
  {
  const int tid = tid2;
  const int lane = tid & 63, w = tid >> 6, wm = w >> 1, wn = w & 1, g = lane >> 5, l32 = lane & 31;
  if (MODE == G_IN) {
    const int region = tn >> 1;
    float* rs = (float*)(smem + 135168);
    rs[tid] = rsqrtf(ss_sum1(p->ss + (size_t)(2 * layer) * 8 * NTOK, rowbase + tid) * (1.f / 1024.f) + EPS);
    __syncthreads();
#pragma unroll
    for (int i = 0; i < 4; i++)
#pragma unroll
      for (int rq = 0; rq < 4; rq++) {
        const int lr0 = wm * 128 + i * 32 + rq * 8 + g * 4;
        const float4 s4 = *(const float4*)(rs + lr0);
        const float sc[4] = {s4.x, s4.y, s4.z, s4.w};
#pragma unroll
        for (int j = 0; j < 4; j++) {
          const int lcol = wn * 128 + j * 32 + l32;
          float v[4];
#pragma unroll
          for (int r4 = 0; r4 < 4; r4++) v[r4] = acc[i][j][rq * 4 + r4] * sc[r4];
          if (region == 3) {
            const int q4 = (lr0 >> 2) & 3;
            const int pq = ((q4 & 1) << 1) | (q4 >> 1);
            u32x2 pk = {pack_bf2(v[0], v[1]), pack_bf2(v[2], v[3])};
            *(u32x2*)(smem + lcol * 528 + ((lr0 & ~15) + pq * 4) * 2) = pk;
          } else {
            if (region != 0 && (j & 1) == 0) {
              float other[4];
#pragma unroll
              for (int r4 = 0; r4 < 4; r4++) other[r4] = __shfl_xor(v[r4], 8);
              if (l32 < 16) {
                const float sgn = (l32 < 8) ? -1.f : 1.f;
#pragma unroll
                for (int r4 = 0; r4 < 4; r4++) {
                  const float2 csv = *(const float2*)(p->cs + ((size_t)(rowbase + lr0 + r4) * 8 + (l32 & 7)) * 2);
                  v[r4] = v[r4] * csv.x + sgn * other[r4] * csv.y;
                }
              }
            }
#pragma unroll
            for (int r4 = 0; r4 < 4; r4++) *(bf16_t*)(smem + (lr0 + r4) * 528 + lcol * 2) = f2bf(v[r4]);
          }
        }
      }
    __syncthreads();
    {
      bf16_t* dbase;
      size_t rstride;
      if (region == 3) { dbase = p->vt + (size_t)((rowbase >> 13) * 512 + (tn & 1) * 256) * SEQL + (rowbase & (SEQL - 1)); rstride = SEQL; }
      else { dbase = (region == 0 ? p->u : (region == 1 ? p->q : p->k)) + (size_t)rowbase * 512 + (tn & 1) * 256; rstride = 512; }
#pragma unroll 8
      for (int it = 0; it < 32; it++) {
        const int id = tid + 256 * it, row = id >> 5, c = id & 31;
        const u32x4 vv = *(const u32x4*)(smem + row * 528 + c * 16);
        *(u32x4*)(dbase + (size_t)row * rstride + c * 8) = vv;
      }
    }
    __syncthreads();
  } else if (MODE == G_GLU) {
#pragma unroll
    for (int i = 0; i < 4; i++)
#pragma unroll
      for (int j = 0; j < 2; j++)
#pragma unroll
        for (int r = 0; r < 16; r++) {
          const int lr = wm * 128 + i * 32 + (r >> 2) * 8 + g * 4 + (r & 3);
          const float av = acc[i][j][r], bv = acc[i][j + 2][r];
          *(bf16_t*)(smem + lr * 272 + (wn * 64 + j * 32 + l32) * 2) = f2bf(av / (1.f + __expf(-bv)));
        }
    __syncthreads();
    {
      float* ssq = p->ssm_ss + ((size_t)layer * 8 + tn * 2) * NTOK;
#pragma unroll 4
      for (int it = 0; it < 16; it++) {
        const int id = tid + 256 * it, row = id >> 4, c = id & 15;
        const u32x4 ov = *(const u32x4*)(smem + row * 272 + c * 16);
        *(u32x4*)(p->outg + (size_t)(rowbase + row) * 512 + tn * 128 + c * 8) = ov;
        float sq = 0.f;
#pragma unroll
        for (int e = 0; e < 4; e++) {
          const float lo = __uint_as_float(ov[e] << 16), hi = __uint_as_float(ov[e] & 0xffff0000u);
          sq += lo * lo + hi * hi;
        }
#pragma unroll
        for (int o = 4; o; o >>= 1) sq += __shfl_xor(sq, o);
        if ((c & 7) == 0) ssq[(size_t)(c >> 3) * NTOK + rowbase + row] = sq;
      }
    }
    __syncthreads();
  } else if (MODE == G_WOUT || MODE == G_DOWN) {
#pragma unroll
    for (int i = 0; i < 4; i++)
#pragma unroll
      for (int j = 0; j < 4; j++)
#pragma unroll
        for (int r = 0; r < 16; r++) {
          const int lr = wm * 128 + i * 32 + (r >> 2) * 8 + g * 4 + (r & 3);
          *(bf16_t*)(smem + lr * 528 + (wn * 128 + j * 32 + l32) * 2) = f2bf(acc[i][j][r]);
        }
    __syncthreads();
    {
      float* ssq = p->ss + ((size_t)(MODE == G_WOUT ? 2 * layer + 1 : 2 * layer + 2) * 8 + tn * 2) * NTOK;
#pragma unroll 4
      for (int it = 0; it < 32; it++) {
        const int id = tid + 256 * it, row = id >> 5, c = id & 31;
        const u32x4 dv = *(const u32x4*)(smem + row * 528 + c * 16);
        const size_t idx = (size_t)(rowbase + row) * 1024 + tn * 256 + c * 8;
        float4 x0 = *(const float4*)(p->xf + idx), x1 = *(const float4*)(p->xf + idx + 4);
        x0.x += __uint_as_float(dv[0] << 16); x0.y += __uint_as_float(dv[0] & 0xffff0000u);
        x0.z += __uint_as_float(dv[1] << 16); x0.w += __uint_as_float(dv[1] & 0xffff0000u);
        x1.x += __uint_as_float(dv[2] << 16); x1.y += __uint_as_float(dv[2] & 0xffff0000u);
        x1.z += __uint_as_float(dv[3] << 16); x1.w += __uint_as_float(dv[3] & 0xffff0000u);
        *(float4*)(p->xf + idx) = x0; *(float4*)(p->xf + idx + 4) = x1;
        u32x4 xbv = {pack_bf2(x0.x, x0.y), pack_bf2(x0.z, x0.w), pack_bf2(x1.x, x1.y), pack_bf2(x1.z, x1.w)};
        *(u32x4*)(p->xb + idx) = xbv;
        float sq = x0.x * x0.x + x0.y * x0.y + x0.z * x0.z + x0.w * x0.w + x1.x * x1.x + x1.y * x1.y + x1.z * x1.z + x1.w * x1.w;
#pragma unroll
        for (int o = 8; o; o >>= 1) sq += __shfl_xor(sq, o);
        if ((c & 15) == 0) ssq[(size_t)(c >> 4) * NTOK + rowbase + row] = sq;
      }
    }
    __syncthreads();
  } else {
#pragma unroll
    for (int i = 0; i < 4; i++)
#pragma unroll
      for (int rq = 0; rq < 4; rq++) {
        const int lr0 = wm * 128 + i * 32 + rq * 8 + g * 4;
#pragma unroll
        for (int j = 0; j < 4; j++) {
          const int pc = wn * 128 + j * 32 + l32;
          u32x2 pk = {pack_bf2(acc[i][j][rq * 4 + 0], acc[i][j][rq * 4 + 1]), pack_bf2(acc[i][j][rq * 4 + 2], acc[i][j][rq * 4 + 3])};
          *(u32x2*)(smem + pc * 528 + lr0 * 2) = pk;
        }
      }
    {
      float* rs = (float*)(smem + 135168);
      const int tb = 254 * upti - 2 + tid;
      float sc = 0.f;
      if (tb >= 0) {
        const int gr = min(upb * SEQL + tb, NTOK - 1);
        sc = rsqrtf(ss_sum1(p->ss + (size_t)(2 * layer + 1) * 8 * NTOK, gr) * (1.f / 1024.f) + EPS);
      }
      rs[tid] = sc;
    }
    __syncthreads();
    {
      const int cp = tid & 127, half = tid >> 7;
      const int pg = (cp >> 6) * 128 + (cp & 63), pv = pg + 64;
      const int ocol = tn * 128 + cp;
      const float* wc = p->w_conv + (size_t)layer * 3 * 5632;
      const float* bc = p->b_conv + (size_t)layer * 5632;
      const float wg0 = wc[ocol], wg1 = wc[5632 + ocol], wg2 = wc[2 * 5632 + ocol], bg = bc[ocol];
      const float wv0 = wc[FFN + ocol], wv1 = wc[5632 + FFN + ocol], wv2 = wc[2 * 5632 + FFN + ocol], bv = bc[FFN + ocol];
      const float* rs = (const float*)(smem + 135168);
      const char* gcol = smem + pg * 528;
      const char* vcol = smem + pv * 528;
      float g0 = 0.f, v0 = 0.f, g1 = 0.f, v1 = 0.f;
      if (half) {
        g0 = rs[126] * bf2f(*(const bf16_t*)(gcol + 126 * 2)); v0 = rs[126] * bf2f(*(const bf16_t*)(vcol + 126 * 2));
        g1 = rs[127] * bf2f(*(const bf16_t*)(gcol + 127 * 2)); v1 = rs[127] * bf2f(*(const bf16_t*)(vcol + 127 * 2));
      }
      for (int grp8 = 0; grp8 < 16; grp8++) {
        const int lrb = half * 128 + grp8 * 8;
        const u32x4 gq = *(const u32x4*)(gcol + lrb * 2);
        const u32x4 vq = *(const u32x4*)(vcol + lrb * 2);
        const float4 r0 = *(const float4*)(rs + lrb), r1 = *(const float4*)(rs + lrb + 4);
        const float rsv[8] = {r0.x, r0.y, r0.z, r0.w, r1.x, r1.y, r1.z, r1.w};
#pragma unroll
        for (int e = 0; e < 8; e++) {
          const unsigned gw = gq[e >> 1], vw = vq[e >> 1];
          const float g2 = rsv[e] * ((e & 1) ? __uint_as_float(gw & 0xffff0000u) : __uint_as_float(gw << 16));
          const float v2 = rsv[e] * ((e & 1) ? __uint_as_float(vw & 0xffff0000u) : __uint_as_float(vw << 16));
          const int lr = lrb + e;
          const int tb = 254 * upti - 2 + lr;
          if (lr >= 2 && tb < SEQL) {
            const float gate = bg + wg0 * g0 + wg1 * g1 + wg2 * g2;
            const float val = bv + wv0 * v0 + wv1 * v1 + wv2 * v2;
            const float o = gate / (1.f + __expf(-gate)) * val;
            p->act[(size_t)(upb * SEQL + tb) * FFN + ocol] = f2bf(o);
          }
          g0 = g1; v0 = v1; g1 = g2; v1 = v2;
        }
      }
    }
    __syncthreads();
  }
  }
}

__device__ __forceinline__ void attn_item(KP p, int layer, int b, int h, int qt, float lam, float outscale, char* smem, const int tid) {
  const int lane = tid & 63, w = tid >> 6, g = lane >> 5, l32 = lane & 31;
  const int tok_q = b * SEQL + qt * 128 + w * 32 + l32;
  bf16x8 qreg[2][4];
#pragma unroll
  for (int c = 0; c < 2; c++)
#pragma unroll
    for (int ks = 0; ks < 4; ks++)
      qreg[c][ks] = *(const bf16x8*)(p->q + (size_t)tok_q * 512 + h * 128 + c * 64 + ks * 16 + g * 8);

  const int NT = 2 * qt + 2;
  const int nkt = 2 * qt + 1 + (w >> 1);
  f32x16 O[2][4];
#pragma unroll
  for (int c = 0; c < 2; c++)
#pragma unroll
    for (int dt = 0; dt < 4; dt++)
#pragma unroll
      for (int r = 0; r < 16; r++) O[c][dt][r] = 0.f;
  float mrun[2] = {-1e30f, -1e30f}, lrun[2] = {0.f, 0.f};
  const float c1 = 0.125f * 1.4426950408889634f;

  u32x4 rk[4], rv[4];
  const bf16_t* kbase = p->k + (size_t)(b * SEQL) * 512 + h * 128;
  const bf16_t* vbase = p->vt + (size_t)((b * 4 + h) * 128) * SEQL;
  const int kkey = tid >> 4, kc = tid & 15;
  const int vd = tid >> 3, vc = tid & 7;
  auto gload = [&](int kt) {
#pragma unroll
    for (int i = 0; i < 4; i++) {
      rk[i] = *(const u32x4*)(kbase + (size_t)(kt * 64 + kkey + 16 * i) * 512 + kc * 8);
      rv[i] = *(const u32x4*)(vbase + (size_t)(vd + 32 * i) * SEQL + kt * 64 + vc * 8);
    }
  };
  const int kw_off = kkey * 256 + ((kc ^ (kkey & 15)) << 4);
  const int vw_off = 16384 + vd * 128 + ((vc ^ ((vd >> 1) & 7)) << 4);
  auto lwrite = [&](int st) {
    char* s = smem + st * 32768;
#pragma unroll
    for (int i = 0; i < 4; i++) {
      *(u32x4*)(s + kw_off + i * 4096) = rk[i];
      *(u32x4*)(s + vw_off + i * 4096) = rv[i];
    }
  };

  gload(0);
  lwrite(0);
  __syncthreads();
  for (int kt = 0; kt < NT; kt++) {
    if (kt + 1 < NT) gload(kt + 1);
    if (kt < nkt) {
      const char* st = smem + (kt & 1) * 32768;
      bf16x8 pf[2][2][2];
      bf16x8 kf[8], vf[2][4];
      f32x16 S[1][2];
      auto loadkq = [&](int c) {
#pragma unroll
        for (int kb = 0; kb < 2; kb++)
#pragma unroll
          for (int ks = 0; ks < 4; ks++) {
            const int key = kb * 32 + l32, chunk = c * 8 + ks * 2 + g;
            kf[kb * 4 + ks] = *(const bf16x8*)(st + key * 256 + ((chunk ^ (key & 15)) << 4));
          }
      };
      auto qk = [&](int c) {
        f32x16 zero;
#pragma unroll
        for (int r = 0; r < 16; r++) zero[r] = 0.f;
#pragma unroll
        for (int kb = 0; kb < 2; kb++) {
          S[0][kb] = MFMA(kf[kb * 4], qreg[c][0], zero);
#pragma unroll
          for (int ks = 1; ks < 4; ks++) S[0][kb] = MFMA(kf[kb * 4 + ks], qreg[c][ks], S[0][kb]);
        }
      };
      auto loadv = [&](int bi) {
#pragma unroll
        for (int dt = 0; dt < 4; dt++) {
          const int d = dt * 32 + l32, chunk = bi * 2 + g;
          vf[bi & 1][dt] = *(const bf16x8*)(st + 16384 + d * 128 + ((chunk ^ ((d >> 1) & 7)) << 4));
        }
      };
      auto softmax = [&](int c) {
        float mx = S[0][0][0];
#pragma unroll
        for (int r = 1; r < 16; r++) mx = fmaxf(mx, S[0][0][r]);
#pragma unroll
        for (int r = 0; r < 16; r++) mx = fmaxf(mx, S[0][1][r]);
        {
          const unsigned mu = __float_as_uint(mx);
          auto sw = __builtin_amdgcn_permlane32_swap(mu, mu, false, false);
          mx = fmaxf(__uint_as_float(sw[0]), __uint_as_float(sw[1]));
        }
        const float mcand = fmaxf(mrun[c], mx * c1);
        if (__any(mcand - mrun[c] > 8.f)) {
          const float alpha = fast_exp2(mrun[c] - mcand);
          mrun[c] = mcand;
          lrun[c] *= alpha;
#pragma unroll
          for (int dt = 0; dt < 4; dt++)
#pragma unroll
            for (int r = 0; r < 16; r++) O[c][dt][r] *= alpha;
        }
        const float mref = mrun[c];
        const f2_t c1v = {c1, c1}, mrv = {-mref, -mref};
        f2_t psum2 = {0.f, 0.f};
#pragma unroll
        for (int kb = 0; kb < 2; kb++)
#pragma unroll
          for (int r = 0; r < 16; r += 2) {
            f2_t sv = {S[0][kb][r], S[0][kb][r + 1]};
            f2_t av = __builtin_elementwise_fma(sv, c1v, mrv);
            f2_t ev = {fast_exp2(av[0]), fast_exp2(av[1])};
            S[0][kb][r] = ev[0]; S[0][kb][r + 1] = ev[1];
            psum2 += ev;
          }
        lrun[c] += psum2[0] + psum2[1];
#pragma unroll
        for (int kb = 0; kb < 2; kb++)
#pragma unroll
          for (int m = 0; m < 2; m++) {
            u32x4 pk = {pack_bf2(S[0][kb][8 * m + 0], S[0][kb][8 * m + 1]), pack_bf2(S[0][kb][8 * m + 2], S[0][kb][8 * m + 3]),
                        pack_bf2(S[0][kb][8 * m + 4], S[0][kb][8 * m + 5]), pack_bf2(S[0][kb][8 * m + 6], S[0][kb][8 * m + 7])};
            pf[c][kb][m] = __builtin_bit_cast(bf16x8, pk);
          }
      };
      loadkq(0);
      __builtin_amdgcn_sched_barrier(0);
      qk(0);
      __builtin_amdgcn_sched_barrier(0);
      loadkq(1);
      __builtin_amdgcn_sched_barrier(0);
      softmax(0);
      __builtin_amdgcn_sched_barrier(0);
      qk(1);
      loadv(0);
      __builtin_amdgcn_sched_barrier(0);
      softmax(1);
      __builtin_amdgcn_sched_barrier(0);
#pragma unroll
      for (int bi = 0; bi < 4; bi++) {
        if (bi < 3) loadv(bi + 1);
#pragma unroll
        for (int dt = 0; dt < 4; dt++) {
          O[0][dt] = MFMA(vf[bi & 1][dt], pf[0][bi >> 1][bi & 1], O[0][dt]);
          O[1][dt] = MFMA(vf[bi & 1][dt], pf[1][bi >> 1][bi & 1], O[1][dt]);
        }
        __builtin_amdgcn_sched_barrier(0);
      }
    }
    if (kt + 1 < NT) lwrite((kt + 1) & 1);
    __syncthreads();
  }

  const float l1 = lrun[0] + __shfl_xor(lrun[0], 32);
  const float l2 = lrun[1] + __shfl_xor(lrun[1], 32);
  const float i1 = 1.f / l1, i2 = lam / l2;
  float ssq = 0.f;
#pragma unroll
  for (int dt = 0; dt < 4; dt++)
#pragma unroll
    for (int r = 0; r < 16; r++) {
      float o = O[0][dt][r] * i1 - O[1][dt][r] * i2;
      O[0][dt][r] = o;
      ssq += o * o;
    }
  ssq += __shfl_xor(ssq, 32);
  const float rstd = rsqrtf(ssq * (1.f / 128.f) + EPS) * outscale;
  const float* gsub = p->subln + layer * 128;
#pragma unroll
  for (int dt = 0; dt < 4; dt++)
#pragma unroll
    for (int rq = 0; rq < 4; rq++) {
      const int d0 = dt * 32 + rq * 8 + g * 4;
      float4 gg = *(const float4*)(gsub + d0);
      u32x2 pk = {pack_bf2(O[0][dt][rq * 4 + 0] * rstd * gg.x, O[0][dt][rq * 4 + 1] * rstd * gg.y),
                  pack_bf2(O[0][dt][rq * 4 + 2] * rstd * gg.z, O[0][dt][rq * 4 + 3] * rstd * gg.w)};
      *(u32x2*)(p->att + (size_t)tok_q * 512 + h * 128 + d0) = pk;
    }
}

DI void s5_store_u(const u32x4 a, const u32x4 bq, int lane, float* ul) {
  float4* d = (float4*)(ul + lane * 16);
  d[0] = make_float4(__uint_as_float(a[0] << 16), __uint_as_float(a[0] & 0xffff0000u), __uint_as_float(a[1] << 16), __uint_as_float(a[1] & 0xffff0000u));
  d[1] = make_float4(__uint_as_float(a[2] << 16), __uint_as_float(a[2] & 0xffff0000u), __uint_as_float(a[3] << 16), __uint_as_float(a[3] & 0xffff0000u));
  d[2] = make_float4(__uint_as_float(bq[0] << 16), __uint_as_float(bq[0] & 0xffff0000u), __uint_as_float(bq[1] << 16), __uint_as_float(bq[1] & 0xffff0000u));
  d[3] = make_float4(__uint_as_float(bq[2] << 16), __uint_as_float(bq[2] & 0xffff0000u), __uint_as_float(bq[3] << 16), __uint_as_float(bq[3] & 0xffff0000u));
}
DI void s5_load_u(KP p, int b, int g, int j, int lane, float* ul) {
  const u32x4* src = (const u32x4*)(p->u + (size_t)(b * SEQL + j * 64 + lane) * 512 + g * 16);
  const u32x4 a = src[0], bq = src[1];
  s5_store_u(a, bq, lane, ul);
}

DI float swap_half(float v, const int which) {
  const unsigned u = __float_as_uint(v);
  auto r = __builtin_amdgcn_permlane32_swap(u, u, false, false);
  return __uint_as_float(which ? r[1] : r[0]);
}

struct S5Coef { float arA, aiA, arB, aiB; };

template <bool STORE>
DI void s5_scan32(const float* ul_sub, const bf16x8 (&bfr)[4], const S5Coef& cf, float& xAr, float& xAi, float& xBr, float& xBi,
                  float* X, const int l32, const int grp) {
  bf16x8 af;
  {
    const float* us = ul_sub + l32 * 16 + grp * 8;
    float4 a = *(const float4*)us, bq = *(const float4*)(us + 4);
    u32x4 pk = {pack_bf2(a.x, a.y), pack_bf2(a.z, a.w), pack_bf2(bq.x, bq.y), pack_bf2(bq.z, bq.w)};
    af = __builtin_bit_cast(bf16x8, pk);
  }
  f32x16 zero;
#pragma unroll
  for (int r = 0; r < 16; r++) zero[r] = 0.f;
  const f32x16 bu0 = MFMA(af, bfr[0], zero), bu1 = MFMA(af, bfr[1], zero), bu2 = MFMA(af, bfr[2], zero), bu3 = MFMA(af, bfr[3], zero);
#pragma unroll
  for (int k = 0; k < 8; k++) {
    float sAr[4], sAi[4], sBr[4], sBi[4];
#pragma unroll
    for (int i = 0; i < 4; i++) {
      const int r = (k >> 1) * 4 + i;
      const float nAr = cf.arA * xAr - cf.aiA * xAi + bu0[r];
      const float nAi = cf.arA * xAi + cf.aiA * xAr + bu2[r];
      const float nBr = cf.arB * xBr - cf.aiB * xBi + bu1[r];
      const float nBi = cf.arB * xBi + cf.aiB * xBr + bu3[r];
      xAr = nAr; xAi = nAi; xBr = nBr; xBi = nBi;
      sAr[i] = nAr; sAi[i] = nAi; sBr[i] = nBr; sBi[i] = nBi;
    }
    if (STORE) {
      if (grp == (k & 1)) {
#pragma unroll
        for (int i = 0; i < 4; i++) {
          float* xr = X + (4 * k + i) * 132;
          xr[l32] = sAr[i]; xr[64 + l32] = sAi[i]; xr[32 + l32] = sBr[i]; xr[96 + l32] = sBi[i];
        }
      }
    }
    xAr = swap_half(xAr, k & 1); xAi = swap_half(xAi, k & 1);
    xBr = swap_half(xBr, k & 1); xBi = swap_half(xBi, k & 1);
  }
}

DI void s5_setup(KP p, int layer, int g, int l32, int grp, S5Coef& cf, bf16x8 (&bfr)[4]) {
  const float* t0 = p->s5tab + (size_t)((layer * 32 + g) * 64) * 40;
  cf.arA = t0[l32 * 40]; cf.aiA = t0[l32 * 40 + 1];
  cf.arB = t0[(32 + l32) * 40]; cf.aiB = t0[(32 + l32) * 40 + 1];
#pragma unroll
  for (int jt = 0; jt < 4; jt++) {
    const float* src = t0 + (l32 + 32 * (jt & 1)) * 40 + 4 + (jt >> 1) * 16 + grp * 8;
    float4 a = *(const float4*)src, bq = *(const float4*)(src + 4);
    u32x4 pk = {pack_bf2(a.x, a.y), pack_bf2(a.z, a.w), pack_bf2(bq.x, bq.y), pack_bf2(bq.z, bq.w)};
    bfr[jt] = __builtin_bit_cast(bf16x8, pk);
  }
}

__device__ __forceinline__ void s5_pass1(KP p, int layer, char* smem, const int tid) {
  const int lane = tid & 63, w = tid >> 6, l32 = lane & 31, grp = lane >> 5;
  float* ul = (float*)(smem + w * 4096);
  for (int wbase = blockIdx.x * 4; wbase < 1024; wbase += gridDim.x * 4) {
    const int wi = wbase + w;
    const int j0 = (wi & 15) * 8, g = (wi >> 4) & 31, b = wi >> 9;
    S5Coef cf; bf16x8 bfr[4];
    s5_setup(p, layer, g, l32, grp, cf, bfr);
    const u32x4* src = (const u32x4*)(p->u + (size_t)(b * SEQL + j0 * 64 + lane) * 512 + g * 16);
    u32x4 v0 = src[0], v1 = src[1];
    for (int jj = 0; jj < 8; jj++) {
      const int j = j0 + jj;
      s5_store_u(v0, v1, lane, ul);
      if (jj < 7) {
        const u32x4* nsrc = (const u32x4*)(p->u + (size_t)(b * SEQL + (j + 1) * 64 + lane) * 512 + g * 16);
        v0 = nsrc[0]; v1 = nsrc[1];
      }
      __syncthreads();
      float xAr = 0.f, xAi = 0.f, xBr = 0.f, xBi = 0.f;
      s5_scan32<false>(ul, bfr, cf, xAr, xAi, xBr, xBi, nullptr, l32, grp);
      s5_scan32<false>(ul + 32 * 16, bfr, cf, xAr, xAi, xBr, xBi, nullptr, l32, grp);
      float* so = p->sloc + (size_t)((b * 32 + g) * 128 + j) * 128;
      so[lane] = grp ? xBr : xAr; so[64 + lane] = grp ? xBi : xAi;
      __syncthreads();
    }
  }
}

__device__ __forceinline__ void s5_pass2(KP p, int layer, char* smem, const int tid) {
  const int lane = tid & 63, w = tid >> 6;
  float* ul = (float*)(smem + w * 21504);
  float* X = ul + 1024;
  const int l32 = lane & 31, grp = lane >> 5;
  for (int wbase = blockIdx.x * 4; wbase < 1024; wbase += gridDim.x * 4) {
   const int wi = wbase + w;
   const int j0 = (wi & 15) * 8, g = (wi >> 4) & 31, b = wi >> 9;
   S5Coef cf; bf16x8 bfr[4];
   s5_setup(p, layer, g, l32, grp, cf, bfr);
   bf16x8 cfr[8];
   {
     const int c = l32 & 15;
     const float* cr = p->c_re + (size_t)((layer * 32 + g) * 16 + c) * 64;
     const float* ci = p->c_im + (size_t)((layer * 32 + g) * 16 + c) * 64;
#pragma unroll
     for (int s8 = 0; s8 < 8; s8++) {
       const int k0 = (s8 & 3) * 16 + grp * 8;
       const float* src = (s8 < 4) ? (cr + k0) : (ci + k0);
       const float sg = (l32 < 16) ? ((s8 < 4) ? 1.f : -1.f) : 0.f;
       float4 a = *(const float4*)src, bq = *(const float4*)(src + 4);
       u32x4 pk = {pack_bf2(a.x * sg, a.y * sg), pack_bf2(a.z * sg, a.w * sg), pack_bf2(bq.x * sg, bq.y * sg), pack_bf2(bq.z * sg, bq.w * sg)};
       cfr[s8] = __builtin_bit_cast(bf16x8, pk);
     }
   }
   const float dd = p->ssm_d[(size_t)(layer * 32 + g) * 16 + (l32 & 15)];
   float xAr, xAi, xBr, xBi;
   {
     const float* tb = p->s5tab + (size_t)((layer * 32 + g) * 64 + lane) * 40;
     const float aTr = tb[2], aTi = tb[3];
     float xr = 0.f, xi = 0.f;
     const float* sl = p->sloc + (size_t)((b * 32 + g) * 128) * 128;
     for (int i0 = 0; i0 < j0; i0 += 8) {
       float sr[8], si[8];
#pragma unroll
       for (int q = 0; q < 8; q++) { sr[q] = sl[(i0 + q) * 128 + lane]; si[q] = sl[(i0 + q) * 128 + 64 + lane]; }
#pragma unroll
       for (int q = 0; q < 8; q++) {
         const float nr = aTr * xr - aTi * xi + sr[q];
         const float ni = aTr * xi + aTi * xr + si[q];
         xr = nr; xi = ni;
       }
     }
     xAr = swap_half(xr, 0); xBr = swap_half(xr, 1);
     xAi = swap_half(xi, 0); xBi = swap_half(xi, 1);
   }
   for (int jj = 0; jj < 8; jj++) {
    const int j = j0 + jj;
    s5_load_u(p, b, g, j, lane, ul);
    __syncthreads();
    for (int sub = 0; sub < 2; sub++) {
      s5_scan32<true>(ul + sub * 32 * 16, bfr, cf, xAr, xAi, xBr, xBi, X, l32, grp);
      __syncthreads();
      f32x16 yacc;
#pragma unroll
      for (int r = 0; r < 16; r++) yacc[r] = 0.f;
#pragma unroll
      for (int s8 = 0; s8 < 8; s8++) {
        const float* xs = X + l32 * 132 + ((s8 < 4) ? 0 : 64) + (s8 & 3) * 16 + grp * 8;
        float4 a = *(const float4*)xs, bq = *(const float4*)(xs + 4);
        u32x4 pk = {pack_bf2(a.x, a.y), pack_bf2(a.z, a.w), pack_bf2(bq.x, bq.y), pack_bf2(bq.z, bq.w)};
        yacc = MFMA(__builtin_bit_cast(bf16x8, pk), cfr[s8], yacc);
      }
      if (l32 < 16) {
#pragma unroll
        for (int r = 0; r < 16; r++) {
          const int tl = sub * 32 + (r >> 2) * 8 + grp * 4 + (r & 3);
          const float yv = yacc[r] + dd * ul[tl * 16 + l32];
          p->gy[(size_t)(b * SEQL + j * 64 + tl) * 512 + g * 16 + l32] = f2bf(gelu_tanh(yv));
        }
      }
      __syncthreads();
    }
   }
  }
}

__device__ __forceinline__ void phase_attn(KP p, int layer, char* smem, const int tid) {
  const int lane = tid & 63;
  const float s1 = wave_sum(p->lq1[layer * 64 + lane] * p->lk1[layer * 64 + lane]);
  const float s2 = wave_sum(p->lq2[layer * 64 + lane] * p->lk2[layer * 64 + lane]);
  const float lam_init = 0.8f - 0.6f * expf(-0.3f * (float)layer);
  const float lam = expf(s1) - expf(s2) + lam_init;
  for (int pb = blockIdx.x; pb < 256; pb += gridDim.x) {
    const int pi = (pb & 7) * 32 + (pb >> 3);
    const int b = pi >> 7, h = (pi >> 5) & 3, i = pi & 31;
    attn_item(p, layer, b, h, 63 - i, lam, 1.f - lam_init, smem, tid);
    attn_item(p, layer, b, h, i, lam, 1.f - lam_init, smem, tid);
  }
  s5_pass1(p, layer, smem, tid);
}

__device__ __forceinline__ void phase_final(KP p, const int tid) {
  const int wave = tid >> 6, lane = tid & 63;
  const float* ssq = p->ss + (size_t)8 * 8 * NTOK;
  for (int row = blockIdx.x * 4 + wave; row < NTOK; row += gridDim.x * 4) {
    const float rstd = rsqrtf(ss_sum1(ssq, row) * (1.f / 1024.f) + EPS);
#pragma unroll
    for (int i = 0; i < 4; i++) {
      float4 v = ((const float4*)(p->xf + (size_t)row * DM))[lane + 64 * i];
      float4 gq = ((const float4*)p->norm_final)[lane + 64 * i];
      float4 o = {v.x * rstd * gq.x, v.y * rstd * gq.y, v.z * rstd * gq.z, v.w * rstd * gq.w};
      ((float4*)(p->out + (size_t)row * DM))[lane + 64 * i] = o;
    }
  }
}

__device__ __forceinline__ void run_phase(KP p, int ph, char* smem) {
  const int tid = opaque_tid();
  if (ph == 0) { phase_prep(p, smem, tid); return; }
  if (ph == 29) { phase_final(p, tid); return; }
  const int layer = (ph - 1) / 7, k = (ph - 1) % 7;
  const int nb = gridDim.x, bid = blockIdx.x;
  if (k == 1) { phase_attn(p, layer, smem, tid); return; }
  if (k == 2) { s5_pass2(p, layer, smem, tid); return; }
  if (k == 0) { for (int r = 0; ; r++) { const int t = (r * 8 + (bid & 7)) * (nb >> 3) + (bid >> 3); if (r * nb >= 512) break; if (t < 512) gemm_tile(p, G_IN, layer, t, smem, tid); } }
  else if (k == 3) { for (int r = 0; ; r++) { const int t = (r * 8 + (bid & 7)) * (nb >> 3) + (bid >> 3); if (r * nb >= 256) break; if (t < 256) gemm_tile(p, G_GLU, layer, t, smem, tid); } }
  else if (k == 4) { for (int r = 0; ; r++) { const int t = (r * 8 + (bid & 7)) * (nb >> 3) + (bid >> 3); if (r * nb >= 256) break; if (t < 256) gemm_tile(p, G_WOUT, layer, t, smem, tid); } }
  else if (k == 5) { for (int r = 0; ; r++) { const int t = (r * 8 + (bid & 7)) * (nb >> 3) + (bid >> 3); if (r * nb >= 2 * 33 * 22) break; if (t < 2 * 33 * 22) gemm_tile(p, G_UP, layer, t, smem, tid); } }
  else { for (int r = 0; ; r++) { const int t = (r * 8 + (bid & 7)) * (nb >> 3) + (bid >> 3); if (r * nb >= 256) break; if (t < 256) gemm_tile(p, G_DOWN, layer, t, smem, tid); } }
}

#define PHASE_KERNEL(name, body)                                                      \
  __global__ void __launch_bounds__(256) name(Params p_unused) {                      \
    extern __shared__ __attribute__((aligned(16))) char smem[];                       \
    KP p = (KP)__builtin_amdgcn_kernarg_segment_ptr();                                \
    const int tid = threadIdx.x, nb = gridDim.x, bid = blockIdx.x;                    \
    const int layer = (int)p->phase_lo;                                               \
    (void)nb; (void)bid; (void)layer;                                                 \
    body                                                                              \
  }
PHASE_KERNEL(k_prep, phase_prep(p, smem, tid);)
PHASE_KERNEL(k_gin, for (int r = 0; ; r++) { const int t = (r * 8 + (bid & 7)) * (nb >> 3) + (bid >> 3); if (r * nb >= 512) break; if (t < 512) gemm_tile(p, G_IN, layer, t, smem, tid); })
PHASE_KERNEL(k_attn, phase_attn(p, layer, smem, tid);)
PHASE_KERNEL(k_s5p2, s5_pass2(p, layer, smem, tid);)
PHASE_KERNEL(k_glu, for (int r = 0; ; r++) { const int t = (r * 8 + (bid & 7)) * (nb >> 3) + (bid >> 3); if (r * nb >= 256) break; if (t < 256) gemm_tile(p, G_GLU, layer, t, smem, tid); })
PHASE_KERNEL(k_wout, for (int r = 0; ; r++) { const int t = (r * 8 + (bid & 7)) * (nb >> 3) + (bid >> 3); if (r * nb >= 256) break; if (t < 256) gemm_tile(p, G_WOUT, layer, t, smem, tid); })
PHASE_KERNEL(k_up, for (int r = 0; ; r++) { const int t = (r * 8 + (bid & 7)) * (nb >> 3) + (bid >> 3); if (r * nb >= 2 * 33 * 22) break; if (t < 2 * 33 * 22) gemm_tile(p, G_UP, layer, t, smem, tid); })
PHASE_KERNEL(k_down, for (int r = 0; ; r++) { const int t = (r * 8 + (bid & 7)) * (nb >> 3) + (bid >> 3); if (r * nb >= 256) break; if (t < 256) gemm_tile(p, G_DOWN, layer, t, smem, tid); })
PHASE_KERNEL(k_final, phase_final(p, tid);)

#if COOP
__global__ void __launch_bounds__(256) mega_kernel(Params p_unused) {
  extern __shared__ __attribute__((aligned(16))) char smem[];
  KP p0 = (KP)__builtin_amdgcn_kernarg_segment_ptr();
  const int ph_lo = (int)p0->phase_lo, ph_hi = (int)p0->phase_hi;
#if COOP
  if (ph_hi > 1000) cg::this_grid().sync();
#endif
#if COOP
  {
    volatile unsigned* st = (volatile unsigned*)(smem + 136192);
    if (threadIdx.x == 0) { st[0] = 0u; st[1] = 0u; xb_add(&p0->bar[XB_CNT(xb_xcc_id())], 1u); }
  }
#endif
  for (int ph = ph_lo; ph < ph_hi; ph++) {
    KP p = p0;
    asm volatile("" : "+s"(p));
#if TPROBE
    if (blockIdx.x == 0) p->ts[ph] = (long long)wall_clock64();
#endif
    run_phase(p, ph, smem);
#if COOP
    if (ph + 1 < ph_hi) {
      if (ph == ph_lo) grid_barrier(p->bar, gridDim.x, opaque_tid());
      else xcd_barrier(p->bar, (volatile unsigned*)(smem + 136192), opaque_tid());
    }
#endif
  }
#if TPROBE
  grid_barrier(p0->bar, (unsigned)(ph_hi - ph_lo) * gridDim.x, opaque_tid());
  if (blockIdx.x == 0) {
    KP p = p0;
    long long tend = (long long)wall_clock64();
    float a = 0.f, b = 0.f;
    for (int ph = 0; ph < 30; ph++) {
      long long t0 = p->ts[ph], t1 = (ph == 29) ? tend : p->ts[ph + 1];
      int c = (ph == 0) ? 0 : (ph == 29 ? 8 : 1 + (ph - 1) % 7);
      float d = (float)(t1 - t0) * 0.01f;
      if (c == TP_A || TP_A == 9) a += d;
      if (c == TP_B || TP_B == 9) b += d;
    }
    const int t = opaque_tid();
    if (t <= 100) p->out[t] += (t == 0) ? a : b;
  }
#endif
}

#endif

extern "C" void kernel_launch(void* const* d_in, const int* in_sizes, int n_in, void* d_out, int out_size, void* d_ws,
                              size_t ws_size, hipStream_t stream) {
  static int grid_blocks = 0;
  if (!grid_blocks) {
    int dev = 0, cus = 0, per_cu = 0;
    (void)hipGetDevice(&dev);
    (void)hipDeviceGetAttribute(&cus, hipDeviceAttributeMultiprocessorCount, dev);
#if COOP
    (void)hipFuncSetAttribute((const void*)mega_kernel, hipFuncAttributeMaxDynamicSharedMemorySize, LDS_BYTES);
    (void)hipOccupancyMaxActiveBlocksPerMultiprocessor(&per_cu, (const void*)mega_kernel, 256, LDS_BYTES);
    if (per_cu < 1) { fprintf(stderr, "occupancy query returned %d\n", per_cu); per_cu = 1; }
#endif
    grid_blocks = cus;
    (void)hipGetLastError();
  }
  Params p{};
  p.x = (const float*)d_in[0]; p.pos = (const int*)d_in[1];
  p.norm_mix = (const float*)d_in[2]; p.w_in = (const float*)d_in[3];
  p.lam_re = (const float*)d_in[4]; p.lam_im = (const float*)d_in[5]; p.log_step = (const float*)d_in[6];
  p.b_re = (const float*)d_in[7]; p.b_im = (const float*)d_in[8]; p.c_re = (const float*)d_in[9]; p.c_im = (const float*)d_in[10];
  p.ssm_d = (const float*)d_in[11]; p.w_glu = (const float*)d_in[12]; p.ssm_norm = (const float*)d_in[13];
  p.lq1 = (const float*)d_in[14]; p.lk1 = (const float*)d_in[15]; p.lq2 = (const float*)d_in[16]; p.lk2 = (const float*)d_in[17];
  p.subln = (const float*)d_in[18]; p.w_out = (const float*)d_in[19]; p.norm_ffn = (const float*)d_in[20];
  p.w_up = (const float*)d_in[21]; p.w_conv = (const float*)d_in[22]; p.b_conv = (const float*)d_in[23];
  p.w_down = (const float*)d_in[24]; p.norm_final = (const float*)d_in[25];
  p.out = (float*)d_out;
  char* ws = (char*)d_ws;
  size_t off = 0;
  auto take = [&](size_t bytes) { char* r = ws + off; off += (bytes + 255) & ~(size_t)255; return r; };
  p.WinT = (bf16_t*)take((size_t)4 * 2048 * 1024 * 2);
  p.WgluT = (bf16_t*)take((size_t)4 * 1024 * 512 * 2);
  p.WoutT = (bf16_t*)take((size_t)4 * 1024 * 1024 * 2);
  p.WupT = (bf16_t*)take((size_t)4 * 5632 * 1024 * 2);
  p.WdownT = (bf16_t*)take((size_t)4 * 1024 * FFN * 2);
  p.xf = (float*)take((size_t)NTOK * DM * 4);
  p.xb = (bf16_t*)take((size_t)NTOK * DM * 2);
  p.ss = (float*)take((size_t)9 * 8 * NTOK * 4);
  p.ssm_ss = (float*)take((size_t)4 * 8 * NTOK * 4);
  p.cs = (float*)take((size_t)NTOK * 16 * 4);
  p.s5tab = (float*)take((size_t)4 * 32 * 64 * 40 * 4);
  p.sloc = (float*)take((size_t)2 * 32 * 128 * 128 * 4);
  p.ts = (long long*)take(256);
  p.bar = (unsigned*)take(XB_WORDS * 4);
  char* region = take((size_t)134217728);
  p.u = (bf16_t*)region;
  p.q = (bf16_t*)(region + 33554432);
  p.k = p.q + (size_t)NTOK * 512;
  p.vt = p.k + (size_t)NTOK * 512;
  p.gy = p.vt + (size_t)NTOK * 512;
  p.outg = p.gy + (size_t)NTOK * 512;
  p.att = p.outg + (size_t)NTOK * 512;
  p.act = (bf16_t*)region;
  if (off > ws_size) { fprintf(stderr, "workspace too small: need %zu have %zu\n", off, ws_size); return; }
#if COOP
  p.phase_lo = 0; p.phase_hi = 30;
  if (hipMemsetAsync(p.bar, 0, XB_WORDS * 4, stream) != hipSuccess) fprintf(stderr, "barrier memset failed\n");
  void* args[] = {&p};
  hipError_t e = hipLaunchCooperativeKernel((const void*)mega_kernel, dim3(grid_blocks), dim3(256), args, LDS_BYTES, stream);
  if (e != hipSuccess) fprintf(stderr, "cooperative launch failed: %s (grid %d)\n", hipGetErrorString(e), grid_blocks);
#else
  typedef void (*kfn)(Params);
  const kfn seq[7] = {k_gin, k_attn, k_s5p2, k_glu, k_wout, k_up, k_down};
  static bool attr_done = false;
  if (!attr_done) {
    (void)hipFuncSetAttribute((const void*)k_prep, hipFuncAttributeMaxDynamicSharedMemorySize, LDS_BYTES);
    (void)hipFuncSetAttribute((const void*)k_final, hipFuncAttributeMaxDynamicSharedMemorySize, LDS_BYTES);
    for (int i = 0; i < 7; i++) (void)hipFuncSetAttribute((const void*)seq[i], hipFuncAttributeMaxDynamicSharedMemorySize, LDS_BYTES);
    attr_done = true;
  }
  p.phase_lo = 0; p.phase_hi = 0;
  hipLaunchKernelGGL(k_prep, dim3(grid_blocks), dim3(256), LDS_BYTES, stream, p);
  for (int layer = 0; layer < 4; layer++) {
    p.phase_lo = layer;
    for (int i = 0; i < 7; i++) hipLaunchKernelGGL(seq[i], dim3(grid_blocks), dim3(256), LDS_BYTES, stream, p);
  }
  hipLaunchKernelGGL(k_final, dim3(grid_blocks), dim3(256), LDS_BYTES, stream, p);
#endif
}
```

```cpp
#include <hip/hip_runtime.h>
#include <hip/hip_cooperative_groups.h>
#include <cstdio>
namespace cg = cooperative_groups;

#ifndef COOP
#define COOP 1
#endif
#ifndef TPROBE
#define TPROBE 0
#endif
#ifndef TP_A
#define TP_A 1
#endif
#ifndef TP_B
#define TP_B 2
#endif

typedef unsigned short bf16_t;
typedef __attribute__((ext_vector_type(8))) short bf16x8;
typedef __attribute__((ext_vector_type(16))) float f32x16;
typedef __attribute__((ext_vector_type(2))) __bf16 bf2_t;
typedef __attribute__((ext_vector_type(2))) float f2_t;
typedef __attribute__((ext_vector_type(4))) unsigned u32x4;
typedef __attribute__((ext_vector_type(2))) unsigned u32x2;

#define DI __device__ __forceinline__
#define MFMA(a, b, c) __builtin_amdgcn_mfma_f32_32x32x16_bf16((a), (b), (c), 0, 0, 0)

constexpr int NTOK = 16384, DM = 1024, SEQL = 8192, FFN = 2816;
constexpr int LDS_BYTES = 136208;
constexpr float EPS = 1e-6f;

struct Params {
  const float* x; const int* pos;
  const float *norm_mix, *w_in, *lam_re, *lam_im, *log_step, *b_re, *b_im, *c_re, *c_im, *ssm_d, *w_glu, *ssm_norm;
  const float *lq1, *lk1, *lq2, *lk2, *subln, *w_out, *norm_ffn, *w_up, *w_conv, *b_conv, *w_down, *norm_final;
  float* out;
  bf16_t *WinT, *WgluT, *WoutT, *WupT, *WdownT;
  float* xf; bf16_t* xb;
  bf16_t *u, *q, *k, *vt, *gy, *outg, *att, *act;
  float *ss, *ssm_ss, *cs, *s5tab, *sloc;
  long long phase_lo, phase_hi;
  long long* ts;
  unsigned* bar;
};

typedef const __attribute__((address_space(4))) Params* KP;

DI unsigned pack_bf2(float a, float b) { f2_t v = {a, b}; return __builtin_bit_cast(unsigned, __builtin_convertvector(v, bf2_t)); }
DI bf16_t f2bf(float a) { return (bf16_t)(pack_bf2(a, 0.f) & 0xffffu); }
DI float bf2f(bf16_t v) { return __uint_as_float(((unsigned)v) << 16); }
DI void grid_barrier(unsigned* ctr, unsigned target, int tid) {
  asm volatile("s_waitcnt vmcnt(0)" ::: "memory");
  __syncthreads();
  if (tid == 0) {
    __builtin_amdgcn_fence(__ATOMIC_RELEASE, "agent");
    asm volatile("s_waitcnt vmcnt(0)" ::: "memory");
    __hip_atomic_fetch_add(ctr, 1u, __ATOMIC_RELAXED, __HIP_MEMORY_SCOPE_AGENT);
    while (__hip_atomic_load(ctr, __ATOMIC_RELAXED, __HIP_MEMORY_SCOPE_AGENT) < target) __builtin_amdgcn_s_sleep(1);
    __builtin_amdgcn_fence(__ATOMIC_ACQUIRE, "agent");
    asm volatile("s_waitcnt vmcnt(0)" ::: "memory");
  }
  __syncthreads();
}
#define XB_CNT(j)  (64 + 64 * (j))
#define XB_SUB(j)  (1088 + 64 * (j))
#define XB_GEN(j)  (2112 + 64 * (j))
#define XB_TOP     3136
#define XB_TOPGEN  3200
#define XB_WORDS   3264
DI unsigned xb_ld(unsigned* q) { return __hip_atomic_load(q, __ATOMIC_RELAXED, __HIP_MEMORY_SCOPE_AGENT); }
DI unsigned xb_add(unsigned* q, unsigned v) { return __hip_atomic_fetch_add(q, v, __ATOMIC_RELAXED, __HIP_MEMORY_SCOPE_AGENT); }
DI unsigned xb_xcc_id() { return (unsigned)__builtin_amdgcn_s_getreg((3 << 11) | 20) & 0xFu; }
DI void xcd_barrier(unsigned* bar, volatile unsigned* st, int tid) {
  asm volatile("s_waitcnt vmcnt(0)" ::: "memory");
  __syncthreads();
  if (tid == 0) {
    const unsigned x = xb_xcc_id();
    unsigned nloc = st[0], nx = st[1];
    if (nloc == 0u) {
      unsigned cnt = 0u, mine = 1u;
#pragma unroll
      for (unsigned j = 0; j < 16; ++j) { const unsigned c = xb_ld(&bar[XB_CNT(j)]); cnt += (c > 0u) ? 1u : 0u; mine = (j == x) ? c : mine; }
      nloc = mine > 0u ? mine : 1u; nx = cnt > 0u ? cnt : 1u;
      st[0] = nloc; st[1] = nx;
    }
    const unsigned old = xb_add(&bar[XB_SUB(x)], 1u);
    const unsigned gen = old / nloc;
    if (old + 1u == (gen + 1u) * nloc) {
      __builtin_amdgcn_fence(__ATOMIC_RELEASE, "agent");
      asm volatile("s_waitcnt vmcnt(0)" ::: "memory");
      const unsigned og = xb_add(&bar[XB_TOP], 1u);
      const unsigned tg = og / nx;
      if (og + 1u == (tg + 1u) * nx) xb_add(&bar[XB_TOPGEN], 1u);
      else { while (xb_ld(&bar[XB_TOPGEN]) == tg) __builtin_amdgcn_s_sleep(1); }
      __builtin_amdgcn_fence(__ATOMIC_ACQUIRE, "agent");
      xb_add(&bar[XB_GEN(x)], 1u);
      asm volatile("s_waitcnt vmcnt(0)" ::: "memory");
    } else {
      while (xb_ld(&bar[XB_GEN(x)]) == gen) __builtin_amdgcn_s_sleep(1);
      __builtin_amdgcn_fence(__ATOMIC_ACQUIRE, "agent");
      asm volatile("s_waitcnt vmcnt(0)" ::: "memory");
    }
  }
  __syncthreads();
}
DI int opaque_tid() { int t = threadIdx.x; asm volatile("" : "+v"(t)); return t; }
DI float4 ss_sum4(const float* base, int row0) {
  float4 a = *(const float4*)(base + row0);
#pragma unroll
  for (int pz = 1; pz < 8; pz++) {
    float4 b = *(const float4*)(base + (size_t)pz * NTOK + row0);
    a.x += b.x; a.y += b.y; a.z += b.z; a.w += b.w;
  }
  return a;
}
DI float ss_sum1(const float* base, int row) {
  float a = base[row];
#pragma unroll
  for (int pz = 1; pz < 8; pz++) a += base[(size_t)pz * NTOK + row];
  return a;
}
DI float wave_sum(float v) { for (int o = 32; o; o >>= 1) v += __shfl_xor(v, o); return v; }
DI float fast_exp2(float x) { return __builtin_amdgcn_exp2f(x); }
DI float gelu_tanh(float x) {
  float z = 0.7978845608028654f * (x + 0.044715f * x * x * x);
  float e = __expf(2.f * z);
  float t = 1.f - 2.f / (1.f + e);
  return 0.5f * x * (1.f + t);
}
DI float reduce_2pi(double a) {
  double n = rint(a * 0.15915494309189535);
  return (float)(a - n * 6.283185307179586);
}

DI void transpose_tile(const float* src, int ldsrc, int k0, int c0, const float* scale, int nscale,
                       bf16_t* dst, int lddst, int n0, float* lds, const int tid) {
#pragma unroll
  for (int i = 0; i < 16; i++) {
    int kk = i * 4 + (tid >> 6), nn = tid & 63;
    float v = src[(size_t)(k0 + kk) * ldsrc + c0 + nn];
    if (scale != nullptr && (k0 + kk) < nscale) v *= scale[k0 + kk];
    lds[kk * 65 + nn] = v;
  }
  __syncthreads();
  {
    int nn = tid >> 2, kq = (tid & 3) * 16;
    unsigned pk[8];
#pragma unroll
    for (int i = 0; i < 8; i++) pk[i] = pack_bf2(lds[(kq + 2 * i) * 65 + nn], lds[(kq + 2 * i + 1) * 65 + nn]);
    u32x4* d = (u32x4*)(dst + (size_t)(n0 + nn) * lddst + k0 + kq);
    u32x4 a = {pk[0], pk[1], pk[2], pk[3]}, b = {pk[4], pk[5], pk[6], pk[7]};
    d[0] = a; d[1] = b;
  }
  __syncthreads();
}

DI void wtask(const float* src, int ldsrc, int k0, int c0, const float* scale, int nscale, bf16_t* dst, int lddst, int n0, int lane) {
  float v[32];
  const float* sp = src + (size_t)k0 * ldsrc + c0 + lane;
#pragma unroll
  for (int i = 0; i < 32; i++) v[i] = sp[(size_t)i * ldsrc];
  if (k0 < nscale) {
#pragma unroll
    for (int i = 0; i < 32; i++) v[i] *= scale[k0 + i];
  }
  u32x4* d = (u32x4*)(dst + (size_t)(n0 + lane) * lddst + k0);
#pragma unroll
  for (int q = 0; q < 4; q++) {
    u32x4 o = {pack_bf2(v[8 * q], v[8 * q + 1]), pack_bf2(v[8 * q + 2], v[8 * q + 3]), pack_bf2(v[8 * q + 4], v[8 * q + 5]), pack_bf2(v[8 * q + 6], v[8 * q + 7])};
    d[q] = o;
  }
}

__device__ __forceinline__ void phase_prep(KP p, char* smem, const int tid) {
  const int nb = gridDim.x, bid = blockIdx.x;
  const int wave = tid >> 6, lane = tid & 63;
  for (int row = bid * 4 + wave; row < NTOK; row += nb * 4) {
    const float4* src = (const float4*)(p->x + (size_t)row * DM);
    float s = 0.f;
#pragma unroll
    for (int i = 0; i < 4; i++) {
      float4 v = src[lane + 64 * i];
      u32x2 pk = {pack_bf2(v.x, v.y), pack_bf2(v.z, v.w)};
      ((u32x2*)(p->xb + (size_t)row * DM))[lane + 64 * i] = pk;
      const float a0 = __uint_as_float(pk[0] << 16), a1 = __uint_as_float(pk[0] & 0xffff0000u);
      const float a2 = __uint_as_float(pk[1] << 16), a3 = __uint_as_float(pk[1] & 0xffff0000u);
      s += a0 * a0 + a1 * a1 + a2 * a2 + a3 * a3;
    }
    s = wave_sum(s);
    if (lane < 8) p->ss[(size_t)lane * NTOK + row] = (lane == 0) ? s : 0.f;
  }
  for (int i = bid * 256 + tid; i < NTOK * 8; i += nb * 256) {
    int tok = i >> 3, j = i & 7;
    double inv = (j & 4) ? ((j & 2) ? ((j & 1) ? 1.031338537721246e-05 : 5.318295896944988e-05) : ((j & 1) ? 0.0002742481756762073 : 0.001414213562373095))
                         : ((j & 2) ? ((j & 1) ? 0.007292664737217109 : 0.03760603093086393) : ((j & 1) ? 0.19392274474868576 : 1.0));
    double ang = (double)p->pos[tok] * inv;
    float r = reduce_2pi(ang);
    p->cs[2 * i] = cosf(r); p->cs[2 * i + 1] = sinf(r);
  }
  for (int i = bid * 256 + tid; i < 4 * 32 * 64; i += nb * 256) {
    int lg = i >> 6;
    float lr = p->lam_re[i], li = p->lam_im[i];
    float step = expf(p->log_step[lg]);
    float mag = expf(step * lr);
    double angd = (double)step * (double)li;
    float r1 = reduce_2pi(angd);
    float ar = mag * cosf(r1), ai = mag * sinf(r1);
    float den = lr * lr + li * li;
    float fr = ((ar - 1.f) * lr + ai * li) / den;
    float fi = (ai * lr - (ar - 1.f) * li) / den;
    float magT = expf(64.f * step * lr);
    float rT = reduce_2pi(64.0 * angd);
    float* tb = p->s5tab + (size_t)i * 40;
    tb[0] = ar; tb[1] = ai; tb[2] = magT * cosf(rT); tb[3] = magT * sinf(rT);
    for (int c = 0; c < 16; c++) {
      float br = p->b_re[(size_t)i * 16 + c], bi = p->b_im[(size_t)i * 16 + c];
      tb[4 + c] = fr * br - fi * bi;
      tb[20 + c] = fr * bi + fi * br;
    }
  }
  {
    const int NTASK = 4 * 6016;
    const int gw = bid * 4 + wave, nw = nb * 4;
    const int per = (NTASK + nw - 1) / nw;
    const int t_lo = gw * per, t_hi = min(t_lo + per, NTASK);
    for (int task = t_lo; task < t_hi; task++) {
      const int layer = task / 6016;
      int t = task % 6016;
      if (t < 1024) {
        const int a = t >> 5, kb = t & 31;
        wtask(p->w_in + (size_t)layer * 1024 * 2048, 2048, kb * 32, a * 64, p->norm_mix + layer * 1024, 1024,
              p->WinT + (size_t)layer * 2048 * 1024, 1024, a * 64, lane);
      } else if (t < 1280) {
        t -= 1024; const int a = t >> 4, kb = t & 15;
        wtask(p->w_glu + (size_t)layer * 512 * 1024, 1024, kb * 32, (a & 1) * 512 + (a >> 1) * 64, p->norm_mix, 0,
              p->WgluT + (size_t)layer * 1024 * 512, 512, a * 64, lane);
      } else if (t < 1792) {
        t -= 1280; const int a = t >> 5, kb = t & 31;
        wtask(p->w_out + (size_t)layer * 1024 * 1024, 1024, kb * 32, a * 64, p->ssm_norm + layer * 512, 512,
              p->WoutT + (size_t)layer * 1024 * 1024, 1024, a * 64, lane);
      } else if (t < 4608) {
        t -= 1792; const int a = t >> 5, kb = t & 31;
        wtask(p->w_up + (size_t)layer * 1024 * 5632, 5632, kb * 32, (a & 1) * FFN + (a >> 1) * 64, p->norm_ffn + layer * 1024, 1024,
              p->WupT + (size_t)layer * 5632 * 1024, 1024, a * 64, lane);
      } else {
        t -= 4608; const int a = t / 88, kb = t % 88;
        wtask(p->w_down + (size_t)layer * FFN * 1024, 1024, kb * 32, a * 64, p->norm_mix, 0,
              p->WdownT + (size_t)layer * 1024 * FFN, FFN, a * 64, lane);
      }
    }
  }
}

enum { G_IN = 0, G_GLU = 1, G_WOUT = 2, G_UP = 3, G_DOWN = 4 };
#define ACC_PIN(tag) _Pragma("unroll") for (int i_ = 0; i_ < 4; i_++) _Pragma("unroll") for (int j_ = 0; j_ < 4; j_++) asm volatile("; pin " tag : "+a"(acc[i_][j_]));


__device__ __forceinline__ void gemm_tile(KP p, const int MODE, int layer, int tile, char* smem, const int tid) {
  const int lane = tid & 63, w = tid >> 6, wm = w >> 1, wn = w & 1, g = lane >> 5, l32 = lane & 31;
  int tn, KT, ldb, rowbase, lda;
  const bf16_t* Bt;
  const bf16_t* A0;
  int upb = 0, upti = 0;
  {
    const int TM = (MODE == G_UP) ? 66 : 64;
    const int TN = (MODE == G_IN) ? 8 : (MODE == G_UP ? 22 : 4);
    const int nfull = TN >> 2, rem = TN & 3;
    int tm;
    if (tile < nfull * 4 * TM) { const int band = tile / (4 * TM), within = tile % (4 * TM); tm = within >> 2; tn = band * 4 + (within & 3); }
    else { const int s2 = tile - nfull * 4 * TM; tm = s2 / rem; tn = nfull * 4 + s2 % rem; }
    rowbase = tm * 256;
    if (MODE == G_UP) { upb = tm / 33; upti = tm % 33; rowbase = upb * SEQL + 254 * upti - 2; }
  }
  if (MODE == G_IN) { KT = 16; ldb = 1024; Bt = p->WinT + (size_t)layer * 2048 * 1024; A0 = p->xb; lda = 1024; }
  else if (MODE == G_GLU) { KT = 8; ldb = 512; Bt = p->WgluT + (size_t)layer * 1024 * 512; A0 = p->gy; lda = 512; }
  else if (MODE == G_WOUT) { KT = 16; ldb = 1024; Bt = p->WoutT + (size_t)layer * 1024 * 1024; A0 = p->outg; lda = 512; }
  else if (MODE == G_UP) { KT = 16; ldb = 1024; Bt = p->WupT + (size_t)layer * 5632 * 1024; A0 = p->xb; lda = 1024; }
  else { KT = 44; ldb = FFN; Bt = p->WdownT + (size_t)layer * 1024 * FFN; A0 = p->act; lda = FFN; }

  u32x4 ra[8], rb[8];
  const int lrow = tid >> 3, lc = tid & 7;
  float arow_sc[8];
#pragma unroll
  for (int i = 0; i < 8; i++) arow_sc[i] = 1.f;
  if (MODE == G_WOUT) {
    const float* ssq = p->ssm_ss + (size_t)layer * 8 * NTOK;
#pragma unroll
    for (int i = 0; i < 8; i++) arow_sc[i] = rsqrtf(ss_sum1(ssq, rowbase + lrow + 32 * i) * (1.f / 512.f) + EPS);
  }
  const bf16_t* bptr = Bt + (size_t)(tn * 256 + lrow) * ldb + lc * 8;
  auto gload = [&](int kt) {
    const bf16_t* abase = A0;
    int kofs = kt * 64;
    if (MODE == G_WOUT && kt >= 8) { abase = p->att; kofs = (kt - 8) * 64; }
#pragma unroll
    for (int i = 0; i < 8; i++) {
      int gr = min(max(rowbase + lrow + 32 * i, 0), NTOK - 1);
      ra[i] = *(const u32x4*)(abase + (size_t)gr * lda + kofs + lc * 8);
      rb[i] = *(const u32x4*)(bptr + (size_t)(32 * i) * ldb + kt * 64);
    }
  };
  auto scaleA = [&](int kt) {
    if (MODE == G_WOUT && kt < 8) {
#pragma unroll
      for (int i = 0; i < 8; i++)
#pragma unroll
        for (int e = 0; e < 4; e++) {
          unsigned v = ra[i][e];
          float lo = __uint_as_float(v << 16) * arow_sc[i], hi = __uint_as_float(v & 0xffff0000u) * arow_sc[i];
          ra[i][e] = pack_bf2(lo, hi);
        }
    }
  };
  const int wr_off = lrow * 128 + ((lc ^ ((lrow >> 1) & 7)) << 4);
  auto lwriteA = [&](int st) {
    char* sa = smem + st * 65536;
#pragma unroll
    for (int i = 0; i < 8; i++) *(u32x4*)(sa + wr_off + i * 4096) = ra[i];
  };
  auto lwriteB = [&](int st) {
    char* sb = smem + st * 65536 + 32768;
#pragma unroll
    for (int i = 0; i < 8; i++) *(u32x4*)(sb + wr_off + i * 4096) = rb[i];
  };

  f32x16 acc[4][4];
#pragma unroll
  for (int i = 0; i < 4; i++)
#pragma unroll
    for (int j = 0; j < 4; j++)
#pragma unroll
      for (int r = 0; r < 16; r++) acc[i][j][r] = 0.f;

  const int swz = (l32 >> 1) & 7;
  const int a_base = (wm * 128 + l32) * 128;
  const int b_base = 32768 + (wn * 128 + l32) * 128;
  bf16x8 af[2][4], bfr[2][4];
  auto lfrag = [&](int buf, const char* st, int ks) {
    const int coff = (((ks * 2 + g) ^ swz) << 4);
#pragma unroll
    for (int i = 0; i < 4; i++) af[buf][i] = *(const bf16x8*)(st + a_base + i * 4096 + coff);
#pragma unroll
    for (int j = 0; j < 4; j++) bfr[buf][j] = *(const bf16x8*)(st + b_base + j * 4096 + coff);
  };
  auto mfma16 = [&](int buf) {
#pragma unroll
    for (int i = 0; i < 4; i++)
#pragma unroll
      for (int j = 0; j < 4; j++) acc[i][j] = MFMA(af[buf][i], bfr[buf][j], acc[i][j]);
  };

  gload(0);
  scaleA(0);
  lwriteA(0);
  lwriteB(0);
  __syncthreads();
  if (KT > 1) gload(1);
  lfrag(0, smem, 0);
  for (int kt = 0; kt < KT; kt++) {
    const char* st = smem + (kt & 1) * 65536;
    const bool has1 = (kt + 1 < KT), has2 = (kt + 2 < KT);
    lfrag(1, st, 1);
    if (has1) { scaleA(kt + 1); lwriteA((kt + 1) & 1); }
    mfma16(0);
    __builtin_amdgcn_sched_barrier(0);
    lfrag(0, st, 2);
    if (has1) lwriteB((kt + 1) & 1);
    mfma16(1);
    __builtin_amdgcn_sched_barrier(0);
    lfrag(1, st, 3);
    if (has2) gload(kt + 2);
    mfma16(0);
    __builtin_amdgcn_sched_barrier(0);
    asm volatile("s_waitcnt lgkmcnt(0)" ::: "memory");
    __builtin_amdgcn_s_barrier();
    __builtin_amdgcn_sched_barrier(0);
    if (has1) lfrag(0, smem + ((kt + 1) & 1) * 65536, 0);
    mfma16(1);
    __builtin_amdgcn_sched_barrier(0);
  }

  int tid2 = tid;
  asm volatile("" : "+v"(tid2));
  {
  const int tid = tid2;
  const int lane = tid & 63, w = tid >> 6, wm = w >> 1, wn = w & 1, g = lane >> 5, l32 = lane & 31;
  if (MODE == G_IN) {
    const int region = tn >> 1;
    float* rs = (float*)(smem + 135168);
    rs[tid] = rsqrtf(ss_sum1(p->ss + (size_t)(2 * layer) * 8 * NTOK, rowbase + tid) * (1.f / 1024.f) + EPS);
    __syncthreads();
#pragma unroll
    for (int i = 0; i < 4; i++)
#pragma unroll
      for (int rq = 0; rq < 4; rq++) {
        const int lr0 = wm * 128 + i * 32 + rq * 8 + g * 4;
        const float4 s4 = *(const float4*)(rs + lr0);
        const float sc[4] = {s4.x, s4.y, s4.z, s4.w};
#pragma unroll
        for (int j = 0; j < 4; j++) {
          const int lcol = wn * 128 + j * 32 + l32;
          float v[4];
#pragma unroll
          for (int r4 = 0; r4 < 4; r4++) v[r4] = acc[i][j][rq * 4 + r4] * sc[r4];
          if (region == 3) {
            const int q4 = (lr0 >> 2) & 3;
            const int pq = ((q4 & 1) << 1) | (q4 >> 1);
            u32x2 pk = {pack_bf2(v[0], v[1]), pack_bf2(v[2], v[3])};
            *(u32x2*)(smem + lcol * 528 + ((lr0 & ~15) + pq * 4) * 2) = pk;
          } else {
            if (region != 0 && (j & 1) == 0) {
              float other[4];
#pragma unroll
              for (int r4 = 0; r4 < 4; r4++) other[r4] = __shfl_xor(v[r4], 8);
              if (l32 < 16) {
                const float sgn = (l32 < 8) ? -1.f : 1.f;
#pragma unroll
                for (int r4 = 0; r4 < 4; r4++) {
                  const float2 csv = *(const float2*)(p->cs + ((size_t)(rowbase + lr0 + r4) * 8 + (l32 & 7)) * 2);
                  v[r4] = v[r4] * csv.x + sgn * other[r4] * csv.y;
                }
              }
            }
#pragma unroll
            for (int r4 = 0; r4 < 4; r4++) *(bf16_t*)(smem + (lr0 + r4) * 528 + lcol * 2) = f2bf(v[r4]);
          }
        }
      }
    __syncthreads();
    {
      bf16_t* dbase;
      size_t rstride;
      if (region == 3) { dbase = p->vt + (size_t)((rowbase >> 13) * 512 + (tn & 1) * 256) * SEQL + (rowbase & (SEQL - 1)); rstride = SEQL; }
      else { dbase = (region == 0 ? p->u : (region == 1 ? p->q : p->k)) + (size_t)rowbase * 512 + (tn & 1) * 256; rstride = 512; }
#pragma unroll 8
      for (int it = 0; it < 32; it++) {
        const int id = tid + 256 * it, row = id >> 5, c = id & 31;
        const u32x4 vv = *(const u32x4*)(smem + row * 528 + c * 16);
        *(u32x4*)(dbase + (size_t)row * rstride + c * 8) = vv;
      }
    }
    __syncthreads();
  } else if (MODE == G_GLU) {
#pragma unroll
    for (int i = 0; i < 4; i++)
#pragma unroll
      for (int j = 0; j < 2; j++)
#pragma unroll
        for (int r = 0; r < 16; r++) {
          const int lr = wm * 128 + i * 32 + (r >> 2) * 8 + g * 4 + (r & 3);
          const float av = acc[i][j][r], bv = acc[i][j + 2][r];
          *(bf16_t*)(smem + lr * 272 + (wn * 64 + j * 32 + l32) * 2) = f2bf(av / (1.f + __expf(-bv)));
        }
    __syncthreads();
    {
      float* ssq = p->ssm_ss + ((size_t)layer * 8 + tn * 2) * NTOK;
#pragma unroll 4
      for (int it = 0; it < 16; it++) {
        const int id = tid + 256 * it, row = id >> 4, c = id & 15;
        const u32x4 ov = *(const u32x4*)(smem + row * 272 + c * 16);
        *(u32x4*)(p->outg + (size_t)(rowbase + row) * 512 + tn * 128 + c * 8) = ov;
        float sq = 0.f;
#pragma unroll
        for (int e = 0; e < 4; e++) {
          const float lo = __uint_as_float(ov[e] << 16), hi = __uint_as_float(ov[e] & 0xffff0000u);
          sq += lo * lo + hi * hi;
        }
#pragma unroll
        for (int o = 4; o; o >>= 1) sq += __shfl_xor(sq, o);
        if ((c & 7) == 0) ssq[(size_t)(c >> 3) * NTOK + rowbase + row] = sq;
      }
    }
    __syncthreads();
  } else if (MODE == G_WOUT || MODE == G_DOWN) {
#pragma unroll
    for (int i = 0; i < 4; i++)
#pragma unroll
      for (int j = 0; j < 4; j++)
#pragma unroll
        for (int r = 0; r < 16; r++) {
          const int lr = wm * 128 + i * 32 + (r >> 2) * 8 + g * 4 + (r & 3);
          *(bf16_t*)(smem + lr * 528 + (wn * 128 + j * 32 + l32) * 2) = f2bf(acc[i][j][r]);
        }
    __syncthreads();
    {
      float* ssq = p->ss + ((size_t)(MODE == G_WOUT ? 2 * layer + 1 : 2 * layer + 2) * 8 + tn * 2) * NTOK;
#pragma unroll 4
      for (int it = 0; it < 32; it++) {
        const int id = tid + 256 * it, row = id >> 5, c = id & 31;
        const u32x4 dv = *(const u32x4*)(smem + row * 528 + c * 16);
        const size_t idx = (size_t)(rowbase + row) * 1024 + tn * 256 + c * 8;
        const u32x4 xv = *(const u32x4*)(p->xb + idx);
        u32x4 xbv;
        float sq = 0.f;
#pragma unroll
        for (int e = 0; e < 4; e++) {
          const float lo = __uint_as_float(xv[e] << 16) + __uint_as_float(dv[e] << 16);
          const float hi = __uint_as_float(xv[e] & 0xffff0000u) + __uint_as_float(dv[e] & 0xffff0000u);
          const unsigned pk = pack_bf2(lo, hi);
          xbv[e] = pk;
          const float rl = __uint_as_float(pk << 16), rh = __uint_as_float(pk & 0xffff0000u);
          sq += rl * rl + rh * rh;
        }
        *(u32x4*)(p->xb + idx) = xbv;
#pragma unroll
        for (int o = 8; o; o >>= 1) sq += __shfl_xor(sq, o);
        if ((c & 15) == 0) ssq[(size_t)(c >> 4) * NTOK + rowbase + row] = sq;
      }
    }
    __syncthreads();
  } else {
#pragma unroll
    for (int i = 0; i < 4; i++)
#pragma unroll
      for (int rq = 0; rq < 4; rq++) {
        const int lr0 = wm * 128 + i * 32 + rq * 8 + g * 4;
#pragma unroll
        for (int j = 0; j < 4; j++) {
          const int pc = wn * 128 + j * 32 + l32;
          u32x2 pk = {pack_bf2(acc[i][j][rq * 4 + 0], acc[i][j][rq * 4 + 1]), pack_bf2(acc[i][j][rq * 4 + 2], acc[i][j][rq * 4 + 3])};
          *(u32x2*)(smem + pc * 528 + lr0 * 2) = pk;
        }
      }
    {
      float* rs = (float*)(smem + 135168);
      const int tb = 254 * upti - 2 + tid;
      float sc = 0.f;
      if (tb >= 0) {
        const int gr = min(upb * SEQL + tb, NTOK - 1);
        sc = rsqrtf(ss_sum1(p->ss + (size_t)(2 * layer + 1) * 8 * NTOK, gr) * (1.f / 1024.f) + EPS);
      }
      rs[tid] = sc;
    }
    __syncthreads();
    {
      const int cp = tid & 127, half = tid >> 7;
      const int pg = (cp >> 6) * 128 + (cp & 63), pv = pg + 64;
      const int ocol = tn * 128 + cp;
      const float* wc = p->w_conv + (size_t)layer * 3 * 5632;
      const float* bc = p->b_conv + (size_t)layer * 5632;
      const float wg0 = wc[ocol], wg1 = wc[5632 + ocol], wg2 = wc[2 * 5632 + ocol], bg = bc[ocol];
      const float wv0 = wc[FFN + ocol], wv1 = wc[5632 + FFN + ocol], wv2 = wc[2 * 5632 + FFN + ocol], bv = bc[FFN + ocol];
      const float* rs = (const float*)(smem + 135168);
      const char* gcol = smem + pg * 528;
      const char* vcol = smem + pv * 528;
      float g0 = 0.f, v0 = 0.f, g1 = 0.f, v1 = 0.f;
      if (half) {
        g0 = rs[126] * bf2f(*(const bf16_t*)(gcol + 126 * 2)); v0 = rs[126] * bf2f(*(const bf16_t*)(vcol + 126 * 2));
        g1 = rs[127] * bf2f(*(const bf16_t*)(gcol + 127 * 2)); v1 = rs[127] * bf2f(*(const bf16_t*)(vcol + 127 * 2));
      }
      for (int grp8 = 0; grp8 < 16; grp8++) {
        const int lrb = half * 128 + grp8 * 8;
        const u32x4 gq = *(const u32x4*)(gcol + lrb * 2);
        const u32x4 vq = *(const u32x4*)(vcol + lrb * 2);
        const float4 r0 = *(const float4*)(rs + lrb), r1 = *(const float4*)(rs + lrb + 4);
        const float rsv[8] = {r0.x, r0.y, r0.z, r0.w, r1.x, r1.y, r1.z, r1.w};
#pragma unroll
        for (int e = 0; e < 8; e++) {
          const unsigned gw = gq[e >> 1], vw = vq[e >> 1];
          const float g2 = rsv[e] * ((e & 1) ? __uint_as_float(gw & 0xffff0000u) : __uint_as_float(gw << 16));
          const float v2 = rsv[e] * ((e & 1) ? __uint_as_float(vw & 0xffff0000u) : __uint_as_float(vw << 16));
          const int lr = lrb + e;
          const int tb = 254 * upti - 2 + lr;
          if (lr >= 2 && tb < SEQL) {
            const float gate = bg + wg0 * g0 + wg1 * g1 + wg2 * g2;
            const float val = bv + wv0 * v0 + wv1 * v1 + wv2 * v2;
            const float o = gate / (1.f + __expf(-gate)) * val;
            p->act[(size_t)(upb * SEQL + tb) * FFN + ocol] = f2bf(o);
          }
          g0 = g1; v0 = v1; g1 = g2; v1 = v2;
        }
      }
    }
    __syncthreads();
  }
  }
}

__device__ __forceinline__ void attn_item(KP p, int layer, int b, int h, int qt, float lam, float outscale, char* smem, const int tid) {
  const int lane = tid & 63, w = tid >> 6, g = lane >> 5, l32 = lane & 31;
  const int tok_q = b * SEQL + qt * 128 + w * 32 + l32;
  bf16x8 qreg[2][4];
#pragma unroll
  for (int c = 0; c < 2; c++)
#pragma unroll
    for (int ks = 0; ks < 4; ks++)
      qreg[c][ks] = *(const bf16x8*)(p->q + (size_t)tok_q * 512 + h * 128 + c * 64 + ks * 16 + g * 8);

  const int NT = 2 * qt + 2;
  const int nkt = 2 * qt + 1 + (w >> 1);
  f32x16 O[2][4];
#pragma unroll
  for (int c = 0; c < 2; c++)
#pragma unroll
    for (int dt = 0; dt < 4; dt++)
#pragma unroll
      for (int r = 0; r < 16; r++) O[c][dt][r] = 0.f;
  float mrun[2] = {-1e30f, -1e30f}, lrun[2] = {0.f, 0.f};
  const float c1 = 0.125f * 1.4426950408889634f;

  u32x4 rk[4], rv[4];
  const bf16_t* kbase = p->k + (size_t)(b * SEQL) * 512 + h * 128;
  const bf16_t* vbase = p->vt + (size_t)((b * 4 + h) * 128) * SEQL;
  const int kkey = tid >> 4, kc = tid & 15;
  const int vd = tid >> 3, vc = tid & 7;
  auto gload = [&](int kt) {
#pragma unroll
    for (int i = 0; i < 4; i++) {
      rk[i] = *(const u32x4*)(kbase + (size_t)(kt * 64 + kkey + 16 * i) * 512 + kc * 8);
      rv[i] = *(const u32x4*)(vbase + (size_t)(vd + 32 * i) * SEQL + kt * 64 + vc * 8);
    }
  };
  const int kw_off = kkey * 256 + ((kc ^ (kkey & 15)) << 4);
  const int vw_off = 16384 + vd * 128 + ((vc ^ ((vd >> 1) & 7)) << 4);
  auto lwrite = [&](int st) {
    char* s = smem + st * 32768;
#pragma unroll
    for (int i = 0; i < 4; i++) {
      *(u32x4*)(s + kw_off + i * 4096) = rk[i];
      *(u32x4*)(s + vw_off + i * 4096) = rv[i];
    }
  };

  gload(0);
  lwrite(0);
  __syncthreads();
  for (int kt = 0; kt < NT; kt++) {
    if (kt + 1 < NT) gload(kt + 1);
    if (kt < nkt) {
      const char* st = smem + (kt & 1) * 32768;
      bf16x8 pf[2][2][2];
      bf16x8 kf[8], vf[2][4];
      f32x16 S[1][2];
      auto loadkq = [&](int c) {
#pragma unroll
        for (int kb = 0; kb < 2; kb++)
#pragma unroll
          for (int ks = 0; ks < 4; ks++) {
            const int key = kb * 32 + l32, chunk = c * 8 + ks * 2 + g;
            kf[kb * 4 + ks] = *(const bf16x8*)(st + key * 256 + ((chunk ^ (key & 15)) << 4));
          }
      };
      auto qk = [&](int c) {
        f32x16 zero;
#pragma unroll
        for (int r = 0; r < 16; r++) zero[r] = 0.f;
#pragma unroll
        for (int kb = 0; kb < 2; kb++) {
          S[0][kb] = MFMA(kf[kb * 4], qreg[c][0], zero);
#pragma unroll
          for (int ks = 1; ks < 4; ks++) S[0][kb] = MFMA(kf[kb * 4 + ks], qreg[c][ks], S[0][kb]);
        }
      };
      auto loadv = [&](int bi) {
#pragma unroll
        for (int dt = 0; dt < 4; dt++) {
          const int d = dt * 32 + l32, chunk = bi * 2 + g;
          vf[bi & 1][dt] = *(const bf16x8*)(st + 16384 + d * 128 + ((chunk ^ ((d >> 1) & 7)) << 4));
        }
      };
      auto softmax = [&](int c) {
        float mx = S[0][0][0];
#pragma unroll
        for (int r = 1; r < 16; r++) mx = fmaxf(mx, S[0][0][r]);
#pragma unroll
        for (int r = 0; r < 16; r++) mx = fmaxf(mx, S[0][1][r]);
        {
          const unsigned mu = __float_as_uint(mx);
          auto sw = __builtin_amdgcn_permlane32_swap(mu, mu, false, false);
          mx = fmaxf(__uint_as_float(sw[0]), __uint_as_float(sw[1]));
        }
        const float mcand = fmaxf(mrun[c], mx * c1);
        if (__any(mcand - mrun[c] > 8.f)) {
          const float alpha = fast_exp2(mrun[c] - mcand);
          mrun[c] = mcand;
          lrun[c] *= alpha;
#pragma unroll
          for (int dt = 0; dt < 4; dt++)
#pragma unroll
            for (int r = 0; r < 16; r++) O[c][dt][r] *= alpha;
        }
        const float mref = mrun[c];
        const f2_t c1v = {c1, c1}, mrv = {-mref, -mref};
        f2_t psum2 = {0.f, 0.f};
#pragma unroll
        for (int kb = 0; kb < 2; kb++)
#pragma unroll
          for (int r = 0; r < 16; r += 2) {
            f2_t sv = {S[0][kb][r], S[0][kb][r + 1]};
            f2_t av = __builtin_elementwise_fma(sv, c1v, mrv);
            f2_t ev = {fast_exp2(av[0]), fast_exp2(av[1])};
            S[0][kb][r] = ev[0]; S[0][kb][r + 1] = ev[1];
            psum2 += ev;
          }
        lrun[c] += psum2[0] + psum2[1];
#pragma unroll
        for (int kb = 0; kb < 2; kb++)
#pragma unroll
          for (int m = 0; m < 2; m++) {
            u32x4 pk = {pack_bf2(S[0][kb][8 * m + 0], S[0][kb][8 * m + 1]), pack_bf2(S[0][kb][8 * m + 2], S[0][kb][8 * m + 3]),
                        pack_bf2(S[0][kb][8 * m + 4], S[0][kb][8 * m + 5]), pack_bf2(S[0][kb][8 * m + 6], S[0][kb][8 * m + 7])};
            pf[c][kb][m] = __builtin_bit_cast(bf16x8, pk);
          }
      };
      loadkq(0);
      __builtin_amdgcn_sched_barrier(0);
      qk(0);
      __builtin_amdgcn_sched_barrier(0);
      loadkq(1);
      __builtin_amdgcn_sched_barrier(0);
      softmax(0);
      __builtin_amdgcn_sched_barrier(0);
      qk(1);
      loadv(0);
      __builtin_amdgcn_sched_barrier(0);
      softmax(1);
      __builtin_amdgcn_sched_barrier(0);
#pragma unroll
      for (int bi = 0; bi < 4; bi++) {
        if (bi < 3) loadv(bi + 1);
#pragma unroll
        for (int dt = 0; dt < 4; dt++) {
          O[0][dt] = MFMA(vf[bi & 1][dt], pf[0][bi >> 1][bi & 1], O[0][dt]);
          O[1][dt] = MFMA(vf[bi & 1][dt], pf[1][bi >> 1][bi & 1], O[1][dt]);
        }
        __builtin_amdgcn_sched_barrier(0);
      }
    }
    if (kt + 1 < NT) lwrite((kt + 1) & 1);
    __syncthreads();
  }

  const float l1 = lrun[0] + __shfl_xor(lrun[0], 32);
  const float l2 = lrun[1] + __shfl_xor(lrun[1], 32);
  const float i1 = 1.f / l1, i2 = lam / l2;
  float ssq = 0.f;
#pragma unroll
  for (int dt = 0; dt < 4; dt++)
#pragma unroll
    for (int r = 0; r < 16; r++) {
      float o = O[0][dt][r] * i1 - O[1][dt][r] * i2;
      O[0][dt][r] = o;
      ssq += o * o;
    }
  ssq += __shfl_xor(ssq, 32);
  const float rstd = rsqrtf(ssq * (1.f / 128.f) + EPS) * outscale;
  const float* gsub = p->subln + layer * 128;
#pragma unroll
  for (int dt = 0; dt < 4; dt++)
#pragma unroll
    for (int rq = 0; rq < 4; rq++) {
      const int d0 = dt * 32 + rq * 8 + g * 4;
      float4 gg = *(const float4*)(gsub + d0);
      u32x2 pk = {pack_bf2(O[0][dt][rq * 4 + 0] * rstd * gg.x, O[0][dt][rq * 4 + 1] * rstd * gg.y),
                  pack_bf2(O[0][dt][rq * 4 + 2] * rstd * gg.z, O[0][dt][rq * 4 + 3] * rstd * gg.w)};
      *(u32x2*)(p->att + (size_t)tok_q * 512 + h * 128 + d0) = pk;
    }
}

DI void s5_store_u(const u32x4 a, const u32x4 bq, int lane, float* ul) {
  float4* d = (float4*)(ul + lane * 16);
  d[0] = make_float4(__uint_as_float(a[0] << 16), __uint_as_float(a[0] & 0xffff0000u), __uint_as_float(a[1] << 16), __uint_as_float(a[1] & 0xffff0000u));
  d[1] = make_float4(__uint_as_float(a[2] << 16), __uint_as_float(a[2] & 0xffff0000u), __uint_as_float(a[3] << 16), __uint_as_float(a[3] & 0xffff0000u));
  d[2] = make_float4(__uint_as_float(bq[0] << 16), __uint_as_float(bq[0] & 0xffff0000u), __uint_as_float(bq[1] << 16), __uint_as_float(bq[1] & 0xffff0000u));
  d[3] = make_float4(__uint_as_float(bq[2] << 16), __uint_as_float(bq[2] & 0xffff0000u), __uint_as_float(bq[3] << 16), __uint_as_float(bq[3] & 0xffff0000u));
}
DI void s5_load_u(KP p, int b, int g, int j, int lane, float* ul) {
  const u32x4* src = (const u32x4*)(p->u + (size_t)(b * SEQL + j * 64 + lane) * 512 + g * 16);
  const u32x4 a = src[0], bq = src[1];
  s5_store_u(a, bq, lane, ul);
}

DI float swap_half(float v, const int which) {
  const unsigned u = __float_as_uint(v);
  auto r = __builtin_amdgcn_permlane32_swap(u, u, false, false);
  return __uint_as_float(which ? r[1] : r[0]);
}

struct S5Coef { float arA, aiA, arB, aiB; };

template <bool STORE>
DI void s5_scan32(const float* ul_sub, const bf16x8 (&bfr)[4], const S5Coef& cf, float& xAr, float& xAi, float& xBr, float& xBi,
                  float* X, const int l32, const int grp) {
  bf16x8 af;
  {
    const float* us = ul_sub + l32 * 16 + grp * 8;
    float4 a = *(const float4*)us, bq = *(const float4*)(us + 4);
    u32x4 pk = {pack_bf2(a.x, a.y), pack_bf2(a.z, a.w), pack_bf2(bq.x, bq.y), pack_bf2(bq.z, bq.w)};
    af = __builtin_bit_cast(bf16x8, pk);
  }
  f32x16 zero;
#pragma unroll
  for (int r = 0; r < 16; r++) zero[r] = 0.f;
  const f32x16 bu0 = MFMA(af, bfr[0], zero), bu1 = MFMA(af, bfr[1], zero), bu2 = MFMA(af, bfr[2], zero), bu3 = MFMA(af, bfr[3], zero);
#pragma unroll
  for (int k = 0; k < 8; k++) {
    float sAr[4], sAi[4], sBr[4], sBi[4];
#pragma unroll
    for (int i = 0; i < 4; i++) {
      const int r = (k >> 1) * 4 + i;
      const float nAr = cf.arA * xAr - cf.aiA * xAi + bu0[r];
      const float nAi = cf.arA * xAi + cf.aiA * xAr + bu2[r];
      const float nBr = cf.arB * xBr - cf.aiB * xBi + bu1[r];
      const float nBi = cf.arB * xBi + cf.aiB * xBr + bu3[r];
      xAr = nAr; xAi = nAi; xBr = nBr; xBi = nBi;
      sAr[i] = nAr; sAi[i] = nAi; sBr[i] = nBr; sBi[i] = nBi;
    }
    if (STORE) {
      if (grp == (k & 1)) {
#pragma unroll
        for (int i = 0; i < 4; i++) {
          float* xr = X + (4 * k + i) * 132;
          xr[l32] = sAr[i]; xr[64 + l32] = sAi[i]; xr[32 + l32] = sBr[i]; xr[96 + l32] = sBi[i];
        }
      }
    }
    xAr = swap_half(xAr, k & 1); xAi = swap_half(xAi, k & 1);
    xBr = swap_half(xBr, k & 1); xBi = swap_half(xBi, k & 1);
  }
}

DI void s5_setup(KP p, int layer, int g, int l32, int grp, S5Coef& cf, bf16x8 (&bfr)[4]) {
  const float* t0 = p->s5tab + (size_t)((layer * 32 + g) * 64) * 40;
  cf.arA = t0[l32 * 40]; cf.aiA = t0[l32 * 40 + 1];
  cf.arB = t0[(32 + l32) * 40]; cf.aiB = t0[(32 + l32) * 40 + 1];
#pragma unroll
  for (int jt = 0; jt < 4; jt++) {
    const float* src = t0 + (l32 + 32 * (jt & 1)) * 40 + 4 + (jt >> 1) * 16 + grp * 8;
    float4 a = *(const float4*)src, bq = *(const float4*)(src + 4);
    u32x4 pk = {pack_bf2(a.x, a.y), pack_bf2(a.z, a.w), pack_bf2(bq.x, bq.y), pack_bf2(bq.z, bq.w)};
    bfr[jt] = __builtin_bit_cast(bf16x8, pk);
  }
}

__device__ __forceinline__ void s5_pass1(KP p, int layer, char* smem, const int tid) {
  const int lane = tid & 63, w = tid >> 6, l32 = lane & 31, grp = lane >> 5;
  float* ul = (float*)(smem + w * 4096);
  for (int wbase = blockIdx.x * 4; wbase < 1024; wbase += gridDim.x * 4) {
    const int wi = wbase + w;
    const int j0 = (wi & 15) * 8, g = (wi >> 4) & 31, b = wi >> 9;
    S5Coef cf; bf16x8 bfr[4];
    s5_setup(p, layer, g, l32, grp, cf, bfr);
    const u32x4* src = (const u32x4*)(p->u + (size_t)(b * SEQL + j0 * 64 + lane) * 512 + g * 16);
    u32x4 v0 = src[0], v1 = src[1];
    for (int jj = 0; jj < 8; jj++) {
      const int j = j0 + jj;
      s5_store_u(v0, v1, lane, ul);
      if (jj < 7) {
        const u32x4* nsrc = (const u32x4*)(p->u + (size_t)(b * SEQL + (j + 1) * 64 + lane) * 512 + g * 16);
        v0 = nsrc[0]; v1 = nsrc[1];
      }
      __syncthreads();
      float xAr = 0.f, xAi = 0.f, xBr = 0.f, xBi = 0.f;
      s5_scan32<false>(ul, bfr, cf, xAr, xAi, xBr, xBi, nullptr, l32, grp);
      s5_scan32<false>(ul + 32 * 16, bfr, cf, xAr, xAi, xBr, xBi, nullptr, l32, grp);
      float* so = p->sloc + (size_t)((b * 32 + g) * 128 + j) * 128;
      so[lane] = grp ? xBr : xAr; so[64 + lane] = grp ? xBi : xAi;
      __syncthreads();
    }
  }
}

__device__ __forceinline__ void s5_pass2(KP p, int layer, char* smem, const int tid) {
  const int lane = tid & 63, w = tid >> 6;
  float* ul = (float*)(smem + w * 21504);
  float* X = ul + 1024;
  const int l32 = lane & 31, grp = lane >> 5;
  for (int wbase = blockIdx.x * 4; wbase < 1024; wbase += gridDim.x * 4) {
   const int wi = wbase + w;
   const int j0 = (wi & 15) * 8, g = (wi >> 4) & 31, b = wi >> 9;
   S5Coef cf; bf16x8 bfr[4];
   s5_setup(p, layer, g, l32, grp, cf, bfr);
   bf16x8 cfr[8];
   {
     const int c = l32 & 15;
     const float* cr = p->c_re + (size_t)((layer * 32 + g) * 16 + c) * 64;
     const float* ci = p->c_im + (size_t)((layer * 32 + g) * 16 + c) * 64;
#pragma unroll
     for (int s8 = 0; s8 < 8; s8++) {
       const int k0 = (s8 & 3) * 16 + grp * 8;
       const float* src = (s8 < 4) ? (cr + k0) : (ci + k0);
       const float sg = (l32 < 16) ? ((s8 < 4) ? 1.f : -1.f) : 0.f;
       float4 a = *(const float4*)src, bq = *(const float4*)(src + 4);
       u32x4 pk = {pack_bf2(a.x * sg, a.y * sg), pack_bf2(a.z * sg, a.w * sg), pack_bf2(bq.x * sg, bq.y * sg), pack_bf2(bq.z * sg, bq.w * sg)};
       cfr[s8] = __builtin_bit_cast(bf16x8, pk);
     }
   }
   const float dd = p->ssm_d[(size_t)(layer * 32 + g) * 16 + (l32 & 15)];
   float xAr, xAi, xBr, xBi;
   {
     const float* tb = p->s5tab + (size_t)((layer * 32 + g) * 64 + lane) * 40;
     const float aTr = tb[2], aTi = tb[3];
     float xr = 0.f, xi = 0.f;
     const float* sl = p->sloc + (size_t)((b * 32 + g) * 128) * 128;
     for (int i0 = 0; i0 < j0; i0 += 8) {
       float sr[8], si[8];
#pragma unroll
       for (int q = 0; q < 8; q++) { sr[q] = sl[(i0 + q) * 128 + lane]; si[q] = sl[(i0 + q) * 128 + 64 + lane]; }
#pragma unroll
       for (int q = 0; q < 8; q++) {
         const float nr = aTr * xr - aTi * xi + sr[q];
         const float ni = aTr * xi + aTi * xr + si[q];
         xr = nr; xi = ni;
       }
     }
     xAr = swap_half(xr, 0); xBr = swap_half(xr, 1);
     xAi = swap_half(xi, 0); xBi = swap_half(xi, 1);
   }
   for (int jj = 0; jj < 8; jj++) {
    const int j = j0 + jj;
    s5_load_u(p, b, g, j, lane, ul);
    __syncthreads();
    for (int sub = 0; sub < 2; sub++) {
      s5_scan32<true>(ul + sub * 32 * 16, bfr, cf, xAr, xAi, xBr, xBi, X, l32, grp);
      __syncthreads();
      f32x16 yacc;
#pragma unroll
      for (int r = 0; r < 16; r++) yacc[r] = 0.f;
#pragma unroll
      for (int s8 = 0; s8 < 8; s8++) {
        const float* xs = X + l32 * 132 + ((s8 < 4) ? 0 : 64) + (s8 & 3) * 16 + grp * 8;
        float4 a = *(const float4*)xs, bq = *(const float4*)(xs + 4);
        u32x4 pk = {pack_bf2(a.x, a.y), pack_bf2(a.z, a.w), pack_bf2(bq.x, bq.y), pack_bf2(bq.z, bq.w)};
        yacc = MFMA(__builtin_bit_cast(bf16x8, pk), cfr[s8], yacc);
      }
      if (l32 < 16) {
#pragma unroll
        for (int r = 0; r < 16; r++) {
          const int tl = sub * 32 + (r >> 2) * 8 + grp * 4 + (r & 3);
          const float yv = yacc[r] + dd * ul[tl * 16 + l32];
          p->gy[(size_t)(b * SEQL + j * 64 + tl) * 512 + g * 16 + l32] = f2bf(gelu_tanh(yv));
        }
      }
      __syncthreads();
    }
   }
  }
}

__device__ __forceinline__ void phase_attn(KP p, int layer, char* smem, const int tid) {
  const int lane = tid & 63;
  const float s1 = wave_sum(p->lq1[layer * 64 + lane] * p->lk1[layer * 64 + lane]);
  const float s2 = wave_sum(p->lq2[layer * 64 + lane] * p->lk2[layer * 64 + lane]);
  const float lam_init = 0.8f - 0.6f * expf(-0.3f * (float)layer);
  const float lam = expf(s1) - expf(s2) + lam_init;
  for (int pb = blockIdx.x; pb < 256; pb += gridDim.x) {
    const int pi = (pb & 7) * 32 + (pb >> 3);
    const int b = pi >> 7, h = (pi >> 5) & 3, i = pi & 31;
    attn_item(p, layer, b, h, 63 - i, lam, 1.f - lam_init, smem, tid);
    attn_item(p, layer, b, h, i, lam, 1.f - lam_init, smem, tid);
  }
  s5_pass1(p, layer, smem, tid);
}

__device__ __forceinline__ void phase_final(KP p, const int tid) {
  const int wave = tid >> 6, lane = tid & 63;
  const float* ssq = p->ss + (size_t)8 * 8 * NTOK;
  for (int row = blockIdx.x * 4 + wave; row < NTOK; row += gridDim.x * 4) {
    const float rstd = rsqrtf(ss_sum1(ssq, row) * (1.f / 1024.f) + EPS);
#pragma unroll
    for (int i = 0; i < 4; i++) {
      const u32x2 xv = ((const u32x2*)(p->xb + (size_t)row * DM))[lane + 64 * i];
      float4 v = {__uint_as_float(xv[0] << 16), __uint_as_float(xv[0] & 0xffff0000u), __uint_as_float(xv[1] << 16), __uint_as_float(xv[1] & 0xffff0000u)};
      float4 gq = ((const float4*)p->norm_final)[lane + 64 * i];
      float4 o = {v.x * rstd * gq.x, v.y * rstd * gq.y, v.z * rstd * gq.z, v.w * rstd * gq.w};
      ((float4*)(p->out + (size_t)row * DM))[lane + 64 * i] = o;
    }
  }
}

__device__ __forceinline__ void run_phase(KP p, int ph, char* smem) {
  const int tid = opaque_tid();
  if (ph == 0) { phase_prep(p, smem, tid); return; }
  if (ph == 29) { phase_final(p, tid); return; }
  const int layer = (ph - 1) / 7, k = (ph - 1) % 7;
  const int nb = gridDim.x, bid = blockIdx.x;
  if (k == 1) { phase_attn(p, layer, smem, tid); return; }
  if (k == 2) { s5_pass2(p, layer, smem, tid); return; }
  if (k == 0) { for (int r = 0; ; r++) { const int t = (r * 8 + (bid & 7)) * (nb >> 3) + (bid >> 3); if (r * nb >= 512) break; if (t < 512) gemm_tile(p, G_IN, layer, t, smem, tid); } }
  else if (k == 3) { for (int r = 0; ; r++) { const int t = (r * 8 + (bid & 7)) * (nb >> 3) + (bid >> 3); if (r * nb >= 256) break; if (t < 256) gemm_tile(p, G_GLU, layer, t, smem, tid); } }
  else if (k == 4) { for (int r = 0; ; r++) { const int t = (r * 8 + (bid & 7)) * (nb >> 3) + (bid >> 3); if (r * nb >= 256) break; if (t < 256) gemm_tile(p, G_WOUT, layer, t, smem, tid); } }
  else if (k == 5) { for (int r = 0; ; r++) { const int t = (r * 8 + (bid & 7)) * (nb >> 3) + (bid >> 3); if (r * nb >= 2 * 33 * 22) break; if (t < 2 * 33 * 22) gemm_tile(p, G_UP, layer, t, smem, tid); } }
  else { for (int r = 0; ; r++) { const int t = (r * 8 + (bid & 7)) * (nb >> 3) + (bid >> 3); if (r * nb >= 256) break; if (t < 256) gemm_tile(p, G_DOWN, layer, t, smem, tid); } }
}

#define PHASE_KERNEL(name, body)                                                      \
  __global__ void __launch_bounds__(256) name(Params p_unused) {                      \
    extern __shared__ __attribute__((aligned(16))) char smem[];                       \
    KP p = (KP)__builtin_amdgcn_kernarg_segment_ptr();                                \
    const int tid = threadIdx.x, nb = gridDim.x, bid = blockIdx.x;                    \
    const int layer = (int)p->phase_lo;                                               \
    (void)nb; (void)bid; (void)layer;                                                 \
    body                                                                              \
  }
PHASE_KERNEL(k_prep, phase_prep(p, smem, tid);)
PHASE_KERNEL(k_gin, for (int r = 0; ; r++) { const int t = (r * 8 + (bid & 7)) * (nb >> 3) + (bid >> 3); if (r * nb >= 512) break; if (t < 512) gemm_tile(p, G_IN, layer, t, smem, tid); })
PHASE_KERNEL(k_attn, phase_attn(p, layer, smem, tid);)
PHASE_KERNEL(k_s5p2, s5_pass2(p, layer, smem, tid);)
PHASE_KERNEL(k_glu, for (int r = 0; ; r++) { const int t = (r * 8 + (bid & 7)) * (nb >> 3) + (bid >> 3); if (r * nb >= 256) break; if (t < 256) gemm_tile(p, G_GLU, layer, t, smem, tid); })
PHASE_KERNEL(k_wout, for (int r = 0; ; r++) { const int t = (r * 8 + (bid & 7)) * (nb >> 3) + (bid >> 3); if (r * nb >= 256) break; if (t < 256) gemm_tile(p, G_WOUT, layer, t, smem, tid); })
PHASE_KERNEL(k_up, for (int r = 0; ; r++) { const int t = (r * 8 + (bid & 7)) * (nb >> 3) + (bid >> 3); if (r * nb >= 2 * 33 * 22) break; if (t < 2 * 33 * 22) gemm_tile(p, G_UP, layer, t, smem, tid); })
PHASE_KERNEL(k_down, for (int r = 0; ; r++) { const int t = (r * 8 + (bid & 7)) * (nb >> 3) + (bid >> 3); if (r * nb >= 256) break; if (t < 256) gemm_tile(p, G_DOWN, layer, t, smem, tid); })
PHASE_KERNEL(k_final, phase_final(p, tid);)

#if COOP
__global__ void __launch_bounds__(256) mega_kernel(Params p_unused) {
  extern __shared__ __attribute__((aligned(16))) char smem[];
  KP p0 = (KP)__builtin_amdgcn_kernarg_segment_ptr();
  const int ph_lo = (int)p0->phase_lo, ph_hi = (int)p0->phase_hi;
#if COOP
  if (ph_hi > 1000) cg::this_grid().sync();
#endif
#if COOP
  {
    volatile unsigned* st = (volatile unsigned*)(smem + 136192);
    if (threadIdx.x == 0) { st[0] = 0u; st[1] = 0u; xb_add(&p0->bar[XB_CNT(xb_xcc_id())], 1u); }
  }
#endif
  for (int ph = ph_lo; ph < ph_hi; ph++) {
    KP p = p0;
    asm volatile("" : "+s"(p));
#if TPROBE
    if (blockIdx.x == 0) p->ts[ph] = (long long)wall_clock64();
#endif
    run_phase(p, ph, smem);
#if COOP
    if (ph + 1 < ph_hi) {
      if (ph == ph_lo) grid_barrier(p->bar, gridDim.x, opaque_tid());
      else xcd_barrier(p->bar, (volatile unsigned*)(smem + 136192), opaque_tid());
    }
#endif
  }
#if TPROBE
  grid_barrier(p0->bar, (unsigned)(ph_hi - ph_lo) * gridDim.x, opaque_tid());
  if (blockIdx.x == 0) {
    KP p = p0;
    long long tend = (long long)wall_clock64();
    float a = 0.f, b = 0.f;
    for (int ph = 0; ph < 30; ph++) {
      long long t0 = p->ts[ph], t1 = (ph == 29) ? tend : p->ts[ph + 1];
      int c = (ph == 0) ? 0 : (ph == 29 ? 8 : 1 + (ph - 1) % 7);
      float d = (float)(t1 - t0) * 0.01f;
      if (c == TP_A || TP_A == 9) a += d;
      if (c == TP_B || TP_B == 9) b += d;
    }
    const int t = opaque_tid();
    if (t <= 100) p->out[t] += (t == 0) ? a : b;
  }
#endif
}

#endif

extern "C" void kernel_launch(void* const* d_in, const int* in_sizes, int n_in, void* d_out, int out_size, void* d_ws,
                              size_t ws_size, hipStream_t stream) {
  static int grid_blocks = 0;
  if (!grid_blocks) {
    int dev = 0, cus = 0, per_cu = 0;
    (void)hipGetDevice(&dev);
    (void)hipDeviceGetAttribute(&cus, hipDeviceAttributeMultiprocessorCount, dev);
#if COOP
    (void)hipFuncSetAttribute((const void*)mega_kernel, hipFuncAttributeMaxDynamicSharedMemorySize, LDS_BYTES);
    (void)hipOccupancyMaxActiveBlocksPerMultiprocessor(&per_cu, (const void*)mega_kernel, 256, LDS_BYTES);
    if (per_cu < 1) { fprintf(stderr, "occupancy query returned %d\n", per_cu); per_cu = 1; }
#endif
    grid_blocks = cus;
    (void)hipGetLastError();
  }
  Params p{};
  p.x = (const float*)d_in[0]; p.pos = (const int*)d_in[1];
  p.norm_mix = (const float*)d_in[2]; p.w_in = (const float*)d_in[3];
  p.lam_re = (const float*)d_in[4]; p.lam_im = (const float*)d_in[5]; p.log_step = (const float*)d_in[6];
  p.b_re = (const float*)d_in[7]; p.b_im = (const float*)d_in[8]; p.c_re = (const float*)d_in[9]; p.c_im = (const float*)d_in[10];
  p.ssm_d = (const float*)d_in[11]; p.w_glu = (const float*)d_in[12]; p.ssm_norm = (const float*)d_in[13];
  p.lq1 = (const float*)d_in[14]; p.lk1 = (const float*)d_in[15]; p.lq2 = (const float*)d_in[16]; p.lk2 = (const float*)d_in[17];
  p.subln = (const float*)d_in[18]; p.w_out = (const float*)d_in[19]; p.norm_ffn = (const float*)d_in[20];
  p.w_up = (const float*)d_in[21]; p.w_conv = (const float*)d_in[22]; p.b_conv = (const float*)d_in[23];
  p.w_down = (const float*)d_in[24]; p.norm_final = (const float*)d_in[25];
  p.out = (float*)d_out;
  char* ws = (char*)d_ws;
  size_t off = 0;
  auto take = [&](size_t bytes) { char* r = ws + off; off += (bytes + 255) & ~(size_t)255; return r; };
  p.WinT = (bf16_t*)take((size_t)4 * 2048 * 1024 * 2);
  p.WgluT = (bf16_t*)take((size_t)4 * 1024 * 512 * 2);
  p.WoutT = (bf16_t*)take((size_t)4 * 1024 * 1024 * 2);
  p.WupT = (bf16_t*)take((size_t)4 * 5632 * 1024 * 2);
  p.WdownT = (bf16_t*)take((size_t)4 * 1024 * FFN * 2);
  p.xf = (float*)take((size_t)NTOK * DM * 4);
  p.xb = (bf16_t*)take((size_t)NTOK * DM * 2);
  p.ss = (float*)take((size_t)9 * 8 * NTOK * 4);
  p.ssm_ss = (float*)take((size_t)4 * 8 * NTOK * 4);
  p.cs = (float*)take((size_t)NTOK * 16 * 4);
  p.s5tab = (float*)take((size_t)4 * 32 * 64 * 40 * 4);
  p.sloc = (float*)take((size_t)2 * 32 * 128 * 128 * 4);
  p.ts = (long long*)take(256);
  p.bar = (unsigned*)take(XB_WORDS * 4);
  char* region = take((size_t)134217728);
  p.u = (bf16_t*)region;
  p.q = (bf16_t*)(region + 33554432);
  p.k = p.q + (size_t)NTOK * 512;
  p.vt = p.k + (size_t)NTOK * 512;
  p.gy = p.vt + (size_t)NTOK * 512;
  p.outg = p.gy + (size_t)NTOK * 512;
  p.att = p.outg + (size_t)NTOK * 512;
  p.act = (bf16_t*)region;
  if (off > ws_size) { fprintf(stderr, "workspace too small: need %zu have %zu\n", off, ws_size); return; }
#if COOP
  p.phase_lo = 0; p.phase_hi = 30;
  if (hipMemsetAsync(p.bar, 0, XB_WORDS * 4, stream) != hipSuccess) fprintf(stderr, "barrier memset failed\n");
  void* args[] = {&p};
  hipError_t e = hipLaunchCooperativeKernel((const void*)mega_kernel, dim3(grid_blocks), dim3(256), args, LDS_BYTES, stream);
  if (e != hipSuccess) fprintf(stderr, "cooperative launch failed: %s (grid %d)\n", hipGetErrorString(e), grid_blocks);
#else
  typedef void (*kfn)(Params);
  const kfn seq[7] = {k_gin, k_attn, k_s5p2, k_glu, k_wout, k_up, k_down};
  static bool attr_done = false;
  if (!attr_done) {
    (void)hipFuncSetAttribute((const void*)k_prep, hipFuncAttributeMaxDynamicSharedMemorySize, LDS_BYTES);
    (void)hipFuncSetAttribute((const void*)k_final, hipFuncAttributeMaxDynamicSharedMemorySize, LDS_BYTES);
    for (int i = 0; i < 7; i++) (void)hipFuncSetAttribute((const void*)seq[i], hipFuncAttributeMaxDynamicSharedMemorySize, LDS_BYTES);
    attr_done = true;
  }
  p.phase_lo = 0; p.phase_hi = 0;
  hipLaunchKernelGGL(k_prep, dim3(grid_blocks), dim3(256), LDS_BYTES, stream, p);
  for (int layer = 0; layer < 4; layer++) {
    p.phase_lo = layer;
    for (int i = 0; i < 7; i++) hipLaunchKernelGGL(seq[i], dim3(grid_blocks), dim3(256), LDS_BYTES, stream, p);
  }
  hipLaunchKernelGGL(k_final, dim3(grid_blocks), dim3(256), LDS_BYTES, stream, p);
#endif
}
```

```cpp
#include <hip/hip_runtime.h>
#include <hip/hip_cooperative_groups.h>
#include <cstdio>
namespace cg = cooperative_groups;

#ifndef COOP
#define COOP 1
#endif
#ifndef TPROBE
#define TPROBE 0
#endif
#ifndef TP_A
#define TP_A 1
#endif
#ifndef TP_B
#define TP_B 2
#endif

typedef unsigned short bf16_t;
typedef __attribute__((ext_vector_type(8))) short bf16x8;
typedef __attribute__((ext_vector_type(16))) float f32x16;
typedef __attribute__((ext_vector_type(2))) __bf16 bf2_t;
typedef __attribute__((ext_vector_type(2))) float f2_t;
typedef __attribute__((ext_vector_type(4))) unsigned u32x4;
typedef __attribute__((ext_vector_type(2))) unsigned u32x2;

#define DI __device__ __forceinline__
#define MFMA(a, b, c) __builtin_amdgcn_mfma_f32_32x32x16_bf16((a), (b), (c), 0, 0, 0)

constexpr int NTOK = 16384, DM = 1024, SEQL = 8192, FFN = 2816;
constexpr int LDS_BYTES = 136208;
constexpr float EPS = 1e-6f;

struct Params {
  const float* x; const int* pos;
  const float *norm_mix, *w_in, *lam_re, *lam_im, *log_step, *b_re, *b_im, *c_re, *c_im, *ssm_d, *w_glu, *ssm_norm;
  const float *lq1, *lk1, *lq2, *lk2, *subln, *w_out, *norm_ffn, *w_up, *w_conv, *b_conv, *w_down, *norm_final;
  float* out;
  bf16_t *WinT, *WgluT, *WoutT, *WupT, *WdownT;
  float* xf; bf16_t* xb;
  bf16_t *u, *q, *k, *vt, *gy, *outg, *att, *act;
  float *ss, *ssm_ss, *cs, *s5tab, *sloc;
  long long phase_lo, phase_hi;
  long long* ts;
  unsigned* bar;
};

typedef const __attribute__((address_space(4))) Params* KP;

DI unsigned pack_bf2(float a, float b) { f2_t v = {a, b}; return __builtin_bit_cast(unsigned, __builtin_convertvector(v, bf2_t)); }
DI bf16_t f2bf(float a) { return (bf16_t)(pack_bf2(a, 0.f) & 0xffffu); }
DI float bf2f(bf16_t v) { return __uint_as_float(((unsigned)v) << 16); }
DI void grid_barrier(unsigned* ctr, unsigned target, int tid) {
  asm volatile("s_waitcnt vmcnt(0)" ::: "memory");
  __syncthreads();
  if (tid == 0) {
    __builtin_amdgcn_fence(__ATOMIC_RELEASE, "agent");
    asm volatile("s_waitcnt vmcnt(0)" ::: "memory");
    __hip_atomic_fetch_add(ctr, 1u, __ATOMIC_RELAXED, __HIP_MEMORY_SCOPE_AGENT);
    while (__hip_atomic_load(ctr, __ATOMIC_RELAXED, __HIP_MEMORY_SCOPE_AGENT) < target) __builtin_amdgcn_s_sleep(1);
    __builtin_amdgcn_fence(__ATOMIC_ACQUIRE, "agent");
    asm volatile("s_waitcnt vmcnt(0)" ::: "memory");
  }
  __syncthreads();
}
#define XB_CNT(j)  (64 + 64 * (j))
#define XB_SUB(j)  (1088 + 64 * (j))
#define XB_GEN(j)  (2112 + 64 * (j))
#define XB_TOP     3136
#define XB_TOPGEN  3200
#define XB_WORDS   3264
DI unsigned xb_ld(unsigned* q) { return __hip_atomic_load(q, __ATOMIC_RELAXED, __HIP_MEMORY_SCOPE_AGENT); }
DI unsigned xb_add(unsigned* q, unsigned v) { return __hip_atomic_fetch_add(q, v, __ATOMIC_RELAXED, __HIP_MEMORY_SCOPE_AGENT); }
DI unsigned xb_xcc_id() { return (unsigned)__builtin_amdgcn_s_getreg((3 << 11) | 20) & 0xFu; }
DI void xcd_barrier(unsigned* bar, volatile unsigned* st, int tid) {
  asm volatile("s_waitcnt vmcnt(0)" ::: "memory");
  __syncthreads();
  if (tid == 0) {
    const unsigned x = xb_xcc_id();
    unsigned nloc = st[0], nx = st[1];
    if (nloc == 0u) {
      unsigned cnt = 0u, mine = 1u;
#pragma unroll
      for (unsigned j = 0; j < 16; ++j) { const unsigned c = xb_ld(&bar[XB_CNT(j)]); cnt += (c > 0u) ? 1u : 0u; mine = (j == x) ? c : mine; }
      nloc = mine > 0u ? mine : 1u; nx = cnt > 0u ? cnt : 1u;
      st[0] = nloc; st[1] = nx;
    }
    const unsigned old = xb_add(&bar[XB_SUB(x)], 1u);
    const unsigned gen = old / nloc;
    if (old + 1u == (gen + 1u) * nloc) {
      __builtin_amdgcn_fence(__ATOMIC_RELEASE, "agent");
      asm volatile("s_waitcnt vmcnt(0)" ::: "memory");
      const unsigned og = xb_add(&bar[XB_TOP], 1u);
      const unsigned tg = og / nx;
      if (og + 1u == (tg + 1u) * nx) xb_add(&bar[XB_TOPGEN], 1u);
      else { while (xb_ld(&bar[XB_TOPGEN]) == tg) __builtin_amdgcn_s_sleep(1); }
      __builtin_amdgcn_fence(__ATOMIC_ACQUIRE, "agent");
      xb_add(&bar[XB_GEN(x)], 1u);
      asm volatile("s_waitcnt vmcnt(0)" ::: "memory");
    } else {
      while (xb_ld(&bar[XB_GEN(x)]) == gen) __builtin_amdgcn_s_sleep(1);
      __builtin_amdgcn_fence(__ATOMIC_ACQUIRE, "agent");
      asm volatile("s_waitcnt vmcnt(0)" ::: "memory");
    }
  }
  __syncthreads();
}
DI int opaque_tid() { int t = threadIdx.x; asm volatile("" : "+v"(t)); return t; }
DI float4 ss_sum4(const float* base, int row0) {
  float4 a = *(const float4*)(base + row0);
#pragma unroll
  for (int pz = 1; pz < 8; pz++) {
    float4 b = *(const float4*)(base + (size_t)pz * NTOK + row0);
    a.x += b.x; a.y += b.y; a.z += b.z; a.w += b.w;
  }
  return a;
}
DI float ss_sum1(const float* base, int row) {
  float a = base[row];
#pragma unroll
  for (int pz = 1; pz < 8; pz++) a += base[(size_t)pz * NTOK + row];
  return a;
}
DI float wave_sum(float v) { for (int o = 32; o; o >>= 1) v += __shfl_xor(v, o); return v; }
DI float fast_exp2(float x) { return __builtin_amdgcn_exp2f(x); }
DI float gelu_tanh(float x) {
  float z = 0.7978845608028654f * (x + 0.044715f * x * x * x);
  float e = __expf(2.f * z);
  float t = 1.f - 2.f / (1.f + e);
  return 0.5f * x * (1.f + t);
}
DI float reduce_2pi(double a) {
  double n = rint(a * 0.15915494309189535);
  return (float)(a - n * 6.283185307179586);
}

DI void transpose_tile(const float* src, int ldsrc, int k0, int c0, const float* scale, int nscale,
                       bf16_t* dst, int lddst, int n0, float* lds, const int tid) {
#pragma unroll
  for (int i = 0; i < 16; i++) {
    int kk = i * 4 + (tid >> 6), nn = tid & 63;
    float v = src[(size_t)(k0 + kk) * ldsrc + c0 + nn];
    if (scale != nullptr && (k0 + kk) < nscale) v *= scale[k0 + kk];
    lds[kk * 65 + nn] = v;
  }
  __syncthreads();
  {
    int nn = tid >> 2, kq = (tid & 3) * 16;
    unsigned pk[8];
#pragma unroll
    for (int i = 0; i < 8; i++) pk[i] = pack_bf2(lds[(kq + 2 * i) * 65 + nn], lds[(kq + 2 * i + 1) * 65 + nn]);
    u32x4* d = (u32x4*)(dst + (size_t)(n0 + nn) * lddst + k0 + kq);
    u32x4 a = {pk[0], pk[1], pk[2], pk[3]}, b = {pk[4], pk[5], pk[6], pk[7]};
    d[0] = a; d[1] = b;
  }
  __syncthreads();
}

DI void wtask(const float* src, int ldsrc, int k0, int c0, const float* scale, int nscale, bf16_t* dst, int lddst, int n0, int lane) {
  float v[32];
  const float* sp = src + (size_t)k0 * ldsrc + c0 + lane;
#pragma unroll
  for (int i = 0; i < 32; i++) v[i] = sp[(size_t)i * ldsrc];
  if (k0 < nscale) {
#pragma unroll
    for (int i = 0; i < 32; i++) v[i] *= scale[k0 + i];
  }
  u32x4* d = (u32x4*)(dst + (size_t)(n0 + lane) * lddst + k0);
#pragma unroll
  for (int q = 0; q < 4; q++) {
    u32x4 o = {pack_bf2(v[8 * q], v[8 * q + 1]), pack_bf2(v[8 * q + 2], v[8 * q + 3]), pack_bf2(v[8 * q + 4], v[8 * q + 5]), pack_bf2(v[8 * q + 6], v[8 * q + 7])};
    d[q] = o;
  }
}

__device__ __forceinline__ void phase_prep(KP p, char* smem, const int tid) {
  const int nb = gridDim.x, bid = blockIdx.x;
  const int wave = tid >> 6, lane = tid & 63;
  for (int row0 = (bid * 4 + wave) * 4; row0 < NTOK; row0 += nb * 16) {
    float4 v[4][4];
#pragma unroll
    for (int rr = 0; rr < 4; rr++)
#pragma unroll
      for (int i = 0; i < 4; i++) v[rr][i] = ((const float4*)(p->x + (size_t)(row0 + rr) * DM))[lane + 64 * i];
#pragma unroll
    for (int rr = 0; rr < 4; rr++) {
      const int row = row0 + rr;
      float s = 0.f;
#pragma unroll
      for (int i = 0; i < 4; i++) {
        u32x2 pk = {pack_bf2(v[rr][i].x, v[rr][i].y), pack_bf2(v[rr][i].z, v[rr][i].w)};
        ((u32x2*)(p->xb + (size_t)row * DM))[lane + 64 * i] = pk;
        const float a0 = __uint_as_float(pk[0] << 16), a1 = __uint_as_float(pk[0] & 0xffff0000u);
        const float a2 = __uint_as_float(pk[1] << 16), a3 = __uint_as_float(pk[1] & 0xffff0000u);
        s += a0 * a0 + a1 * a1 + a2 * a2 + a3 * a3;
      }
      s = wave_sum(s);
      if (lane < 8) p->ss[(size_t)lane * NTOK + row] = (lane == 0) ? s : 0.f;
    }
  }
  for (int i = bid * 256 + tid; i < NTOK * 8; i += nb * 256) {
    int tok = i >> 3, j = i & 7;
    double inv = (j & 4) ? ((j & 2) ? ((j & 1) ? 1.031338537721246e-05 : 5.318295896944988e-05) : ((j & 1) ? 0.0002742481756762073 : 0.001414213562373095))
                         : ((j & 2) ? ((j & 1) ? 0.007292664737217109 : 0.03760603093086393) : ((j & 1) ? 0.19392274474868576 : 1.0));
    double ang = (double)p->pos[tok] * inv;
    float r = reduce_2pi(ang);
    p->cs[2 * i] = cosf(r); p->cs[2 * i + 1] = sinf(r);
  }
  for (int i = bid * 256 + tid; i < 4 * 32 * 64; i += nb * 256) {
    int lg = i >> 6;
    float lr = p->lam_re[i], li = p->lam_im[i];
    float step = expf(p->log_step[lg]);
    float mag = expf(step * lr);
    double angd = (double)step * (double)li;
    float r1 = reduce_2pi(angd);
    float ar = mag * cosf(r1), ai = mag * sinf(r1);
    float den = lr * lr + li * li;
    float fr = ((ar - 1.f) * lr + ai * li) / den;
    float fi = (ai * lr - (ar - 1.f) * li) / den;
    float magT = expf(64.f * step * lr);
    float rT = reduce_2pi(64.0 * angd);
    float* tb = p->s5tab + (size_t)i * 40;
    tb[0] = ar; tb[1] = ai; tb[2] = magT * cosf(rT); tb[3] = magT * sinf(rT);
    for (int c = 0; c < 16; c++) {
      float br = p->b_re[(size_t)i * 16 + c], bi = p->b_im[(size_t)i * 16 + c];
      tb[4 + c] = fr * br - fi * bi;
      tb[20 + c] = fr * bi + fi * br;
    }
  }
  {
    const int NTASK = 4 * 6016;
    const int gw = bid * 4 + wave, nw = nb * 4;
    const int per = (NTASK + nw - 1) / nw;
    const int t_lo = gw * per, t_hi = min(t_lo + per, NTASK);
    for (int task = t_lo; task < t_hi; task++) {
      const int layer = task / 6016;
      int t = task % 6016;
      if (t < 1024) {
        const int a = t >> 5, kb = t & 31;
        wtask(p->w_in + (size_t)layer * 1024 * 2048, 2048, kb * 32, a * 64, p->norm_mix + layer * 1024, 1024,
              p->WinT + (size_t)layer * 2048 * 1024, 1024, a * 64, lane);
      } else if (t < 1280) {
        t -= 1024; const int a = t >> 4, kb = t & 15;
        wtask(p->w_glu + (size_t)layer * 512 * 1024, 1024, kb * 32, (a & 1) * 512 + (a >> 1) * 64, p->norm_mix, 0,
              p->WgluT + (size_t)layer * 1024 * 512, 512, a * 64, lane);
      } else if (t < 1792) {
        t -= 1280; const int a = t >> 5, kb = t & 31;
        wtask(p->w_out + (size_t)layer * 1024 * 1024, 1024, kb * 32, a * 64, p->ssm_norm + layer * 512, 512,
              p->WoutT + (size_t)layer * 1024 * 1024, 1024, a * 64, lane);
      } else if (t < 4608) {
        t -= 1792; const int a = t >> 5, kb = t & 31;
        wtask(p->w_up + (size_t)layer * 1024 * 5632, 5632, kb * 32, (a & 1) * FFN + (a >> 1) * 64, p->norm_ffn + layer * 1024, 1024,
              p->WupT + (size_t)layer * 5632 * 1024, 1024, a * 64, lane);
      } else {
        t -= 4608; const int a = t / 88, kb = t % 88;
        wtask(p->w_down + (size_t)layer * FFN * 1024, 1024, kb * 32, a * 64, p->norm_mix, 0,
              p->WdownT + (size_t)layer * 1024 * FFN, FFN, a * 64, lane);
      }
    }
  }
}

enum { G_IN = 0, G_GLU = 1, G_WOUT = 2, G_UP = 3, G_DOWN = 4 };
#define ACC_PIN(tag) _Pragma("unroll") for (int i_ = 0; i_ < 4; i_++) _Pragma("unroll") for (int j_ = 0; j_ < 4; j_++) asm volatile("; pin " tag : "+a"(acc[i_][j_]));


__device__ __forceinline__ void gemm_tile(KP p, const int MODE, int layer, int tile, char* smem, const int tid) {
  const int lane = tid & 63, w = tid >> 6, wm = w >> 1, wn = w & 1, g = lane >> 5, l32 = lane & 31;
  int tn, KT, ldb, rowbase, lda;
  const bf16_t* Bt;
  const bf16_t* A0;
  int upb = 0, upti = 0;
  {
    const int TM = (MODE == G_UP) ? 66 : 64;
    const int TN = (MODE == G_IN) ? 8 : (MODE == G_UP ? 22 : 4);
    const int nfull = TN >> 2, rem = TN & 3;
    int tm;
    if (tile < nfull * 4 * TM) { const int band = tile / (4 * TM), within = tile % (4 * TM); tm = within >> 2; tn = band * 4 + (within & 3); }
    else { const int s2 = tile - nfull * 4 * TM; tm = s2 / rem; tn = nfull * 4 + s2 % rem; }
    rowbase = tm * 256;
    if (MODE == G_UP) { upb = tm / 33; upti = tm % 33; rowbase = upb * SEQL + 254 * upti - 2; }
  }
  if (MODE == G_IN) { KT = 16; ldb = 1024; Bt = p->WinT + (size_t)layer * 2048 * 1024; A0 = p->xb; lda = 1024; }
  else if (MODE == G_GLU) { KT = 8; ldb = 512; Bt = p->WgluT + (size_t)layer * 1024 * 512; A0 = p->gy; lda = 512; }
  else if (MODE == G_WOUT) { KT = 16; ldb = 1024; Bt = p->WoutT + (size_t)layer * 1024 * 1024; A0 = p->outg; lda = 512; }
  else if (MODE == G_UP) { KT = 16; ldb = 1024; Bt = p->WupT + (size_t)layer * 5632 * 1024; A0 = p->xb; lda = 1024; }
  else { KT = 44; ldb = FFN; Bt = p->WdownT + (size_t)layer * 1024 * FFN; A0 = p->act; lda = FFN; }

  u32x4 ra[8], rb[8];
  const int lrow = tid >> 3, lc = tid & 7;
  float arow_sc[8];
#pragma unroll
  for (int i = 0; i < 8; i++) arow_sc[i] = 1.f;
  if (MODE == G_WOUT) {
    const float* ssq = p->ssm_ss + (size_t)layer * 8 * NTOK;
#pragma unroll
    for (int i = 0; i < 8; i++) arow_sc[i] = rsqrtf(ss_sum1(ssq, rowbase + lrow + 32 * i) * (1.f / 512.f) + EPS);
  }
  const bf16_t* bptr = Bt + (size_t)(tn * 256 + lrow) * ldb + lc * 8;
  auto gload = [&](int kt) {
    const bf16_t* abase = A0;
    int kofs = kt * 64;
    if (MODE == G_WOUT && kt >= 8) { abase = p->att; kofs = (kt - 8) * 64; }
#pragma unroll
    for (int i = 0; i < 8; i++) {
      int gr = min(max(rowbase + lrow + 32 * i, 0), NTOK - 1);
      ra[i] = *(const u32x4*)(abase + (size_t)gr * lda + kofs + lc * 8);
      rb[i] = *(const u32x4*)(bptr + (size_t)(32 * i) * ldb + kt * 64);
    }
  };
  auto scaleA = [&](int kt) {
    if (MODE == G_WOUT && kt < 8) {
#pragma unroll
      for (int i = 0; i < 8; i++)
#pragma unroll
        for (int e = 0; e < 4; e++) {
          unsigned v = ra[i][e];
          float lo = __uint_as_float(v << 16) * arow_sc[i], hi = __uint_as_float(v & 0xffff0000u) * arow_sc[i];
          ra[i][e] = pack_bf2(lo, hi);
        }
    }
  };
  const int wr_off = lrow * 128 + ((lc ^ ((lrow >> 1) & 7)) << 4);
  auto lwriteA = [&](int st) {
    char* sa = smem + st * 65536;
#pragma unroll
    for (int i = 0; i < 8; i++) *(u32x4*)(sa + wr_off + i * 4096) = ra[i];
  };
  auto lwriteB = [&](int st) {
    char* sb = smem + st * 65536 + 32768;
#pragma unroll
    for (int i = 0; i < 8; i++) *(u32x4*)(sb + wr_off + i * 4096) = rb[i];
  };

  f32x16 acc[4][4];
#pragma unroll
  for (int i = 0; i < 4; i++)
#pragma unroll
    for (int j = 0; j < 4; j++)
#pragma unroll
      for (int r = 0; r < 16; r++) acc[i][j][r] = 0.f;

  const int swz = (l32 >> 1) & 7;
  const int a_base = (wm * 128 + l32) * 128;
  const int b_base = 32768 + (wn * 128 + l32) * 128;
  bf16x8 af[2][4], bfr[2][4];
  auto lfrag = [&](int buf, const char* st, int ks) {
    const int coff = (((ks * 2 + g) ^ swz) << 4);
#pragma unroll
    for (int i = 0; i < 4; i++) af[buf][i] = *(const bf16x8*)(st + a_base + i * 4096 + coff);
#pragma unroll
    for (int j = 0; j < 4; j++) bfr[buf][j] = *(const bf16x8*)(st + b_base + j * 4096 + coff);
  };
  auto mfma16 = [&](int buf) {
#pragma unroll
    for (int i = 0; i < 4; i++)
#pragma unroll
      for (int j = 0; j < 4; j++) acc[i][j] = MFMA(af[buf][i], bfr[buf][j], acc[i][j]);
  };

  gload(0);
  scaleA(0);
  lwriteA(0);
  lwriteB(0);
  __syncthreads();
  if (KT > 1) gload(1);
  lfrag(0, smem, 0);
  for (int kt = 0; kt < KT; kt++) {
    const char* st = smem + (kt & 1) * 65536;
    const bool has1 = (kt + 1 < KT), has2 = (kt + 2 < KT);
    lfrag(1, st, 1);
    if (has1) { scaleA(kt + 1); lwriteA((kt + 1) & 1); }
    mfma16(0);
    __builtin_amdgcn_sched_barrier(0);
    lfrag(0, st, 2);
    if (has1) lwriteB((kt + 1) & 1);
    mfma16(1);
    __builtin_amdgcn_sched_barrier(0);
    lfrag(1, st, 3);
    if (has2) gload(kt + 2);
    mfma16(0);
    __builtin_amdgcn_sched_barrier(0);
    asm volatile("s_waitcnt lgkmcnt(0)" ::: "memory");
    __builtin_amdgcn_s_barrier();
    __builtin_amdgcn_sched_barrier(0);
    if (has1) lfrag(0, smem + ((kt + 1) & 1) * 65536, 0);
    mfma16(1);
    __builtin_amdgcn_sched_barrier(0);
  }

  int tid2 = tid;
  asm volatile("" : "+v"(tid2));
  {
  const int tid = tid2;
  const int lane = tid & 63, w = tid >> 6, wm = w >> 1, wn = w & 1, g = lane >> 5, l32 = lane & 31;
  if (MODE == G_IN) {
    const int region = tn >> 1;
    float* rs = (float*)(smem + 135168);
    rs[tid] = rsqrtf(ss_sum1(p->ss + (size_t)(2 * layer) * 8 * NTOK, rowbase + tid) * (1.f / 1024.f) + EPS);
    __syncthreads();
#pragma unroll
    for (int i = 0; i < 4; i++)
#pragma unroll
      for (int rq = 0; rq < 4; rq++) {
        const int lr0 = wm * 128 + i * 32 + rq * 8 + g * 4;
        const float4 s4 = *(const float4*)(rs + lr0);
        const float sc[4] = {s4.x, s4.y, s4.z, s4.w};
#pragma unroll
        for (int j = 0; j < 4; j++) {
          const int lcol = wn * 128 + j * 32 + l32;
          float v[4];
#pragma unroll
          for (int r4 = 0; r4 < 4; r4++) v[r4] = acc[i][j][rq * 4 + r4] * sc[r4];
          if (region == 3) {
            const int q4 = (lr0 >> 2) & 3;
            const int pq = ((q4 & 1) << 1) | (q4 >> 1);
            u32x2 pk = {pack_bf2(v[0], v[1]), pack_bf2(v[2], v[3])};
            *(u32x2*)(smem + lcol * 528 + ((lr0 & ~15) + pq * 4) * 2) = pk;
          } else {
            if (region != 0 && (j & 1) == 0) {
              float other[4];
#pragma unroll
              for (int r4 = 0; r4 < 4; r4++) other[r4] = __shfl_xor(v[r4], 8);
              if (l32 < 16) {
                const float sgn = (l32 < 8) ? -1.f : 1.f;
#pragma unroll
                for (int r4 = 0; r4 < 4; r4++) {
                  const float2 csv = *(const float2*)(p->cs + ((size_t)(rowbase + lr0 + r4) * 8 + (l32 & 7)) * 2);
                  v[r4] = v[r4] * csv.x + sgn * other[r4] * csv.y;
                }
              }
            }
#pragma unroll
            for (int r4 = 0; r4 < 4; r4++) *(bf16_t*)(smem + (lr0 + r4) * 528 + lcol * 2) = f2bf(v[r4]);
          }
        }
      }
    __syncthreads();
    {
      bf16_t* dbase;
      size_t rstride;
      if (region == 3) { dbase = p->vt + (size_t)((rowbase >> 13) * 512 + (tn & 1) * 256) * SEQL + (rowbase & (SEQL - 1)); rstride = SEQL; }
      else { dbase = (region == 0 ? p->u : (region == 1 ? p->q : p->k)) + (size_t)rowbase * 512 + (tn & 1) * 256; rstride = 512; }
#pragma unroll 8
      for (int it = 0; it < 32; it++) {
        const int id = tid + 256 * it, row = id >> 5, c = id & 31;
        const u32x4 vv = *(const u32x4*)(smem + row * 528 + c * 16);
        *(u32x4*)(dbase + (size_t)row * rstride + c * 8) = vv;
      }
    }
    __syncthreads();
  } else if (MODE == G_GLU) {
#pragma unroll
    for (int i = 0; i < 4; i++)
#pragma unroll
      for (int j = 0; j < 2; j++)
#pragma unroll
        for (int r = 0; r < 16; r++) {
          const int lr = wm * 128 + i * 32 + (r >> 2) * 8 + g * 4 + (r & 3);
          const float av = acc[i][j][r], bv = acc[i][j + 2][r];
          *(bf16_t*)(smem + lr * 272 + (wn * 64 + j * 32 + l32) * 2) = f2bf(av / (1.f + __expf(-bv)));
        }
    __syncthreads();
    {
      float* ssq = p->ssm_ss + ((size_t)layer * 8 + tn * 2) * NTOK;
#pragma unroll 4
      for (int it = 0; it < 16; it++) {
        const int id = tid + 256 * it, row = id >> 4, c = id & 15;
        const u32x4 ov = *(const u32x4*)(smem + row * 272 + c * 16);
        *(u32x4*)(p->outg + (size_t)(rowbase + row) * 512 + tn * 128 + c * 8) = ov;
        float sq = 0.f;
#pragma unroll
        for (int e = 0; e < 4; e++) {
          const float lo = __uint_as_float(ov[e] << 16), hi = __uint_as_float(ov[e] & 0xffff0000u);
          sq += lo * lo + hi * hi;
        }
#pragma unroll
        for (int o = 4; o; o >>= 1) sq += __shfl_xor(sq, o);
        if ((c & 7) == 0) ssq[(size_t)(c >> 3) * NTOK + rowbase + row] = sq;
      }
    }
    __syncthreads();
  } else if (MODE == G_WOUT || MODE == G_DOWN) {
#pragma unroll
    for (int i = 0; i < 4; i++)
#pragma unroll
      for (int j = 0; j < 4; j++)
#pragma unroll
        for (int r = 0; r < 16; r++) {
          const int lr = wm * 128 + i * 32 + (r >> 2) * 8 + g * 4 + (r & 3);
          *(bf16_t*)(smem + lr * 528 + (wn * 128 + j * 32 + l32) * 2) = f2bf(acc[i][j][r]);
        }
    __syncthreads();
    {
      float* ssq = p->ss + ((size_t)(MODE == G_WOUT ? 2 * layer + 1 : 2 * layer + 2) * 8 + tn * 2) * NTOK;
#pragma unroll 4
      for (int it = 0; it < 32; it++) {
        const int id = tid + 256 * it, row = id >> 5, c = id & 31;
        const u32x4 dv = *(const u32x4*)(smem + row * 528 + c * 16);
        const size_t idx = (size_t)(rowbase + row) * 1024 + tn * 256 + c * 8;
        const u32x4 xv = *(const u32x4*)(p->xb + idx);
        u32x4 xbv;
        float sq = 0.f;
#pragma unroll
        for (int e = 0; e < 4; e++) {
          const float lo = __uint_as_float(xv[e] << 16) + __uint_as_float(dv[e] << 16);
          const float hi = __uint_as_float(xv[e] & 0xffff0000u) + __uint_as_float(dv[e] & 0xffff0000u);
          const unsigned pk = pack_bf2(lo, hi);
          xbv[e] = pk;
          const float rl = __uint_as_float(pk << 16), rh = __uint_as_float(pk & 0xffff0000u);
          sq += rl * rl + rh * rh;
        }
        *(u32x4*)(p->xb + idx) = xbv;
#pragma unroll
        for (int o = 8; o; o >>= 1) sq += __shfl_xor(sq, o);
        if ((c & 15) == 0) ssq[(size_t)(c >> 4) * NTOK + rowbase + row] = sq;
      }
    }
    __syncthreads();
  } else {
#pragma unroll
    for (int i = 0; i < 4; i++)
#pragma unroll
      for (int rq = 0; rq < 4; rq++) {
        const int lr0 = wm * 128 + i * 32 + rq * 8 + g * 4;
#pragma unroll
        for (int j = 0; j < 4; j++) {
          const int pc = wn * 128 + j * 32 + l32;
          u32x2 pk = {pack_bf2(acc[i][j][rq * 4 + 0], acc[i][j][rq * 4 + 1]), pack_bf2(acc[i][j][rq * 4 + 2], acc[i][j][rq * 4 + 3])};
          *(u32x2*)(smem + pc * 528 + lr0 * 2) = pk;
        }
      }
    {
      float* rs = (float*)(smem + 135168);
      const int tb = 254 * upti - 2 + tid;
      float sc = 0.f;
      if (tb >= 0) {
        const int gr = min(upb * SEQL + tb, NTOK - 1);
        sc = rsqrtf(ss_sum1(p->ss + (size_t)(2 * layer + 1) * 8 * NTOK, gr) * (1.f / 1024.f) + EPS);
      }
      rs[tid] = sc;
    }
    __syncthreads();
    {
      const int cp = tid & 127, half = tid >> 7;
      const int pg = (cp >> 6) * 128 + (cp & 63), pv = pg + 64;
      const int ocol = tn * 128 + cp;
      const float* wc = p->w_conv + (size_t)layer * 3 * 5632;
      const float* bc = p->b_conv + (size_t)layer * 5632;
      const float wg0 = wc[ocol], wg1 = wc[5632 + ocol], wg2 = wc[2 * 5632 + ocol], bg = bc[ocol];
      const float wv0 = wc[FFN + ocol], wv1 = wc[5632 + FFN + ocol], wv2 = wc[2 * 5632 + FFN + ocol], bv = bc[FFN + ocol];
      const float* rs = (const float*)(smem + 135168);
      const char* gcol = smem + pg * 528;
      const char* vcol = smem + pv * 528;
      float g0 = 0.f, v0 = 0.f, g1 = 0.f, v1 = 0.f;
      if (half) {
        g0 = rs[126] * bf2f(*(const bf16_t*)(gcol + 126 * 2)); v0 = rs[126] * bf2f(*(const bf16_t*)(vcol + 126 * 2));
        g1 = rs[127] * bf2f(*(const bf16_t*)(gcol + 127 * 2)); v1 = rs[127] * bf2f(*(const bf16_t*)(vcol + 127 * 2));
      }
      for (int grp8 = 0; grp8 < 16; grp8++) {
        const int lrb = half * 128 + grp8 * 8;
        const u32x4 gq = *(const u32x4*)(gcol + lrb * 2);
        const u32x4 vq = *(const u32x4*)(vcol + lrb * 2);
        const float4 r0 = *(const float4*)(rs + lrb), r1 = *(const float4*)(rs + lrb + 4);
        const float rsv[8] = {r0.x, r0.y, r0.z, r0.w, r1.x, r1.y, r1.z, r1.w};
#pragma unroll
        for (int e = 0; e < 8; e++) {
          const unsigned gw = gq[e >> 1], vw = vq[e >> 1];
          const float g2 = rsv[e] * ((e & 1) ? __uint_as_float(gw & 0xffff0000u) : __uint_as_float(gw << 16));
          const float v2 = rsv[e] * ((e & 1) ? __uint_as_float(vw & 0xffff0000u) : __uint_as_float(vw << 16));
          const int lr = lrb + e;
          const int tb = 254 * upti - 2 + lr;
          if (lr >= 2 && tb < SEQL) {
            const float gate = bg + wg0 * g0 + wg1 * g1 + wg2 * g2;
            const float val = bv + wv0 * v0 + wv1 * v1 + wv2 * v2;
            const float o = gate / (1.f + __expf(-gate)) * val;
            p->act[(size_t)(upb * SEQL + tb) * FFN + ocol] = f2bf(o);
          }
          g0 = g1; v0 = v1; g1 = g2; v1 = v2;
        }
      }
    }
    __syncthreads();
  }
  }
}

__device__ __forceinline__ void attn_item(KP p, int layer, int b, int h, int qt, float lam, float outscale, char* smem, const int tid) {
  const int lane = tid & 63, w = tid >> 6, g = lane >> 5, l32 = lane & 31;
  const int tok_q = b * SEQL + qt * 128 + w * 32 + l32;
  bf16x8 qreg[2][4];
#pragma unroll
  for (int c = 0; c < 2; c++)
#pragma unroll
    for (int ks = 0; ks < 4; ks++)
      qreg[c][ks] = *(const bf16x8*)(p->q + (size_t)tok_q * 512 + h * 128 + c * 64 + ks * 16 + g * 8);

  const int NT = 2 * qt + 2;
  const int nkt = 2 * qt + 1 + (w >> 1);
  f32x16 O[2][4];
#pragma unroll
  for (int c = 0; c < 2; c++)
#pragma unroll
    for (int dt = 0; dt < 4; dt++)
#pragma unroll
      for (int r = 0; r < 16; r++) O[c][dt][r] = 0.f;
  float mrun[2] = {-1e30f, -1e30f}, lrun[2] = {0.f, 0.f};
  const float c1 = 0.125f * 1.4426950408889634f;

  u32x4 rk[4], rv[4];
  const bf16_t* kbase = p->k + (size_t)(b * SEQL) * 512 + h * 128;
  const bf16_t* vbase = p->vt + (size_t)((b * 4 + h) * 128) * SEQL;
  const int kkey = tid >> 4, kc = tid & 15;
  const int vd = tid >> 3, vc = tid & 7;
  auto gload = [&](int kt) {
#pragma unroll
    for (int i = 0; i < 4; i++) {
      rk[i] = *(const u32x4*)(kbase + (size_t)(kt * 64 + kkey + 16 * i) * 512 + kc * 8);
      rv[i] = *(const u32x4*)(vbase + (size_t)(vd + 32 * i) * SEQL + kt * 64 + vc * 8);
    }
  };
  const int kw_off = kkey * 256 + ((kc ^ (kkey & 15)) << 4);
  const int vw_off = 16384 + vd * 128 + ((vc ^ ((vd >> 1) & 7)) << 4);
  auto lwrite = [&](int st) {
    char* s = smem + st * 32768;
#pragma unroll
    for (int i = 0; i < 4; i++) {
      *(u32x4*)(s + kw_off + i * 4096) = rk[i];
      *(u32x4*)(s + vw_off + i * 4096) = rv[i];
    }
  };

  gload(0);
  lwrite(0);
  __syncthreads();
  for (int kt = 0; kt < NT; kt++) {
    if (kt + 1 < NT) gload(kt + 1);
    if (kt < nkt) {
      const char* st = smem + (kt & 1) * 32768;
      bf16x8 pf[2][2][2];
      bf16x8 kf[8], vf[2][4];
      f32x16 S[1][2];
      auto loadkq = [&](int c) {
#pragma unroll
        for (int kb = 0; kb < 2; kb++)
#pragma unroll
          for (int ks = 0; ks < 4; ks++) {
            const int key = kb * 32 + l32, chunk = c * 8 + ks * 2 + g;
            kf[kb * 4 + ks] = *(const bf16x8*)(st + key * 256 + ((chunk ^ (key & 15)) << 4));
          }
      };
      auto qk = [&](int c) {
        f32x16 zero;
#pragma unroll
        for (int r = 0; r < 16; r++) zero[r] = 0.f;
#pragma unroll
        for (int kb = 0; kb < 2; kb++) {
          S[0][kb] = MFMA(kf[kb * 4], qreg[c][0], zero);
#pragma unroll
          for (int ks = 1; ks < 4; ks++) S[0][kb] = MFMA(kf[kb * 4 + ks], qreg[c][ks], S[0][kb]);
        }
      };
      auto loadv = [&](int bi) {
#pragma unroll
        for (int dt = 0; dt < 4; dt++) {
          const int d = dt * 32 + l32, chunk = bi * 2 + g;
          vf[bi & 1][dt] = *(const bf16x8*)(st + 16384 + d * 128 + ((chunk ^ ((d >> 1) & 7)) << 4));
        }
      };
      auto softmax = [&](int c) {
        float mx = S[0][0][0];
#pragma unroll
        for (int r = 1; r < 16; r++) mx = fmaxf(mx, S[0][0][r]);
#pragma unroll
        for (int r = 0; r < 16; r++) mx = fmaxf(mx, S[0][1][r]);
        {
          const unsigned mu = __float_as_uint(mx);
          auto sw = __builtin_amdgcn_permlane32_swap(mu, mu, false, false);
          mx = fmaxf(__uint_as_float(sw[0]), __uint_as_float(sw[1]));
        }
        const float mcand = fmaxf(mrun[c], mx * c1);
        if (__any(mcand - mrun[c] > 8.f)) {
          const float alpha = fast_exp2(mrun[c] - mcand);
          mrun[c] = mcand;
          lrun[c] *= alpha;
#pragma unroll
          for (int dt = 0; dt < 4; dt++)
#pragma unroll
            for (int r = 0; r < 16; r++) O[c][dt][r] *= alpha;
        }
        const float mref = mrun[c];
        const f2_t c1v = {c1, c1}, mrv = {-mref, -mref};
        f2_t psum2 = {0.f, 0.f};
#pragma unroll
        for (int kb = 0; kb < 2; kb++)
#pragma unroll
          for (int r = 0; r < 16; r += 2) {
            f2_t sv = {S[0][kb][r], S[0][kb][r + 1]};
            f2_t av = __builtin_elementwise_fma(sv, c1v, mrv);
            f2_t ev = {fast_exp2(av[0]), fast_exp2(av[1])};
            S[0][kb][r] = ev[0]; S[0][kb][r + 1] = ev[1];
            psum2 += ev;
          }
        lrun[c] += psum2[0] + psum2[1];
#pragma unroll
        for (int kb = 0; kb < 2; kb++)
#pragma unroll
          for (int m = 0; m < 2; m++) {
            u32x4 pk = {pack_bf2(S[0][kb][8 * m + 0], S[0][kb][8 * m + 1]), pack_bf2(S[0][kb][8 * m + 2], S[0][kb][8 * m + 3]),
                        pack_bf2(S[0][kb][8 * m + 4], S[0][kb][8 * m + 5]), pack_bf2(S[0][kb][8 * m + 6], S[0][kb][8 * m + 7])};
            pf[c][kb][m] = __builtin_bit_cast(bf16x8, pk);
          }
      };
      loadkq(0);
      __builtin_amdgcn_sched_barrier(0);
      qk(0);
      __builtin_amdgcn_sched_barrier(0);
      loadkq(1);
      __builtin_amdgcn_sched_barrier(0);
      softmax(0);
      __builtin_amdgcn_sched_barrier(0);
      qk(1);
      loadv(0);
      __builtin_amdgcn_sched_barrier(0);
      softmax(1);
      __builtin_amdgcn_sched_barrier(0);
#pragma unroll
      for (int bi = 0; bi < 4; bi++) {
        if (bi < 3) loadv(bi + 1);
#pragma unroll
        for (int dt = 0; dt < 4; dt++) {
          O[0][dt] = MFMA(vf[bi & 1][dt], pf[0][bi >> 1][bi & 1], O[0][dt]);
          O[1][dt] = MFMA(vf[bi & 1][dt], pf[1][bi >> 1][bi & 1], O[1][dt]);
        }
        __builtin_amdgcn_sched_barrier(0);
      }
    }
    if (kt + 1 < NT) lwrite((kt + 1) & 1);
    __syncthreads();
  }

  const float l1 = lrun[0] + __shfl_xor(lrun[0], 32);
  const float l2 = lrun[1] + __shfl_xor(lrun[1], 32);
  const float i1 = 1.f / l1, i2 = lam / l2;
  float ssq = 0.f;
#pragma unroll
  for (int dt = 0; dt < 4; dt++)
#pragma unroll
    for (int r = 0; r < 16; r++) {
      float o = O[0][dt][r] * i1 - O[1][dt][r] * i2;
      O[0][dt][r] = o;
      ssq += o * o;
    }
  ssq += __shfl_xor(ssq, 32);
  const float rstd = rsqrtf(ssq * (1.f / 128.f) + EPS) * outscale;
  const float* gsub = p->subln + layer * 128;
#pragma unroll
  for (int dt = 0; dt < 4; dt++)
#pragma unroll
    for (int rq = 0; rq < 4; rq++) {
      const int d0 = dt * 32 + rq * 8 + g * 4;
      float4 gg = *(const float4*)(gsub + d0);
      u32x2 pk = {pack_bf2(O[0][dt][rq * 4 + 0] * rstd * gg.x, O[0][dt][rq * 4 + 1] * rstd * gg.y),
                  pack_bf2(O[0][dt][rq * 4 + 2] * rstd * gg.z, O[0][dt][rq * 4 + 3] * rstd * gg.w)};
      *(u32x2*)(p->att + (size_t)tok_q * 512 + h * 128 + d0) = pk;
    }
}

DI void s5_store_u(const u32x4 a, const u32x4 bq, int lane, float* ul) {
  float4* d = (float4*)(ul + lane * 16);
  d[0] = make_float4(__uint_as_float(a[0] << 16), __uint_as_float(a[0] & 0xffff0000u), __uint_as_float(a[1] << 16), __uint_as_float(a[1] & 0xffff0000u));
  d[1] = make_float4(__uint_as_float(a[2] << 16), __uint_as_float(a[2] & 0xffff0000u), __uint_as_float(a[3] << 16), __uint_as_float(a[3] & 0xffff0000u));
  d[2] = make_float4(__uint_as_float(bq[0] << 16), __uint_as_float(bq[0] & 0xffff0000u), __uint_as_float(bq[1] << 16), __uint_as_float(bq[1] & 0xffff0000u));
  d[3] = make_float4(__uint_as_float(bq[2] << 16), __uint_as_float(bq[2] & 0xffff0000u), __uint_as_float(bq[3] << 16), __uint_as_float(bq[3] & 0xffff0000u));
}
DI void s5_load_u(KP p, int b, int g, int j, int lane, float* ul) {
  const u32x4* src = (const u32x4*)(p->u + (size_t)(b * SEQL + j * 64 + lane) * 512 + g * 16);
  const u32x4 a = src[0], bq = src[1];
  s5_store_u(a, bq, lane, ul);
}

DI float swap_half(float v, const int which) {
  const unsigned u = __float_as_uint(v);
  auto r = __builtin_amdgcn_permlane32_swap(u, u, false, false);
  return __uint_as_float(which ? r[1] : r[0]);
}

struct S5Coef { float arA, aiA, arB, aiB; };

template <bool STORE>
DI void s5_scan32(const float* ul_sub, const bf16x8 (&bfr)[4], const S5Coef& cf, float& xAr, float& xAi, float& xBr, float& xBi,
                  float* X, const int l32, const int grp) {
  bf16x8 af;
  {
    const float* us = ul_sub + l32 * 16 + grp * 8;
    float4 a = *(const float4*)us, bq = *(const float4*)(us + 4);
    u32x4 pk = {pack_bf2(a.x, a.y), pack_bf2(a.z, a.w), pack_bf2(bq.x, bq.y), pack_bf2(bq.z, bq.w)};
    af = __builtin_bit_cast(bf16x8, pk);
  }
  f32x16 zero;
#pragma unroll
  for (int r = 0; r < 16; r++) zero[r] = 0.f;
  const f32x16 bu0 = MFMA(af, bfr[0], zero), bu1 = MFMA(af, bfr[1], zero), bu2 = MFMA(af, bfr[2], zero), bu3 = MFMA(af, bfr[3], zero);
#pragma unroll
  for (int k = 0; k < 8; k++) {
    float sAr[4], sAi[4], sBr[4], sBi[4];
#pragma unroll
    for (int i = 0; i < 4; i++) {
      const int r = (k >> 1) * 4 + i;
      const float nAr = cf.arA * xAr - cf.aiA * xAi + bu0[r];
      const float nAi = cf.arA * xAi + cf.aiA * xAr + bu2[r];
      const float nBr = cf.arB * xBr - cf.aiB * xBi + bu1[r];
      const float nBi = cf.arB * xBi + cf.aiB * xBr + bu3[r];
      xAr = nAr; xAi = nAi; xBr = nBr; xBi = nBi;
      sAr[i] = nAr; sAi[i] = nAi; sBr[i] = nBr; sBi[i] = nBi;
    }
    if (STORE) {
      if (grp == (k & 1)) {
#pragma unroll
        for (int i = 0; i < 4; i++) {
          float* xr = X + (4 * k + i) * 132;
          xr[l32] = sAr[i]; xr[64 + l32] = sAi[i]; xr[32 + l32] = sBr[i]; xr[96 + l32] = sBi[i];
        }
      }
    }
    xAr = swap_half(xAr, k & 1); xAi = swap_half(xAi, k & 1);
    xBr = swap_half(xBr, k & 1); xBi = swap_half(xBi, k & 1);
  }
}

DI void s5_setup(KP p, int layer, int g, int l32, int grp, S5Coef& cf, bf16x8 (&bfr)[4]) {
  const float* t0 = p->s5tab + (size_t)((layer * 32 + g) * 64) * 40;
  cf.arA = t0[l32 * 40]; cf.aiA = t0[l32 * 40 + 1];
  cf.arB = t0[(32 + l32) * 40]; cf.aiB = t0[(32 + l32) * 40 + 1];
#pragma unroll
  for (int jt = 0; jt < 4; jt++) {
    const float* src = t0 + (l32 + 32 * (jt & 1)) * 40 + 4 + (jt >> 1) * 16 + grp * 8;
    float4 a = *(const float4*)src, bq = *(const float4*)(src + 4);
    u32x4 pk = {pack_bf2(a.x, a.y), pack_bf2(a.z, a.w), pack_bf2(bq.x, bq.y), pack_bf2(bq.z, bq.w)};
    bfr[jt] = __builtin_bit_cast(bf16x8, pk);
  }
}

__device__ __forceinline__ void s5_pass1(KP p, int layer, char* smem, const int tid) {
  const int lane = tid & 63, w = tid >> 6, l32 = lane & 31, grp = lane >> 5;
  float* ul = (float*)(smem + w * 4096);
  for (int wbase = blockIdx.x * 4; wbase < 1024; wbase += gridDim.x * 4) {
    const int wi = wbase + w;
    const int j0 = (wi & 15) * 8, g = (wi >> 4) & 31, b = wi >> 9;
    S5Coef cf; bf16x8 bfr[4];
    s5_setup(p, layer, g, l32, grp, cf, bfr);
    const u32x4* src = (const u32x4*)(p->u + (size_t)(b * SEQL + j0 * 64 + lane) * 512 + g * 16);
    u32x4 v0 = src[0], v1 = src[1];
    for (int jj = 0; jj < 8; jj++) {
      const int j = j0 + jj;
      s5_store_u(v0, v1, lane, ul);
      if (jj < 7) {
        const u32x4* nsrc = (const u32x4*)(p->u + (size_t)(b * SEQL + (j + 1) * 64 + lane) * 512 + g * 16);
        v0 = nsrc[0]; v1 = nsrc[1];
      }
      __syncthreads();
      float xAr = 0.f, xAi = 0.f, xBr = 0.f, xBi = 0.f;
      s5_scan32<false>(ul, bfr, cf, xAr, xAi, xBr, xBi, nullptr, l32, grp);
      s5_scan32<false>(ul + 32 * 16, bfr, cf, xAr, xAi, xBr, xBi, nullptr, l32, grp);
      float* so = p->sloc + (size_t)((b * 32 + g) * 128 + j) * 128;
      so[lane] = grp ? xBr : xAr; so[64 + lane] = grp ? xBi : xAi;
      __syncthreads();
    }
  }
}

__device__ __forceinline__ void s5_pass2(KP p, int layer, char* smem, const int tid) {
  const int lane = tid & 63, w = tid >> 6;
  float* ul = (float*)(smem + w * 21504);
  float* X = ul + 1024;
  const int l32 = lane & 31, grp = lane >> 5;
  for (int wbase = blockIdx.x * 4; wbase < 1024; wbase += gridDim.x * 4) {
   const int wi = wbase + w;
   const int j0 = (wi & 15) * 8, g = (wi >> 4) & 31, b = wi >> 9;
   S5Coef cf; bf16x8 bfr[4];
   s5_setup(p, layer, g, l32, grp, cf, bfr);
   bf16x8 cfr[8];
   {
     const int c = l32 & 15;
     const float* cr = p->c_re + (size_t)((layer * 32 + g) * 16 + c) * 64;
     const float* ci = p->c_im + (size_t)((layer * 32 + g) * 16 + c) * 64;
#pragma unroll
     for (int s8 = 0; s8 < 8; s8++) {
       const int k0 = (s8 & 3) * 16 + grp * 8;
       const float* src = (s8 < 4) ? (cr + k0) : (ci + k0);
       const float sg = (l32 < 16) ? ((s8 < 4) ? 1.f : -1.f) : 0.f;
       float4 a = *(const float4*)src, bq = *(const float4*)(src + 4);
       u32x4 pk = {pack_bf2(a.x * sg, a.y * sg), pack_bf2(a.z * sg, a.w * sg), pack_bf2(bq.x * sg, bq.y * sg), pack_bf2(bq.z * sg, bq.w * sg)};
       cfr[s8] = __builtin_bit_cast(bf16x8, pk);
     }
   }
   const float dd = p->ssm_d[(size_t)(layer * 32 + g) * 16 + (l32 & 15)];
   float xAr, xAi, xBr, xBi;
   {
     const float* tb = p->s5tab + (size_t)((layer * 32 + g) * 64 + lane) * 40;
     const float aTr = tb[2], aTi = tb[3];
     float xr = 0.f, xi = 0.f;
     const float* sl = p->sloc + (size_t)((b * 32 + g) * 128) * 128;
     for (int i0 = 0; i0 < j0; i0 += 8) {
       float sr[8], si[8];
#pragma unroll
       for (int q = 0; q < 8; q++) { sr[q] = sl[(i0 + q) * 128 + lane]; si[q] = sl[(i0 + q) * 128 + 64 + lane]; }
#pragma unroll
       for (int q = 0; q < 8; q++) {
         const float nr = aTr * xr - aTi * xi + sr[q];
         const float ni = aTr * xi + aTi * xr + si[q];
         xr = nr; xi = ni;
       }
     }
     xAr = swap_half(xr, 0); xBr = swap_half(xr, 1);
     xAi = swap_half(xi, 0); xBi = swap_half(xi, 1);
   }
   for (int jj = 0; jj < 8; jj++) {
    const int j = j0 + jj;
    s5_load_u(p, b, g, j, lane, ul);
    __syncthreads();
    for (int sub = 0; sub < 2; sub++) {
      s5_scan32<true>(ul + sub * 32 * 16, bfr, cf, xAr, xAi, xBr, xBi, X, l32, grp);
      __syncthreads();
      f32x16 yacc;
#pragma unroll
      for (int r = 0; r < 16; r++) yacc[r] = 0.f;
#pragma unroll
      for (int s8 = 0; s8 < 8; s8++) {
        const float* xs = X + l32 * 132 + ((s8 < 4) ? 0 : 64) + (s8 & 3) * 16 + grp * 8;
        float4 a = *(const float4*)xs, bq = *(const float4*)(xs + 4);
        u32x4 pk = {pack_bf2(a.x, a.y), pack_bf2(a.z, a.w), pack_bf2(bq.x, bq.y), pack_bf2(bq.z, bq.w)};
        yacc = MFMA(__builtin_bit_cast(bf16x8, pk), cfr[s8], yacc);
      }
      if (l32 < 16) {
#pragma unroll
        for (int r = 0; r < 16; r++) {
          const int tl = sub * 32 + (r >> 2) * 8 + grp * 4 + (r & 3);
          const float yv = yacc[r] + dd * ul[tl * 16 + l32];
          p->gy[(size_t)(b * SEQL + j * 64 + tl) * 512 + g * 16 + l32] = f2bf(gelu_tanh(yv));
        }
      }
      __syncthreads();
    }
   }
  }
}

__device__ __forceinline__ void phase_attn(KP p, int layer, char* smem, const int tid) {
  const int lane = tid & 63;
  const float s1 = wave_sum(p->lq1[layer * 64 + lane] * p->lk1[layer * 64 + lane]);
  const float s2 = wave_sum(p->lq2[layer * 64 + lane] * p->lk2[layer * 64 + lane]);
  const float lam_init = 0.8f - 0.6f * expf(-0.3f * (float)layer);
  const float lam = expf(s1) - expf(s2) + lam_init;
  for (int pb = blockIdx.x; pb < 256; pb += gridDim.x) {
    const int pi = (pb & 7) * 32 + (pb >> 3);
    const int b = pi >> 7, h = (pi >> 5) & 3, i = pi & 31;
    attn_item(p, layer, b, h, 63 - i, lam, 1.f - lam_init, smem, tid);
    attn_item(p, layer, b, h, i, lam, 1.f - lam_init, smem, tid);
  }
  s5_pass1(p, layer, smem, tid);
}

__device__ __forceinline__ void phase_final(KP p, const int tid) {
  const int wave = tid >> 6, lane = tid & 63;
  const float* ssq = p->ss + (size_t)8 * 8 * NTOK;
  for (int row = blockIdx.x * 4 + wave; row < NTOK; row += gridDim.x * 4) {
    const float rstd = rsqrtf(ss_sum1(ssq, row) * (1.f / 1024.f) + EPS);
#pragma unroll
    for (int i = 0; i < 4; i++) {
      const u32x2 xv = ((const u32x2*)(p->xb + (size_t)row * DM))[lane + 64 * i];
      float4 v = {__uint_as_float(xv[0] << 16), __uint_as_float(xv[0] & 0xffff0000u), __uint_as_float(xv[1] << 16), __uint_as_float(xv[1] & 0xffff0000u)};
      float4 gq = ((const float4*)p->norm_final)[lane + 64 * i];
      float4 o = {v.x * rstd * gq.x, v.y * rstd * gq.y, v.z * rstd * gq.z, v.w * rstd * gq.w};
      ((float4*)(p->out + (size_t)row * DM))[lane + 64 * i] = o;
    }
  }
}

__device__ __forceinline__ void run_phase(KP p, int ph, char* smem) {
  const int tid = opaque_tid();
  if (ph == 0) { phase_prep(p, smem, tid); return; }
  if (ph == 29) { phase_final(p, tid); return; }
  const int layer = (ph - 1) / 7, k = (ph - 1) % 7;
  const int nb = gridDim.x, bid = blockIdx.x;
  if (k == 1) { phase_attn(p, layer, smem, tid); return; }
  if (k == 2) { s5_pass2(p, layer, smem, tid); return; }
  if (k == 0) { for (int r = 0; ; r++) { const int t = (r * 8 + (bid & 7)) * (nb >> 3) + (bid >> 3); if (r * nb >= 512) break; if (t < 512) gemm_tile(p, G_IN, layer, t, smem, tid); } }
  else if (k == 3) { for (int r = 0; ; r++) { const int t = (r * 8 + (bid & 7)) * (nb >> 3) + (bid >> 3); if (r * nb >= 256) break; if (t < 256) gemm_tile(p, G_GLU, layer, t, smem, tid); } }
  else if (k == 4) { for (int r = 0; ; r++) { const int t = (r * 8 + (bid & 7)) * (nb >> 3) + (bid >> 3); if (r * nb >= 256) break; if (t < 256) gemm_tile(p, G_WOUT, layer, t, smem, tid); } }
  else if (k == 5) { for (int r = 0; ; r++) { const int t = (r * 8 + (bid & 7)) * (nb >> 3) + (bid >> 3); if (r * nb >= 2 * 33 * 22) break; if (t < 2 * 33 * 22) gemm_tile(p, G_UP, layer, t, smem, tid); } }
  else { for (int r = 0; ; r++) { const int t = (r * 8 + (bid & 7)) * (nb >> 3) + (bid >> 3); if (r * nb >= 256) break; if (t < 256) gemm_tile(p, G_DOWN, layer, t, smem, tid); } }
}

#define PHASE_KERNEL(name, body)                                                      \
  __global__ void __launch_bounds__(256) name(Params p_unused) {                      \
    extern __shared__ __attribute__((aligned(16))) char smem[];                       \
    KP p = (KP)__builtin_amdgcn_kernarg_segment_ptr();                                \
    const int tid = threadIdx.x, nb = gridDim.x, bid = blockIdx.x;                    \
    const int layer = (int)p->phase_lo;                                               \
    (void)nb; (void)bid; (void)layer;                                                 \
    body                                                                              \
  }
PHASE_KERNEL(k_prep, phase_prep(p, smem, tid);)
PHASE_KERNEL(k_gin, for (int r = 0; ; r++) { const int t = (r * 8 + (bid & 7)) * (nb >> 3) + (bid >> 3); if (r * nb >= 512) break; if (t < 512) gemm_tile(p, G_IN, layer, t, smem, tid); })
PHASE_KERNEL(k_attn, phase_attn(p, layer, smem, tid);)
PHASE_KERNEL(k_s5p2, s5_pass2(p, layer, smem, tid);)
PHASE_KERNEL(k_glu, for (int r = 0; ; r++) { const int t = (r * 8 + (bid & 7)) * (nb >> 3) + (bid >> 3); if (r * nb >= 256) break; if (t < 256) gemm_tile(p, G_GLU, layer, t, smem, tid); })
PHASE_KERNEL(k_wout, for (int r = 0; ; r++) { const int t = (r * 8 + (bid & 7)) * (nb >> 3) + (bid >> 3); if (r * nb >= 256) break; if (t < 256) gemm_tile(p, G_WOUT, layer, t, smem, tid); })
PHASE_KERNEL(k_up, for (int r = 0; ; r++) { const int t = (r * 8 + (bid & 7)) * (nb >> 3) + (bid >> 3); if (r * nb >= 2 * 33 * 22) break; if (t < 2 * 33 * 22) gemm_tile(p, G_UP, layer, t, smem, tid); })
PHASE_KERNEL(k_down, for (int r = 0; ; r++) { const int t = (r * 8 + (bid & 7)) * (nb >> 3) + (bid >> 3); if (r * nb >= 256) break; if (t < 256) gemm_tile(p, G_DOWN, layer, t, smem, tid); })
PHASE_KERNEL(k_final, phase_final(p, tid);)

#if COOP
__global__ void __launch_bounds__(256) mega_kernel(Params p_unused) {
  extern __shared__ __attribute__((aligned(16))) char smem[];
  KP p0 = (KP)__builtin_amdgcn_kernarg_segment_ptr();
  const int ph_lo = (int)p0->phase_lo, ph_hi = (int)p0->phase_hi;
#if COOP
  if (ph_hi > 1000) cg::this_grid().sync();
#endif
#if COOP
  {
    volatile unsigned* st = (volatile unsigned*)(smem + 136192);
    if (threadIdx.x == 0) { st[0] = 0u; st[1] = 0u; xb_add(&p0->bar[XB_CNT(xb_xcc_id())], 1u); }
  }
#endif
  for (int ph = ph_lo; ph < ph_hi; ph++) {
    KP p = p0;
    asm volatile("" : "+s"(p));
#if TPROBE
    if (blockIdx.x == 0) p->ts[ph] = (long long)wall_clock64();
#endif
    run_phase(p, ph, smem);
#if COOP
    if (ph + 1 < ph_hi) {
      if (ph == ph_lo) grid_barrier(p->bar, gridDim.x, opaque_tid());
      else xcd_barrier(p->bar, (volatile unsigned*)(smem + 136192), opaque_tid());
    }
#endif
  }
#if TPROBE
  grid_barrier(p0->bar, (unsigned)(ph_hi - ph_lo) * gridDim.x, opaque_tid());
  if (blockIdx.x == 0) {
    KP p = p0;
    long long tend = (long long)wall_clock64();
    float a = 0.f, b = 0.f;
    for (int ph = 0; ph < 30; ph++) {
      long long t0 = p->ts[ph], t1 = (ph == 29) ? tend : p->ts[ph + 1];
      int c = (ph == 0) ? 0 : (ph == 29 ? 8 : 1 + (ph - 1) % 7);
      float d = (float)(t1 - t0) * 0.01f;
      if (c == TP_A || TP_A == 9) a += d;
      if (c == TP_B || TP_B == 9) b += d;
    }
    const int t = opaque_tid();
    if (t <= 100) p->out[t] += (t == 0) ? a : b;
  }
#endif
}

#endif

extern "C" void kernel_launch(void* const* d_in, const int* in_sizes, int n_in, void* d_out, int out_size, void* d_ws,
                              size_t ws_size, hipStream_t stream) {
  static int grid_blocks = 0;
  if (!grid_blocks) {
    int dev = 0, cus = 0, per_cu = 0;
    (void)hipGetDevice(&dev);
    (void)hipDeviceGetAttribute(&cus, hipDeviceAttributeMultiprocessorCount, dev);
#if COOP
    (void)hipFuncSetAttribute((const void*)mega_kernel, hipFuncAttributeMaxDynamicSharedMemorySize, LDS_BYTES);
    (void)hipOccupancyMaxActiveBlocksPerMultiprocessor(&per_cu, (const void*)mega_kernel, 256, LDS_BYTES);
    if (per_cu < 1) { fprintf(stderr, "occupancy query returned %d\n", per_cu); per_cu = 1; }
#endif
    grid_blocks = cus;
    (void)hipGetLastError();
  }
  Params p{};
  p.x = (const float*)d_in[0]; p.pos = (const int*)d_in[1];
  p.norm_mix = (const float*)d_in[2]; p.w_in = (const float*)d_in[3];
  p.lam_re = (const float*)d_in[4]; p.lam_im = (const float*)d_in[5]; p.log_step = (const float*)d_in[6];
  p.b_re = (const float*)d_in[7]; p.b_im = (const float*)d_in[8]; p.c_re = (const float*)d_in[9]; p.c_im = (const float*)d_in[10];
  p.ssm_d = (const float*)d_in[11]; p.w_glu = (const float*)d_in[12]; p.ssm_norm = (const float*)d_in[13];
  p.lq1 = (const float*)d_in[14]; p.lk1 = (const float*)d_in[15]; p.lq2 = (const float*)d_in[16]; p.lk2 = (const float*)d_in[17];
  p.subln = (const float*)d_in[18]; p.w_out = (const float*)d_in[19]; p.norm_ffn = (const float*)d_in[20];
  p.w_up = (const float*)d_in[21]; p.w_conv = (const float*)d_in[22]; p.b_conv = (const float*)d_in[23];
  p.w_down = (const float*)d_in[24]; p.norm_final = (const float*)d_in[25];
  p.out = (float*)d_out;
  char* ws = (char*)d_ws;
  size_t off = 0;
  auto take = [&](size_t bytes) { char* r = ws + off; off += (bytes + 255) & ~(size_t)255; return r; };
  p.WinT = (bf16_t*)take((size_t)4 * 2048 * 1024 * 2);
  p.WgluT = (bf16_t*)take((size_t)4 * 1024 * 512 * 2);
  p.WoutT = (bf16_t*)take((size_t)4 * 1024 * 1024 * 2);
  p.WupT = (bf16_t*)take((size_t)4 * 5632 * 1024 * 2);
  p.WdownT = (bf16_t*)take((size_t)4 * 1024 * FFN * 2);
  p.xf = (float*)take((size_t)NTOK * DM * 4);
  p.xb = (bf16_t*)take((size_t)NTOK * DM * 2);
  p.ss = (float*)take((size_t)9 * 8 * NTOK * 4);
  p.ssm_ss = (float*)take((size_t)4 * 8 * NTOK * 4);
  p.cs = (float*)take((size_t)NTOK * 16 * 4);
  p.s5tab = (float*)take((size_t)4 * 32 * 64 * 40 * 4);
  p.sloc = (float*)take((size_t)2 * 32 * 128 * 128 * 4);
  p.ts = (long long*)take(256);
  p.bar = (unsigned*)take(XB_WORDS * 4);
  char* region = take((size_t)134217728);
  p.u = (bf16_t*)region;
  p.q = (bf16_t*)(region + 33554432);
  p.k = p.q + (size_t)NTOK * 512;
  p.vt = p.k + (size_t)NTOK * 512;
  p.gy = p.vt + (size_t)NTOK * 512;
  p.outg = p.gy + (size_t)NTOK * 512;
  p.att = p.outg + (size_t)NTOK * 512;
  p.act = (bf16_t*)region;
  if (off > ws_size) { fprintf(stderr, "workspace too small: need %zu have %zu\n", off, ws_size); return; }
#if COOP
  p.phase_lo = 0; p.phase_hi = 30;
  if (hipMemsetAsync(p.bar, 0, XB_WORDS * 4, stream) != hipSuccess) fprintf(stderr, "barrier memset failed\n");
  void* args[] = {&p};
  hipError_t e = hipLaunchCooperativeKernel((const void*)mega_kernel, dim3(grid_blocks), dim3(256), args, LDS_BYTES, stream);
  if (e != hipSuccess) fprintf(stderr, "cooperative launch failed: %s (grid %d)\n", hipGetErrorString(e), grid_blocks);
#else
  typedef void (*kfn)(Params);
  const kfn seq[7] = {k_gin, k_attn, k_s5p2, k_glu, k_wout, k_up, k_down};
  static bool attr_done = false;
  if (!attr_done) {
    (void)hipFuncSetAttribute((const void*)k_prep, hipFuncAttributeMaxDynamicSharedMemorySize, LDS_BYTES);
    (void)hipFuncSetAttribute((const void*)k_final, hipFuncAttributeMaxDynamicSharedMemorySize, LDS_BYTES);
    for (int i = 0; i < 7; i++) (void)hipFuncSetAttribute((const void*)seq[i], hipFuncAttributeMaxDynamicSharedMemorySize, LDS_BYTES);
    attr_done = true;
  }
  p.phase_lo = 0; p.phase_hi = 0;
  hipLaunchKernelGGL(k_prep, dim3(grid_blocks), dim3(256), LDS_BYTES, stream, p);
  for (int layer = 0; layer < 4; layer++) {
    p.phase_lo = layer;
    for (int i = 0; i < 7; i++) hipLaunchKernelGGL(seq[i], dim3(grid_blocks), dim3(256), LDS_BYTES, stream, p);
  }
  hipLaunchKernelGGL(k_final, dim3(grid_blocks), dim3(256), LDS_BYTES, stream, p);
#endif
}
```

```cpp
#include <hip/hip_runtime.h>
#include <hip/hip_cooperative_groups.h>
#include <cstdio>
namespace cg = cooperative_groups;

#ifndef COOP
#define COOP 1
#endif
#ifndef TPROBE
#define TPROBE 0
#endif
#ifndef TP_A
#define TP_A 1
#endif
#ifndef TP_B
#define TP_B 2
#endif

typedef unsigned short bf16_t;
typedef __attribute__((ext_vector_type(8))) short bf16x8;
typedef __attribute__((ext_vector_type(16))) float f32x16;
typedef __attribute__((ext_vector_type(2))) __bf16 bf2_t;
typedef __attribute__((ext_vector_type(2))) float f2_t;
typedef __attribute__((ext_vector_type(4))) unsigned u32x4;
typedef __attribute__((ext_vector_type(2))) unsigned u32x2;

#define DI __device__ __forceinline__
#define MFMA(a, b, c) __builtin_amdgcn_mfma_f32_32x32x16_bf16((a), (b), (c), 0, 0, 0)

constexpr int NTOK = 16384, DM = 1024, SEQL = 8192, FFN = 2816;
constexpr int LDS_BYTES = 136208;
constexpr float EPS = 1e-6f;

struct Params {
  const float* x; const int* pos;
  const float *norm_mix, *w_in, *lam_re, *lam_im, *log_step, *b_re, *b_im, *c_re, *c_im, *ssm_d, *w_glu, *ssm_norm;
  const float *lq1, *lk1, *lq2, *lk2, *subln, *w_out, *norm_ffn, *w_up, *w_conv, *b_conv, *w_down, *norm_final;
  float* out;
  bf16_t *WinT, *WgluT, *WoutT, *WupT, *WdownT;
  float* xf; bf16_t* xb;
  bf16_t *u, *q, *k, *vt, *gy, *outg, *att, *act;
  float *ss, *ssm_ss, *cs, *s5tab, *sloc;
  long long phase_lo, phase_hi;
  long long* ts;
  unsigned* bar;
};

typedef const __attribute__((address_space(4))) Params* KP;

DI unsigned pack_bf2(float a, float b) { f2_t v = {a, b}; return __builtin_bit_cast(unsigned, __builtin_convertvector(v, bf2_t)); }
DI bf16_t f2bf(float a) { return (bf16_t)(pack_bf2(a, 0.f) & 0xffffu); }
DI float bf2f(bf16_t v) { return __uint_as_float(((unsigned)v) << 16); }
DI void grid_barrier(unsigned* ctr, unsigned target, int tid) {
  asm volatile("s_waitcnt vmcnt(0)" ::: "memory");
  __syncthreads();
  if (tid == 0) {
    __builtin_amdgcn_fence(__ATOMIC_RELEASE, "agent");
    asm volatile("s_waitcnt vmcnt(0)" ::: "memory");
    __hip_atomic_fetch_add(ctr, 1u, __ATOMIC_RELAXED, __HIP_MEMORY_SCOPE_AGENT);
    while (__hip_atomic_load(ctr, __ATOMIC_RELAXED, __HIP_MEMORY_SCOPE_AGENT) < target) __builtin_amdgcn_s_sleep(1);
    __builtin_amdgcn_fence(__ATOMIC_ACQUIRE, "agent");
    asm volatile("s_waitcnt vmcnt(0)" ::: "memory");
  }
  __syncthreads();
}
#define XB_CNT(j)  (64 + 64 * (j))
#define XB_SUB(j)  (1088 + 64 * (j))
#define XB_GEN(j)  (2112 + 64 * (j))
#define XB_TOP     3136
#define XB_TOPGEN  3200
#define XB_WORDS   3264
DI unsigned xb_ld(unsigned* q) { return __hip_atomic_load(q, __ATOMIC_RELAXED, __HIP_MEMORY_SCOPE_AGENT); }
DI unsigned xb_add(unsigned* q, unsigned v) { return __hip_atomic_fetch_add(q, v, __ATOMIC_RELAXED, __HIP_MEMORY_SCOPE_AGENT); }
DI unsigned xb_xcc_id() { return (unsigned)__builtin_amdgcn_s_getreg((3 << 11) | 20) & 0xFu; }
DI void xcd_barrier(unsigned* bar, volatile unsigned* st, int tid) {
  asm volatile("s_waitcnt vmcnt(0)" ::: "memory");
  __syncthreads();
  if (tid == 0) {
    const unsigned x = xb_xcc_id();
    unsigned nloc = st[0], nx = st[1];
    if (nloc == 0u) {
      unsigned cnt = 0u, mine = 1u;
#pragma unroll
      for (unsigned j = 0; j < 16; ++j) { const unsigned c = xb_ld(&bar[XB_CNT(j)]); cnt += (c > 0u) ? 1u : 0u; mine = (j == x) ? c : mine; }
      nloc = mine > 0u ? mine : 1u; nx = cnt > 0u ? cnt : 1u;
      st[0] = nloc; st[1] = nx;
    }
    const unsigned old = xb_add(&bar[XB_SUB(x)], 1u);
    const unsigned gen = old / nloc;
    if (old + 1u == (gen + 1u) * nloc) {
      __builtin_amdgcn_fence(__ATOMIC_RELEASE, "agent");
      asm volatile("s_waitcnt vmcnt(0)" ::: "memory");
      const unsigned og = xb_add(&bar[XB_TOP], 1u);
      const unsigned tg = og / nx;
      if (og + 1u == (tg + 1u) * nx) xb_add(&bar[XB_TOPGEN], 1u);
      else { while (xb_ld(&bar[XB_TOPGEN]) == tg) __builtin_amdgcn_s_sleep(1); }
      __builtin_amdgcn_fence(__ATOMIC_ACQUIRE, "agent");
      xb_add(&bar[XB_GEN(x)], 1u);
      asm volatile("s_waitcnt vmcnt(0)" ::: "memory");
    } else {
      while (xb_ld(&bar[XB_GEN(x)]) == gen) __builtin_amdgcn_s_sleep(1);
      __builtin_amdgcn_fence(__ATOMIC_ACQUIRE, "agent");
      asm volatile("s_waitcnt vmcnt(0)" ::: "memory");
    }
  }
  __syncthreads();
}
DI int opaque_tid() { int t = threadIdx.x; asm volatile("" : "+v"(t)); return t; }
DI float4 ss_sum4(const float* base, int row0) {
  float4 a = *(const float4*)(base + row0);
#pragma unroll
  for (int pz = 1; pz < 8; pz++) {
    float4 b = *(const float4*)(base + (size_t)pz * NTOK + row0);
    a.x += b.x; a.y += b.y; a.z += b.z; a.w += b.w;
  }
  return a;
}
DI float ss_sum1(const float* base, int row) {
  float a = base[row];
#pragma unroll
  for (int pz = 1; pz < 8; pz++) a += base[(size_t)pz * NTOK + row];
  return a;
}
DI float wave_sum(float v) { for (int o = 32; o; o >>= 1) v += __shfl_xor(v, o); return v; }
DI float fast_exp2(float x) { return __builtin_amdgcn_exp2f(x); }
DI float gelu_tanh(float x) {
  float z = 0.7978845608028654f * (x + 0.044715f * x * x * x);
  float e = __expf(2.f * z);
  float t = 1.f - 2.f / (1.f + e);
  return 0.5f * x * (1.f + t);
}
DI float reduce_2pi(double a) {
  double n = rint(a * 0.15915494309189535);
  return (float)(a - n * 6.283185307179586);
}

DI void transpose_tile(const float* src, int ldsrc, int k0, int c0, const float* scale, int nscale,
                       bf16_t* dst, int lddst, int n0, float* lds, const int tid) {
#pragma unroll
  for (int i = 0; i < 16; i++) {
    int kk = i * 4 + (tid >> 6), nn = tid & 63;
    float v = src[(size_t)(k0 + kk) * ldsrc + c0 + nn];
    if (scale != nullptr && (k0 + kk) < nscale) v *= scale[k0 + kk];
    lds[kk * 65 + nn] = v;
  }
  __syncthreads();
  {
    int nn = tid >> 2, kq = (tid & 3) * 16;
    unsigned pk[8];
#pragma unroll
    for (int i = 0; i < 8; i++) pk[i] = pack_bf2(lds[(kq + 2 * i) * 65 + nn], lds[(kq + 2 * i + 1) * 65 + nn]);
    u32x4* d = (u32x4*)(dst + (size_t)(n0 + nn) * lddst + k0 + kq);
    u32x4 a = {pk[0], pk[1], pk[2], pk[3]}, b = {pk[4], pk[5], pk[6], pk[7]};
    d[0] = a; d[1] = b;
  }
  __syncthreads();
}

DI void wtask(const float* src, int ldsrc, int k0, int c0, const float* scale, int nscale, bf16_t* dst, int lddst, int n0, int lane) {
  float v[32];
  const float* sp = src + (size_t)k0 * ldsrc + c0 + lane;
#pragma unroll
  for (int i = 0; i < 32; i++) v[i] = __builtin_nontemporal_load(sp + (size_t)i * ldsrc);
  if (k0 < nscale) {
#pragma unroll
    for (int i = 0; i < 32; i++) v[i] *= scale[k0 + i];
  }
  u32x4* d = (u32x4*)(dst + (size_t)(n0 + lane) * lddst + k0);
#pragma unroll
  for (int q = 0; q < 4; q++) {
    u32x4 o = {pack_bf2(v[8 * q], v[8 * q + 1]), pack_bf2(v[8 * q + 2], v[8 * q + 3]), pack_bf2(v[8 * q + 4], v[8 * q + 5]), pack_bf2(v[8 * q + 6], v[8 * q + 7])};
    d[q] = o;
  }
}

__device__ __forceinline__ void phase_prep(KP p, char* smem, const int tid) {
  const int nb = gridDim.x, bid = blockIdx.x;
  const int wave = tid >> 6, lane = tid & 63;
  for (int row0 = (bid * 4 + wave) * 4; row0 < NTOK; row0 += nb * 16) {
    float4 v[4][4];
#pragma unroll
    for (int rr = 0; rr < 4; rr++)
#pragma unroll
      for (int i = 0; i < 4; i++) v[rr][i] = ((const float4*)(p->x + (size_t)(row0 + rr) * DM))[lane + 64 * i];
#pragma unroll
    for (int rr = 0; rr < 4; rr++) {
      const int row = row0 + rr;
      float s = 0.f;
#pragma unroll
      for (int i = 0; i < 4; i++) {
        u32x2 pk = {pack_bf2(v[rr][i].x, v[rr][i].y), pack_bf2(v[rr][i].z, v[rr][i].w)};
        ((u32x2*)(p->xb + (size_t)row * DM))[lane + 64 * i] = pk;
        const float a0 = __uint_as_float(pk[0] << 16), a1 = __uint_as_float(pk[0] & 0xffff0000u);
        const float a2 = __uint_as_float(pk[1] << 16), a3 = __uint_as_float(pk[1] & 0xffff0000u);
        s += a0 * a0 + a1 * a1 + a2 * a2 + a3 * a3;
      }
      s = wave_sum(s);
      if (lane < 8) p->ss[(size_t)lane * NTOK + row] = (lane == 0) ? s : 0.f;
    }
  }
  for (int i = bid * 256 + tid; i < NTOK * 8; i += nb * 256) {
    int tok = i >> 3, j = i & 7;
    double inv = (j & 4) ? ((j & 2) ? ((j & 1) ? 1.031338537721246e-05 : 5.318295896944988e-05) : ((j & 1) ? 0.0002742481756762073 : 0.001414213562373095))
                         : ((j & 2) ? ((j & 1) ? 0.007292664737217109 : 0.03760603093086393) : ((j & 1) ? 0.19392274474868576 : 1.0));
    double ang = (double)p->pos[tok] * inv;
    float r = reduce_2pi(ang);
    p->cs[2 * i] = cosf(r); p->cs[2 * i + 1] = sinf(r);
  }
  for (int i = bid * 256 + tid; i < 4 * 32 * 64; i += nb * 256) {
    int lg = i >> 6;
    float lr = p->lam_re[i], li = p->lam_im[i];
    float step = expf(p->log_step[lg]);
    float mag = expf(step * lr);
    double angd = (double)step * (double)li;
    float r1 = reduce_2pi(angd);
    float ar = mag * cosf(r1), ai = mag * sinf(r1);
    float den = lr * lr + li * li;
    float fr = ((ar - 1.f) * lr + ai * li) / den;
    float fi = (ai * lr - (ar - 1.f) * li) / den;
    float magT = expf(64.f * step * lr);
    float rT = reduce_2pi(64.0 * angd);
    float* tb = p->s5tab + (size_t)i * 40;
    tb[0] = ar; tb[1] = ai; tb[2] = magT * cosf(rT); tb[3] = magT * sinf(rT);
    for (int c = 0; c < 16; c++) {
      float br = p->b_re[(size_t)i * 16 + c], bi = p->b_im[(size_t)i * 16 + c];
      tb[4 + c] = fr * br - fi * bi;
      tb[20 + c] = fr * bi + fi * br;
    }
  }
  {
    const int NTASK = 4 * 6016;
    const int gw = bid * 4 + wave, nw = nb * 4;
    const int per = (NTASK + nw - 1) / nw;
    const int t_lo = gw * per, t_hi = min(t_lo + per, NTASK);
    for (int task = t_lo; task < t_hi; task++) {
      const int layer = task / 6016;
      int t = task % 6016;
      if (t < 1024) {
        const int a = t >> 5, kb = t & 31;
        wtask(p->w_in + (size_t)layer * 1024 * 2048, 2048, kb * 32, a * 64, p->norm_mix + layer * 1024, 1024,
              p->WinT + (size_t)layer * 2048 * 1024, 1024, a * 64, lane);
      } else if (t < 1280) {
        t -= 1024; const int a = t >> 4, kb = t & 15;
        wtask(p->w_glu + (size_t)layer * 512 * 1024, 1024, kb * 32, (a & 1) * 512 + (a >> 1) * 64, p->norm_mix, 0,
              p->WgluT + (size_t)layer * 1024 * 512, 512, a * 64, lane);
      } else if (t < 1792) {
        t -= 1280; const int a = t >> 5, kb = t & 31;
        wtask(p->w_out + (size_t)layer * 1024 * 1024, 1024, kb * 32, a * 64, p->ssm_norm + layer * 512, 512,
              p->WoutT + (size_t)layer * 1024 * 1024, 1024, a * 64, lane);
      } else if (t < 4608) {
        t -= 1792; const int a = t >> 5, kb = t & 31;
        wtask(p->w_up + (size_t)layer * 1024 * 5632, 5632, kb * 32, (a & 1) * FFN + (a >> 1) * 64, p->norm_ffn + layer * 1024, 1024,
              p->WupT + (size_t)layer * 5632 * 1024, 1024, a * 64, lane);
      } else {
        t -= 4608; const int a = t / 88, kb = t % 88;
        wtask(p->w_down + (size_t)layer * FFN * 1024, 1024, kb * 32, a * 64, p->norm_mix, 0,
              p->WdownT + (size_t)layer * 1024 * FFN, FFN, a * 64, lane);
      }
    }
  }
}

enum { G_IN = 0, G_GLU = 1, G_WOUT = 2, G_UP = 3, G_DOWN = 4 };
#define ACC_PIN(tag) _Pragma("unroll") for (int i_ = 0; i_ < 4; i_++) _Pragma("unroll") for (int j_ = 0; j_ < 4; j_++) asm volatile("; pin " tag : "+a"(acc[i_][j_]));


__device__ __forceinline__ void gemm_tile(KP p, const int MODE, int layer, int tile, char* smem, const int tid) {
  const int lane = tid & 63, w = tid >> 6, wm = w >> 1, wn = w & 1, g = lane >> 5, l32 = lane & 31;
  int tn, KT, ldb, rowbase, lda;
  const bf16_t* Bt;
  const bf16_t* A0;
  int upb = 0, upti = 0;
  {
    const int TM = (MODE == G_UP) ? 66 : 64;
    const int TN = (MODE == G_IN) ? 8 : (MODE == G_UP ? 22 : 4);
    const int nfull = TN >> 2, rem = TN & 3;
    int tm;
    if (tile < nfull * 4 * TM) { const int band = tile / (4 * TM), within = tile % (4 * TM); tm = within >> 2; tn = band * 4 + (within & 3); }
    else { const int s2 = tile - nfull * 4 * TM; tm = s2 / rem; tn = nfull * 4 + s2 % rem; }
    rowbase = tm * 256;
    if (MODE == G_UP) { upb = tm / 33; upti = tm % 33; rowbase = upb * SEQL + 254 * upti - 2; }
  }
  if (MODE == G_IN) { KT = 16; ldb = 1024; Bt = p->WinT + (size_t)layer * 2048 * 1024; A0 = p->xb; lda = 1024; }
  else if (MODE == G_GLU) { KT = 8; ldb = 512; Bt = p->WgluT + (size_t)layer * 1024 * 512; A0 = p->gy; lda = 512; }
  else if (MODE == G_WOUT) { KT = 16; ldb = 1024; Bt = p->WoutT + (size_t)layer * 1024 * 1024; A0 = p->outg; lda = 512; }
  else if (MODE == G_UP) { KT = 16; ldb = 1024; Bt = p->WupT + (size_t)layer * 5632 * 1024; A0 = p->xb; lda = 1024; }
  else { KT = 44; ldb = FFN; Bt = p->WdownT + (size_t)layer * 1024 * FFN; A0 = p->act; lda = FFN; }

  u32x4 ra[8], rb[8];
  const int lrow = tid >> 3, lc = tid & 7;
  float arow_sc[8];
#pragma unroll
  for (int i = 0; i < 8; i++) arow_sc[i] = 1.f;
  if (MODE == G_WOUT) {
    const float* ssq = p->ssm_ss + (size_t)layer * 8 * NTOK;
#pragma unroll
    for (int i = 0; i < 8; i++) arow_sc[i] = rsqrtf(ss_sum1(ssq, rowbase + lrow + 32 * i) * (1.f / 512.f) + EPS);
  }
  const bf16_t* bptr = Bt + (size_t)(tn * 256 + lrow) * ldb + lc * 8;
  auto gload = [&](int kt) {
    const bf16_t* abase = A0;
    int kofs = kt * 64;
    if (MODE == G_WOUT && kt >= 8) { abase = p->att; kofs = (kt - 8) * 64; }
#pragma unroll
    for (int i = 0; i < 8; i++) {
      int gr = min(max(rowbase + lrow + 32 * i, 0), NTOK - 1);
      ra[i] = *(const u32x4*)(abase + (size_t)gr * lda + kofs + lc * 8);
      rb[i] = *(const u32x4*)(bptr + (size_t)(32 * i) * ldb + kt * 64);
    }
  };
  auto scaleA = [&](int kt) {
    if (MODE == G_WOUT && kt < 8) {
#pragma unroll
      for (int i = 0; i < 8; i++)
#pragma unroll
        for (int e = 0; e < 4; e++) {
          unsigned v = ra[i][e];
          float lo = __uint_as_float(v << 16) * arow_sc[i], hi = __uint_as_float(v & 0xffff0000u) * arow_sc[i];
          ra[i][e] = pack_bf2(lo, hi);
        }
    }
  };
  const int wr_off = lrow * 128 + ((lc ^ ((lrow >> 1) & 7)) << 4);
  auto lwriteA = [&](int st) {
    char* sa = smem + st * 65536;
#pragma unroll
    for (int i = 0; i < 8; i++) *(u32x4*)(sa + wr_off + i * 4096) = ra[i];
  };
  auto lwriteB = [&](int st) {
    char* sb = smem + st * 65536 + 32768;
#pragma unroll
    for (int i = 0; i < 8; i++) *(u32x4*)(sb + wr_off + i * 4096) = rb[i];
  };

  f32x16 acc[4][4];
#pragma unroll
  for (int i = 0; i < 4; i++)
#pragma unroll
    for (int j = 0; j < 4; j++)
#pragma unroll
      for (int r = 0; r < 16; r++) acc[i][j][r] = 0.f;

  const int swz = (l32 >> 1) & 7;
  const int a_base = (wm * 128 + l32) * 128;
  const int b_base = 32768 + (wn * 128 + l32) * 128;
  bf16x8 af[2][4], bfr[2][4];
  auto lfrag = [&](int buf, const char* st, int ks) {
    const int coff = (((ks * 2 + g) ^ swz) << 4);
#pragma unroll
    for (int i = 0; i < 4; i++) af[buf][i] = *(const bf16x8*)(st + a_base + i * 4096 + coff);
#pragma unroll
    for (int j = 0; j < 4; j++) bfr[buf][j] = *(const bf16x8*)(st + b_base + j * 4096 + coff);
  };
  auto mfma16 = [&](int buf) {
#pragma unroll
    for (int i = 0; i < 4; i++)
#pragma unroll
      for (int j = 0; j < 4; j++) acc[i][j] = MFMA(af[buf][i], bfr[buf][j], acc[i][j]);
  };

  gload(0);
  scaleA(0);
  lwriteA(0);
  lwriteB(0);
  __syncthreads();
  if (KT > 1) gload(1);
  lfrag(0, smem, 0);
  for (int kt = 0; kt < KT; kt++) {
    const char* st = smem + (kt & 1) * 65536;
    const bool has1 = (kt + 1 < KT), has2 = (kt + 2 < KT);
    lfrag(1, st, 1);
    if (has1) { scaleA(kt + 1); lwriteA((kt + 1) & 1); }
    mfma16(0);
    __builtin_amdgcn_sched_barrier(0);
    lfrag(0, st, 2);
    if (has1) lwriteB((kt + 1) & 1);
    mfma16(1);
    __builtin_amdgcn_sched_barrier(0);
    lfrag(1, st, 3);
    if (has2) gload(kt + 2);
    mfma16(0);
    __builtin_amdgcn_sched_barrier(0);
    asm volatile("s_waitcnt lgkmcnt(0)" ::: "memory");
    __builtin_amdgcn_s_barrier();
    __builtin_amdgcn_sched_barrier(0);
    if (has1) lfrag(0, smem + ((kt + 1) & 1) * 65536, 0);
    mfma16(1);
    __builtin_amdgcn_sched_barrier(0);
  }

  int tid2 = tid;
  asm volatile("" : "+v"(tid2));
  {
  const int tid = tid2;
  const int lane = tid & 63, w = tid >> 6, wm = w >> 1, wn = w & 1, g = lane >> 5, l32 = lane & 31;
  if (MODE == G_IN) {
    const int region = tn >> 1;
    float* rs = (float*)(smem + 135168);
    rs[tid] = rsqrtf(ss_sum1(p->ss + (size_t)(2 * layer) * 8 * NTOK, rowbase + tid) * (1.f / 1024.f) + EPS);
    __syncthreads();
#pragma unroll
    for (int i = 0; i < 4; i++)
#pragma unroll
      for (int rq = 0; rq < 4; rq++) {
        const int lr0 = wm * 128 + i * 32 + rq * 8 + g * 4;
        const float4 s4 = *(const float4*)(rs + lr0);
        const float sc[4] = {s4.x, s4.y, s4.z, s4.w};
#pragma unroll
        for (int j = 0; j < 4; j++) {
          const int lcol = wn * 128 + j * 32 + l32;
          float v[4];
#pragma unroll
          for (int r4 = 0; r4 < 4; r4++) v[r4] = acc[i][j][rq * 4 + r4] * sc[r4];
          if (region == 3) {
            const int q4 = (lr0 >> 2) & 3;
            const int pq = ((q4 & 1) << 1) | (q4 >> 1);
            u32x2 pk = {pack_bf2(v[0], v[1]), pack_bf2(v[2], v[3])};
            *(u32x2*)(smem + lcol * 528 + ((lr0 & ~15) + pq * 4) * 2) = pk;
          } else {
            if (region != 0 && (j & 1) == 0) {
              float other[4];
#pragma unroll
              for (int r4 = 0; r4 < 4; r4++) other[r4] = __shfl_xor(v[r4], 8);
              if (l32 < 16) {
                const float sgn = (l32 < 8) ? -1.f : 1.f;
#pragma unroll
                for (int r4 = 0; r4 < 4; r4++) {
                  const float2 csv = *(const float2*)(p->cs + ((size_t)(rowbase + lr0 + r4) * 8 + (l32 & 7)) * 2);
                  v[r4] = v[r4] * csv.x + sgn * other[r4] * csv.y;
                }
              }
            }
#pragma unroll
            for (int r4 = 0; r4 < 4; r4++) *(bf16_t*)(smem + (lr0 + r4) * 528 + lcol * 2) = f2bf(v[r4]);
          }
        }
      }
    __syncthreads();
    {
      bf16_t* dbase;
      size_t rstride;
      if (region == 3) { dbase = p->vt + (size_t)((rowbase >> 13) * 512 + (tn & 1) * 256) * SEQL + (rowbase & (SEQL - 1)); rstride = SEQL; }
      else { dbase = (region == 0 ? p->u : (region == 1 ? p->q : p->k)) + (size_t)rowbase * 512 + (tn & 1) * 256; rstride = 512; }
#pragma unroll 8
      for (int it = 0; it < 32; it++) {
        const int id = tid + 256 * it, row = id >> 5, c = id & 31;
        const u32x4 vv = *(const u32x4*)(smem + row * 528 + c * 16);
        *(u32x4*)(dbase + (size_t)row * rstride + c * 8) = vv;
      }
    }
    __syncthreads();
  } else if (MODE == G_GLU) {
#pragma unroll
    for (int i = 0; i < 4; i++)
#pragma unroll
      for (int j = 0; j < 2; j++)
#pragma unroll
        for (int r = 0; r < 16; r++) {
          const int lr = wm * 128 + i * 32 + (r >> 2) * 8 + g * 4 + (r & 3);
          const float av = acc[i][j][r], bv = acc[i][j + 2][r];
          *(bf16_t*)(smem + lr * 272 + (wn * 64 + j * 32 + l32) * 2) = f2bf(av / (1.f + __expf(-bv)));
        }
    __syncthreads();
    {
      float* ssq = p->ssm_ss + ((size_t)layer * 8 + tn * 2) * NTOK;
#pragma unroll 4
      for (int it = 0; it < 16; it++) {
        const int id = tid + 256 * it, row = id >> 4, c = id & 15;
        const u32x4 ov = *(const u32x4*)(smem + row * 272 + c * 16);
        *(u32x4*)(p->outg + (size_t)(rowbase + row) * 512 + tn * 128 + c * 8) = ov;
        float sq = 0.f;
#pragma unroll
        for (int e = 0; e < 4; e++) {
          const float lo = __uint_as_float(ov[e] << 16), hi = __uint_as_float(ov[e] & 0xffff0000u);
          sq += lo * lo + hi * hi;
        }
#pragma unroll
        for (int o = 4; o; o >>= 1) sq += __shfl_xor(sq, o);
        if ((c & 7) == 0) ssq[(size_t)(c >> 3) * NTOK + rowbase + row] = sq;
      }
    }
    __syncthreads();
  } else if (MODE == G_WOUT || MODE == G_DOWN) {
#pragma unroll
    for (int i = 0; i < 4; i++)
#pragma unroll
      for (int j = 0; j < 4; j++)
#pragma unroll
        for (int r = 0; r < 16; r++) {
          const int lr = wm * 128 + i * 32 + (r >> 2) * 8 + g * 4 + (r & 3);
          *(bf16_t*)(smem + lr * 528 + (wn * 128 + j * 32 + l32) * 2) = f2bf(acc[i][j][r]);
        }
    __syncthreads();
    {
      float* ssq = p->ss + ((size_t)(MODE == G_WOUT ? 2 * layer + 1 : 2 * layer + 2) * 8 + tn * 2) * NTOK;
#pragma unroll 4
      for (int it = 0; it < 32; it++) {
        const int id = tid + 256 * it, row = id >> 5, c = id & 31;
        const u32x4 dv = *(const u32x4*)(smem + row * 528 + c * 16);
        const size_t idx = (size_t)(rowbase + row) * 1024 + tn * 256 + c * 8;
        const u32x4 xv = *(const u32x4*)(p->xb + idx);
        u32x4 xbv;
        float sq = 0.f;
#pragma unroll
        for (int e = 0; e < 4; e++) {
          const float lo = __uint_as_float(xv[e] << 16) + __uint_as_float(dv[e] << 16);
          const float hi = __uint_as_float(xv[e] & 0xffff0000u) + __uint_as_float(dv[e] & 0xffff0000u);
          const unsigned pk = pack_bf2(lo, hi);
          xbv[e] = pk;
          const float rl = __uint_as_float(pk << 16), rh = __uint_as_float(pk & 0xffff0000u);
          sq += rl * rl + rh * rh;
        }
        *(u32x4*)(p->xb + idx) = xbv;
#pragma unroll
        for (int o = 8; o; o >>= 1) sq += __shfl_xor(sq, o);
        if ((c & 15) == 0) ssq[(size_t)(c >> 4) * NTOK + rowbase + row] = sq;
      }
    }
    __syncthreads();
  } else {
#pragma unroll
    for (int i = 0; i < 4; i++)
#pragma unroll
      for (int rq = 0; rq < 4; rq++) {
        const int lr0 = wm * 128 + i * 32 + rq * 8 + g * 4;
#pragma unroll
        for (int j = 0; j < 4; j++) {
          const int pc = wn * 128 + j * 32 + l32;
          u32x2 pk = {pack_bf2(acc[i][j][rq * 4 + 0], acc[i][j][rq * 4 + 1]), pack_bf2(acc[i][j][rq * 4 + 2], acc[i][j][rq * 4 + 3])};
          *(u32x2*)(smem + pc * 528 + lr0 * 2) = pk;
        }
      }
    {
      float* rs = (float*)(smem + 135168);
      const int tb = 254 * upti - 2 + tid;
      float sc = 0.f;
      if (tb >= 0) {
        const int gr = min(upb * SEQL + tb, NTOK - 1);
        sc = rsqrtf(ss_sum1(p->ss + (size_t)(2 * layer + 1) * 8 * NTOK, gr) * (1.f / 1024.f) + EPS);
      }
      rs[tid] = sc;
    }
    __syncthreads();
    {
      const int cp = tid & 127, half = tid >> 7;
      const int pg = (cp >> 6) * 128 + (cp & 63), pv = pg + 64;
      const int ocol = tn * 128 + cp;
      const float* wc = p->w_conv + (size_t)layer * 3 * 5632;
      const float* bc = p->b_conv + (size_t)layer * 5632;
      const float wg0 = wc[ocol], wg1 = wc[5632 + ocol], wg2 = wc[2 * 5632 + ocol], bg = bc[ocol];
      const float wv0 = wc[FFN + ocol], wv1 = wc[5632 + FFN + ocol], wv2 = wc[2 * 5632 + FFN + ocol], bv = bc[FFN + ocol];
      const float* rs = (const float*)(smem + 135168);
      const char* gcol = smem + pg * 528;
      const char* vcol = smem + pv * 528;
      float g0 = 0.f, v0 = 0.f, g1 = 0.f, v1 = 0.f;
      if (half) {
        g0 = rs[126] * bf2f(*(const bf16_t*)(gcol + 126 * 2)); v0 = rs[126] * bf2f(*(const bf16_t*)(vcol + 126 * 2));
        g1 = rs[127] * bf2f(*(const bf16_t*)(gcol + 127 * 2)); v1 = rs[127] * bf2f(*(const bf16_t*)(vcol + 127 * 2));
      }
      for (int grp8 = 0; grp8 < 16; grp8++) {
        const int lrb = half * 128 + grp8 * 8;
        const u32x4 gq = *(const u32x4*)(gcol + lrb * 2);
        const u32x4 vq = *(const u32x4*)(vcol + lrb * 2);
        const float4 r0 = *(const float4*)(rs + lrb), r1 = *(const float4*)(rs + lrb + 4);
        const float rsv[8] = {r0.x, r0.y, r0.z, r0.w, r1.x, r1.y, r1.z, r1.w};
#pragma unroll
        for (int e = 0; e < 8; e++) {
          const unsigned gw = gq[e >> 1], vw = vq[e >> 1];
          const float g2 = rsv[e] * ((e & 1) ? __uint_as_float(gw & 0xffff0000u) : __uint_as_float(gw << 16));
          const float v2 = rsv[e] * ((e & 1) ? __uint_as_float(vw & 0xffff0000u) : __uint_as_float(vw << 16));
          const int lr = lrb + e;
          const int tb = 254 * upti - 2 + lr;
          if (lr >= 2 && tb < SEQL) {
            const float gate = bg + wg0 * g0 + wg1 * g1 + wg2 * g2;
            const float val = bv + wv0 * v0 + wv1 * v1 + wv2 * v2;
            const float o = gate / (1.f + __expf(-gate)) * val;
            p->act[(size_t)(upb * SEQL + tb) * FFN + ocol] = f2bf(o);
          }
          g0 = g1; v0 = v1; g1 = g2; v1 = v2;
        }
      }
    }
    __syncthreads();
  }
  }
}

__device__ __forceinline__ void attn_item(KP p, int layer, int b, int h, int qt, float lam, float outscale, char* smem, const int tid) {
  const int lane = tid & 63, w = tid >> 6, g = lane >> 5, l32 = lane & 31;
  const int tok_q = b * SEQL + qt * 128 + w * 32 + l32;
  bf16x8 qreg[2][4];
#pragma unroll
  for (int c = 0; c < 2; c++)
#pragma unroll
    for (int ks = 0; ks < 4; ks++)
      qreg[c][ks] = *(const bf16x8*)(p->q + (size_t)tok_q * 512 + h * 128 + c * 64 + ks * 16 + g * 8);

  const int NT = 2 * qt + 2;
  const int nkt = 2 * qt + 1 + (w >> 1);
  f32x16 O[2][4];
#pragma unroll
  for (int c = 0; c < 2; c++)
#pragma unroll
    for (int dt = 0; dt < 4; dt++)
#pragma unroll
      for (int r = 0; r < 16; r++) O[c][dt][r] = 0.f;
  float mrun[2] = {-1e30f, -1e30f}, lrun[2] = {0.f, 0.f};
  const float c1 = 0.125f * 1.4426950408889634f;

  u32x4 rk[4], rv[4];
  const bf16_t* kbase = p->k + (size_t)(b * SEQL) * 512 + h * 128;
  const bf16_t* vbase = p->vt + (size_t)((b * 4 + h) * 128) * SEQL;
  const int kkey = tid >> 4, kc = tid & 15;
  const int vd = tid >> 3, vc = tid & 7;
  auto gload = [&](int kt) {
#pragma unroll
    for (int i = 0; i < 4; i++) {
      rk[i] = *(const u32x4*)(kbase + (size_t)(kt * 64 + kkey + 16 * i) * 512 + kc * 8);
      rv[i] = *(const u32x4*)(vbase + (size_t)(vd + 32 * i) * SEQL + kt * 64 + vc * 8);
    }
  };
  const int kw_off = kkey * 256 + ((kc ^ (kkey & 15)) << 4);
  const int vw_off = 16384 + vd * 128 + ((vc ^ ((vd >> 1) & 7)) << 4);
  auto lwrite = [&](int st) {
    char* s = smem + st * 32768;
#pragma unroll
    for (int i = 0; i < 4; i++) {
      *(u32x4*)(s + kw_off + i * 4096) = rk[i];
      *(u32x4*)(s + vw_off + i * 4096) = rv[i];
    }
  };

  gload(0);
  lwrite(0);
  __syncthreads();
  for (int kt = 0; kt < NT; kt++) {
    if (kt + 1 < NT) gload(kt + 1);
    if (kt < nkt) {
      const char* st = smem + (kt & 1) * 32768;
      bf16x8 pf[2][2][2];
      bf16x8 kf[8], vf[2][4];
      f32x16 S[1][2];
      auto loadkq = [&](int c) {
#pragma unroll
        for (int kb = 0; kb < 2; kb++)
#pragma unroll
          for (int ks = 0; ks < 4; ks++) {
            const int key = kb * 32 + l32, chunk = c * 8 + ks * 2 + g;
            kf[kb * 4 + ks] = *(const bf16x8*)(st + key * 256 + ((chunk ^ (key & 15)) << 4));
          }
      };
      auto qk = [&](int c) {
        f32x16 zero;
#pragma unroll
        for (int r = 0; r < 16; r++) zero[r] = 0.f;
#pragma unroll
        for (int kb = 0; kb < 2; kb++) {
          S[0][kb] = MFMA(kf[kb * 4], qreg[c][0], zero);
#pragma unroll
          for (int ks = 1; ks < 4; ks++) S[0][kb] = MFMA(kf[kb * 4 + ks], qreg[c][ks], S[0][kb]);
        }
      };
      auto loadv = [&](int bi) {
#pragma unroll
        for (int dt = 0; dt < 4; dt++) {
          const int d = dt * 32 + l32, chunk = bi * 2 + g;
          vf[bi & 1][dt] = *(const bf16x8*)(st + 16384 + d * 128 + ((chunk ^ ((d >> 1) & 7)) << 4));
        }
      };
      auto softmax = [&](int c) {
        float mx = S[0][0][0];
#pragma unroll
        for (int r = 1; r < 16; r++) mx = fmaxf(mx, S[0][0][r]);
#pragma unroll
        for (int r = 0; r < 16; r++) mx = fmaxf(mx, S[0][1][r]);
        {
          const unsigned mu = __float_as_uint(mx);
          auto sw = __builtin_amdgcn_permlane32_swap(mu, mu, false, false);
          mx = fmaxf(__uint_as_float(sw[0]), __uint_as_float(sw[1]));
        }
        const float mcand = fmaxf(mrun[c], mx * c1);
        if (__any(mcand - mrun[c] > 8.f)) {
          const float alpha = fast_exp2(mrun[c] - mcand);
          mrun[c] = mcand;
          lrun[c] *= alpha;
#pragma unroll
          for (int dt = 0; dt < 4; dt++)
#pragma unroll
            for (int r = 0; r < 16; r++) O[c][dt][r] *= alpha;
        }
        const float mref = mrun[c];
        const f2_t c1v = {c1, c1}, mrv = {-mref, -mref};
        f2_t psum2 = {0.f, 0.f};
#pragma unroll
        for (int kb = 0; kb < 2; kb++)
#pragma unroll
          for (int r = 0; r < 16; r += 2) {
            f2_t sv = {S[0][kb][r], S[0][kb][r + 1]};
            f2_t av = __builtin_elementwise_fma(sv, c1v, mrv);
            f2_t ev = {fast_exp2(av[0]), fast_exp2(av[1])};
            S[0][kb][r] = ev[0]; S[0][kb][r + 1] = ev[1];
            psum2 += ev;
          }
        lrun[c] += psum2[0] + psum2[1];
#pragma unroll
        for (int kb = 0; kb < 2; kb++)
#pragma unroll
          for (int m = 0; m < 2; m++) {
            u32x4 pk = {pack_bf2(S[0][kb][8 * m + 0], S[0][kb][8 * m + 1]), pack_bf2(S[0][kb][8 * m + 2], S[0][kb][8 * m + 3]),
                        pack_bf2(S[0][kb][8 * m + 4], S[0][kb][8 * m + 5]), pack_bf2(S[0][kb][8 * m + 6], S[0][kb][8 * m + 7])};
            pf[c][kb][m] = __builtin_bit_cast(bf16x8, pk);
          }
      };
      loadkq(0);
      __builtin_amdgcn_sched_barrier(0);
      qk(0);
      __builtin_amdgcn_sched_barrier(0);
      loadkq(1);
      __builtin_amdgcn_sched_barrier(0);
      softmax(0);
      __builtin_amdgcn_sched_barrier(0);
      qk(1);
      loadv(0);
      __builtin_amdgcn_sched_barrier(0);
      softmax(1);
      __builtin_amdgcn_sched_barrier(0);
#pragma unroll
      for (int bi = 0; bi < 4; bi++) {
        if (bi < 3) loadv(bi + 1);
#pragma unroll
        for (int dt = 0; dt < 4; dt++) {
          O[0][dt] = MFMA(vf[bi & 1][dt], pf[0][bi >> 1][bi & 1], O[0][dt]);
          O[1][dt] = MFMA(vf[bi & 1][dt], pf[1][bi >> 1][bi & 1], O[1][dt]);
        }
        __builtin_amdgcn_sched_barrier(0);
      }
    }
    if (kt + 1 < NT) lwrite((kt + 1) & 1);
    __syncthreads();
  }

  const float l1 = lrun[0] + __shfl_xor(lrun[0], 32);
  const float l2 = lrun[1] + __shfl_xor(lrun[1], 32);
  const float i1 = 1.f / l1, i2 = lam / l2;
  float ssq = 0.f;
#pragma unroll
  for (int dt = 0; dt < 4; dt++)
#pragma unroll
    for (int r = 0; r < 16; r++) {
      float o = O[0][dt][r] * i1 - O[1][dt][r] * i2;
      O[0][dt][r] = o;
      ssq += o * o;
    }
  ssq += __shfl_xor(ssq, 32);
  const float rstd = rsqrtf(ssq * (1.f / 128.f) + EPS) * outscale;
  const float* gsub = p->subln + layer * 128;
#pragma unroll
  for (int dt = 0; dt < 4; dt++)
#pragma unroll
    for (int rq = 0; rq < 4; rq++) {
      const int d0 = dt * 32 + rq * 8 + g * 4;
      float4 gg = *(const float4*)(gsub + d0);
      u32x2 pk = {pack_bf2(O[0][dt][rq * 4 + 0] * rstd * gg.x, O[0][dt][rq * 4 + 1] * rstd * gg.y),
                  pack_bf2(O[0][dt][rq * 4 + 2] * rstd * gg.z, O[0][dt][rq * 4 + 3] * rstd * gg.w)};
      *(u32x2*)(p->att + (size_t)tok_q * 512 + h * 128 + d0) = pk;
    }
}

DI void s5_store_u(const u32x4 a, const u32x4 bq, int lane, float* ul) {
  float4* d = (float4*)(ul + lane * 16);
  d[0] = make_float4(__uint_as_float(a[0] << 16), __uint_as_float(a[0] & 0xffff0000u), __uint_as_float(a[1] << 16), __uint_as_float(a[1] & 0xffff0000u));
  d[1] = make_float4(__uint_as_float(a[2] << 16), __uint_as_float(a[2] & 0xffff0000u), __uint_as_float(a[3] << 16), __uint_as_float(a[3] & 0xffff0000u));
  d[2] = make_float4(__uint_as_float(bq[0] << 16), __uint_as_float(bq[0] & 0xffff0000u), __uint_as_float(bq[1] << 16), __uint_as_float(bq[1] & 0xffff0000u));
  d[3] = make_float4(__uint_as_float(bq[2] << 16), __uint_as_float(bq[2] & 0xffff0000u), __uint_as_float(bq[3] << 16), __uint_as_float(bq[3] & 0xffff0000u));
}
DI void s5_load_u(KP p, int b, int g, int j, int lane, float* ul) {
  const u32x4* src = (const u32x4*)(p->u + (size_t)(b * SEQL + j * 64 + lane) * 512 + g * 16);
  const u32x4 a = src[0], bq = src[1];
  s5_store_u(a, bq, lane, ul);
}

DI float swap_half(float v, const int which) {
  const unsigned u = __float_as_uint(v);
  auto r = __builtin_amdgcn_permlane32_swap(u, u, false, false);
  return __uint_as_float(which ? r[1] : r[0]);
}

struct S5Coef { float arA, aiA, arB, aiB; };

template <bool STORE>
DI void s5_scan32(const float* ul_sub, const bf16x8 (&bfr)[4], const S5Coef& cf, float& xAr, float& xAi, float& xBr, float& xBi,
                  float* X, const int l32, const int grp) {
  bf16x8 af;
  {
    const float* us = ul_sub + l32 * 16 + grp * 8;
    float4 a = *(const float4*)us, bq = *(const float4*)(us + 4);
    u32x4 pk = {pack_bf2(a.x, a.y), pack_bf2(a.z, a.w), pack_bf2(bq.x, bq.y), pack_bf2(bq.z, bq.w)};
    af = __builtin_bit_cast(bf16x8, pk);
  }
  f32x16 zero;
#pragma unroll
  for (int r = 0; r < 16; r++) zero[r] = 0.f;
  const f32x16 bu0 = MFMA(af, bfr[0], zero), bu1 = MFMA(af, bfr[1], zero), bu2 = MFMA(af, bfr[2], zero), bu3 = MFMA(af, bfr[3], zero);
#pragma unroll
  for (int k = 0; k < 8; k++) {
    float sAr[4], sAi[4], sBr[4], sBi[4];
#pragma unroll
    for (int i = 0; i < 4; i++) {
      const int r = (k >> 1) * 4 + i;
      const float nAr = cf.arA * xAr - cf.aiA * xAi + bu0[r];
      const float nAi = cf.arA * xAi + cf.aiA * xAr + bu2[r];
      const float nBr = cf.arB * xBr - cf.aiB * xBi + bu1[r];
      const float nBi = cf.arB * xBi + cf.aiB * xBr + bu3[r];
      xAr = nAr; xAi = nAi; xBr = nBr; xBi = nBi;
      sAr[i] = nAr; sAi[i] = nAi; sBr[i] = nBr; sBi[i] = nBi;
    }
    if (STORE) {
      if (grp == (k & 1)) {
#pragma unroll
        for (int i = 0; i < 4; i++) {
          float* xr = X + (4 * k + i) * 132;
          xr[l32] = sAr[i]; xr[64 + l32] = sAi[i]; xr[32 + l32] = sBr[i]; xr[96 + l32] = sBi[i];
        }
      }
    }
    xAr = swap_half(xAr, k & 1); xAi = swap_half(xAi, k & 1);
    xBr = swap_half(xBr, k & 1); xBi = swap_half(xBi, k & 1);
  }
}

DI void s5_setup(KP p, int layer, int g, int l32, int grp, S5Coef& cf, bf16x8 (&bfr)[4]) {
  const float* t0 = p->s5tab + (size_t)((layer * 32 + g) * 64) * 40;
  cf.arA = t0[l32 * 40]; cf.aiA = t0[l32 * 40 + 1];
  cf.arB = t0[(32 + l32) * 40]; cf.aiB = t0[(32 + l32) * 40 + 1];
#pragma unroll
  for (int jt = 0; jt < 4; jt++) {
    const float* src = t0 + (l32 + 32 * (jt & 1)) * 40 + 4 + (jt >> 1) * 16 + grp * 8;
    float4 a = *(const float4*)src, bq = *(const float4*)(src + 4);
    u32x4 pk = {pack_bf2(a.x, a.y), pack_bf2(a.z, a.w), pack_bf2(bq.x, bq.y), pack_bf2(bq.z, bq.w)};
    bfr[jt] = __builtin_bit_cast(bf16x8, pk);
  }
}

__device__ __forceinline__ void s5_pass1(KP p, int layer, char* smem, const int tid) {
  const int lane = tid & 63, w = tid >> 6, l32 = lane & 31, grp = lane >> 5;
  float* ul = (float*)(smem + w * 4096);
  for (int wbase = blockIdx.x * 4; wbase < 1024; wbase += gridDim.x * 4) {
    const int wi = wbase + w;
    const int j0 = (wi & 15) * 8, g = (wi >> 4) & 31, b = wi >> 9;
    S5Coef cf; bf16x8 bfr[4];
    s5_setup(p, layer, g, l32, grp, cf, bfr);
    const u32x4* src = (const u32x4*)(p->u + (size_t)(b * SEQL + j0 * 64 + lane) * 512 + g * 16);
    u32x4 v0 = src[0], v1 = src[1];
    for (int jj = 0; jj < 8; jj++) {
      const int j = j0 + jj;
      s5_store_u(v0, v1, lane, ul);
      if (jj < 7) {
        const u32x4* nsrc = (const u32x4*)(p->u + (size_t)(b * SEQL + (j + 1) * 64 + lane) * 512 + g * 16);
        v0 = nsrc[0]; v1 = nsrc[1];
      }
      __syncthreads();
      float xAr = 0.f, xAi = 0.f, xBr = 0.f, xBi = 0.f;
      s5_scan32<false>(ul, bfr, cf, xAr, xAi, xBr, xBi, nullptr, l32, grp);
      s5_scan32<false>(ul + 32 * 16, bfr, cf, xAr, xAi, xBr, xBi, nullptr, l32, grp);
      float* so = p->sloc + (size_t)((b * 32 + g) * 128 + j) * 128;
      so[lane] = grp ? xBr : xAr; so[64 + lane] = grp ? xBi : xAi;
      __syncthreads();
    }
  }
}

__device__ __forceinline__ void s5_pass2(KP p, int layer, char* smem, const int tid) {
  const int lane = tid & 63, w = tid >> 6;
  float* ul = (float*)(smem + w * 21504);
  float* X = ul + 1024;
  const int l32 = lane & 31, grp = lane >> 5;
  for (int wbase = blockIdx.x * 4; wbase < 1024; wbase += gridDim.x * 4) {
   const int wi = wbase + w;
   const int j0 = (wi & 15) * 8, g = (wi >> 4) & 31, b = wi >> 9;
   S5Coef cf; bf16x8 bfr[4];
   s5_setup(p, layer, g, l32, grp, cf, bfr);
   bf16x8 cfr[8];
   {
     const int c = l32 & 15;
     const float* cr = p->c_re + (size_t)((layer * 32 + g) * 16 + c) * 64;
     const float* ci = p->c_im + (size_t)((layer * 32 + g) * 16 + c) * 64;
#pragma unroll
     for (int s8 = 0; s8 < 8; s8++) {
       const int k0 = (s8 & 3) * 16 + grp * 8;
       const float* src = (s8 < 4) ? (cr + k0) : (ci + k0);
       const float sg = (l32 < 16) ? ((s8 < 4) ? 1.f : -1.f) : 0.f;
       float4 a = *(const float4*)src, bq = *(const float4*)(src + 4);
       u32x4 pk = {pack_bf2(a.x * sg, a.y * sg), pack_bf2(a.z * sg, a.w * sg), pack_bf2(bq.x * sg, bq.y * sg), pack_bf2(bq.z * sg, bq.w * sg)};
       cfr[s8] = __builtin_bit_cast(bf16x8, pk);
     }
   }
   const float dd = p->ssm_d[(size_t)(layer * 32 + g) * 16 + (l32 & 15)];
   float xAr, xAi, xBr, xBi;
   {
     const float* tb = p->s5tab + (size_t)((layer * 32 + g) * 64 + lane) * 40;
     const float aTr = tb[2], aTi = tb[3];
     float xr = 0.f, xi = 0.f;
     const float* sl = p->sloc + (size_t)((b * 32 + g) * 128) * 128;
     for (int i0 = 0; i0 < j0; i0 += 8) {
       float sr[8], si[8];
#pragma unroll
       for (int q = 0; q < 8; q++) { sr[q] = sl[(i0 + q) * 128 + lane]; si[q] = sl[(i0 + q) * 128 + 64 + lane]; }
#pragma unroll
       for (int q = 0; q < 8; q++) {
         const float nr = aTr * xr - aTi * xi + sr[q];
         const float ni = aTr * xi + aTi * xr + si[q];
         xr = nr; xi = ni;
       }
     }
     xAr = swap_half(xr, 0); xBr = swap_half(xr, 1);
     xAi = swap_half(xi, 0); xBi = swap_half(xi, 1);
   }
   for (int jj = 0; jj < 8; jj++) {
    const int j = j0 + jj;
    s5_load_u(p, b, g, j, lane, ul);
    __syncthreads();
    for (int sub = 0; sub < 2; sub++) {
      s5_scan32<true>(ul + sub * 32 * 16, bfr, cf, xAr, xAi, xBr, xBi, X, l32, grp);
      __syncthreads();
      f32x16 yacc;
#pragma unroll
      for (int r = 0; r < 16; r++) yacc[r] = 0.f;
#pragma unroll
      for (int s8 = 0; s8 < 8; s8++) {
        const float* xs = X + l32 * 132 + ((s8 < 4) ? 0 : 64) + (s8 & 3) * 16 + grp * 8;
        float4 a = *(const float4*)xs, bq = *(const float4*)(xs + 4);
        u32x4 pk = {pack_bf2(a.x, a.y), pack_bf2(a.z, a.w), pack_bf2(bq.x, bq.y), pack_bf2(bq.z, bq.w)};
        yacc = MFMA(__builtin_bit_cast(bf16x8, pk), cfr[s8], yacc);
      }
      if (l32 < 16) {
#pragma unroll
        for (int r = 0; r < 16; r++) {
          const int tl = sub * 32 + (r >> 2) * 8 + grp * 4 + (r & 3);
          const float yv = yacc[r] + dd * ul[tl * 16 + l32];
          p->gy[(size_t)(b * SEQL + j * 64 + tl) * 512 + g * 16 + l32] = f2bf(gelu_tanh(yv));
        }
      }
      __syncthreads();
    }
   }
  }
}

__device__ __forceinline__ void phase_attn(KP p, int layer, char* smem, const int tid) {
  const int lane = tid & 63;
  const float s1 = wave_sum(p->lq1[layer * 64 + lane] * p->lk1[layer * 64 + lane]);
  const float s2 = wave_sum(p->lq2[layer * 64 + lane] * p->lk2[layer * 64 + lane]);
  const float lam_init = 0.8f - 0.6f * expf(-0.3f * (float)layer);
  const float lam = expf(s1) - expf(s2) + lam_init;
  for (int pb = blockIdx.x; pb < 256; pb += gridDim.x) {
    const int pi = (pb & 7) * 32 + (pb >> 3);
    const int b = pi >> 7, h = (pi >> 5) & 3, i = pi & 31;
    attn_item(p, layer, b, h, 63 - i, lam, 1.f - lam_init, smem, tid);
    attn_item(p, layer, b, h, i, lam, 1.f - lam_init, smem, tid);
  }
  s5_pass1(p, layer, smem, tid);
}

__device__ __forceinline__ void phase_final(KP p, const int tid) {
  const int wave = tid >> 6, lane = tid & 63;
  const float* ssq = p->ss + (size_t)8 * 8 * NTOK;
  for (int row = blockIdx.x * 4 + wave; row < NTOK; row += gridDim.x * 4) {
    const float rstd = rsqrtf(ss_sum1(ssq, row) * (1.f / 1024.f) + EPS);
#pragma unroll
    for (int i = 0; i < 4; i++) {
      const u32x2 xv = ((const u32x2*)(p->xb + (size_t)row * DM))[lane + 64 * i];
      float4 v = {__uint_as_float(xv[0] << 16), __uint_as_float(xv[0] & 0xffff0000u), __uint_as_float(xv[1] << 16), __uint_as_float(xv[1] & 0xffff0000u)};
      float4 gq = ((const float4*)p->norm_final)[lane + 64 * i];
      float4 o = {v.x * rstd * gq.x, v.y * rstd * gq.y, v.z * rstd * gq.z, v.w * rstd * gq.w};
      ((float4*)(p->out + (size_t)row * DM))[lane + 64 * i] = o;
    }
  }
}

__device__ __forceinline__ void run_phase(KP p, int ph, char* smem) {
  const int tid = opaque_tid();
  if (ph == 0) { phase_prep(p, smem, tid); return; }
  if (ph == 29) { phase_final(p, tid); return; }
  const int layer = (ph - 1) / 7, k = (ph - 1) % 7;
  const int nb = gridDim.x, bid = blockIdx.x;
  if (k == 1) { phase_attn(p, layer, smem, tid); return; }
  if (k == 2) { s5_pass2(p, layer, smem, tid); return; }
  if (k == 0) { for (int r = 0; ; r++) { const int t = (r * 8 + (bid & 7)) * (nb >> 3) + (bid >> 3); if (r * nb >= 512) break; if (t < 512) gemm_tile(p, G_IN, layer, t, smem, tid); } }
  else if (k == 3) { for (int r = 0; ; r++) { const int t = (r * 8 + (bid & 7)) * (nb >> 3) + (bid >> 3); if (r * nb >= 256) break; if (t < 256) gemm_tile(p, G_GLU, layer, t, smem, tid); } }
  else if (k == 4) { for (int r = 0; ; r++) { const int t = (r * 8 + (bid & 7)) * (nb >> 3) + (bid >> 3); if (r * nb >= 256) break; if (t < 256) gemm_tile(p, G_WOUT, layer, t, smem, tid); } }
  else if (k == 5) { for (int r = 0; ; r++) { const int t = (r * 8 + (bid & 7)) * (nb >> 3) + (bid >> 3); if (r * nb >= 2 * 33 * 22) break; if (t < 2 * 33 * 22) gemm_tile(p, G_UP, layer, t, smem, tid); } }
  else { for (int r = 0; ; r++) { const int t = (r * 8 + (bid & 7)) * (nb >> 3) + (bid >> 3); if (r * nb >= 256) break; if (t < 256) gemm_tile(p, G_DOWN, layer, t, smem, tid); } }
}

#define PHASE_KERNEL(name, body)                                                      \
  __global__ void __launch_bounds__(256) name(Params p_unused) {                      \
    extern __shared__ __attribute__((aligned(16))) char smem[];                       \
    KP p = (KP)__builtin_amdgcn_kernarg_segment_ptr();                                \
    const int tid = threadIdx.x, nb = gridDim.x, bid = blockIdx.x;                    \
    const int layer = (int)p->phase_lo;                                               \
    (void)nb; (void)bid; (void)layer;                                                 \
    body                                                                              \
  }
PHASE_KERNEL(k_prep, phase_prep(p, smem, tid);)
PHASE_KERNEL(k_gin, for (int r = 0; ; r++) { const int t = (r * 8 + (bid & 7)) * (nb >> 3) + (bid >> 3); if (r * nb >= 512) break; if (t < 512) gemm_tile(p, G_IN, layer, t, smem, tid); })
PHASE_KERNEL(k_attn, phase_attn(p, layer, smem, tid);)
PHASE_KERNEL(k_s5p2, s5_pass2(p, layer, smem, tid);)
PHASE_KERNEL(k_glu, for (int r = 0; ; r++) { const int t = (r * 8 + (bid & 7)) * (nb >> 3) + (bid >> 3); if (r * nb >= 256) break; if (t < 256) gemm_tile(p, G_GLU, layer, t, smem, tid); })
PHASE_KERNEL(k_wout, for (int r = 0; ; r++) { const int t = (r * 8 + (bid & 7)) * (nb >> 3) + (bid >> 3); if (r * nb >= 256) break; if (t < 256) gemm_tile(p, G_WOUT, layer, t, smem, tid); })
PHASE_KERNEL(k_up, for (int r = 0; ; r++) { const int t = (r * 8 + (bid & 7)) * (nb >> 3) + (bid >> 3); if (r * nb >= 2 * 33 * 22) break; if (t < 2 * 33 * 22) gemm_tile(p, G_UP, layer, t, smem, tid); })
PHASE_KERNEL(k_down, for (int r = 0; ; r++) { const int t = (r * 8 + (bid & 7)) * (nb >> 3) + (bid >> 3); if (r * nb >= 256) break; if (t < 256) gemm_tile(p, G_DOWN, layer, t, smem, tid); })
PHASE_KERNEL(k_final, phase_final(p, tid);)

#if COOP
__global__ void __launch_bounds__(256) mega_kernel(Params p_unused) {
  extern __shared__ __attribute__((aligned(16))) char smem[];
  KP p0 = (KP)__builtin_amdgcn_kernarg_segment_ptr();
  const int ph_lo = (int)p0->phase_lo, ph_hi = (int)p0->phase_hi;
#if COOP
  if (ph_hi > 1000) cg::this_grid().sync();
#endif
#if COOP
  {
    volatile unsigned* st = (volatile unsigned*)(smem + 136192);
    if (threadIdx.x == 0) { st[0] = 0u; st[1] = 0u; xb_add(&p0->bar[XB_CNT(xb_xcc_id())], 1u); }
  }
#endif
  for (int ph = ph_lo; ph < ph_hi; ph++) {
    KP p = p0;
    asm volatile("" : "+s"(p));
#if TPROBE
    if (blockIdx.x == 0) p->ts[ph] = (long long)wall_clock64();
#endif
    run_phase(p, ph, smem);
#if COOP
    if (ph + 1 < ph_hi) {
      if (ph == ph_lo) grid_barrier(p->bar, gridDim.x, opaque_tid());
      else xcd_barrier(p->bar, (volatile unsigned*)(smem + 136192), opaque_tid());
    }
#endif
  }
#if TPROBE
  grid_barrier(p0->bar, (unsigned)(ph_hi - ph_lo) * gridDim.x, opaque_tid());
  if (blockIdx.x == 0) {
    KP p = p0;
    long long tend = (long long)wall_clock64();
    float a = 0.f, b = 0.f;
    for (int ph = 0; ph < 30; ph++) {
      long long t0 = p->ts[ph], t1 = (ph == 29) ? tend : p->ts[ph + 1];
      int c = (ph == 0) ? 0 : (ph == 29 ? 8 : 1 + (ph - 1) % 7);
      float d = (float)(t1 - t0) * 0.01f;
      if (c == TP_A || TP_A == 9) a += d;
      if (c == TP_B || TP_B == 9) b += d;
    }
    const int t = opaque_tid();
    if (t <= 100) p->out[t] += (t == 0) ? a : b;
  }
#endif
}

#endif

extern "C" void kernel_launch(void* const* d_in, const int* in_sizes, int n_in, void* d_out, int out_size, void* d_ws,
                              size_t ws_size, hipStream_t stream) {
  static int grid_blocks = 0;
  if (!grid_blocks) {
    int dev = 0, cus = 0, per_cu = 0;
    (void)hipGetDevice(&dev);
    (void)hipDeviceGetAttribute(&cus, hipDeviceAttributeMultiprocessorCount, dev);
#if COOP
    (void)hipFuncSetAttribute((const void*)mega_kernel, hipFuncAttributeMaxDynamicSharedMemorySize, LDS_BYTES);
    (void)hipOccupancyMaxActiveBlocksPerMultiprocessor(&per_cu, (const void*)mega_kernel, 256, LDS_BYTES);
    if (per_cu < 1) { fprintf(stderr, "occupancy query returned %d\n", per_cu); per_cu = 1; }
#endif
    grid_blocks = cus;
    (void)hipGetLastError();
  }
  Params p{};
  p.x = (const float*)d_in[0]; p.pos = (const int*)d_in[1];
  p.norm_mix = (const float*)d_in[2]; p.w_in = (const float*)d_in[3];
  p.lam_re = (const float*)d_in[4]; p.lam_im = (const float*)d_in[5]; p.log_step = (const float*)d_in[6];
  p.b_re = (const float*)d_in[7]; p.b_im = (const float*)d_in[8]; p.c_re = (const float*)d_in[9]; p.c_im = (const float*)d_in[10];
  p.ssm_d = (const float*)d_in[11]; p.w_glu = (const float*)d_in[12]; p.ssm_norm = (const float*)d_in[13];
  p.lq1 = (const float*)d_in[14]; p.lk1 = (const float*)d_in[15]; p.lq2 = (const float*)d_in[16]; p.lk2 = (const float*)d_in[17];
  p.subln = (const float*)d_in[18]; p.w_out = (const float*)d_in[19]; p.norm_ffn = (const float*)d_in[20];
  p.w_up = (const float*)d_in[21]; p.w_conv = (const float*)d_in[22]; p.b_conv = (const float*)d_in[23];
  p.w_down = (const float*)d_in[24]; p.norm_final = (const float*)d_in[25];
  p.out = (float*)d_out;
  char* ws = (char*)d_ws;
  size_t off = 0;
  auto take = [&](size_t bytes) { char* r = ws + off; off += (bytes + 255) & ~(size_t)255; return r; };
  p.WinT = (bf16_t*)take((size_t)4 * 2048 * 1024 * 2);
  p.WgluT = (bf16_t*)take((size_t)4 * 1024 * 512 * 2);
  p.WoutT = (bf16_t*)take((size_t)4 * 1024 * 1024 * 2);
  p.WupT = (bf16_t*)take((size_t)4 * 5632 * 1024 * 2);
  p.WdownT = (bf16_t*)take((size_t)4 * 1024 * FFN * 2);
  p.xf = (float*)take((size_t)NTOK * DM * 4);
  p.xb = (bf16_t*)take((size_t)NTOK * DM * 2);
  p.ss = (float*)take((size_t)9 * 8 * NTOK * 4);
  p.ssm_ss = (float*)take((size_t)4 * 8 * NTOK * 4);
  p.cs = (float*)take((size_t)NTOK * 16 * 4);
  p.s5tab = (float*)take((size_t)4 * 32 * 64 * 40 * 4);
  p.sloc = (float*)take((size_t)2 * 32 * 128 * 128 * 4);
  p.ts = (long long*)take(256);
  p.bar = (unsigned*)take(XB_WORDS * 4);
  char* region = take((size_t)134217728);
  p.u = (bf16_t*)region;
  p.q = (bf16_t*)(region + 33554432);
  p.k = p.q + (size_t)NTOK * 512;
  p.vt = p.k + (size_t)NTOK * 512;
  p.gy = p.vt + (size_t)NTOK * 512;
  p.outg = p.gy + (size_t)NTOK * 512;
  p.att = p.outg + (size_t)NTOK * 512;
  p.act = (bf16_t*)region;
  if (off > ws_size) { fprintf(stderr, "workspace too small: need %zu have %zu\n", off, ws_size); return; }
#if COOP
  p.phase_lo = 0; p.phase_hi = 30;
  if (hipMemsetAsync(p.bar, 0, XB_WORDS * 4, stream) != hipSuccess) fprintf(stderr, "barrier memset failed\n");
  void* args[] = {&p};
  hipError_t e = hipLaunchCooperativeKernel((const void*)mega_kernel, dim3(grid_blocks), dim3(256), args, LDS_BYTES, stream);
  if (e != hipSuccess) fprintf(stderr, "cooperative launch failed: %s (grid %d)\n", hipGetErrorString(e), grid_blocks);
#else
  typedef void (*kfn)(Params);
  const kfn seq[7] = {k_gin, k_attn, k_s5p2, k_glu, k_wout, k_up, k_down};
  static bool attr_done = false;
  if (!attr_done) {
    (void)hipFuncSetAttribute((const void*)k_prep, hipFuncAttributeMaxDynamicSharedMemorySize, LDS_BYTES);
    (void)hipFuncSetAttribute((const void*)k_final, hipFuncAttributeMaxDynamicSharedMemorySize, LDS_BYTES);
    for (int i = 0; i < 7; i++) (void)hipFuncSetAttribute((const void*)seq[i], hipFuncAttributeMaxDynamicSharedMemorySize, LDS_BYTES);
    attr_done = true;
  }
  p.phase_lo = 0; p.phase_hi = 0;
  hipLaunchKernelGGL(k_prep, dim3(grid_blocks), dim3(256), LDS_BYTES, stream, p);
  for (int layer = 0; layer < 4; layer++) {
    p.phase_lo = layer;
    for (int i = 0; i < 7; i++) hipLaunchKernelGGL(seq[i], dim3(grid_blocks), dim3(256), LDS_BYTES, stream, p);
  }
  hipLaunchKernelGGL(k_final, dim3(grid_blocks), dim3(256), LDS_BYTES, stream, p);
#endif
}
```

```cpp
#include <hip/hip_runtime.h>
#include <hip/hip_cooperative_groups.h>
#include <cstdio>
namespace cg = cooperative_groups;

#ifndef COOP
#define COOP 1
#endif
#ifndef TPROBE
#define TPROBE 0
#endif
#ifndef TP_A
#define TP_A 1
#endif
#ifndef TP_B
#define TP_B 2
#endif

typedef unsigned short bf16_t;
typedef __attribute__((ext_vector_type(8))) short bf16x8;
typedef __attribute__((ext_vector_type(16))) float f32x16;
typedef __attribute__((ext_vector_type(2))) __bf16 bf2_t;
typedef __attribute__((ext_vector_type(2))) float f2_t;
typedef __attribute__((ext_vector_type(4))) unsigned u32x4;
typedef __attribute__((ext_vector_type(2))) unsigned u32x2;

#define DI __device__ __forceinline__
#define MFMA(a, b, c) __builtin_amdgcn_mfma_f32_32x32x16_bf16((a), (b), (c), 0, 0, 0)

constexpr int NTOK = 16384, DM = 1024, SEQL = 8192, FFN = 2816;
constexpr int LDS_BYTES = 136208;
constexpr float EPS = 1e-6f;

struct Params {
  const float* x; const int* pos;
  const float *norm_mix, *w_in, *lam_re, *lam_im, *log_step, *b_re, *b_im, *c_re, *c_im, *ssm_d, *w_glu, *ssm_norm;
  const float *lq1, *lk1, *lq2, *lk2, *subln, *w_out, *norm_ffn, *w_up, *w_conv, *b_conv, *w_down, *norm_final;
  float* out;
  bf16_t *WinT, *WgluT, *WoutT, *WupT, *WdownT;
  float* xf; bf16_t* xb;
  bf16_t *u, *q, *k, *vt, *gy, *outg, *att, *act;
  float *ss, *ssm_ss, *cs, *s5tab, *sloc;
  long long phase_lo, phase_hi;
  long long* ts;
  unsigned* bar;
};

typedef const __attribute__((address_space(4))) Params* KP;

DI unsigned pack_bf2(float a, float b) { f2_t v = {a, b}; return __builtin_bit_cast(unsigned, __builtin_convertvector(v, bf2_t)); }
DI bf16_t f2bf(float a) { return (bf16_t)(pack_bf2(a, 0.f) & 0xffffu); }
DI float bf2f(bf16_t v) { return __uint_as_float(((unsigned)v) << 16); }
DI void grid_barrier(unsigned* ctr, unsigned target, int tid) {
  asm volatile("s_waitcnt vmcnt(0)" ::: "memory");
  __syncthreads();
  if (tid == 0) {
    __builtin_amdgcn_fence(__ATOMIC_RELEASE, "agent");
    asm volatile("s_waitcnt vmcnt(0)" ::: "memory");
    __hip_atomic_fetch_add(ctr, 1u, __ATOMIC_RELAXED, __HIP_MEMORY_SCOPE_AGENT);
    while (__hip_atomic_load(ctr, __ATOMIC_RELAXED, __HIP_MEMORY_SCOPE_AGENT) < target) __builtin_amdgcn_s_sleep(1);
    __builtin_amdgcn_fence(__ATOMIC_ACQUIRE, "agent");
    asm volatile("s_waitcnt vmcnt(0)" ::: "memory");
  }
  __syncthreads();
}
#define XB_CNT(j)  (64 + 64 * (j))
#define XB_SUB(j)  (1088 + 64 * (j))
#define XB_GEN(j)  (2112 + 64 * (j))
#define XB_TOP     3136
#define XB_TOPGEN  3200
#define XB_WORDS   3264
DI unsigned xb_ld(unsigned* q) { return __hip_atomic_load(q, __ATOMIC_RELAXED, __HIP_MEMORY_SCOPE_AGENT); }
DI unsigned xb_add(unsigned* q, unsigned v) { return __hip_atomic_fetch_add(q, v, __ATOMIC_RELAXED, __HIP_MEMORY_SCOPE_AGENT); }
DI unsigned xb_xcc_id() { return (unsigned)__builtin_amdgcn_s_getreg((3 << 11) | 20) & 0xFu; }
DI void xcd_barrier(unsigned* bar, volatile unsigned* st, int tid) {
  asm volatile("s_waitcnt vmcnt(0)" ::: "memory");
  __syncthreads();
  if (tid == 0) {
    const unsigned x = xb_xcc_id();
    unsigned nloc = st[0], nx = st[1];
    if (nloc == 0u) {
      unsigned cnt = 0u, mine = 1u;
#pragma unroll
      for (unsigned j = 0; j < 16; ++j) { const unsigned c = xb_ld(&bar[XB_CNT(j)]); cnt += (c > 0u) ? 1u : 0u; mine = (j == x) ? c : mine; }
      nloc = mine > 0u ? mine : 1u; nx = cnt > 0u ? cnt : 1u;
      st[0] = nloc; st[1] = nx;
    }
    const unsigned old = xb_add(&bar[XB_SUB(x)], 1u);
    const unsigned gen = old / nloc;
    if (old + 1u == (gen + 1u) * nloc) {
      __builtin_amdgcn_fence(__ATOMIC_RELEASE, "agent");
      asm volatile("s_waitcnt vmcnt(0)" ::: "memory");
      const unsigned og = xb_add(&bar[XB_TOP], 1u);
      const unsigned tg = og / nx;
      if (og + 1u == (tg + 1u) * nx) xb_add(&bar[XB_TOPGEN], 1u);
      else { while (xb_ld(&bar[XB_TOPGEN]) == tg) __builtin_amdgcn_s_sleep(1); }
      __builtin_amdgcn_fence(__ATOMIC_ACQUIRE, "agent");
      xb_add(&bar[XB_GEN(x)], 1u);
      asm volatile("s_waitcnt vmcnt(0)" ::: "memory");
    } else {
      while (xb_ld(&bar[XB_GEN(x)]) == gen) __builtin_amdgcn_s_sleep(1);
      __builtin_amdgcn_fence(__ATOMIC_ACQUIRE, "agent");
      asm volatile("s_waitcnt vmcnt(0)" ::: "memory");
    }
  }
  __syncthreads();
}
DI int opaque_tid() { int t = threadIdx.x; asm volatile("" : "+v"(t)); return t; }
DI float4 ss_sum4(const float* base, int row0) {
  float4 a = *(const float4*)(base + row0);
#pragma unroll
  for (int pz = 1; pz < 8; pz++) {
    float4 b = *(const float4*)(base + (size_t)pz * NTOK + row0);
    a.x += b.x; a.y += b.y; a.z += b.z; a.w += b.w;
  }
  return a;
}
DI float ss_sum1(const float* base, int row) {
  float a = base[row];
#pragma unroll
  for (int pz = 1; pz < 8; pz++) a += base[(size_t)pz * NTOK + row];
  return a;
}
DI float wave_sum(float v) { for (int o = 32; o; o >>= 1) v += __shfl_xor(v, o); return v; }
DI float fast_exp2(float x) { return __builtin_amdgcn_exp2f(x); }
DI float gelu_tanh(float x) {
  float z = 0.7978845608028654f * (x + 0.044715f * x * x * x);
  float e = __expf(2.f * z);
  float t = 1.f - 2.f / (1.f + e);
  return 0.5f * x * (1.f + t);
}
DI float reduce_2pi(double a) {
  double n = rint(a * 0.15915494309189535);
  return (float)(a - n * 6.283185307179586);
}

DI void transpose_tile(const float* src, int ldsrc, int k0, int c0, const float* scale, int nscale,
                       bf16_t* dst, int lddst, int n0, float* lds, const int tid) {
#pragma unroll
  for (int i = 0; i < 16; i++) {
    int kk = i * 4 + (tid >> 6), nn = tid & 63;
    float v = src[(size_t)(k0 + kk) * ldsrc + c0 + nn];
    if (scale != nullptr && (k0 + kk) < nscale) v *= scale[k0 + kk];
    lds[kk * 65 + nn] = v;
  }
  __syncthreads();
  {
    int nn = tid >> 2, kq = (tid & 3) * 16;
    unsigned pk[8];
#pragma unroll
    for (int i = 0; i < 8; i++) pk[i] = pack_bf2(lds[(kq + 2 * i) * 65 + nn], lds[(kq + 2 * i + 1) * 65 + nn]);
    u32x4* d = (u32x4*)(dst + (size_t)(n0 + nn) * lddst + k0 + kq);
    u32x4 a = {pk[0], pk[1], pk[2], pk[3]}, b = {pk[4], pk[5], pk[6], pk[7]};
    d[0] = a; d[1] = b;
  }
  __syncthreads();
}

DI void wtask(const float* src, int ldsrc, int k0, int c0, const float* scale, int nscale, bf16_t* dst, int lddst, int n0, int lane) {
  float v[32];
  const float* sp = src + (size_t)k0 * ldsrc + c0 + lane;
#pragma unroll
  for (int i = 0; i < 32; i++) v[i] = __builtin_nontemporal_load(sp + (size_t)i * ldsrc);
  if (k0 < nscale) {
#pragma unroll
    for (int i = 0; i < 32; i++) v[i] *= scale[k0 + i];
  }
  u32x4* d = (u32x4*)(dst + (size_t)(n0 + lane) * lddst + k0);
#pragma unroll
  for (int q = 0; q < 4; q++) {
    u32x4 o = {pack_bf2(v[8 * q], v[8 * q + 1]), pack_bf2(v[8 * q + 2], v[8 * q + 3]), pack_bf2(v[8 * q + 4], v[8 * q + 5]), pack_bf2(v[8 * q + 6], v[8 * q + 7])};
    d[q] = o;
  }
}

__device__ __forceinline__ void phase_prep(KP p, char* smem, const int tid) {
  const int nb = gridDim.x, bid = blockIdx.x;
  const int wave = tid >> 6, lane = tid & 63;
  for (int row0 = (bid * 4 + wave) * 4; row0 < NTOK; row0 += nb * 16) {
    float4 v[4][4];
#pragma unroll
    for (int rr = 0; rr < 4; rr++)
#pragma unroll
      for (int i = 0; i < 4; i++) v[rr][i] = ((const float4*)(p->x + (size_t)(row0 + rr) * DM))[lane + 64 * i];
#pragma unroll
    for (int rr = 0; rr < 4; rr++) {
      const int row = row0 + rr;
      float s = 0.f;
#pragma unroll
      for (int i = 0; i < 4; i++) {
        u32x2 pk = {pack_bf2(v[rr][i].x, v[rr][i].y), pack_bf2(v[rr][i].z, v[rr][i].w)};
        ((u32x2*)(p->xb + (size_t)row * DM))[lane + 64 * i] = pk;
        const float a0 = __uint_as_float(pk[0] << 16), a1 = __uint_as_float(pk[0] & 0xffff0000u);
        const float a2 = __uint_as_float(pk[1] << 16), a3 = __uint_as_float(pk[1] & 0xffff0000u);
        s += a0 * a0 + a1 * a1 + a2 * a2 + a3 * a3;
      }
      s = wave_sum(s);
      if (lane < 8) p->ss[(size_t)lane * NTOK + row] = (lane == 0) ? s : 0.f;
    }
  }
  for (int i = bid * 256 + tid; i < NTOK * 8; i += nb * 256) {
    int tok = i >> 3, j = i & 7;
    double inv = (j & 4) ? ((j & 2) ? ((j & 1) ? 1.031338537721246e-05 : 5.318295896944988e-05) : ((j & 1) ? 0.0002742481756762073 : 0.001414213562373095))
                         : ((j & 2) ? ((j & 1) ? 0.007292664737217109 : 0.03760603093086393) : ((j & 1) ? 0.19392274474868576 : 1.0));
    double ang = (double)p->pos[tok] * inv;
    float r = reduce_2pi(ang);
    p->cs[2 * i] = cosf(r); p->cs[2 * i + 1] = sinf(r);
  }
  for (int i = bid * 256 + tid; i < 4 * 32 * 64; i += nb * 256) {
    int lg = i >> 6;
    float lr = p->lam_re[i], li = p->lam_im[i];
    float step = expf(p->log_step[lg]);
    float mag = expf(step * lr);
    double angd = (double)step * (double)li;
    float r1 = reduce_2pi(angd);
    float ar = mag * cosf(r1), ai = mag * sinf(r1);
    float den = lr * lr + li * li;
    float fr = ((ar - 1.f) * lr + ai * li) / den;
    float fi = (ai * lr - (ar - 1.f) * li) / den;
    float magT = expf(64.f * step * lr);
    float rT = reduce_2pi(64.0 * angd);
    float* tb = p->s5tab + (size_t)i * 40;
    tb[0] = ar; tb[1] = ai; tb[2] = magT * cosf(rT); tb[3] = magT * sinf(rT);
    for (int c = 0; c < 16; c++) {
      float br = p->b_re[(size_t)i * 16 + c], bi = p->b_im[(size_t)i * 16 + c];
      tb[4 + c] = fr * br - fi * bi;
      tb[20 + c] = fr * bi + fi * br;
    }
  }
  {
    const int NTASK = 4 * 6016;
    const int gw = bid * 4 + wave, nw = nb * 4;
    const int per = (NTASK + nw - 1) / nw;
    const int t_lo = gw * per, t_hi = min(t_lo + per, NTASK);
    for (int task = t_lo; task < t_hi; task++) {
      const int layer = task / 6016;
      int t = task % 6016;
      if (t < 1024) {
        const int a = t >> 5, kb = t & 31;
        wtask(p->w_in + (size_t)layer * 1024 * 2048, 2048, kb * 32, a * 64, p->norm_mix + layer * 1024, 1024,
              p->WinT + (size_t)layer * 2048 * 1024, 1024, a * 64, lane);
      } else if (t < 1280) {
        t -= 1024; const int a = t >> 4, kb = t & 15;
        wtask(p->w_glu + (size_t)layer * 512 * 1024, 1024, kb * 32, (a & 1) * 512 + (a >> 1) * 64, p->norm_mix, 0,
              p->WgluT + (size_t)layer * 1024 * 512, 512, a * 64, lane);
      } else if (t < 1792) {
        t -= 1280; const int a = t >> 5, kb = t & 31;
        wtask(p->w_out + (size_t)layer * 1024 * 1024, 1024, kb * 32, a * 64, p->ssm_norm + layer * 512, 512,
              p->WoutT + (size_t)layer * 1024 * 1024, 1024, a * 64, lane);
      } else if (t < 4608) {
        t -= 1792; const int a = t >> 5, kb = t & 31;
        wtask(p->w_up + (size_t)layer * 1024 * 5632, 5632, kb * 32, (a & 1) * FFN + (a >> 1) * 64, p->norm_ffn + layer * 1024, 1024,
              p->WupT + (size_t)layer * 5632 * 1024, 1024, a * 64, lane);
      } else {
        t -= 4608; const int a = t / 88, kb = t % 88;
        wtask(p->w_down + (size_t)layer * FFN * 1024, 1024, kb * 32, a * 64, p->norm_mix, 0,
              p->WdownT + (size_t)layer * 1024 * FFN, FFN, a * 64, lane);
      }
    }
  }
}

enum { G_IN = 0, G_GLU = 1, G_WOUT = 2, G_UP = 3, G_DOWN = 4 };
#define ACC_PIN(tag) _Pragma("unroll") for (int i_ = 0; i_ < 4; i_++) _Pragma("unroll") for (int j_ = 0; j_ < 4; j_++) asm volatile("; pin " tag : "+a"(acc[i_][j_]));


__device__ __forceinline__ void gemm_tile(KP p, const int MODE, int layer, int tile, char* smem, const int tid) {
  const int lane = tid & 63, w = tid >> 6, wm = w >> 1, wn = w & 1, g = lane >> 5, l32 = lane & 31;
  int tn, KT, ldb, rowbase, lda;
  const bf16_t* Bt;
  const bf16_t* A0;
  int upb = 0, upti = 0;
  {
    const int TM = (MODE == G_UP) ? 66 : 64;
    const int TN = (MODE == G_IN) ? 8 : (MODE == G_UP ? 22 : 4);
    const int nfull = TN >> 2, rem = TN & 3;
    int tm;
    if (tile < nfull * 4 * TM) { const int band = tile / (4 * TM), within = tile % (4 * TM); tm = within >> 2; tn = band * 4 + (within & 3); }
    else { const int s2 = tile - nfull * 4 * TM; tm = s2 / rem; tn = nfull * 4 + s2 % rem; }
    rowbase = tm * 256;
    if (MODE == G_UP) { upb = tm / 33; upti = tm % 33; rowbase = upb * SEQL + 254 * upti - 2; }
  }
  if (MODE == G_IN) { KT = 16; ldb = 1024; Bt = p->WinT + (size_t)layer * 2048 * 1024; A0 = p->xb; lda = 1024; }
  else if (MODE == G_GLU) { KT = 8; ldb = 512; Bt = p->WgluT + (size_t)layer * 1024 * 512; A0 = p->gy; lda = 512; }
  else if (MODE == G_WOUT) { KT = 16; ldb = 1024; Bt = p->WoutT + (size_t)layer * 1024 * 1024; A0 = p->outg; lda = 512; }
  else if (MODE == G_UP) { KT = 16; ldb = 1024; Bt = p->WupT + (size_t)layer * 5632 * 1024; A0 = p->xb; lda = 1024; }
  else { KT = 44; ldb = FFN; Bt = p->WdownT + (size_t)layer * 1024 * FFN; A0 = p->act; lda = FFN; }

  u32x4 ra[8], rb[8];
  const int lrow = tid >> 3, lc = tid & 7;
  float arow_sc[8];
#pragma unroll
  for (int i = 0; i < 8; i++) arow_sc[i] = 1.f;
  if (MODE == G_WOUT) {
    const float* ssq = p->ssm_ss + (size_t)layer * 8 * NTOK;
#pragma unroll
    for (int i = 0; i < 8; i++) arow_sc[i] = rsqrtf(ss_sum1(ssq, rowbase + lrow + 32 * i) * (1.f / 512.f) + EPS);
  }
  const bf16_t* bptr = Bt + (size_t)(tn * 256 + lrow) * ldb + lc * 8;
  auto gload = [&](int kt) {
    const bf16_t* abase = A0;
    int kofs = kt * 64;
    if (MODE == G_WOUT && kt >= 8) { abase = p->att; kofs = (kt - 8) * 64; }
#pragma unroll
    for (int i = 0; i < 8; i++) {
      int gr = min(max(rowbase + lrow + 32 * i, 0), NTOK - 1);
      ra[i] = *(const u32x4*)(abase + (size_t)gr * lda + kofs + lc * 8);
      rb[i] = *(const u32x4*)(bptr + (size_t)(32 * i) * ldb + kt * 64);
    }
  };
  auto scaleA = [&](int kt) {
    if (MODE == G_WOUT && kt < 8) {
#pragma unroll
      for (int i = 0; i < 8; i++)
#pragma unroll
        for (int e = 0; e < 4; e++) {
          unsigned v = ra[i][e];
          float lo = __uint_as_float(v << 16) * arow_sc[i], hi = __uint_as_float(v & 0xffff0000u) * arow_sc[i];
          ra[i][e] = pack_bf2(lo, hi);
        }
    }
  };
  const int wr_off = lrow * 128 + ((lc ^ ((lrow >> 1) & 7)) << 4);
  auto lwriteA = [&](int st) {
    char* sa = smem + st * 65536;
#pragma unroll
    for (int i = 0; i < 8; i++) *(u32x4*)(sa + wr_off + i * 4096) = ra[i];
  };
  auto lwriteB = [&](int st) {
    char* sb = smem + st * 65536 + 32768;
#pragma unroll
    for (int i = 0; i < 8; i++) *(u32x4*)(sb + wr_off + i * 4096) = rb[i];
  };

  f32x16 acc[4][4];
#pragma unroll
  for (int i = 0; i < 4; i++)
#pragma unroll
    for (int j = 0; j < 4; j++)
#pragma unroll
      for (int r = 0; r < 16; r++) acc[i][j][r] = 0.f;

  const int swz = (l32 >> 1) & 7;
  const int a_base = (wm * 128 + l32) * 128;
  const int b_base = 32768 + (wn * 128 + l32) * 128;
  bf16x8 af[2][4], bfr[2][4];
  auto lfrag = [&](int buf, const char* st, int ks) {
    const int coff = (((ks * 2 + g) ^ swz) << 4);
#pragma unroll
    for (int i = 0; i < 4; i++) af[buf][i] = *(const bf16x8*)(st + a_base + i * 4096 + coff);
#pragma unroll
    for (int j = 0; j < 4; j++) bfr[buf][j] = *(const bf16x8*)(st + b_base + j * 4096 + coff);
  };
  auto mfma16 = [&](int buf) {
#pragma unroll
    for (int i = 0; i < 4; i++)
#pragma unroll
      for (int j = 0; j < 4; j++) acc[i][j] = MFMA(af[buf][i], bfr[buf][j], acc[i][j]);
  };

  gload(0);
  scaleA(0);
  lwriteA(0);
  lwriteB(0);
  __syncthreads();
  if (KT > 1) gload(1);
  lfrag(0, smem, 0);
  for (int kt = 0; kt < KT; kt++) {
    const char* st = smem + (kt & 1) * 65536;
    const bool has1 = (kt + 1 < KT), has2 = (kt + 2 < KT);
    lfrag(1, st, 1);
    if (has1) { scaleA(kt + 1); lwriteA((kt + 1) & 1); }
    mfma16(0);
    __builtin_amdgcn_sched_barrier(0);
    lfrag(0, st, 2);
    if (has1) lwriteB((kt + 1) & 1);
    mfma16(1);
    __builtin_amdgcn_sched_barrier(0);
    lfrag(1, st, 3);
    if (has2) gload(kt + 2);
    mfma16(0);
    __builtin_amdgcn_sched_barrier(0);
    asm volatile("s_waitcnt lgkmcnt(0)" ::: "memory");
    __builtin_amdgcn_s_barrier();
    __builtin_amdgcn_sched_barrier(0);
    if (has1) lfrag(0, smem + ((kt + 1) & 1) * 65536, 0);
    mfma16(1);
    __builtin_amdgcn_sched_barrier(0);
  }

  int tid2 = tid;
  asm volatile("" : "+v"(tid2));
  {
  const int tid = tid2;
  const int lane = tid & 63, w = tid >> 6, wm = w >> 1, wn = w & 1, g = lane >> 5, l32 = lane & 31;
  if (MODE == G_IN) {
    const int region = tn >> 1;
    float* rs = (float*)(smem + 135168);
    rs[tid] = rsqrtf(ss_sum1(p->ss + (size_t)(2 * layer) * 8 * NTOK, rowbase + tid) * (1.f / 1024.f) + EPS);
    __syncthreads();
#pragma unroll
    for (int i = 0; i < 4; i++)
#pragma unroll
      for (int rq = 0; rq < 4; rq++) {
        const int lr0 = wm * 128 + i * 32 + rq * 8 + g * 4;
        const float4 s4 = *(const float4*)(rs + lr0);
        const float sc[4] = {s4.x, s4.y, s4.z, s4.w};
#pragma unroll
        for (int j = 0; j < 4; j++) {
          const int lcol = wn * 128 + j * 32 + l32;
          float v[4];
#pragma unroll
          for (int r4 = 0; r4 < 4; r4++) v[r4] = acc[i][j][rq * 4 + r4] * sc[r4];
          if (region == 3) {
            const int q4 = (lr0 >> 2) & 3;
            const int pq = ((q4 & 1) << 1) | (q4 >> 1);
            u32x2 pk = {pack_bf2(v[0], v[1]), pack_bf2(v[2], v[3])};
            *(u32x2*)(smem + lcol * 528 + ((lr0 & ~15) + pq * 4) * 2) = pk;
          } else {
            if (region != 0 && (j & 1) == 0) {
              float other[4];
#pragma unroll
              for (int r4 = 0; r4 < 4; r4++) other[r4] = __shfl_xor(v[r4], 8);
              if (l32 < 16) {
                const float sgn = (l32 < 8) ? -1.f : 1.f;
#pragma unroll
                for (int r4 = 0; r4 < 4; r4++) {
                  const float2 csv = *(const float2*)(p->cs + ((size_t)(rowbase + lr0 + r4) * 8 + (l32 & 7)) * 2);
                  v[r4] = v[r4] * csv.x + sgn * other[r4] * csv.y;
                }
              }
            }
#pragma unroll
            for (int r4 = 0; r4 < 4; r4++) *(bf16_t*)(smem + (lr0 + r4) * 528 + lcol * 2) = f2bf(v[r4]);
          }
        }
      }
    __syncthreads();
    {
      bf16_t* dbase;
      size_t rstride;
      if (region == 3) { dbase = p->vt + (size_t)((rowbase >> 13) * 512 + (tn & 1) * 256) * SEQL + (rowbase & (SEQL - 1)); rstride = SEQL; }
      else { dbase = (region == 0 ? p->u : (region == 1 ? p->q : p->k)) + (size_t)rowbase * 512 + (tn & 1) * 256; rstride = 512; }
#pragma unroll 8
      for (int it = 0; it < 32; it++) {
        const int id = tid + 256 * it, row = id >> 5, c = id & 31;
        const u32x4 vv = *(const u32x4*)(smem + row * 528 + c * 16);
        *(u32x4*)(dbase + (size_t)row * rstride + c * 8) = vv;
      }
    }
    __syncthreads();
  } else if (MODE == G_GLU) {
#pragma unroll
    for (int i = 0; i < 4; i++)
#pragma unroll
      for (int j = 0; j < 2; j++)
#pragma unroll
        for (int r = 0; r < 16; r++) {
          const int lr = wm * 128 + i * 32 + (r >> 2) * 8 + g * 4 + (r & 3);
          const float av = acc[i][j][r], bv = acc[i][j + 2][r];
          *(bf16_t*)(smem + lr * 272 + (wn * 64 + j * 32 + l32) * 2) = f2bf(av / (1.f + __expf(-bv)));
        }
    __syncthreads();
    {
      float* ssq = p->ssm_ss + ((size_t)layer * 8 + tn * 2) * NTOK;
#pragma unroll 4
      for (int it = 0; it < 16; it++) {
        const int id = tid + 256 * it, row = id >> 4, c = id & 15;
        const u32x4 ov = *(const u32x4*)(smem + row * 272 + c * 16);
        *(u32x4*)(p->outg + (size_t)(rowbase + row) * 512 + tn * 128 + c * 8) = ov;
        float sq = 0.f;
#pragma unroll
        for (int e = 0; e < 4; e++) {
          const float lo = __uint_as_float(ov[e] << 16), hi = __uint_as_float(ov[e] & 0xffff0000u);
          sq += lo * lo + hi * hi;
        }
#pragma unroll
        for (int o = 4; o; o >>= 1) sq += __shfl_xor(sq, o);
        if ((c & 7) == 0) ssq[(size_t)(c >> 3) * NTOK + rowbase + row] = sq;
      }
    }
    __syncthreads();
  } else if (MODE == G_WOUT || MODE == G_DOWN) {
#pragma unroll
    for (int i = 0; i < 4; i++)
#pragma unroll
      for (int j = 0; j < 4; j++)
#pragma unroll
        for (int r = 0; r < 16; r++) {
          const int lr = wm * 128 + i * 32 + (r >> 2) * 8 + g * 4 + (r & 3);
          *(bf16_t*)(smem + lr * 528 + (wn * 128 + j * 32 + l32) * 2) = f2bf(acc[i][j][r]);
        }
    __syncthreads();
    {
      float* ssq = p->ss + ((size_t)(MODE == G_WOUT ? 2 * layer + 1 : 2 * layer + 2) * 8 + tn * 2) * NTOK;
#pragma unroll 4
      for (int it = 0; it < 32; it++) {
        const int id = tid + 256 * it, row = id >> 5, c = id & 31;
        const u32x4 dv = *(const u32x4*)(smem + row * 528 + c * 16);
        const size_t idx = (size_t)(rowbase + row) * 1024 + tn * 256 + c * 8;
        const u32x4 xv = *(const u32x4*)(p->xb + idx);
        u32x4 xbv;
        float sq = 0.f;
#pragma unroll
        for (int e = 0; e < 4; e++) {
          const float lo = __uint_as_float(xv[e] << 16) + __uint_as_float(dv[e] << 16);
          const float hi = __uint_as_float(xv[e] & 0xffff0000u) + __uint_as_float(dv[e] & 0xffff0000u);
          const unsigned pk = pack_bf2(lo, hi);
          xbv[e] = pk;
          const float rl = __uint_as_float(pk << 16), rh = __uint_as_float(pk & 0xffff0000u);
          sq += rl * rl + rh * rh;
        }
        *(u32x4*)(p->xb + idx) = xbv;
#pragma unroll
        for (int o = 8; o; o >>= 1) sq += __shfl_xor(sq, o);
        if ((c & 15) == 0) ssq[(size_t)(c >> 4) * NTOK + rowbase + row] = sq;
      }
    }
    __syncthreads();
  } else {
#pragma unroll
    for (int i = 0; i < 4; i++)
#pragma unroll
      for (int rq = 0; rq < 4; rq++) {
        const int lr0 = wm * 128 + i * 32 + rq * 8 + g * 4;
#pragma unroll
        for (int j = 0; j < 4; j++) {
          const int pc = wn * 128 + j * 32 + l32;
          u32x2 pk = {pack_bf2(acc[i][j][rq * 4 + 0], acc[i][j][rq * 4 + 1]), pack_bf2(acc[i][j][rq * 4 + 2], acc[i][j][rq * 4 + 3])};
          *(u32x2*)(smem + pc * 528 + lr0 * 2) = pk;
        }
      }
    {
      float* rs = (float*)(smem + 135168);
      const int tb = 254 * upti - 2 + tid;
      float sc = 0.f;
      if (tb >= 0) {
        const int gr = min(upb * SEQL + tb, NTOK - 1);
        sc = rsqrtf(ss_sum1(p->ss + (size_t)(2 * layer + 1) * 8 * NTOK, gr) * (1.f / 1024.f) + EPS);
      }
      rs[tid] = sc;
    }
    __syncthreads();
    {
      const int cp2 = tid & 63, quarter = tid >> 6;
      const int oc = 2 * cp2;
      const int pg = (oc >> 6) * 128 + (oc & 63), pv = pg + 64;
      const int ocol = tn * 128 + oc;
      const float* wc = p->w_conv + (size_t)layer * 3 * 5632;
      const float* bc = p->b_conv + (size_t)layer * 5632;
      float wg[2][3], wv[2][3], bg[2], bv[2];
#pragma unroll
      for (int q = 0; q < 2; q++) {
#pragma unroll
        for (int j = 0; j < 3; j++) { wg[q][j] = wc[j * 5632 + ocol + q]; wv[q][j] = wc[j * 5632 + FFN + ocol + q]; }
        bg[q] = bc[ocol + q]; bv[q] = bc[FFN + ocol + q];
      }
      const float* rs = (const float*)(smem + 135168);
      const char* gcol0 = smem + pg * 528;
      const char* vcol0 = smem + pv * 528;
      float g0[2] = {0.f, 0.f}, v0[2] = {0.f, 0.f}, g1[2] = {0.f, 0.f}, v1[2] = {0.f, 0.f};
      if (quarter) {
        const int ra = quarter * 64 - 2, rb2 = quarter * 64 - 1;
#pragma unroll
        for (int q = 0; q < 2; q++) {
          g0[q] = rs[ra] * bf2f(*(const bf16_t*)(gcol0 + q * 528 + ra * 2)); v0[q] = rs[ra] * bf2f(*(const bf16_t*)(vcol0 + q * 528 + ra * 2));
          g1[q] = rs[rb2] * bf2f(*(const bf16_t*)(gcol0 + q * 528 + rb2 * 2)); v1[q] = rs[rb2] * bf2f(*(const bf16_t*)(vcol0 + q * 528 + rb2 * 2));
        }
      }
      for (int grp8 = 0; grp8 < 8; grp8++) {
        const int lrb = quarter * 64 + grp8 * 8;
        u32x4 gq[2], vq[2];
#pragma unroll
        for (int q = 0; q < 2; q++) { gq[q] = *(const u32x4*)(gcol0 + q * 528 + lrb * 2); vq[q] = *(const u32x4*)(vcol0 + q * 528 + lrb * 2); }
        const float4 r0 = *(const float4*)(rs + lrb), r1 = *(const float4*)(rs + lrb + 4);
        const float rsv[8] = {r0.x, r0.y, r0.z, r0.w, r1.x, r1.y, r1.z, r1.w};
#pragma unroll
        for (int e = 0; e < 8; e++) {
          float o[2];
#pragma unroll
          for (int q = 0; q < 2; q++) {
            const unsigned gw = gq[q][e >> 1], vw = vq[q][e >> 1];
            const float g2 = rsv[e] * ((e & 1) ? __uint_as_float(gw & 0xffff0000u) : __uint_as_float(gw << 16));
            const float v2 = rsv[e] * ((e & 1) ? __uint_as_float(vw & 0xffff0000u) : __uint_as_float(vw << 16));
            const float gate = bg[q] + wg[q][0] * g0[q] + wg[q][1] * g1[q] + wg[q][2] * g2;
            const float val = bv[q] + wv[q][0] * v0[q] + wv[q][1] * v1[q] + wv[q][2] * v2;
            o[q] = gate / (1.f + __expf(-gate)) * val;
            g0[q] = g1[q]; v0[q] = v1[q]; g1[q] = g2; v1[q] = v2;
          }
          const int lr = lrb + e;
          const int tb = 254 * upti - 2 + lr;
          if (lr >= 2 && tb < SEQL) *(unsigned*)(p->act + (size_t)(upb * SEQL + tb) * FFN + ocol) = pack_bf2(o[0], o[1]);
        }
      }
    }
    __syncthreads();
  }
  }
}

__device__ __forceinline__ void attn_item(KP p, int layer, int b, int h, int qt, float lam, float outscale, char* smem, const int tid) {
  const int lane = tid & 63, w = tid >> 6, g = lane >> 5, l32 = lane & 31;
  const int tok_q = b * SEQL + qt * 128 + w * 32 + l32;
  bf16x8 qreg[2][4];
#pragma unroll
  for (int c = 0; c < 2; c++)
#pragma unroll
    for (int ks = 0; ks < 4; ks++)
      qreg[c][ks] = *(const bf16x8*)(p->q + (size_t)tok_q * 512 + h * 128 + c * 64 + ks * 16 + g * 8);

  const int NT = 2 * qt + 2;
  const int nkt = 2 * qt + 1 + (w >> 1);
  f32x16 O[2][4];
#pragma unroll
  for (int c = 0; c < 2; c++)
#pragma unroll
    for (int dt = 0; dt < 4; dt++)
#pragma unroll
      for (int r = 0; r < 16; r++) O[c][dt][r] = 0.f;
  float mrun[2] = {-1e30f, -1e30f}, lrun[2] = {0.f, 0.f};
  const float c1 = 0.125f * 1.4426950408889634f;

  u32x4 rk[4], rv[4];
  const bf16_t* kbase = p->k + (size_t)(b * SEQL) * 512 + h * 128;
  const bf16_t* vbase = p->vt + (size_t)((b * 4 + h) * 128) * SEQL;
  const int kkey = tid >> 4, kc = tid & 15;
  const int vd = tid >> 3, vc = tid & 7;
  auto gload = [&](int kt) {
#pragma unroll
    for (int i = 0; i < 4; i++) {
      rk[i] = *(const u32x4*)(kbase + (size_t)(kt * 64 + kkey + 16 * i) * 512 + kc * 8);
      rv[i] = *(const u32x4*)(vbase + (size_t)(vd + 32 * i) * SEQL + kt * 64 + vc * 8);
    }
  };
  const int kw_off = kkey * 256 + ((kc ^ (kkey & 15)) << 4);
  const int vw_off = 16384 + vd * 128 + ((vc ^ ((vd >> 1) & 7)) << 4);
  auto lwrite = [&](int st) {
    char* s = smem + st * 32768;
#pragma unroll
    for (int i = 0; i < 4; i++) {
      *(u32x4*)(s + kw_off + i * 4096) = rk[i];
      *(u32x4*)(s + vw_off + i * 4096) = rv[i];
    }
  };

  gload(0);
  lwrite(0);
  __syncthreads();
  for (int kt = 0; kt < NT; kt++) {
    if (kt + 1 < NT) gload(kt + 1);
    if (kt < nkt) {
      const char* st = smem + (kt & 1) * 32768;
      bf16x8 pf[2][2][2];
      bf16x8 kf[8], vf[2][4];
      f32x16 S[1][2];
      auto loadkq = [&](int c) {
#pragma unroll
        for (int kb = 0; kb < 2; kb++)
#pragma unroll
          for (int ks = 0; ks < 4; ks++) {
            const int key = kb * 32 + l32, chunk = c * 8 + ks * 2 + g;
            kf[kb * 4 + ks] = *(const bf16x8*)(st + key * 256 + ((chunk ^ (key & 15)) << 4));
          }
      };
      auto qk = [&](int c) {
        f32x16 zero;
#pragma unroll
        for (int r = 0; r < 16; r++) zero[r] = 0.f;
#pragma unroll
        for (int kb = 0; kb < 2; kb++) {
          S[0][kb] = MFMA(kf[kb * 4], qreg[c][0], zero);
#pragma unroll
          for (int ks = 1; ks < 4; ks++) S[0][kb] = MFMA(kf[kb * 4 + ks], qreg[c][ks], S[0][kb]);
        }
      };
      auto loadv = [&](int bi) {
#pragma unroll
        for (int dt = 0; dt < 4; dt++) {
          const int d = dt * 32 + l32, chunk = bi * 2 + g;
          vf[bi & 1][dt] = *(const bf16x8*)(st + 16384 + d * 128 + ((chunk ^ ((d >> 1) & 7)) << 4));
        }
      };
      auto softmax = [&](int c) {
        float mx = S[0][0][0];
#pragma unroll
        for (int r = 1; r < 16; r++) mx = fmaxf(mx, S[0][0][r]);
#pragma unroll
        for (int r = 0; r < 16; r++) mx = fmaxf(mx, S[0][1][r]);
        {
          const unsigned mu = __float_as_uint(mx);
          auto sw = __builtin_amdgcn_permlane32_swap(mu, mu, false, false);
          mx = fmaxf(__uint_as_float(sw[0]), __uint_as_float(sw[1]));
        }
        const float mcand = fmaxf(mrun[c], mx * c1);
        if (__any(mcand - mrun[c] > 8.f)) {
          const float alpha = fast_exp2(mrun[c] - mcand);
          mrun[c] = mcand;
          lrun[c] *= alpha;
#pragma unroll
          for (int dt = 0; dt < 4; dt++)
#pragma unroll
            for (int r = 0; r < 16; r++) O[c][dt][r] *= alpha;
        }
        const float mref = mrun[c];
        const f2_t c1v = {c1, c1}, mrv = {-mref, -mref};
        f2_t psum2 = {0.f, 0.f};
#pragma unroll
        for (int kb = 0; kb < 2; kb++)
#pragma unroll
          for (int r = 0; r < 16; r += 2) {
            f2_t sv = {S[0][kb][r], S[0][kb][r + 1]};
            f2_t av = __builtin_elementwise_fma(sv, c1v, mrv);
            f2_t ev = {fast_exp2(av[0]), fast_exp2(av[1])};
            S[0][kb][r] = ev[0]; S[0][kb][r + 1] = ev[1];
            psum2 += ev;
          }
        lrun[c] += psum2[0] + psum2[1];
#pragma unroll
        for (int kb = 0; kb < 2; kb++)
#pragma unroll
          for (int m = 0; m < 2; m++) {
            u32x4 pk = {pack_bf2(S[0][kb][8 * m + 0], S[0][kb][8 * m + 1]), pack_bf2(S[0][kb][8 * m + 2], S[0][kb][8 * m + 3]),
                        pack_bf2(S[0][kb][8 * m + 4], S[0][kb][8 * m + 5]), pack_bf2(S[0][kb][8 * m + 6], S[0][kb][8 * m + 7])};
            pf[c][kb][m] = __builtin_bit_cast(bf16x8, pk);
          }
      };
      loadkq(0);
      __builtin_amdgcn_sched_barrier(0);
      qk(0);
      __builtin_amdgcn_sched_barrier(0);
      loadkq(1);
      __builtin_amdgcn_sched_barrier(0);
      softmax(0);
      __builtin_amdgcn_sched_barrier(0);
      qk(1);
      loadv(0);
      __builtin_amdgcn_sched_barrier(0);
      softmax(1);
      __builtin_amdgcn_sched_barrier(0);
#pragma unroll
      for (int bi = 0; bi < 4; bi++) {
        if (bi < 3) loadv(bi + 1);
#pragma unroll
        for (int dt = 0; dt < 4; dt++) {
          O[0][dt] = MFMA(vf[bi & 1][dt], pf[0][bi >> 1][bi & 1], O[0][dt]);
          O[1][dt] = MFMA(vf[bi & 1][dt], pf[1][bi >> 1][bi & 1], O[1][dt]);
        }
        __builtin_amdgcn_sched_barrier(0);
      }
    }
    if (kt + 1 < NT) lwrite((kt + 1) & 1);
    __syncthreads();
  }

  const float l1 = lrun[0] + __shfl_xor(lrun[0], 32);
  const float l2 = lrun[1] + __shfl_xor(lrun[1], 32);
  const float i1 = 1.f / l1, i2 = lam / l2;
  float ssq = 0.f;
#pragma unroll
  for (int dt = 0; dt < 4; dt++)
#pragma unroll
    for (int r = 0; r < 16; r++) {
      float o = O[0][dt][r] * i1 - O[1][dt][r] * i2;
      O[0][dt][r] = o;
      ssq += o * o;
    }
  ssq += __shfl_xor(ssq, 32);
  const float rstd = rsqrtf(ssq * (1.f / 128.f) + EPS) * outscale;
  const float* gsub = p->subln + layer * 128;
#pragma unroll
  for (int dt = 0; dt < 4; dt++)
#pragma unroll
    for (int rq = 0; rq < 4; rq++) {
      const int d0 = dt * 32 + rq * 8 + g * 4;
      float4 gg = *(const float4*)(gsub + d0);
      u32x2 pk = {pack_bf2(O[0][dt][rq * 4 + 0] * rstd * gg.x, O[0][dt][rq * 4 + 1] * rstd * gg.y),
                  pack_bf2(O[0][dt][rq * 4 + 2] * rstd * gg.z, O[0][dt][rq * 4 + 3] * rstd * gg.w)};
      *(u32x2*)(p->att + (size_t)tok_q * 512 + h * 128 + d0) = pk;
    }
}

DI void s5_store_u(const u32x4 a, const u32x4 bq, int lane, float* ul) {
  float4* d = (float4*)(ul + lane * 16);
  d[0] = make_float4(__uint_as_float(a[0] << 16), __uint_as_float(a[0] & 0xffff0000u), __uint_as_float(a[1] << 16), __uint_as_float(a[1] & 0xffff0000u));
  d[1] = make_float4(__uint_as_float(a[2] << 16), __uint_as_float(a[2] & 0xffff0000u), __uint_as_float(a[3] << 16), __uint_as_float(a[3] & 0xffff0000u));
  d[2] = make_float4(__uint_as_float(bq[0] << 16), __uint_as_float(bq[0] & 0xffff0000u), __uint_as_float(bq[1] << 16), __uint_as_float(bq[1] & 0xffff0000u));
  d[3] = make_float4(__uint_as_float(bq[2] << 16), __uint_as_float(bq[2] & 0xffff0000u), __uint_as_float(bq[3] << 16), __uint_as_float(bq[3] & 0xffff0000u));
}
DI void s5_load_u(KP p, int b, int g, int j, int lane, float* ul) {
  const u32x4* src = (const u32x4*)(p->u + (size_t)(b * SEQL + j * 64 + lane) * 512 + g * 16);
  const u32x4 a = src[0], bq = src[1];
  s5_store_u(a, bq, lane, ul);
}

DI float swap_half(float v, const int which) {
  const unsigned u = __float_as_uint(v);
  auto r = __builtin_amdgcn_permlane32_swap(u, u, false, false);
  return __uint_as_float(which ? r[1] : r[0]);
}

struct S5Coef { float arA, aiA, arB, aiB; };

template <bool STORE>
DI void s5_scan32(const float* ul_sub, const bf16x8 (&bfr)[4], const S5Coef& cf, float& xAr, float& xAi, float& xBr, float& xBi,
                  float* X, const int l32, const int grp) {
  bf16x8 af;
  {
    const float* us = ul_sub + l32 * 16 + grp * 8;
    float4 a = *(const float4*)us, bq = *(const float4*)(us + 4);
    u32x4 pk = {pack_bf2(a.x, a.y), pack_bf2(a.z, a.w), pack_bf2(bq.x, bq.y), pack_bf2(bq.z, bq.w)};
    af = __builtin_bit_cast(bf16x8, pk);
  }
  f32x16 zero;
#pragma unroll
  for (int r = 0; r < 16; r++) zero[r] = 0.f;
  const f32x16 bu0 = MFMA(af, bfr[0], zero), bu1 = MFMA(af, bfr[1], zero), bu2 = MFMA(af, bfr[2], zero), bu3 = MFMA(af, bfr[3], zero);
#pragma unroll
  for (int k = 0; k < 8; k++) {
    float sAr[4], sAi[4], sBr[4], sBi[4];
#pragma unroll
    for (int i = 0; i < 4; i++) {
      const int r = (k >> 1) * 4 + i;
      const float nAr = cf.arA * xAr - cf.aiA * xAi + bu0[r];
      const float nAi = cf.arA * xAi + cf.aiA * xAr + bu2[r];
      const float nBr = cf.arB * xBr - cf.aiB * xBi + bu1[r];
      const float nBi = cf.arB * xBi + cf.aiB * xBr + bu3[r];
      xAr = nAr; xAi = nAi; xBr = nBr; xBi = nBi;
      sAr[i] = nAr; sAi[i] = nAi; sBr[i] = nBr; sBi[i] = nBi;
    }
    if (STORE) {
      if (grp == (k & 1)) {
#pragma unroll
        for (int i = 0; i < 4; i++) {
          float* xr = X + (4 * k + i) * 132;
          xr[l32] = sAr[i]; xr[64 + l32] = sAi[i]; xr[32 + l32] = sBr[i]; xr[96 + l32] = sBi[i];
        }
      }
    }
    xAr = swap_half(xAr, k & 1); xAi = swap_half(xAi, k & 1);
    xBr = swap_half(xBr, k & 1); xBi = swap_half(xBi, k & 1);
  }
}

DI void s5_setup(KP p, int layer, int g, int l32, int grp, S5Coef& cf, bf16x8 (&bfr)[4]) {
  const float* t0 = p->s5tab + (size_t)((layer * 32 + g) * 64) * 40;
  cf.arA = t0[l32 * 40]; cf.aiA = t0[l32 * 40 + 1];
  cf.arB = t0[(32 + l32) * 40]; cf.aiB = t0[(32 + l32) * 40 + 1];
#pragma unroll
  for (int jt = 0; jt < 4; jt++) {
    const float* src = t0 + (l32 + 32 * (jt & 1)) * 40 + 4 + (jt >> 1) * 16 + grp * 8;
    float4 a = *(const float4*)src, bq = *(const float4*)(src + 4);
    u32x4 pk = {pack_bf2(a.x, a.y), pack_bf2(a.z, a.w), pack_bf2(bq.x, bq.y), pack_bf2(bq.z, bq.w)};
    bfr[jt] = __builtin_bit_cast(bf16x8, pk);
  }
}

__device__ __forceinline__ void s5_pass1(KP p, int layer, char* smem, const int tid) {
  const int lane = tid & 63, w = tid >> 6, l32 = lane & 31, grp = lane >> 5;
  float* ul = (float*)(smem + w * 4096);
  for (int wbase = blockIdx.x * 4; wbase < 1024; wbase += gridDim.x * 4) {
    const int wi = wbase + w;
    const int j0 = (wi & 15) * 8, g = (wi >> 4) & 31, b = wi >> 9;
    S5Coef cf; bf16x8 bfr[4];
    s5_setup(p, layer, g, l32, grp, cf, bfr);
    const u32x4* src = (const u32x4*)(p->u + (size_t)(b * SEQL + j0 * 64 + lane) * 512 + g * 16);
    u32x4 v0 = src[0], v1 = src[1];
    for (int jj = 0; jj < 8; jj++) {
      const int j = j0 + jj;
      s5_store_u(v0, v1, lane, ul);
      if (jj < 7) {
        const u32x4* nsrc = (const u32x4*)(p->u + (size_t)(b * SEQL + (j + 1) * 64 + lane) * 512 + g * 16);
        v0 = nsrc[0]; v1 = nsrc[1];
      }
      __syncthreads();
      float xAr = 0.f, xAi = 0.f, xBr = 0.f, xBi = 0.f;
      s5_scan32<false>(ul, bfr, cf, xAr, xAi, xBr, xBi, nullptr, l32, grp);
      s5_scan32<false>(ul + 32 * 16, bfr, cf, xAr, xAi, xBr, xBi, nullptr, l32, grp);
      float* so = p->sloc + (size_t)((b * 32 + g) * 128 + j) * 128;
      so[lane] = grp ? xBr : xAr; so[64 + lane] = grp ? xBi : xAi;
      __syncthreads();
    }
  }
}

__device__ __forceinline__ void s5_pass2(KP p, int layer, char* smem, const int tid) {
  const int lane = tid & 63, w = tid >> 6;
  float* ul = (float*)(smem + w * 21504);
  float* X = ul + 1024;
  const int l32 = lane & 31, grp = lane >> 5;
  for (int wbase = blockIdx.x * 4; wbase < 1024; wbase += gridDim.x * 4) {
   const int wi = wbase + w;
   const int j0 = (wi & 15) * 8, g = (wi >> 4) & 31, b = wi >> 9;
   S5Coef cf; bf16x8 bfr[4];
   s5_setup(p, layer, g, l32, grp, cf, bfr);
   bf16x8 cfr[8];
   {
     const int c = l32 & 15;
     const float* cr = p->c_re + (size_t)((layer * 32 + g) * 16 + c) * 64;
     const float* ci = p->c_im + (size_t)((layer * 32 + g) * 16 + c) * 64;
#pragma unroll
     for (int s8 = 0; s8 < 8; s8++) {
       const int k0 = (s8 & 3) * 16 + grp * 8;
       const float* src = (s8 < 4) ? (cr + k0) : (ci + k0);
       const float sg = (l32 < 16) ? ((s8 < 4) ? 1.f : -1.f) : 0.f;
       float4 a = *(const float4*)src, bq = *(const float4*)(src + 4);
       u32x4 pk = {pack_bf2(a.x * sg, a.y * sg), pack_bf2(a.z * sg, a.w * sg), pack_bf2(bq.x * sg, bq.y * sg), pack_bf2(bq.z * sg, bq.w * sg)};
       cfr[s8] = __builtin_bit_cast(bf16x8, pk);
     }
   }
   const float dd = p->ssm_d[(size_t)(layer * 32 + g) * 16 + (l32 & 15)];
   float xAr, xAi, xBr, xBi;
   {
     const float* tb = p->s5tab + (size_t)((layer * 32 + g) * 64 + lane) * 40;
     const float aTr = tb[2], aTi = tb[3];
     float xr = 0.f, xi = 0.f;
     const float* sl = p->sloc + (size_t)((b * 32 + g) * 128) * 128;
     for (int i0 = 0; i0 < j0; i0 += 8) {
       float sr[8], si[8];
#pragma unroll
       for (int q = 0; q < 8; q++) { sr[q] = sl[(i0 + q) * 128 + lane]; si[q] = sl[(i0 + q) * 128 + 64 + lane]; }
#pragma unroll
       for (int q = 0; q < 8; q++) {
         const float nr = aTr * xr - aTi * xi + sr[q];
         const float ni = aTr * xi + aTi * xr + si[q];
         xr = nr; xi = ni;
       }
     }
     xAr = swap_half(xr, 0); xBr = swap_half(xr, 1);
     xAi = swap_half(xi, 0); xBi = swap_half(xi, 1);
   }
   for (int jj = 0; jj < 8; jj++) {
    const int j = j0 + jj;
    s5_load_u(p, b, g, j, lane, ul);
    __syncthreads();
    for (int sub = 0; sub < 2; sub++) {
      s5_scan32<true>(ul + sub * 32 * 16, bfr, cf, xAr, xAi, xBr, xBi, X, l32, grp);
      __syncthreads();
      f32x16 yacc;
#pragma unroll
      for (int r = 0; r < 16; r++) yacc[r] = 0.f;
#pragma unroll
      for (int s8 = 0; s8 < 8; s8++) {
        const float* xs = X + l32 * 132 + ((s8 < 4) ? 0 : 64) + (s8 & 3) * 16 + grp * 8;
        float4 a = *(const float4*)xs, bq = *(const float4*)(xs + 4);
        u32x4 pk = {pack_bf2(a.x, a.y), pack_bf2(a.z, a.w), pack_bf2(bq.x, bq.y), pack_bf2(bq.z, bq.w)};
        yacc = MFMA(__builtin_bit_cast(bf16x8, pk), cfr[s8], yacc);
      }
      if (l32 < 16) {
#pragma unroll
        for (int r = 0; r < 16; r++) {
          const int tl = sub * 32 + (r >> 2) * 8 + grp * 4 + (r & 3);
          const float yv = yacc[r] + dd * ul[tl * 16 + l32];
          p->gy[(size_t)(b * SEQL + j * 64 + tl) * 512 + g * 16 + l32] = f2bf(gelu_tanh(yv));
        }
      }
      __syncthreads();
    }
   }
  }
}

__device__ __forceinline__ void phase_attn(KP p, int layer, char* smem, const int tid) {
  const int lane = tid & 63;
  const float s1 = wave_sum(p->lq1[layer * 64 + lane] * p->lk1[layer * 64 + lane]);
  const float s2 = wave_sum(p->lq2[layer * 64 + lane] * p->lk2[layer * 64 + lane]);
  const float lam_init = 0.8f - 0.6f * expf(-0.3f * (float)layer);
  const float lam = expf(s1) - expf(s2) + lam_init;
  for (int pb = blockIdx.x; pb < 256; pb += gridDim.x) {
    const int pi = (pb & 7) * 32 + (pb >> 3);
    const int b = pi >> 7, h = (pi >> 5) & 3, i = pi & 31;
    attn_item(p, layer, b, h, 63 - i, lam, 1.f - lam_init, smem, tid);
    attn_item(p, layer, b, h, i, lam, 1.f - lam_init, smem, tid);
  }
  s5_pass1(p, layer, smem, tid);
}

__device__ __forceinline__ void phase_final(KP p, const int tid) {
  const int wave = tid >> 6, lane = tid & 63;
  const float* ssq = p->ss + (size_t)8 * 8 * NTOK;
  for (int row = blockIdx.x * 4 + wave; row < NTOK; row += gridDim.x * 4) {
    const float rstd = rsqrtf(ss_sum1(ssq, row) * (1.f / 1024.f) + EPS);
#pragma unroll
    for (int i = 0; i < 4; i++) {
      const u32x2 xv = ((const u32x2*)(p->xb + (size_t)row * DM))[lane + 64 * i];
      float4 v = {__uint_as_float(xv[0] << 16), __uint_as_float(xv[0] & 0xffff0000u), __uint_as_float(xv[1] << 16), __uint_as_float(xv[1] & 0xffff0000u)};
      float4 gq = ((const float4*)p->norm_final)[lane + 64 * i];
      float4 o = {v.x * rstd * gq.x, v.y * rstd * gq.y, v.z * rstd * gq.z, v.w * rstd * gq.w};
      ((float4*)(p->out + (size_t)row * DM))[lane + 64 * i] = o;
    }
  }
}

__device__ __forceinline__ void run_phase(KP p, int ph, char* smem) {
  const int tid = opaque_tid();
  if (ph == 0) { phase_prep(p, smem, tid); return; }
  if (ph == 29) { phase_final(p, tid); return; }
  const int layer = (ph - 1) / 7, k = (ph - 1) % 7;
  const int nb = gridDim.x, bid = blockIdx.x;
  if (k == 1) { phase_attn(p, layer, smem, tid); return; }
  if (k == 2) { s5_pass2(p, layer, smem, tid); return; }
  if (k == 0) { for (int r = 0; ; r++) { const int t = (r * 8 + (bid & 7)) * (nb >> 3) + (bid >> 3); if (r * nb >= 512) break; if (t < 512) gemm_tile(p, G_IN, layer, t, smem, tid); } }
  else if (k == 3) { for (int r = 0; ; r++) { const int t = (r * 8 + (bid & 7)) * (nb >> 3) + (bid >> 3); if (r * nb >= 256) break; if (t < 256) gemm_tile(p, G_GLU, layer, t, smem, tid); } }
  else if (k == 4) { for (int r = 0; ; r++) { const int t = (r * 8 + (bid & 7)) * (nb >> 3) + (bid >> 3); if (r * nb >= 256) break; if (t < 256) gemm_tile(p, G_WOUT, layer, t, smem, tid); } }
  else if (k == 5) { for (int r = 0; ; r++) { const int t = (r * 8 + (bid & 7)) * (nb >> 3) + (bid >> 3); if (r * nb >= 2 * 33 * 22) break; if (t < 2 * 33 * 22) gemm_tile(p, G_UP, layer, t, smem, tid); } }
  else { for (int r = 0; ; r++) { const int t = (r * 8 + (bid & 7)) * (nb >> 3) + (bid >> 3); if (r * nb >= 256) break; if (t < 256) gemm_tile(p, G_DOWN, layer, t, smem, tid); } }
}

#define PHASE_KERNEL(name, body)                                                      \
  __global__ void __launch_bounds__(256) name(Params p_unused) {                      \
    extern __shared__ __attribute__((aligned(16))) char smem[];                       \
    KP p = (KP)__builtin_amdgcn_kernarg_segment_ptr();                                \
    const int tid = threadIdx.x, nb = gridDim.x, bid = blockIdx.x;                    \
    const int layer = (int)p->phase_lo;                                               \
    (void)nb; (void)bid; (void)layer;                                                 \
    body                                                                              \
  }
PHASE_KERNEL(k_prep, phase_prep(p, smem, tid);)
PHASE_KERNEL(k_gin, for (int r = 0; ; r++) { const int t = (r * 8 + (bid & 7)) * (nb >> 3) + (bid >> 3); if (r * nb >= 512) break; if (t < 512) gemm_tile(p, G_IN, layer, t, smem, tid); })
PHASE_KERNEL(k_attn, phase_attn(p, layer, smem, tid);)
PHASE_KERNEL(k_s5p2, s5_pass2(p, layer, smem, tid);)
PHASE_KERNEL(k_glu, for (int r = 0; ; r++) { const int t = (r * 8 + (bid & 7)) * (nb >> 3) + (bid >> 3); if (r * nb >= 256) break; if (t < 256) gemm_tile(p, G_GLU, layer, t, smem, tid); })
PHASE_KERNEL(k_wout, for (int r = 0; ; r++) { const int t = (r * 8 + (bid & 7)) * (nb >> 3) + (bid >> 3); if (r * nb >= 256) break; if (t < 256) gemm_tile(p, G_WOUT, layer, t, smem, tid); })
PHASE_KERNEL(k_up, for (int r = 0; ; r++) { const int t = (r * 8 + (bid & 7)) * (nb >> 3) + (bid >> 3); if (r * nb >= 2 * 33 * 22) break; if (t < 2 * 33 * 22) gemm_tile(p, G_UP, layer, t, smem, tid); })
PHASE_KERNEL(k_down, for (int r = 0; ; r++) { const int t = (r * 8 + (bid & 7)) * (nb >> 3) + (bid >> 3); if (r * nb >= 256) break; if (t < 256) gemm_tile(p, G_DOWN, layer, t, smem, tid); })
PHASE_KERNEL(k_final, phase_final(p, tid);)

#if COOP
__global__ void __launch_bounds__(256) mega_kernel(Params p_unused) {
  extern __shared__ __attribute__((aligned(16))) char smem[];
  KP p0 = (KP)__builtin_amdgcn_kernarg_segment_ptr();
  const int ph_lo = (int)p0->phase_lo, ph_hi = (int)p0->phase_hi;
#if COOP
  if (ph_hi > 1000) cg::this_grid().sync();
#endif
#if COOP
  {
    volatile unsigned* st = (volatile unsigned*)(smem + 136192);
    if (threadIdx.x == 0) { st[0] = 0u; st[1] = 0u; xb_add(&p0->bar[XB_CNT(xb_xcc_id())], 1u); }
  }
#endif
  for (int ph = ph_lo; ph < ph_hi; ph++) {
    KP p = p0;
    asm volatile("" : "+s"(p));
#if TPROBE
    if (blockIdx.x == 0) p->ts[ph] = (long long)wall_clock64();
#endif
    run_phase(p, ph, smem);
#if COOP
    if (ph + 1 < ph_hi) {
      if (ph == ph_lo) grid_barrier(p->bar, gridDim.x, opaque_tid());
      else xcd_barrier(p->bar, (volatile unsigned*)(smem + 136192), opaque_tid());
    }
#endif
  }
#if TPROBE
  grid_barrier(p0->bar, (unsigned)(ph_hi - ph_lo) * gridDim.x, opaque_tid());
  if (blockIdx.x == 0) {
    KP p = p0;
    long long tend = (long long)wall_clock64();
    float a = 0.f, b = 0.f;
    for (int ph = 0; ph < 30; ph++) {
      long long t0 = p->ts[ph], t1 = (ph == 29) ? tend : p->ts[ph + 1];
      int c = (ph == 0) ? 0 : (ph == 29 ? 8 : 1 + (ph - 1) % 7);
      float d = (float)(t1 - t0) * 0.01f;
      if (c == TP_A || TP_A == 9) a += d;
      if (c == TP_B || TP_B == 9) b += d;
    }
    const int t = opaque_tid();
    if (t <= 100) p->out[t] += (t == 0) ? a : b;
  }
#endif
}

#endif

extern "C" void kernel_launch(void* const* d_in, const int* in_sizes, int n_in, void* d_out, int out_size, void* d_ws,
                              size_t ws_size, hipStream_t stream) {
  static int grid_blocks = 0;
  if (!grid_blocks) {
    int dev = 0, cus = 0, per_cu = 0;
    (void)hipGetDevice(&dev);
    (void)hipDeviceGetAttribute(&cus, hipDeviceAttributeMultiprocessorCount, dev);
#if COOP
    (void)hipFuncSetAttribute((const void*)mega_kernel, hipFuncAttributeMaxDynamicSharedMemorySize, LDS_BYTES);
    (void)hipOccupancyMaxActiveBlocksPerMultiprocessor(&per_cu, (const void*)mega_kernel, 256, LDS_BYTES);
    if (per_cu < 1) { fprintf(stderr, "occupancy query returned %d\n", per_cu); per_cu = 1; }
#endif
    grid_blocks = cus;
    (void)hipGetLastError();
  }
  Params p{};
  p.x = (const float*)d_in[0]; p.pos = (const int*)d_in[1];
  p.norm_mix = (const float*)d_in[2]; p.w_in = (const float*)d_in[3];
  p.lam_re = (const float*)d_in[4]; p.lam_im = (const float*)d_in[5]; p.log_step = (const float*)d_in[6];
  p.b_re = (const float*)d_in[7]; p.b_im = (const float*)d_in[8]; p.c_re = (const float*)d_in[9]; p.c_im = (const float*)d_in[10];
  p.ssm_d = (const float*)d_in[11]; p.w_glu = (const float*)d_in[12]; p.ssm_norm = (const float*)d_in[13];
  p.lq1 = (const float*)d_in[14]; p.lk1 = (const float*)d_in[15]; p.lq2 = (const float*)d_in[16]; p.lk2 = (const float*)d_in[17];
  p.subln = (const float*)d_in[18]; p.w_out = (const float*)d_in[19]; p.norm_ffn = (const float*)d_in[20];
  p.w_up = (const float*)d_in[21]; p.w_conv = (const float*)d_in[22]; p.b_conv = (const float*)d_in[23];
  p.w_down = (const float*)d_in[24]; p.norm_final = (const float*)d_in[25];
  p.out = (float*)d_out;
  char* ws = (char*)d_ws;
  size_t off = 0;
  auto take = [&](size_t bytes) { char* r = ws + off; off += (bytes + 255) & ~(size_t)255; return r; };
  p.WinT = (bf16_t*)take((size_t)4 * 2048 * 1024 * 2);
  p.WgluT = (bf16_t*)take((size_t)4 * 1024 * 512 * 2);
  p.WoutT = (bf16_t*)take((size_t)4 * 1024 * 1024 * 2);
  p.WupT = (bf16_t*)take((size_t)4 * 5632 * 1024 * 2);
  p.WdownT = (bf16_t*)take((size_t)4 * 1024 * FFN * 2);
  p.xf = (float*)take((size_t)NTOK * DM * 4);
  p.xb = (bf16_t*)take((size_t)NTOK * DM * 2);
  p.ss = (float*)take((size_t)9 * 8 * NTOK * 4);
  p.ssm_ss = (float*)take((size_t)4 * 8 * NTOK * 4);
  p.cs = (float*)take((size_t)NTOK * 16 * 4);
  p.s5tab = (float*)take((size_t)4 * 32 * 64 * 40 * 4);
  p.sloc = (float*)take((size_t)2 * 32 * 128 * 128 * 4);
  p.ts = (long long*)take(256);
  p.bar = (unsigned*)take(XB_WORDS * 4);
  char* region = take((size_t)134217728);
  p.u = (bf16_t*)region;
  p.q = (bf16_t*)(region + 33554432);
  p.k = p.q + (size_t)NTOK * 512;
  p.vt = p.k + (size_t)NTOK * 512;
  p.gy = p.vt + (size_t)NTOK * 512;
  p.outg = p.gy + (size_t)NTOK * 512;
  p.att = p.outg + (size_t)NTOK * 512;
  p.act = (bf16_t*)region;
  if (off > ws_size) { fprintf(stderr, "workspace too small: need %zu have %zu\n", off, ws_size); return; }
#if COOP
  p.phase_lo = 0; p.phase_hi = 30;
  if (hipMemsetAsync(p.bar, 0, XB_WORDS * 4, stream) != hipSuccess) fprintf(stderr, "barrier memset failed\n");
  void* args[] = {&p};
  hipError_t e = hipLaunchCooperativeKernel((const void*)mega_kernel, dim3(grid_blocks), dim3(256), args, LDS_BYTES, stream);
  if (e != hipSuccess) fprintf(stderr, "cooperative launch failed: %s (grid %d)\n", hipGetErrorString(e), grid_blocks);
#else
  typedef void (*kfn)(Params);
  const kfn seq[7] = {k_gin, k_attn, k_s5p2, k_glu, k_wout, k_up, k_down};
  static bool attr_done = false;
  if (!attr_done) {
    (void)hipFuncSetAttribute((const void*)k_prep, hipFuncAttributeMaxDynamicSharedMemorySize, LDS_BYTES);
    (void)hipFuncSetAttribute((const void*)k_final, hipFuncAttributeMaxDynamicSharedMemorySize, LDS_BYTES);
    for (int i = 0; i < 7; i++) (void)hipFuncSetAttribute((const void*)seq[i], hipFuncAttributeMaxDynamicSharedMemorySize, LDS_BYTES);
    attr_done = true;
  }
  p.phase_lo = 0; p.phase_hi = 0;
  hipLaunchKernelGGL(k_prep, dim3(grid_blocks), dim3(256), LDS_BYTES, stream, p);
  for (int layer = 0; layer < 4; layer++) {
    p.phase_lo = layer;
    for (int i = 0; i < 7; i++) hipLaunchKernelGGL(seq[i], dim3(grid_blocks), dim3(256), LDS_BYTES, stream, p);
  }
  hipLaunchKernelGGL(k_final, dim3(grid_blocks), dim3(256), LDS_BYTES, stream, p);
#endif
}
```

```cpp
#include <hip/hip_runtime.h>
#include <hip/hip_cooperative_groups.h>
#include <cstdio>
namespace cg = cooperative_groups;

#ifndef COOP
#define COOP 1
#endif
#ifndef TPROBE
#define TPROBE 0
#endif
#ifndef TP_A
#define TP_A 1
#endif
#ifndef TP_B
#define TP_B 2
#endif

typedef unsigned short bf16_t;
typedef __attribute__((ext_vector_type(8))) short bf16x8;
typedef __attribute__((ext_vector_type(16))) float f32x16;
typedef __attribute__((ext_vector_type(2))) __bf16 bf2_t;
typedef __attribute__((ext_vector_type(2))) float f2_t;
typedef __attribute__((ext_vector_type(4))) unsigned u32x4;
typedef __attribute__((ext_vector_type(2))) unsigned u32x2;

#define DI __device__ __forceinline__
#define MFMA(a, b, c) __builtin_amdgcn_mfma_f32_32x32x16_bf16((a), (b), (c), 0, 0, 0)

constexpr int NTOK = 16384, DM = 1024, SEQL = 8192, FFN = 2816;
constexpr int LDS_BYTES = 136208;
constexpr float EPS = 1e-6f;

struct Params {
  const float* x; const int* pos;
  const float *norm_mix, *w_in, *lam_re, *lam_im, *log_step, *b_re, *b_im, *c_re, *c_im, *ssm_d, *w_glu, *ssm_norm;
  const float *lq1, *lk1, *lq2, *lk2, *subln, *w_out, *norm_ffn, *w_up, *w_conv, *b_conv, *w_down, *norm_final;
  float* out;
  bf16_t *WinT, *WgluT, *WoutT, *WupT, *WdownT;
  float* xf; bf16_t* xb;
  bf16_t *u, *q, *k, *vt, *gy, *outg, *att, *act;
  float *ss, *ssm_ss, *cs, *s5tab, *sloc;
  long long phase_lo, phase_hi;
  long long* ts;
  unsigned* bar;
};

typedef const __attribute__((address_space(4))) Params* KP;

DI unsigned pack_bf2(float a, float b) { f2_t v = {a, b}; return __builtin_bit_cast(unsigned, __builtin_convertvector(v, bf2_t)); }
DI bf16_t f2bf(float a) { return (bf16_t)(pack_bf2(a, 0.f) & 0xffffu); }
DI float bf2f(bf16_t v) { return __uint_as_float(((unsigned)v) << 16); }
DI void grid_barrier(unsigned* ctr, unsigned target, int tid) {
  asm volatile("s_waitcnt vmcnt(0)" ::: "memory");
  __syncthreads();
  if (tid == 0) {
    __builtin_amdgcn_fence(__ATOMIC_RELEASE, "agent");
    asm volatile("s_waitcnt vmcnt(0)" ::: "memory");
    __hip_atomic_fetch_add(ctr, 1u, __ATOMIC_RELAXED, __HIP_MEMORY_SCOPE_AGENT);
    while (__hip_atomic_load(ctr, __ATOMIC_RELAXED, __HIP_MEMORY_SCOPE_AGENT) < target) __builtin_amdgcn_s_sleep(1);
    __builtin_amdgcn_fence(__ATOMIC_ACQUIRE, "agent");
    asm volatile("s_waitcnt vmcnt(0)" ::: "memory");
  }
  __syncthreads();
}
#define XB_CNT(j)  (64 + 64 * (j))
#define XB_SUB(j)  (1088 + 64 * (j))
#define XB_GEN(j)  (2112 + 64 * (j))
#define XB_TOP     3136
#define XB_TOPGEN  3200
#define XB_WORDS   3264
DI unsigned xb_ld(unsigned* q) { return __hip_atomic_load(q, __ATOMIC_RELAXED, __HIP_MEMORY_SCOPE_AGENT); }
DI unsigned xb_add(unsigned* q, unsigned v) { return __hip_atomic_fetch_add(q, v, __ATOMIC_RELAXED, __HIP_MEMORY_SCOPE_AGENT); }
DI unsigned xb_xcc_id() { return (unsigned)__builtin_amdgcn_s_getreg((3 << 11) | 20) & 0xFu; }
DI void xcd_barrier(unsigned* bar, volatile unsigned* st, int tid) {
  asm volatile("s_waitcnt vmcnt(0)" ::: "memory");
  __syncthreads();
  if (tid == 0) {
    const unsigned x = xb_xcc_id();
    unsigned nloc = st[0], nx = st[1];
    if (nloc == 0u) {
      unsigned cnt = 0u, mine = 1u;
#pragma unroll
      for (unsigned j = 0; j < 16; ++j) { const unsigned c = xb_ld(&bar[XB_CNT(j)]); cnt += (c > 0u) ? 1u : 0u; mine = (j == x) ? c : mine; }
      nloc = mine > 0u ? mine : 1u; nx = cnt > 0u ? cnt : 1u;
      st[0] = nloc; st[1] = nx;
    }
    const unsigned old = xb_add(&bar[XB_SUB(x)], 1u);
    const unsigned gen = old / nloc;
    if (old + 1u == (gen + 1u) * nloc) {
      __builtin_amdgcn_fence(__ATOMIC_RELEASE, "agent");
      asm volatile("s_waitcnt vmcnt(0)" ::: "memory");
      const unsigned og = xb_add(&bar[XB_TOP], 1u);
      const unsigned tg = og / nx;
      if (og + 1u == (tg + 1u) * nx) xb_add(&bar[XB_TOPGEN], 1u);
      else { while (xb_ld(&bar[XB_TOPGEN]) == tg) __builtin_amdgcn_s_sleep(1); }
      __builtin_amdgcn_fence(__ATOMIC_ACQUIRE, "agent");
      xb_add(&bar[XB_GEN(x)], 1u);
      asm volatile("s_waitcnt vmcnt(0)" ::: "memory");
    } else {
      while (xb_ld(&bar[XB_GEN(x)]) == gen) __builtin_amdgcn_s_sleep(1);
      __builtin_amdgcn_fence(__ATOMIC_ACQUIRE, "agent");
      asm volatile("s_waitcnt vmcnt(0)" ::: "memory");
    }
  }
  __syncthreads();
}
DI int opaque_tid() { int t = threadIdx.x; asm volatile("" : "+v"(t)); return t; }
DI float4 ss_sum4(const float* base, int row0) {
  float4 a = *(const float4*)(base + row0);
#pragma unroll
  for (int pz = 1; pz < 8; pz++) {
    float4 b = *(const float4*)(base + (size_t)pz * NTOK + row0);
    a.x += b.x; a.y += b.y; a.z += b.z; a.w += b.w;
  }
  return a;
}
DI float ss_sum1(const float* base, int row) {
  float a = base[row];
#pragma unroll
  for (int pz = 1; pz < 8; pz++) a += base[(size_t)pz * NTOK + row];
  return a;
}
DI float wave_sum(float v) { for (int o = 32; o; o >>= 1) v += __shfl_xor(v, o); return v; }
DI float fast_exp2(float x) { return __builtin_amdgcn_exp2f(x); }
DI float gelu_tanh(float x) {
  float z = 0.7978845608028654f * (x + 0.044715f * x * x * x);
  float e = __expf(2.f * z);
  float t = 1.f - 2.f / (1.f + e);
  return 0.5f * x * (1.f + t);
}
DI float reduce_2pi(double a) {
  double n = rint(a * 0.15915494309189535);
  return (float)(a - n * 6.283185307179586);
}

DI void transpose_tile(const float* src, int ldsrc, int k0, int c0, const float* scale, int nscale,
                       bf16_t* dst, int lddst, int n0, float* lds, const int tid) {
#pragma unroll
  for (int i = 0; i < 16; i++) {
    int kk = i * 4 + (tid >> 6), nn = tid & 63;
    float v = src[(size_t)(k0 + kk) * ldsrc + c0 + nn];
    if (scale != nullptr && (k0 + kk) < nscale) v *= scale[k0 + kk];
    lds[kk * 65 + nn] = v;
  }
  __syncthreads();
  {
    int nn = tid >> 2, kq = (tid & 3) * 16;
    unsigned pk[8];
#pragma unroll
    for (int i = 0; i < 8; i++) pk[i] = pack_bf2(lds[(kq + 2 * i) * 65 + nn], lds[(kq + 2 * i + 1) * 65 + nn]);
    u32x4* d = (u32x4*)(dst + (size_t)(n0 + nn) * lddst + k0 + kq);
    u32x4 a = {pk[0], pk[1], pk[2], pk[3]}, b = {pk[4], pk[5], pk[6], pk[7]};
    d[0] = a; d[1] = b;
  }
  __syncthreads();
}

DI void wtask(const float* src, int ldsrc, int k0, int c0, const float* scale, int nscale, bf16_t* dst, int lddst, int n0, int lane) {
  float v[32];
  const float* sp = src + (size_t)k0 * ldsrc + c0 + lane;
#pragma unroll
  for (int i = 0; i < 32; i++) v[i] = __builtin_nontemporal_load(sp + (size_t)i * ldsrc);
  if (k0 < nscale) {
#pragma unroll
    for (int i = 0; i < 32; i++) v[i] *= scale[k0 + i];
  }
  u32x4* d = (u32x4*)(dst + (size_t)(n0 + lane) * lddst + k0);
#pragma unroll
  for (int q = 0; q < 4; q++) {
    u32x4 o = {pack_bf2(v[8 * q], v[8 * q + 1]), pack_bf2(v[8 * q + 2], v[8 * q + 3]), pack_bf2(v[8 * q + 4], v[8 * q + 5]), pack_bf2(v[8 * q + 6], v[8 * q + 7])};
    d[q] = o;
  }
}

__device__ __forceinline__ void phase_prep(KP p, char* smem, const int tid) {
  const int nb = gridDim.x, bid = blockIdx.x;
  const int wave = tid >> 6, lane = tid & 63;
  for (int row0 = (bid * 4 + wave) * 4; row0 < NTOK; row0 += nb * 16) {
    float4 v[4][4];
#pragma unroll
    for (int rr = 0; rr < 4; rr++)
#pragma unroll
      for (int i = 0; i < 4; i++) v[rr][i] = ((const float4*)(p->x + (size_t)(row0 + rr) * DM))[lane + 64 * i];
#pragma unroll
    for (int rr = 0; rr < 4; rr++) {
      const int row = row0 + rr;
      float s = 0.f;
#pragma unroll
      for (int i = 0; i < 4; i++) {
        u32x2 pk = {pack_bf2(v[rr][i].x, v[rr][i].y), pack_bf2(v[rr][i].z, v[rr][i].w)};
        ((u32x2*)(p->xb + (size_t)row * DM))[lane + 64 * i] = pk;
        const float a0 = __uint_as_float(pk[0] << 16), a1 = __uint_as_float(pk[0] & 0xffff0000u);
        const float a2 = __uint_as_float(pk[1] << 16), a3 = __uint_as_float(pk[1] & 0xffff0000u);
        s += a0 * a0 + a1 * a1 + a2 * a2 + a3 * a3;
      }
      s = wave_sum(s);
      if (lane < 8) p->ss[(size_t)lane * NTOK + row] = (lane == 0) ? s : 0.f;
    }
  }
  for (int i = bid * 256 + tid; i < NTOK * 8; i += nb * 256) {
    int tok = i >> 3, j = i & 7;
    double inv = (j & 4) ? ((j & 2) ? ((j & 1) ? 1.031338537721246e-05 : 5.318295896944988e-05) : ((j & 1) ? 0.0002742481756762073 : 0.001414213562373095))
                         : ((j & 2) ? ((j & 1) ? 0.007292664737217109 : 0.03760603093086393) : ((j & 1) ? 0.19392274474868576 : 1.0));
    double ang = (double)p->pos[tok] * inv;
    float r = reduce_2pi(ang);
    p->cs[2 * i] = cosf(r); p->cs[2 * i + 1] = sinf(r);
  }
  for (int i = bid * 256 + tid; i < 4 * 32 * 64; i += nb * 256) {
    int lg = i >> 6;
    float lr = p->lam_re[i], li = p->lam_im[i];
    float step = expf(p->log_step[lg]);
    float mag = expf(step * lr);
    double angd = (double)step * (double)li;
    float r1 = reduce_2pi(angd);
    float ar = mag * cosf(r1), ai = mag * sinf(r1);
    float den = lr * lr + li * li;
    float fr = ((ar - 1.f) * lr + ai * li) / den;
    float fi = (ai * lr - (ar - 1.f) * li) / den;
    float magT = expf(64.f * step * lr);
    float rT = reduce_2pi(64.0 * angd);
    float* tb = p->s5tab + (size_t)i * 40;
    tb[0] = ar; tb[1] = ai; tb[2] = magT * cosf(rT); tb[3] = magT * sinf(rT);
    for (int c = 0; c < 16; c++) {
      float br = p->b_re[(size_t)i * 16 + c], bi = p->b_im[(size_t)i * 16 + c];
      tb[4 + c] = fr * br - fi * bi;
      tb[20 + c] = fr * bi + fi * br;
    }
  }
  {
    const int NTASK = 4 * 6016;
    const int gw = bid * 4 + wave, nw = nb * 4;
    const int per = (NTASK + nw - 1) / nw;
    const int t_lo = gw * per, t_hi = min(t_lo + per, NTASK);
    for (int task = t_lo; task < t_hi; task++) {
      const int layer = task / 6016;
      int t = task % 6016;
      if (t < 1024) {
        const int a = t >> 5, kb = t & 31;
        wtask(p->w_in + (size_t)layer * 1024 * 2048, 2048, kb * 32, a * 64, p->norm_mix + layer * 1024, 1024,
              p->WinT + (size_t)layer * 2048 * 1024, 1024, a * 64, lane);
      } else if (t < 1280) {
        t -= 1024; const int a = t >> 4, kb = t & 15;
        wtask(p->w_glu + (size_t)layer * 512 * 1024, 1024, kb * 32, (a & 1) * 512 + (a >> 1) * 64, p->norm_mix, 0,
              p->WgluT + (size_t)layer * 1024 * 512, 512, a * 64, lane);
      } else if (t < 1792) {
        t -= 1280; const int a = t >> 5, kb = t & 31;
        wtask(p->w_out + (size_t)layer * 1024 * 1024, 1024, kb * 32, a * 64, p->ssm_norm + layer * 512, 512,
              p->WoutT + (size_t)layer * 1024 * 1024, 1024, a * 64, lane);
      } else if (t < 4608) {
        t -= 1792; const int a = t >> 5, kb = t & 31;
        wtask(p->w_up + (size_t)layer * 1024 * 5632, 5632, kb * 32, (a & 1) * FFN + (a >> 1) * 64, p->norm_ffn + layer * 1024, 1024,
              p->WupT + (size_t)layer * 5632 * 1024, 1024, a * 64, lane);
      } else {
        t -= 4608; const int a = t / 88, kb = t % 88;
        wtask(p->w_down + (size_t)layer * FFN * 1024, 1024, kb * 32, a * 64, p->norm_mix, 0,
              p->WdownT + (size_t)layer * 1024 * FFN, FFN, a * 64, lane);
      }
    }
  }
}

enum { G_IN = 0, G_GLU = 1, G_WOUT = 2, G_UP = 3, G_DOWN = 4 };
#define ACC_PIN(tag) _Pragma("unroll") for (int i_ = 0; i_ < 4; i_++) _Pragma("unroll") for (int j_ = 0; j_ < 4; j_++) asm volatile("; pin " tag : "+a"(acc[i_][j_]));


__device__ __forceinline__ void gemm_tile(KP p, const int MODE, int layer, int tile, char* smem, const int tid) {
  const int lane = tid & 63, w = tid >> 6, wm = w >> 1, wn = w & 1, g = lane >> 5, l32 = lane & 31;
  int tn, KT, ldb, rowbase, lda;
  const bf16_t* Bt;
  const bf16_t* A0;
  int upb = 0, upti = 0;
  {
    const int TM = (MODE == G_UP) ? 66 : 64;
    const int TN = (MODE == G_IN) ? 8 : (MODE == G_UP ? 22 : 4);
    const int nfull = TN >> 2, rem = TN & 3;
    int tm;
    if (tile < nfull * 4 * TM) { const int band = tile / (4 * TM), within = tile % (4 * TM); tm = within >> 2; tn = band * 4 + (within & 3); }
    else { const int s2 = tile - nfull * 4 * TM; tm = s2 / rem; tn = nfull * 4 + s2 % rem; }
    rowbase = tm * 256;
    if (MODE == G_UP) { upb = tm / 33; upti = tm % 33; rowbase = upb * SEQL + 254 * upti - 2; }
  }
  if (MODE == G_IN) { KT = 16; ldb = 1024; Bt = p->WinT + (size_t)layer * 2048 * 1024; A0 = p->xb; lda = 1024; }
  else if (MODE == G_GLU) { KT = 8; ldb = 512; Bt = p->WgluT + (size_t)layer * 1024 * 512; A0 = p->gy; lda = 512; }
  else if (MODE == G_WOUT) { KT = 16; ldb = 1024; Bt = p->WoutT + (size_t)layer * 1024 * 1024; A0 = p->outg; lda = 512; }
  else if (MODE == G_UP) { KT = 16; ldb = 1024; Bt = p->WupT + (size_t)layer * 5632 * 1024; A0 = p->xb; lda = 1024; }
  else { KT = 44; ldb = FFN; Bt = p->WdownT + (size_t)layer * 1024 * FFN; A0 = p->act; lda = FFN; }

  u32x4 ra[8], rb[8];
  const int lrow = tid >> 3, lc = tid & 7;
  float arow_sc[8];
#pragma unroll
  for (int i = 0; i < 8; i++) arow_sc[i] = 1.f;
  if (MODE == G_WOUT) {
    const float* ssq = p->ssm_ss + (size_t)layer * 8 * NTOK;
#pragma unroll
    for (int i = 0; i < 8; i++) arow_sc[i] = rsqrtf(ss_sum1(ssq, rowbase + lrow + 32 * i) * (1.f / 512.f) + EPS);
  }
  const bf16_t* bptr = Bt + (size_t)(tn * 256 + lrow) * ldb + lc * 8;
  auto gload = [&](int kt) {
    const bf16_t* abase = A0;
    int kofs = kt * 64;
    if (MODE == G_WOUT && kt >= 8) { abase = p->att; kofs = (kt - 8) * 64; }
#pragma unroll
    for (int i = 0; i < 8; i++) {
      int gr = min(max(rowbase + lrow + 32 * i, 0), NTOK - 1);
      ra[i] = *(const u32x4*)(abase + (size_t)gr * lda + kofs + lc * 8);
      rb[i] = *(const u32x4*)(bptr + (size_t)(32 * i) * ldb + kt * 64);
    }
  };
  auto scaleA = [&](int kt) {
    if (MODE == G_WOUT && kt < 8) {
#pragma unroll
      for (int i = 0; i < 8; i++)
#pragma unroll
        for (int e = 0; e < 4; e++) {
          unsigned v = ra[i][e];
          float lo = __uint_as_float(v << 16) * arow_sc[i], hi = __uint_as_float(v & 0xffff0000u) * arow_sc[i];
          ra[i][e] = pack_bf2(lo, hi);
        }
    }
  };
  const int wr_off = lrow * 128 + ((lc ^ ((lrow >> 1) & 7)) << 4);
  auto lwriteA = [&](int st) {
    char* sa = smem + st * 65536;
#pragma unroll
    for (int i = 0; i < 8; i++) *(u32x4*)(sa + wr_off + i * 4096) = ra[i];
  };
  auto lwriteB = [&](int st) {
    char* sb = smem + st * 65536 + 32768;
#pragma unroll
    for (int i = 0; i < 8; i++) *(u32x4*)(sb + wr_off + i * 4096) = rb[i];
  };

  f32x16 acc[4][4];
#pragma unroll
  for (int i = 0; i < 4; i++)
#pragma unroll
    for (int j = 0; j < 4; j++)
#pragma unroll
      for (int r = 0; r < 16; r++) acc[i][j][r] = 0.f;

  const int swz = (l32 >> 1) & 7;
  const int a_base = (wm * 128 + l32) * 128;
  const int b_base = 32768 + (wn * 128 + l32) * 128;
  bf16x8 af[2][4], bfr[2][4];
  auto lfrag = [&](int buf, const char* st, int ks) {
    const int coff = (((ks * 2 + g) ^ swz) << 4);
#pragma unroll
    for (int i = 0; i < 4; i++) af[buf][i] = *(const bf16x8*)(st + a_base + i * 4096 + coff);
#pragma unroll
    for (int j = 0; j < 4; j++) bfr[buf][j] = *(const bf16x8*)(st + b_base + j * 4096 + coff);
  };
  auto mfma16 = [&](int buf) {
#pragma unroll
    for (int i = 0; i < 4; i++)
#pragma unroll
      for (int j = 0; j < 4; j++) acc[i][j] = MFMA(af[buf][i], bfr[buf][j], acc[i][j]);
  };

  gload(0);
  scaleA(0);
  lwriteA(0);
  lwriteB(0);
  __syncthreads();
  if (KT > 1) gload(1);
  lfrag(0, smem, 0);
  for (int kt = 0; kt < KT; kt++) {
    const char* st = smem + (kt & 1) * 65536;
    const bool has1 = (kt + 1 < KT), has2 = (kt + 2 < KT);
    lfrag(1, st, 1);
    if (has1) { scaleA(kt + 1); lwriteA((kt + 1) & 1); }
    mfma16(0);
    __builtin_amdgcn_sched_barrier(0);
    lfrag(0, st, 2);
    if (has1) lwriteB((kt + 1) & 1);
    mfma16(1);
    __builtin_amdgcn_sched_barrier(0);
    lfrag(1, st, 3);
    if (has2) gload(kt + 2);
    mfma16(0);
    __builtin_amdgcn_sched_barrier(0);
    asm volatile("s_waitcnt lgkmcnt(0)" ::: "memory");
    __builtin_amdgcn_s_barrier();
    __builtin_amdgcn_sched_barrier(0);
    if (has1) lfrag(0, smem + ((kt + 1) & 1) * 65536, 0);
    mfma16(1);
    __builtin_amdgcn_sched_barrier(0);
  }

  int tid2 = tid;
  asm volatile("" : "+v"(tid2));
  {
  const int tid = tid2;
  const int lane = tid & 63, w = tid >> 6, wm = w >> 1, wn = w & 1, g = lane >> 5, l32 = lane & 31;
  if (MODE == G_IN) {
    const int region = tn >> 1;
    float* rs = (float*)(smem + 135168);
    rs[tid] = rsqrtf(ss_sum1(p->ss + (size_t)(2 * layer) * 8 * NTOK, rowbase + tid) * (1.f / 1024.f) + EPS);
    __syncthreads();
#pragma unroll
    for (int i = 0; i < 4; i++)
#pragma unroll
      for (int rq = 0; rq < 4; rq++) {
        const int lr0 = wm * 128 + i * 32 + rq * 8 + g * 4;
        const float4 s4 = *(const float4*)(rs + lr0);
        const float sc[4] = {s4.x, s4.y, s4.z, s4.w};
#pragma unroll
        for (int j = 0; j < 4; j++) {
          const int lcol = wn * 128 + j * 32 + l32;
          float v[4];
#pragma unroll
          for (int r4 = 0; r4 < 4; r4++) v[r4] = acc[i][j][rq * 4 + r4] * sc[r4];
          if (region == 3) {
            const int q4 = (lr0 >> 2) & 3;
            const int pq = ((q4 & 1) << 1) | (q4 >> 1);
            u32x2 pk = {pack_bf2(v[0], v[1]), pack_bf2(v[2], v[3])};
            *(u32x2*)(smem + lcol * 528 + ((lr0 & ~15) + pq * 4) * 2) = pk;
          } else {
            if (region != 0 && (j & 1) == 0) {
              float other[4];
#pragma unroll
              for (int r4 = 0; r4 < 4; r4++) other[r4] = __shfl_xor(v[r4], 8);
              if (l32 < 16) {
                const float sgn = (l32 < 8) ? -1.f : 1.f;
#pragma unroll
                for (int r4 = 0; r4 < 4; r4++) {
                  const float2 csv = *(const float2*)(p->cs + ((size_t)(rowbase + lr0 + r4) * 8 + (l32 & 7)) * 2);
                  v[r4] = v[r4] * csv.x + sgn * other[r4] * csv.y;
                }
              }
            }
#pragma unroll
            for (int r4 = 0; r4 < 4; r4++) *(bf16_t*)(smem + (lr0 + r4) * 528 + lcol * 2) = f2bf(v[r4]);
          }
        }
      }
    __syncthreads();
    {
      bf16_t* dbase;
      size_t rstride;
      if (region == 3) { dbase = p->vt + (size_t)((rowbase >> 13) * 512 + (tn & 1) * 256) * SEQL + (rowbase & (SEQL - 1)); rstride = SEQL; }
      else { dbase = (region == 0 ? p->u : (region == 1 ? p->q : p->k)) + (size_t)rowbase * 512 + (tn & 1) * 256; rstride = 512; }
#pragma unroll 8
      for (int it = 0; it < 32; it++) {
        const int id = tid + 256 * it, row = id >> 5, c = id & 31;
        const u32x4 vv = *(const u32x4*)(smem + row * 528 + c * 16);
        *(u32x4*)(dbase + (size_t)row * rstride + c * 8) = vv;
      }
    }
    __syncthreads();
  } else if (MODE == G_GLU) {
#pragma unroll
    for (int i = 0; i < 4; i++)
#pragma unroll
      for (int j = 0; j < 2; j++)
#pragma unroll
        for (int r = 0; r < 16; r++) {
          const int lr = wm * 128 + i * 32 + (r >> 2) * 8 + g * 4 + (r & 3);
          const float av = acc[i][j][r], bv = acc[i][j + 2][r];
          *(bf16_t*)(smem + lr * 272 + (wn * 64 + j * 32 + l32) * 2) = f2bf(av / (1.f + __expf(-bv)));
        }
    __syncthreads();
    {
      float* ssq = p->ssm_ss + ((size_t)layer * 8 + tn * 2) * NTOK;
#pragma unroll 4
      for (int it = 0; it < 16; it++) {
        const int id = tid + 256 * it, row = id >> 4, c = id & 15;
        const u32x4 ov = *(const u32x4*)(smem + row * 272 + c * 16);
        *(u32x4*)(p->outg + (size_t)(rowbase + row) * 512 + tn * 128 + c * 8) = ov;
        float sq = 0.f;
#pragma unroll
        for (int e = 0; e < 4; e++) {
          const float lo = __uint_as_float(ov[e] << 16), hi = __uint_as_float(ov[e] & 0xffff0000u);
          sq += lo * lo + hi * hi;
        }
#pragma unroll
        for (int o = 4; o; o >>= 1) sq += __shfl_xor(sq, o);
        if ((c & 7) == 0) ssq[(size_t)(c >> 3) * NTOK + rowbase + row] = sq;
      }
    }
    __syncthreads();
  } else if (MODE == G_WOUT || MODE == G_DOWN) {
#pragma unroll
    for (int i = 0; i < 4; i++)
#pragma unroll
      for (int j = 0; j < 4; j++)
#pragma unroll
        for (int r = 0; r < 16; r++) {
          const int lr = wm * 128 + i * 32 + (r >> 2) * 8 + g * 4 + (r & 3);
          *(bf16_t*)(smem + lr * 528 + (wn * 128 + j * 32 + l32) * 2) = f2bf(acc[i][j][r]);
        }
    __syncthreads();
    {
      float* ssq = p->ss + ((size_t)(MODE == G_WOUT ? 2 * layer + 1 : 2 * layer + 2) * 8 + tn * 2) * NTOK;
#pragma unroll 4
      for (int it = 0; it < 32; it++) {
        const int id = tid + 256 * it, row = id >> 5, c = id & 31;
        const u32x4 dv = *(const u32x4*)(smem + row * 528 + c * 16);
        const size_t idx = (size_t)(rowbase + row) * 1024 + tn * 256 + c * 8;
        const u32x4 xv = *(const u32x4*)(p->xb + idx);
        u32x4 xbv;
        float sq = 0.f;
#pragma unroll
        for (int e = 0; e < 4; e++) {
          const float lo = __uint_as_float(xv[e] << 16) + __uint_as_float(dv[e] << 16);
          const float hi = __uint_as_float(xv[e] & 0xffff0000u) + __uint_as_float(dv[e] & 0xffff0000u);
          const unsigned pk = pack_bf2(lo, hi);
          xbv[e] = pk;
          const float rl = __uint_as_float(pk << 16), rh = __uint_as_float(pk & 0xffff0000u);
          sq += rl * rl + rh * rh;
        }
        *(u32x4*)(p->xb + idx) = xbv;
#pragma unroll
        for (int o = 8; o; o >>= 1) sq += __shfl_xor(sq, o);
        if ((c & 15) == 0) ssq[(size_t)(c >> 4) * NTOK + rowbase + row] = sq;
      }
    }
    __syncthreads();
  } else {
#pragma unroll
    for (int i = 0; i < 4; i++)
#pragma unroll
      for (int rq = 0; rq < 4; rq++) {
        const int lr0 = wm * 128 + i * 32 + rq * 8 + g * 4;
#pragma unroll
        for (int j = 0; j < 4; j++) {
          const int pc = wn * 128 + j * 32 + l32;
          u32x2 pk = {pack_bf2(acc[i][j][rq * 4 + 0], acc[i][j][rq * 4 + 1]), pack_bf2(acc[i][j][rq * 4 + 2], acc[i][j][rq * 4 + 3])};
          *(u32x2*)(smem + pc * 528 + lr0 * 2) = pk;
        }
      }
    {
      float* rs = (float*)(smem + 135168);
      const int tb = 254 * upti - 2 + tid;
      float sc = 0.f;
      if (tb >= 0) {
        const int gr = min(upb * SEQL + tb, NTOK - 1);
        sc = rsqrtf(ss_sum1(p->ss + (size_t)(2 * layer + 1) * 8 * NTOK, gr) * (1.f / 1024.f) + EPS);
      }
      rs[tid] = sc;
    }
    __syncthreads();
    {
      const int cp4 = tid & 31, part = tid >> 5;
      const int oc = 4 * cp4;
      const int pg = (oc >> 6) * 128 + (oc & 63), pv = pg + 64;
      const int ocol = tn * 128 + oc;
      const float* wc = p->w_conv + (size_t)layer * 3 * 5632;
      const float* bc = p->b_conv + (size_t)layer * 5632;
      float wg[4][3], wv[4][3], bg[4], bv[4];
#pragma unroll
      for (int q = 0; q < 4; q++) {
#pragma unroll
        for (int j = 0; j < 3; j++) { wg[q][j] = wc[j * 5632 + ocol + q]; wv[q][j] = wc[j * 5632 + FFN + ocol + q]; }
        bg[q] = bc[ocol + q]; bv[q] = bc[FFN + ocol + q];
      }
      const float* rs = (const float*)(smem + 135168);
      const char* gcol0 = smem + pg * 528;
      const char* vcol0 = smem + pv * 528;
      float g0[4], v0[4], g1[4], v1[4];
#pragma unroll
      for (int q = 0; q < 4; q++) { g0[q] = 0.f; v0[q] = 0.f; g1[q] = 0.f; v1[q] = 0.f; }
      if (part) {
        const int ra = part * 32 - 2, rb2 = part * 32 - 1;
#pragma unroll
        for (int q = 0; q < 4; q++) {
          g0[q] = rs[ra] * bf2f(*(const bf16_t*)(gcol0 + q * 528 + ra * 2)); v0[q] = rs[ra] * bf2f(*(const bf16_t*)(vcol0 + q * 528 + ra * 2));
          g1[q] = rs[rb2] * bf2f(*(const bf16_t*)(gcol0 + q * 528 + rb2 * 2)); v1[q] = rs[rb2] * bf2f(*(const bf16_t*)(vcol0 + q * 528 + rb2 * 2));
        }
      }
      for (int grp8 = 0; grp8 < 4; grp8++) {
        const int lrb = part * 32 + grp8 * 8;
        u32x4 gq[4], vq[4];
#pragma unroll
        for (int q = 0; q < 4; q++) { gq[q] = *(const u32x4*)(gcol0 + q * 528 + lrb * 2); vq[q] = *(const u32x4*)(vcol0 + q * 528 + lrb * 2); }
        const float4 r0 = *(const float4*)(rs + lrb), r1 = *(const float4*)(rs + lrb + 4);
        const float rsv[8] = {r0.x, r0.y, r0.z, r0.w, r1.x, r1.y, r1.z, r1.w};
#pragma unroll
        for (int e = 0; e < 8; e++) {
          float o[4];
#pragma unroll
          for (int q = 0; q < 4; q++) {
            const unsigned gw = gq[q][e >> 1], vw = vq[q][e >> 1];
            const float g2 = rsv[e] * ((e & 1) ? __uint_as_float(gw & 0xffff0000u) : __uint_as_float(gw << 16));
            const float v2 = rsv[e] * ((e & 1) ? __uint_as_float(vw & 0xffff0000u) : __uint_as_float(vw << 16));
            const float gate = bg[q] + wg[q][0] * g0[q] + wg[q][1] * g1[q] + wg[q][2] * g2;
            const float val = bv[q] + wv[q][0] * v0[q] + wv[q][1] * v1[q] + wv[q][2] * v2;
            o[q] = gate / (1.f + __expf(-gate)) * val;
            g0[q] = g1[q]; v0[q] = v1[q]; g1[q] = g2; v1[q] = v2;
          }
          const int lr = lrb + e;
          const int tb = 254 * upti - 2 + lr;
          if (lr >= 2 && tb < SEQL) {
            u32x2 pk = {pack_bf2(o[0], o[1]), pack_bf2(o[2], o[3])};
            *(u32x2*)(p->act + (size_t)(upb * SEQL + tb) * FFN + ocol) = pk;
          }
        }
      }
    }
    __syncthreads();
  }
  }
}

__device__ __forceinline__ void attn_item(KP p, int layer, int b, int h, int qt, float lam, float outscale, char* smem, const int tid) {
  const int lane = tid & 63, w = tid >> 6, g = lane >> 5, l32 = lane & 31;
  const int tok_q = b * SEQL + qt * 128 + w * 32 + l32;
  bf16x8 qreg[2][4];
#pragma unroll
  for (int c = 0; c < 2; c++)
#pragma unroll
    for (int ks = 0; ks < 4; ks++)
      qreg[c][ks] = *(const bf16x8*)(p->q + (size_t)tok_q * 512 + h * 128 + c * 64 + ks * 16 + g * 8);

  const int NT = 2 * qt + 2;
  const int nkt = 2 * qt + 1 + (w >> 1);
  f32x16 O[2][4];
#pragma unroll
  for (int c = 0; c < 2; c++)
#pragma unroll
    for (int dt = 0; dt < 4; dt++)
#pragma unroll
      for (int r = 0; r < 16; r++) O[c][dt][r] = 0.f;
  float mrun[2] = {-1e30f, -1e30f}, lrun[2] = {0.f, 0.f};
  const float c1 = 0.125f * 1.4426950408889634f;

  u32x4 rk[4], rv[4];
  const bf16_t* kbase = p->k + (size_t)(b * SEQL) * 512 + h * 128;
  const bf16_t* vbase = p->vt + (size_t)((b * 4 + h) * 128) * SEQL;
  const int kkey = tid >> 4, kc = tid & 15;
  const int vd = tid >> 3, vc = tid & 7;
  auto gload = [&](int kt) {
#pragma unroll
    for (int i = 0; i < 4; i++) {
      rk[i] = *(const u32x4*)(kbase + (size_t)(kt * 64 + kkey + 16 * i) * 512 + kc * 8);
      rv[i] = *(const u32x4*)(vbase + (size_t)(vd + 32 * i) * SEQL + kt * 64 + vc * 8);
    }
  };
  const int kw_off = kkey * 256 + ((kc ^ (kkey & 15)) << 4);
  const int vw_off = 16384 + vd * 128 + ((vc ^ ((vd >> 1) & 7)) << 4);
  auto lwrite = [&](int st) {
    char* s = smem + st * 32768;
#pragma unroll
    for (int i = 0; i < 4; i++) {
      *(u32x4*)(s + kw_off + i * 4096) = rk[i];
      *(u32x4*)(s + vw_off + i * 4096) = rv[i];
    }
  };

  gload(0);
  lwrite(0);
  __syncthreads();
  for (int kt = 0; kt < NT; kt++) {
    if (kt + 1 < NT) gload(kt + 1);
    if (kt < nkt) {
      const char* st = smem + (kt & 1) * 32768;
      bf16x8 pf[2][2][2];
      bf16x8 kf[8], vf[2][4];
      f32x16 S[1][2];
      auto loadkq = [&](int c) {
#pragma unroll
        for (int kb = 0; kb < 2; kb++)
#pragma unroll
          for (int ks = 0; ks < 4; ks++) {
            const int key = kb * 32 + l32, chunk = c * 8 + ks * 2 + g;
            kf[kb * 4 + ks] = *(const bf16x8*)(st + key * 256 + ((chunk ^ (key & 15)) << 4));
          }
      };
      auto qk = [&](int c) {
        f32x16 zero;
#pragma unroll
        for (int r = 0; r < 16; r++) zero[r] = 0.f;
#pragma unroll
        for (int kb = 0; kb < 2; kb++) {
          S[0][kb] = MFMA(kf[kb * 4], qreg[c][0], zero);
#pragma unroll
          for (int ks = 1; ks < 4; ks++) S[0][kb] = MFMA(kf[kb * 4 + ks], qreg[c][ks], S[0][kb]);
        }
      };
      auto loadv = [&](int bi) {
#pragma unroll
        for (int dt = 0; dt < 4; dt++) {
          const int d = dt * 32 + l32, chunk = bi * 2 + g;
          vf[bi & 1][dt] = *(const bf16x8*)(st + 16384 + d * 128 + ((chunk ^ ((d >> 1) & 7)) << 4));
        }
      };
      auto softmax = [&](int c) {
        float mx = S[0][0][0];
#pragma unroll
        for (int r = 1; r < 16; r++) mx = fmaxf(mx, S[0][0][r]);
#pragma unroll
        for (int r = 0; r < 16; r++) mx = fmaxf(mx, S[0][1][r]);
        {
          const unsigned mu = __float_as_uint(mx);
          auto sw = __builtin_amdgcn_permlane32_swap(mu, mu, false, false);
          mx = fmaxf(__uint_as_float(sw[0]), __uint_as_float(sw[1]));
        }
        const float mcand = fmaxf(mrun[c], mx * c1);
        if (__any(mcand - mrun[c] > 8.f)) {
          const float alpha = fast_exp2(mrun[c] - mcand);
          mrun[c] = mcand;
          lrun[c] *= alpha;
#pragma unroll
          for (int dt = 0; dt < 4; dt++)
#pragma unroll
            for (int r = 0; r < 16; r++) O[c][dt][r] *= alpha;
        }
        const float mref = mrun[c];
        const f2_t c1v = {c1, c1}, mrv = {-mref, -mref};
        f2_t psum2 = {0.f, 0.f};
#pragma unroll
        for (int kb = 0; kb < 2; kb++)
#pragma unroll
          for (int r = 0; r < 16; r += 2) {
            f2_t sv = {S[0][kb][r], S[0][kb][r + 1]};
            f2_t av = __builtin_elementwise_fma(sv, c1v, mrv);
            f2_t ev = {fast_exp2(av[0]), fast_exp2(av[1])};
            S[0][kb][r] = ev[0]; S[0][kb][r + 1] = ev[1];
            psum2 += ev;
          }
        lrun[c] += psum2[0] + psum2[1];
#pragma unroll
        for (int kb = 0; kb < 2; kb++)
#pragma unroll
          for (int m = 0; m < 2; m++) {
            u32x4 pk = {pack_bf2(S[0][kb][8 * m + 0], S[0][kb][8 * m + 1]), pack_bf2(S[0][kb][8 * m + 2], S[0][kb][8 * m + 3]),
                        pack_bf2(S[0][kb][8 * m + 4], S[0][kb][8 * m + 5]), pack_bf2(S[0][kb][8 * m + 6], S[0][kb][8 * m + 7])};
            pf[c][kb][m] = __builtin_bit_cast(bf16x8, pk);
          }
      };
      loadkq(0);
      __builtin_amdgcn_sched_barrier(0);
      qk(0);
      __builtin_amdgcn_sched_barrier(0);
      loadkq(1);
      __builtin_amdgcn_sched_barrier(0);
      softmax(0);
      __builtin_amdgcn_sched_barrier(0);
      qk(1);
      loadv(0);
      __builtin_amdgcn_sched_barrier(0);
      softmax(1);
      __builtin_amdgcn_sched_barrier(0);
#pragma unroll
      for (int bi = 0; bi < 4; bi++) {
        if (bi < 3) loadv(bi + 1);
#pragma unroll
        for (int dt = 0; dt < 4; dt++) {
          O[0][dt] = MFMA(vf[bi & 1][dt], pf[0][bi >> 1][bi & 1], O[0][dt]);
          O[1][dt] = MFMA(vf[bi & 1][dt], pf[1][bi >> 1][bi & 1], O[1][dt]);
        }
        __builtin_amdgcn_sched_barrier(0);
      }
    }
    if (kt + 1 < NT) lwrite((kt + 1) & 1);
    __syncthreads();
  }

  const float l1 = lrun[0] + __shfl_xor(lrun[0], 32);
  const float l2 = lrun[1] + __shfl_xor(lrun[1], 32);
  const float i1 = 1.f / l1, i2 = lam / l2;
  float ssq = 0.f;
#pragma unroll
  for (int dt = 0; dt < 4; dt++)
#pragma unroll
    for (int r = 0; r < 16; r++) {
      float o = O[0][dt][r] * i1 - O[1][dt][r] * i2;
      O[0][dt][r] = o;
      ssq += o * o;
    }
  ssq += __shfl_xor(ssq, 32);
  const float rstd = rsqrtf(ssq * (1.f / 128.f) + EPS) * outscale;
  const float* gsub = p->subln + layer * 128;
#pragma unroll
  for (int dt = 0; dt < 4; dt++)
#pragma unroll
    for (int rq = 0; rq < 4; rq++) {
      const int d0 = dt * 32 + rq * 8 + g * 4;
      float4 gg = *(const float4*)(gsub + d0);
      u32x2 pk = {pack_bf2(O[0][dt][rq * 4 + 0] * rstd * gg.x, O[0][dt][rq * 4 + 1] * rstd * gg.y),
                  pack_bf2(O[0][dt][rq * 4 + 2] * rstd * gg.z, O[0][dt][rq * 4 + 3] * rstd * gg.w)};
      *(u32x2*)(p->att + (size_t)tok_q * 512 + h * 128 + d0) = pk;
    }
}

DI void s5_store_u(const u32x4 a, const u32x4 bq, int lane, float* ul) {
  float4* d = (float4*)(ul + lane * 16);
  d[0] = make_float4(__uint_as_float(a[0] << 16), __uint_as_float(a[0] & 0xffff0000u), __uint_as_float(a[1] << 16), __uint_as_float(a[1] & 0xffff0000u));
  d[1] = make_float4(__uint_as_float(a[2] << 16), __uint_as_float(a[2] & 0xffff0000u), __uint_as_float(a[3] << 16), __uint_as_float(a[3] & 0xffff0000u));
  d[2] = make_float4(__uint_as_float(bq[0] << 16), __uint_as_float(bq[0] & 0xffff0000u), __uint_as_float(bq[1] << 16), __uint_as_float(bq[1] & 0xffff0000u));
  d[3] = make_float4(__uint_as_float(bq[2] << 16), __uint_as_float(bq[2] & 0xffff0000u), __uint_as_float(bq[3] << 16), __uint_as_float(bq[3] & 0xffff0000u));
}
DI void s5_load_u(KP p, int b, int g, int j, int lane, float* ul) {
  const u32x4* src = (const u32x4*)(p->u + (size_t)(b * SEQL + j * 64 + lane) * 512 + g * 16);
  const u32x4 a = src[0], bq = src[1];
  s5_store_u(a, bq, lane, ul);
}

DI float swap_half(float v, const int which) {
  const unsigned u = __float_as_uint(v);
  auto r = __builtin_amdgcn_permlane32_swap(u, u, false, false);
  return __uint_as_float(which ? r[1] : r[0]);
}

struct S5Coef { float arA, aiA, arB, aiB; };

template <bool STORE>
DI void s5_scan32(const float* ul_sub, const bf16x8 (&bfr)[4], const S5Coef& cf, float& xAr, float& xAi, float& xBr, float& xBi,
                  float* X, const int l32, const int grp) {
  bf16x8 af;
  {
    const float* us = ul_sub + l32 * 16 + grp * 8;
    float4 a = *(const float4*)us, bq = *(const float4*)(us + 4);
    u32x4 pk = {pack_bf2(a.x, a.y), pack_bf2(a.z, a.w), pack_bf2(bq.x, bq.y), pack_bf2(bq.z, bq.w)};
    af = __builtin_bit_cast(bf16x8, pk);
  }
  f32x16 zero;
#pragma unroll
  for (int r = 0; r < 16; r++) zero[r] = 0.f;
  const f32x16 bu0 = MFMA(af, bfr[0], zero), bu1 = MFMA(af, bfr[1], zero), bu2 = MFMA(af, bfr[2], zero), bu3 = MFMA(af, bfr[3], zero);
#pragma unroll
  for (int k = 0; k < 8; k++) {
    float sAr[4], sAi[4], sBr[4], sBi[4];
#pragma unroll
    for (int i = 0; i < 4; i++) {
      const int r = (k >> 1) * 4 + i;
      const float nAr = cf.arA * xAr - cf.aiA * xAi + bu0[r];
      const float nAi = cf.arA * xAi + cf.aiA * xAr + bu2[r];
      const float nBr = cf.arB * xBr - cf.aiB * xBi + bu1[r];
      const float nBi = cf.arB * xBi + cf.aiB * xBr + bu3[r];
      xAr = nAr; xAi = nAi; xBr = nBr; xBi = nBi;
      sAr[i] = nAr; sAi[i] = nAi; sBr[i] = nBr; sBi[i] = nBi;
    }
    if (STORE) {
      if (grp == (k & 1)) {
#pragma unroll
        for (int i = 0; i < 4; i++) {
          float* xr = X + (4 * k + i) * 132;
          xr[l32] = sAr[i]; xr[64 + l32] = sAi[i]; xr[32 + l32] = sBr[i]; xr[96 + l32] = sBi[i];
        }
      }
    }
    xAr = swap_half(xAr, k & 1); xAi = swap_half(xAi, k & 1);
    xBr = swap_half(xBr, k & 1); xBi = swap_half(xBi, k & 1);
  }
}

DI void s5_setup(KP p, int layer, int g, int l32, int grp, S5Coef& cf, bf16x8 (&bfr)[4]) {
  const float* t0 = p->s5tab + (size_t)((layer * 32 + g) * 64) * 40;
  cf.arA = t0[l32 * 40]; cf.aiA = t0[l32 * 40 + 1];
  cf.arB = t0[(32 + l32) * 40]; cf.aiB = t0[(32 + l32) * 40 + 1];
#pragma unroll
  for (int jt = 0; jt < 4; jt++) {
    const float* src = t0 + (l32 + 32 * (jt & 1)) * 40 + 4 + (jt >> 1) * 16 + grp * 8;
    float4 a = *(const float4*)src, bq = *(const float4*)(src + 4);
    u32x4 pk = {pack_bf2(a.x, a.y), pack_bf2(a.z, a.w), pack_bf2(bq.x, bq.y), pack_bf2(bq.z, bq.w)};
    bfr[jt] = __builtin_bit_cast(bf16x8, pk);
  }
}

__device__ __forceinline__ void s5_pass1(KP p, int layer, char* smem, const int tid) {
  const int lane = tid & 63, w = tid >> 6, l32 = lane & 31, grp = lane >> 5;
  float* ul = (float*)(smem + w * 4096);
  for (int wbase = blockIdx.x * 4; wbase < 1024; wbase += gridDim.x * 4) {
    const int wi = wbase + w;
    const int j0 = (wi & 15) * 8, g = (wi >> 4) & 31, b = wi >> 9;
    S5Coef cf; bf16x8 bfr[4];
    s5_setup(p, layer, g, l32, grp, cf, bfr);
    const u32x4* src = (const u32x4*)(p->u + (size_t)(b * SEQL + j0 * 64 + lane) * 512 + g * 16);
    u32x4 v0 = src[0], v1 = src[1];
    for (int jj = 0; jj < 8; jj++) {
      const int j = j0 + jj;
      s5_store_u(v0, v1, lane, ul);
      if (jj < 7) {
        const u32x4* nsrc = (const u32x4*)(p->u + (size_t)(b * SEQL + (j + 1) * 64 + lane) * 512 + g * 16);
        v0 = nsrc[0]; v1 = nsrc[1];
      }
      __syncthreads();
      float xAr = 0.f, xAi = 0.f, xBr = 0.f, xBi = 0.f;
      s5_scan32<false>(ul, bfr, cf, xAr, xAi, xBr, xBi, nullptr, l32, grp);
      s5_scan32<false>(ul + 32 * 16, bfr, cf, xAr, xAi, xBr, xBi, nullptr, l32, grp);
      float* so = p->sloc + (size_t)((b * 32 + g) * 128 + j) * 128;
      so[lane] = grp ? xBr : xAr; so[64 + lane] = grp ? xBi : xAi;
      __syncthreads();
    }
  }
}

__device__ __forceinline__ void s5_pass2(KP p, int layer, char* smem, const int tid) {
  const int lane = tid & 63, w = tid >> 6;
  float* ul = (float*)(smem + w * 21504);
  float* X = ul + 1024;
  const int l32 = lane & 31, grp = lane >> 5;
  for (int wbase = blockIdx.x * 4; wbase < 1024; wbase += gridDim.x * 4) {
   const int wi = wbase + w;
   const int j0 = (wi & 15) * 8, g = (wi >> 4) & 31, b = wi >> 9;
   S5Coef cf; bf16x8 bfr[4];
   s5_setup(p, layer, g, l32, grp, cf, bfr);
   bf16x8 cfr[8];
   {
     const int c = l32 & 15;
     const float* cr = p->c_re + (size_t)((layer * 32 + g) * 16 + c) * 64;
     const float* ci = p->c_im + (size_t)((layer * 32 + g) * 16 + c) * 64;
#pragma unroll
     for (int s8 = 0; s8 < 8; s8++) {
       const int k0 = (s8 & 3) * 16 + grp * 8;
       const float* src = (s8 < 4) ? (cr + k0) : (ci + k0);
       const float sg = (l32 < 16) ? ((s8 < 4) ? 1.f : -1.f) : 0.f;
       float4 a = *(const float4*)src, bq = *(const float4*)(src + 4);
       u32x4 pk = {pack_bf2(a.x * sg, a.y * sg), pack_bf2(a.z * sg, a.w * sg), pack_bf2(bq.x * sg, bq.y * sg), pack_bf2(bq.z * sg, bq.w * sg)};
       cfr[s8] = __builtin_bit_cast(bf16x8, pk);
     }
   }
   const float dd = p->ssm_d[(size_t)(layer * 32 + g) * 16 + (l32 & 15)];
   float xAr, xAi, xBr, xBi;
   {
     const float* tb = p->s5tab + (size_t)((layer * 32 + g) * 64 + lane) * 40;
     const float aTr = tb[2], aTi = tb[3];
     float xr = 0.f, xi = 0.f;
     const float* sl = p->sloc + (size_t)((b * 32 + g) * 128) * 128;
     for (int i0 = 0; i0 < j0; i0 += 8) {
       float sr[8], si[8];
#pragma unroll
       for (int q = 0; q < 8; q++) { sr[q] = sl[(i0 + q) * 128 + lane]; si[q] = sl[(i0 + q) * 128 + 64 + lane]; }
#pragma unroll
       for (int q = 0; q < 8; q++) {
         const float nr = aTr * xr - aTi * xi + sr[q];
         const float ni = aTr * xi + aTi * xr + si[q];
         xr = nr; xi = ni;
       }
     }
     xAr = swap_half(xr, 0); xBr = swap_half(xr, 1);
     xAi = swap_half(xi, 0); xBi = swap_half(xi, 1);
   }
   for (int jj = 0; jj < 8; jj++) {
    const int j = j0 + jj;
    s5_load_u(p, b, g, j, lane, ul);
    __syncthreads();
    for (int sub = 0; sub < 2; sub++) {
      s5_scan32<true>(ul + sub * 32 * 16, bfr, cf, xAr, xAi, xBr, xBi, X, l32, grp);
      __syncthreads();
      f32x16 yacc;
#pragma unroll
      for (int r = 0; r < 16; r++) yacc[r] = 0.f;
#pragma unroll
      for (int s8 = 0; s8 < 8; s8++) {
        const float* xs = X + l32 * 132 + ((s8 < 4) ? 0 : 64) + (s8 & 3) * 16 + grp * 8;
        float4 a = *(const float4*)xs, bq = *(const float4*)(xs + 4);
        u32x4 pk = {pack_bf2(a.x, a.y), pack_bf2(a.z, a.w), pack_bf2(bq.x, bq.y), pack_bf2(bq.z, bq.w)};
        yacc = MFMA(__builtin_bit_cast(bf16x8, pk), cfr[s8], yacc);
      }
      if (l32 < 16) {
#pragma unroll
        for (int r = 0; r < 16; r++) {
          const int tl = sub * 32 + (r >> 2) * 8 + grp * 4 + (r & 3);
          const float yv = yacc[r] + dd * ul[tl * 16 + l32];
          p->gy[(size_t)(b * SEQL + j * 64 + tl) * 512 + g * 16 + l32] = f2bf(gelu_tanh(yv));
        }
      }
      __syncthreads();
    }
   }
  }
}

__device__ __forceinline__ void phase_attn(KP p, int layer, char* smem, const int tid) {
  const int lane = tid & 63;
  const float s1 = wave_sum(p->lq1[layer * 64 + lane] * p->lk1[layer * 64 + lane]);
  const float s2 = wave_sum(p->lq2[layer * 64 + lane] * p->lk2[layer * 64 + lane]);
  const float lam_init = 0.8f - 0.6f * expf(-0.3f * (float)layer);
  const float lam = expf(s1) - expf(s2) + lam_init;
  for (int pb = blockIdx.x; pb < 256; pb += gridDim.x) {
    const int pi = (pb & 7) * 32 + (pb >> 3);
    const int b = pi >> 7, h = (pi >> 5) & 3, i = pi & 31;
    attn_item(p, layer, b, h, 63 - i, lam, 1.f - lam_init, smem, tid);
    attn_item(p, layer, b, h, i, lam, 1.f - lam_init, smem, tid);
  }
  s5_pass1(p, layer, smem, tid);
}

__device__ __forceinline__ void phase_final(KP p, const int tid) {
  const int wave = tid >> 6, lane = tid & 63;
  const float* ssq = p->ss + (size_t)8 * 8 * NTOK;
  for (int row = blockIdx.x * 4 + wave; row < NTOK; row += gridDim.x * 4) {
    const float rstd = rsqrtf(ss_sum1(ssq, row) * (1.f / 1024.f) + EPS);
#pragma unroll
    for (int i = 0; i < 4; i++) {
      const u32x2 xv = ((const u32x2*)(p->xb + (size_t)row * DM))[lane + 64 * i];
      float4 v = {__uint_as_float(xv[0] << 16), __uint_as_float(xv[0] & 0xffff0000u), __uint_as_float(xv[1] << 16), __uint_as_float(xv[1] & 0xffff0000u)};
      float4 gq = ((const float4*)p->norm_final)[lane + 64 * i];
      float4 o = {v.x * rstd * gq.x, v.y * rstd * gq.y, v.z * rstd * gq.z, v.w * rstd * gq.w};
      ((float4*)(p->out + (size_t)row * DM))[lane + 64 * i] = o;
    }
  }
}

__device__ __forceinline__ void run_phase(KP p, int ph, char* smem) {
  const int tid = opaque_tid();
  if (ph == 0) { phase_prep(p, smem, tid); return; }
  if (ph == 29) { phase_final(p, tid); return; }
  const int layer = (ph - 1) / 7, k = (ph - 1) % 7;
  const int nb = gridDim.x, bid = blockIdx.x;
  if (k == 1) { phase_attn(p, layer, smem, tid); return; }
  if (k == 2) { s5_pass2(p, layer, smem, tid); return; }
  if (k == 0) { for (int r = 0; ; r++) { const int t = (r * 8 + (bid & 7)) * (nb >> 3) + (bid >> 3); if (r * nb >= 512) break; if (t < 512) gemm_tile(p, G_IN, layer, t, smem, tid); } }
  else if (k == 3) { for (int r = 0; ; r++) { const int t = (r * 8 + (bid & 7)) * (nb >> 3) + (bid >> 3); if (r * nb >= 256) break; if (t < 256) gemm_tile(p, G_GLU, layer, t, smem, tid); } }
  else if (k == 4) { for (int r = 0; ; r++) { const int t = (r * 8 + (bid & 7)) * (nb >> 3) + (bid >> 3); if (r * nb >= 256) break; if (t < 256) gemm_tile(p, G_WOUT, layer, t, smem, tid); } }
  else if (k == 5) { for (int r = 0; ; r++) { const int t = (r * 8 + (bid & 7)) * (nb >> 3) + (bid >> 3); if (r * nb >= 2 * 33 * 22) break; if (t < 2 * 33 * 22) gemm_tile(p, G_UP, layer, t, smem, tid); } }
  else { for (int r = 0; ; r++) { const int t = (r * 8 + (bid & 7)) * (nb >> 3) + (bid >> 3); if (r * nb >= 256) break; if (t < 256) gemm_tile(p, G_DOWN, layer, t, smem, tid); } }
}

#define PHASE_KERNEL(name, body)                                                      \
  __global__ void __launch_bounds__(256) name(Params p_unused) {                      \
    extern __shared__ __attribute__((aligned(16))) char smem[];                       \
    KP p = (KP)__builtin_amdgcn_kernarg_segment_ptr();                                \
    const int tid = threadIdx.x, nb = gridDim.x, bid = blockIdx.x;                    \
    const int layer = (int)p->phase_lo;                                               \
    (void)nb; (void)bid; (void)layer;                                                 \
    body                                                                              \
  }
PHASE_KERNEL(k_prep, phase_prep(p, smem, tid);)
PHASE_KERNEL(k_gin, for (int r = 0; ; r++) { const int t = (r * 8 + (bid & 7)) * (nb >> 3) + (bid >> 3); if (r * nb >= 512) break; if (t < 512) gemm_tile(p, G_IN, layer, t, smem, tid); })
PHASE_KERNEL(k_attn, phase_attn(p, layer, smem, tid);)
PHASE_KERNEL(k_s5p2, s5_pass2(p, layer, smem, tid);)
PHASE_KERNEL(k_glu, for (int r = 0; ; r++) { const int t = (r * 8 + (bid & 7)) * (nb >> 3) + (bid >> 3); if (r * nb >= 256) break; if (t < 256) gemm_tile(p, G_GLU, layer, t, smem, tid); })
PHASE_KERNEL(k_wout, for (int r = 0; ; r++) { const int t = (r * 8 + (bid & 7)) * (nb >> 3) + (bid >> 3); if (r * nb >= 256) break; if (t < 256) gemm_tile(p, G_WOUT, layer, t, smem, tid); })
PHASE_KERNEL(k_up, for (int r = 0; ; r++) { const int t = (r * 8 + (bid & 7)) * (nb >> 3) + (bid >> 3); if (r * nb >= 2 * 33 * 22) break; if (t < 2 * 33 * 22) gemm_tile(p, G_UP, layer, t, smem, tid); })
PHASE_KERNEL(k_down, for (int r = 0; ; r++) { const int t = (r * 8 + (bid & 7)) * (nb >> 3) + (bid >> 3); if (r * nb >= 256) break; if (t < 256) gemm_tile(p, G_DOWN, layer, t, smem, tid); })
PHASE_KERNEL(k_final, phase_final(p, tid);)

#if COOP
__global__ void __launch_bounds__(256) mega_kernel(Params p_unused) {
  extern __shared__ __attribute__((aligned(16))) char smem[];
  KP p0 = (KP)__builtin_amdgcn_kernarg_segment_ptr();
  const int ph_lo = (int)p0->phase_lo, ph_hi = (int)p0->phase_hi;
#if COOP
  if (ph_hi > 1000) cg::this_grid().sync();
#endif
#if COOP
  {
    volatile unsigned* st = (volatile unsigned*)(smem + 136192);
    if (threadIdx.x == 0) { st[0] = 0u; st[1] = 0u; xb_add(&p0->bar[XB_CNT(xb_xcc_id())], 1u); }
  }
#endif
  for (int ph = ph_lo; ph < ph_hi; ph++) {
    KP p = p0;
    asm volatile("" : "+s"(p));
#if TPROBE
    if (blockIdx.x == 0) p->ts[ph] = (long long)wall_clock64();
#endif
    run_phase(p, ph, smem);
#if COOP
    if (ph + 1 < ph_hi) {
      if (ph == ph_lo) grid_barrier(p->bar, gridDim.x, opaque_tid());
      else xcd_barrier(p->bar, (volatile unsigned*)(smem + 136192), opaque_tid());
    }
#endif
  }
#if TPROBE
  grid_barrier(p0->bar, (unsigned)(ph_hi - ph_lo) * gridDim.x, opaque_tid());
  if (blockIdx.x == 0) {
    KP p = p0;
    long long tend = (long long)wall_clock64();
    float a = 0.f, b = 0.f;
    for (int ph = 0; ph < 30; ph++) {
      long long t0 = p->ts[ph], t1 = (ph == 29) ? tend : p->ts[ph + 1];
      int c = (ph == 0) ? 0 : (ph == 29 ? 8 : 1 + (ph - 1) % 7);
      float d = (float)(t1 - t0) * 0.01f;
      if (c == TP_A || TP_A == 9) a += d;
      if (c == TP_B || TP_B == 9) b += d;
    }
    const int t = opaque_tid();
    if (t <= 100) p->out[t] += (t == 0) ? a : b;
  }
#endif
}

#endif

extern "C" void kernel_launch(void* const* d_in, const int* in_sizes, int n_in, void* d_out, int out_size, void* d_ws,
                              size_t ws_size, hipStream_t stream) {
  static int grid_blocks = 0;
  if (!grid_blocks) {
    int dev = 0, cus = 0, per_cu = 0;
    (void)hipGetDevice(&dev);
    (void)hipDeviceGetAttribute(&cus, hipDeviceAttributeMultiprocessorCount, dev);
#if COOP
    (void)hipFuncSetAttribute((const void*)mega_kernel, hipFuncAttributeMaxDynamicSharedMemorySize, LDS_BYTES);
    (void)hipOccupancyMaxActiveBlocksPerMultiprocessor(&per_cu, (const void*)mega_kernel, 256, LDS_BYTES);
    if (per_cu < 1) { fprintf(stderr, "occupancy query returned %d\n", per_cu); per_cu = 1; }
#endif
    grid_blocks = cus;
    (void)hipGetLastError();
  }
  Params p{};
  p.x = (const float*)d_in[0]; p.pos = (const int*)d_in[1];
  p.norm_mix = (const float*)d_in[2]; p.w_in = (const float*)d_in[3];
  p.lam_re = (const float*)d_in[4]; p.lam_im = (const float*)d_in[5]; p.log_step = (const float*)d_in[6];
  p.b_re = (const float*)d_in[7]; p.b_im = (const float*)d_in[8]; p.c_re = (const float*)d_in[9]; p.c_im = (const float*)d_in[10];
  p.ssm_d = (const float*)d_in[11]; p.w_glu = (const float*)d_in[12]; p.ssm_norm = (const float*)d_in[13];
  p.lq1 = (const float*)d_in[14]; p.lk1 = (const float*)d_in[15]; p.lq2 = (const float*)d_in[16]; p.lk2 = (const float*)d_in[17];
  p.subln = (const float*)d_in[18]; p.w_out = (const float*)d_in[19]; p.norm_ffn = (const float*)d_in[20];
  p.w_up = (const float*)d_in[21]; p.w_conv = (const float*)d_in[22]; p.b_conv = (const float*)d_in[23];
  p.w_down = (const float*)d_in[24]; p.norm_final = (const float*)d_in[25];
  p.out = (float*)d_out;
  char* ws = (char*)d_ws;
  size_t off = 0;
  auto take = [&](size_t bytes) { char* r = ws + off; off += (bytes + 255) & ~(size_t)255; return r; };
  p.WinT = (bf16_t*)take((size_t)4 * 2048 * 1024 * 2);
  p.WgluT = (bf16_t*)take((size_t)4 * 1024 * 512 * 2);
  p.WoutT = (bf16_t*)take((size_t)4 * 1024 * 1024 * 2);
  p.WupT = (bf16_t*)take((size_t)4 * 5632 * 1024 * 2);
  p.WdownT = (bf16_t*)take((size_t)4 * 1024 * FFN * 2);
  p.xf = (float*)take((size_t)NTOK * DM * 4);
  p.xb = (bf16_t*)take((size_t)NTOK * DM * 2);
  p.ss = (float*)take((size_t)9 * 8 * NTOK * 4);
  p.ssm_ss = (float*)take((size_t)4 * 8 * NTOK * 4);
  p.cs = (float*)take((size_t)NTOK * 16 * 4);
  p.s5tab = (float*)take((size_t)4 * 32 * 64 * 40 * 4);
  p.sloc = (float*)take((size_t)2 * 32 * 128 * 128 * 4);
  p.ts = (long long*)take(256);
  p.bar = (unsigned*)take(XB_WORDS * 4);
  char* region = take((size_t)134217728);
  p.u = (bf16_t*)region;
  p.q = (bf16_t*)(region + 33554432);
  p.k = p.q + (size_t)NTOK * 512;
  p.vt = p.k + (size_t)NTOK * 512;
  p.gy = p.vt + (size_t)NTOK * 512;
  p.outg = p.gy + (size_t)NTOK * 512;
  p.att = p.outg + (size_t)NTOK * 512;
  p.act = (bf16_t*)region;
  if (off > ws_size) { fprintf(stderr, "workspace too small: need %zu have %zu\n", off, ws_size); return; }
#if COOP
  p.phase_lo = 0; p.phase_hi = 30;
  if (hipMemsetAsync(p.bar, 0, XB_WORDS * 4, stream) != hipSuccess) fprintf(stderr, "barrier memset failed\n");
  void* args[] = {&p};
  hipError_t e = hipLaunchCooperativeKernel((const void*)mega_kernel, dim3(grid_blocks), dim3(256), args, LDS_BYTES, stream);
  if (e != hipSuccess) fprintf(stderr, "cooperative launch failed: %s (grid %d)\n", hipGetErrorString(e), grid_blocks);
#else
  typedef void (*kfn)(Params);
  const kfn seq[7] = {k_gin, k_attn, k_s5p2, k_glu, k_wout, k_up, k_down};
  static bool attr_done = false;
  if (!attr_done) {
    (void)hipFuncSetAttribute((const void*)k_prep, hipFuncAttributeMaxDynamicSharedMemorySize, LDS_BYTES);
    (void)hipFuncSetAttribute((const void*)k_final, hipFuncAttributeMaxDynamicSharedMemorySize, LDS_BYTES);
    for (int i = 0; i < 7; i++) (void)hipFuncSetAttribute((const void*)seq[i], hipFuncAttributeMaxDynamicSharedMemorySize, LDS_BYTES);
    attr_done = true;
  }
  p.phase_lo = 0; p.phase_hi = 0;
  hipLaunchKernelGGL(k_prep, dim3(grid_blocks), dim3(256), LDS_BYTES, stream, p);
  for (int layer = 0; layer < 4; layer++) {
    p.phase_lo = layer;
    for (int i = 0; i < 7; i++) hipLaunchKernelGGL(seq[i], dim3(grid_blocks), dim3(256), LDS_BYTES, stream, p);
  }
  hipLaunchKernelGGL(k_final, dim3(grid_blocks), dim3(256), LDS_BYTES, stream, p);
#endif
}
```
